# Optimizing an MI355X kernel written in HIP

```python
import math
import jax, jax.numpy as jnp
from jax import lax
import numpy as np

D_MODEL = 1024
BATCH = 8
SEQ = 2048
DEPTH = 1
DEC_BATCH = 128
DEC_SEQ = 8
PAST_LEN = 16384
PAGE_SIZE = 128

W_LRU = D_MODEL
LRU_BLOCKS = 16
LRU_BLOCK = W_LRU // LRU_BLOCKS
CONV_W = 4
LRU_C = 8.0
GLA_HEADS = 4
GLA_DK = D_MODEL // 2
GLA_DV = D_MODEL
HEAD_K = GLA_DK // GLA_HEADS
HEAD_V = GLA_DV // GLA_HEADS
GK_RANK = 16
GK_TAU = 16.0
GLA_CHUNK = 64
D_MIX = W_LRU + GLA_DV
SPLITS = [W_LRU, W_LRU, GLA_DK, GLA_DK, GLA_DV, GLA_DV, GK_RANK]
D_IN = sum(SPLITS)
EPS = 1e-6

kernel_name = "hymba_rglru_gla_decode_step"


def rmsnorm(x, g):
    xf = x.astype(jnp.float32)
    ms = jnp.mean(xf * xf, axis=-1, keepdims=True)
    return (xf * lax.rsqrt(ms + EPS) * g.astype(jnp.float32)).astype(x.dtype)


def causal_conv(x, buf, w, b):
    L = x.shape[1]
    xp = jnp.concatenate([buf.astype(x.dtype), x], axis=1)
    out = b + sum(xp[:, j:j + L] * w[j] for j in range(CONV_W))
    return out, xp[:, -(CONV_W - 1):]


def rg_lru(x, h0, w_rg, b_rg, w_ig, b_ig, lam):
    Bn, L, _ = x.shape
    xf = x.astype(jnp.float32)
    xb = xf.reshape(Bn, L, LRU_BLOCKS, LRU_BLOCK)
    r = jax.nn.sigmoid(jnp.einsum('blnd,nde->blne', xb, w_rg.astype(jnp.float32)).reshape(Bn, L, W_LRU) + b_rg)
    i = jax.nn.sigmoid(jnp.einsum('blnd,nde->blne', xb, w_ig.astype(jnp.float32)).reshape(Bn, L, W_LRU) + b_ig)
    log_a = LRU_C * r * jax.nn.log_sigmoid(lam.astype(jnp.float32))
    a = jnp.exp(log_a)
    u = jnp.sqrt(-jnp.expm1(2.0 * log_a)) * (i * xf)

    def combine(e1, e2):
        a1, b1 = e1
        a2, b2 = e2
        return a1 * a2, a2 * b1 + b2

    a_cum, h_zero = lax.associative_scan(combine, (a, u), axis=1)
    h = h_zero + a_cum * h0.astype(jnp.float32)[:, None]
    return h.astype(x.dtype), h[:, -1]


def gla(q, k, v, log_alpha, S0):
    Bn, L = q.shape[:2]
    C = math.gcd(L, GLA_CHUNK)
    N = L // C

    def to_chunks(t):
        return t.astype(jnp.float32).reshape(Bn, N, C, GLA_HEADS, t.shape[-1]).transpose(0, 3, 1, 2, 4)

    q, k, v, g = to_chunks(q), to_chunks(k), to_chunks(v), to_chunks(log_alpha)
    b = jnp.cumsum(g, axis=3)
    b_last = b[:, :, :, -1:]
    q_t = q * jnp.exp(b)
    k_t = k * jnp.exp(-b)
    k_end = k * jnp.exp(b_last - b)
    mask = jnp.tril(jnp.ones((C, C), dtype=bool))
    att = jnp.where(mask, jnp.einsum('bhncd,bhnsd->bhncs', q_t, k_t), 0.0)
    o_intra = jnp.einsum('bhncs,bhnsv->bhncv', att, v)
    upd = jnp.einsum('bhncd,bhncv->nbhdv', k_end, v)
    dec = jnp.exp(b_last[:, :, :, 0]).transpose(2, 0, 1, 3)

    def step(S, inp):
        d, u = inp
        return d[..., None] * S + u, S

    S_final, S_starts = lax.scan(step, S0.astype(jnp.float32), (dec, upd))
    o_inter = jnp.einsum('bhncd,nbhdv->bhncv', q_t, S_starts)
    o = (o_intra + o_inter).transpose(0, 2, 3, 1, 4).reshape(Bn, L, GLA_HEADS, HEAD_V)
    return o, S_final


def mixer_layer(x, h0, conv0, S0, g_pre, w_in, conv_w, conv_b, w_rg, b_rg, w_ig, b_ig,
                lru_lambda, w_gk2, b_gk, g_head, w_out, g_post):
    Bn, L, _ = x.shape
    xn = rmsnorm(x, g_pre)
    proj = xn @ w_in
    idx = [int(s) for s in np.cumsum(SPLITS)[:-1]]
    x_lru, z_lru, q, k, v, z_gla, r_gk = jnp.split(proj, idx, axis=-1)
    xc, conv_new = causal_conv(x_lru, conv0, conv_w, conv_b)
    h, h_new = rg_lru(xc, h0, w_rg, b_rg, w_ig, b_ig, lru_lambda)
    y_lru = h * jax.nn.silu(z_lru)
    log_alpha = jax.nn.log_sigmoid((r_gk @ w_gk2 + b_gk).astype(jnp.float32)) / GK_TAU
    q = q.reshape(Bn, L, GLA_HEADS, HEAD_K) * (HEAD_K ** -0.5)
    k = k.reshape(Bn, L, GLA_HEADS, HEAD_K)
    v = v.reshape(Bn, L, GLA_HEADS, HEAD_V)
    log_alpha = log_alpha.reshape(Bn, L, GLA_HEADS, HEAD_K)
    o, S_new = gla(q, k, v, log_alpha, S0)
    o = rmsnorm(o, g_head).reshape(Bn, L, GLA_DV).astype(x.dtype)
    y_gla = o * jax.nn.silu(z_gla)
    y = jnp.concatenate([y_lru, y_gla], axis=-1) @ w_out
    x_out = x + rmsnorm(y, g_post)
    return x_out, h_new.astype(h0.dtype), conv_new.astype(conv0.dtype), S_new.astype(S0.dtype)


def setup_inputs(seed: int = 0) -> dict:
    key = jax.random.key(seed)
    ks = jax.random.split(key, 20)
    f32 = jnp.float32
    nrm = lambda k, s, sc: jax.random.normal(k, s, f32) * sc
    return {
        "x_prompt": nrm(ks[0], (BATCH, SEQ, D_MODEL), 1.0),
        "x_sample": nrm(ks[1], (DEC_BATCH, DEC_SEQ, D_MODEL), 1.0),
        "state_lru_h": nrm(ks[2], (DEPTH, DEC_BATCH, W_LRU), 0.5),
        "state_lru_conv": nrm(ks[3], (DEPTH, DEC_BATCH, CONV_W - 1, W_LRU), 1.0),
        "state_gla": nrm(ks[4], (DEPTH, DEC_BATCH, GLA_HEADS, HEAD_K, HEAD_V), 0.5),
        "g_pre": 1.0 + nrm(ks[5], (DEPTH, D_MODEL), 0.05),
        "w_in": nrm(ks[6], (DEPTH, D_MODEL, D_IN), D_MODEL ** -0.5),
        "conv_w": nrm(ks[7], (DEPTH, CONV_W, W_LRU), CONV_W ** -0.5),
        "conv_b": nrm(ks[8], (DEPTH, W_LRU), 0.01),
        "w_rg": nrm(ks[9], (DEPTH, LRU_BLOCKS, LRU_BLOCK, LRU_BLOCK), LRU_BLOCK ** -0.5),
        "b_rg": nrm(ks[10], (DEPTH, W_LRU), 0.01),
        "w_ig": nrm(ks[11], (DEPTH, LRU_BLOCKS, LRU_BLOCK, LRU_BLOCK), LRU_BLOCK ** -0.5),
        "b_ig": nrm(ks[12], (DEPTH, W_LRU), 0.01),
        "lru_lambda": jax.random.uniform(ks[13], (DEPTH, W_LRU), f32, 4.3, 9.0),
        "w_gk2": nrm(ks[14], (DEPTH, GK_RANK, GLA_DK), GK_RANK ** -0.5),
        "b_gk": jax.random.uniform(ks[15], (DEPTH, GLA_DK), f32, 1.0, 4.0),
        "g_head": 1.0 + nrm(ks[16], (DEPTH, HEAD_V), 0.05),
        "w_out": nrm(ks[17], (DEPTH, D_MIX, D_MODEL), D_MIX ** -0.5),
        "g_post": 1.0 + nrm(ks[18], (DEPTH, D_MODEL), 0.05),
    }


def reference(x_prompt, x_sample, state_lru_h, state_lru_conv, state_gla, g_pre, w_in, conv_w, conv_b,
              w_rg, b_rg, w_ig, b_ig, lru_lambda, w_gk2, b_gk, g_head, w_out, g_post):
    dt = x_prompt.dtype
    xp, xs = x_prompt, x_sample
    hp_l, cp_l, sp_l, hs_l, cs_l, ss_l = [], [], [], [], [], []
    for l in range(DEPTH):
        params = (g_pre[l], w_in[l], conv_w[l], conv_b[l], w_rg[l], b_rg[l], w_ig[l], b_ig[l],
                  lru_lambda[l], w_gk2[l], b_gk[l], g_head[l], w_out[l], g_post[l])
        h0 = jnp.zeros((BATCH, W_LRU), dt)
        c0 = jnp.zeros((BATCH, CONV_W - 1, W_LRU), dt)
        s0 = jnp.zeros((BATCH, GLA_HEADS, HEAD_K, HEAD_V), dt)
        xp, hp, cp, sp = mixer_layer(xp, h0, c0, s0, *params)
        xs, hs, cs, ss = mixer_layer(xs, state_lru_h[l], state_lru_conv[l], state_gla[l], *params)
        hp_l.append(hp); cp_l.append(cp); sp_l.append(sp)
        hs_l.append(hs); cs_l.append(cs); ss_l.append(ss)
    return (xp, xs, jnp.stack(hp_l), jnp.stack(cp_l), jnp.stack(sp_l),
            jnp.stack(hs_l), jnp.stack(cs_l), jnp.stack(ss_l))
```

```cpp
#define MK_N_LAUNCHES 5
#include <hip/hip_runtime.h>
#include <cstdio>
#include <cstdint>
namespace pg8 {
#define PG8_LAS __attribute__((address_space(3)))
typedef unsigned short bf16_t;
typedef short bf16x8 __attribute__((ext_vector_type(8)));
typedef float f32x4 __attribute__((ext_vector_type(4)));
typedef unsigned u32x4 __attribute__((ext_vector_type(4)));
constexpr int BM = 256, BK = 64, HALF = 128, HTB = HALF * BK * 2  , STAGE_BYTES = 8 * HTB, NXCD = 8, WGM = 8;

__host__ __device__ __forceinline__ int lds_byte(int r, int c) { const int st = (r >> 4) * 2 + (c >> 5), rr = r & 15, cc = c & 31, ob = rr * 64 + cc * 2; return st * 1024 + (ob ^ (((ob >> 9) & 1) << 5)); }
__host__ __device__ __forceinline__ void stage_rc(int b, int& R, int& C) { const int st = b / 1024, sb = b % 1024, swz = sb ^ (((sb >> 9) & 1) << 5); R = (st >> 1) * 16 + swz / 64; C = (st & 1) * 32 + (swz % 64) / 2; }
__host__ __device__ __forceinline__ int perm32(int rho) { const int n = rho >> 4, i = rho & 15; return 8 * (i >> 2) + 4 * n + (i & 3); }

struct Unit { int pm, pn; };
struct Gemm { const bf16_t* A; const bf16_t* Bt; int M, N, K; };

struct StaticOrder {
    int nM, nN, nwg, G, c;
    __host__ __device__ void init(int M, int N, int G_, int c_) { nM = M / BM; nN = N / BM; nwg = nM * nN; G = G_; c = c_; }
    __host__ __device__ bool next(int i, Unit& u) const {
        const long L = (long)i * G + c; if (L >= nwg) return false;
        int wgid = (int)L; { const int q = nwg / NXCD, r = nwg % NXCD, xcd = wgid % NXCD, off = wgid / NXCD; wgid = (xcd < r ? xcd * (q + 1) : r * (q + 1) + (xcd - r) * q) + off; }
        const int nig = WGM * nN, gid = wgid / nig, fm = gid * WGM, gsz = (nM - fm) < WGM ? (nM - fm) : WGM;
        u.pm = fm + ((wgid % nig) % gsz); u.pn = (wgid % nig) / gsz; return true;
    }
    __device__ __forceinline__ void a_ready(const Unit&) const {}
    __device__ __forceinline__ void done(const Unit&) const {}
};
__device__ __forceinline__ unsigned cvt_pk_bf16(float lo, float hi) { unsigned r; asm volatile("v_cvt_pk_bf16_f32 %0, %1, %2" : "=v"(r) : "v"(lo), "v"(hi)); return r; }
typedef float f32x2 __attribute__((ext_vector_type(2)));
struct EpiProj {
    static constexpr bool PERM = true, AFTER_DRAIN = false;
    bf16_t* O; int ldc;
    __device__ __forceinline__ void operator()(const f32x4 (&acc)[2][2][4][2], const Unit& u, int wr, int wc, int fr, int fq) const {
        const int row0 = u.pm * BM + wr * 64 + fr; const int col0 = u.pn * BM + wc * 32 + 8 * fq;
#pragma unroll
        for (int ai = 0; ai < 2; ++ai)
#pragma unroll
            for (int m = 0; m < 4; ++m) { bf16_t* rowp = O + (size_t)(row0 + ai * HALF + m * 16) * ldc + col0;
#pragma unroll
                for (int bj = 0; bj < 2; ++bj) { const f32x4 v0 = acc[ai][bj][m][0], v1 = acc[ai][bj][m][1];
                    u32x4 w; w.x = cvt_pk_bf16(v0[0], v0[1]); w.y = cvt_pk_bf16(v0[2], v0[3]); w.z = cvt_pk_bf16(v1[0], v1[1]); w.w = cvt_pk_bf16(v1[2], v1[3]);
                    *(u32x4*)(rowp + bj * HALF) = w; } }
    }
};
struct EpiY {
    static constexpr bool PERM = true, AFTER_DRAIN = false;
    bf16_t* O; int ldc; float* part; int M;
    __device__ __forceinline__ void operator()(const f32x4 (&acc)[2][2][4][2], const Unit& u, int wr, int wc, int fr, int fq) const {
        const int row0 = u.pm * BM + wr * 64 + fr; const int col0 = u.pn * BM + wc * 32 + 8 * fq;
#pragma unroll
        for (int ai = 0; ai < 2; ++ai)
#pragma unroll
            for (int m = 0; m < 4; ++m) { const int row = row0 + ai * HALF + m * 16; bf16_t* rowp = O + (size_t)row * ldc + col0; float ss = 0.f;
#pragma unroll
                for (int bj = 0; bj < 2; ++bj) { const f32x4 v0 = acc[ai][bj][m][0], v1 = acc[ai][bj][m][1];
                    ss += (v0[0] * v0[0] + v0[1] * v0[1]) + (v0[2] * v0[2] + v0[3] * v0[3]); ss += (v1[0] * v1[0] + v1[1] * v1[1]) + (v1[2] * v1[2] + v1[3] * v1[3]);
                    u32x4 w; w.x = cvt_pk_bf16(v0[0], v0[1]); w.y = cvt_pk_bf16(v0[2], v0[3]); w.z = cvt_pk_bf16(v1[0], v1[1]); w.w = cvt_pk_bf16(v1[2], v1[3]);
                    *(u32x4*)(rowp + bj * HALF) = w; }
                ss += __shfl_xor(ss, 16); ss += __shfl_xor(ss, 32);
                if (fq == 0) part[(size_t)(u.pn * 4 + wc) * M + row] = ss; }
    }
};
template <class Epi, class Sched, bool ALIGN_EPI = false, bool SP2 = false>
__device__ __forceinline__ void gemm_phase(PG8_LAS unsigned char* lds, const Gemm g, const Sched& S, const Epi& E) {
    const int tid = threadIdx.x, wid = __builtin_amdgcn_readfirstlane(tid >> 6), lane = tid & 63, wr = wid >> 2, wc = wid & 3, fr = lane & 15, fq = lane >> 4;
    const int K = g.K, nt = K / BK;
    unsigned voffA[2], voffB[2];
#pragma unroll
    for (int i = 0; i < 2; ++i) { int R, C; stage_rc(tid * 16 + i * 8192, R, C); const int Rb = Epi::PERM ? ((R & ~31) + perm32(R & 31)) : R;
        voffA[i] = (unsigned)(R * K + C) * 2u; voffB[i] = (unsigned)(Rb * K + C) * 2u; }
    const size_t kstep = (size_t)(BK * 2);
    const size_t hstep = (size_t)HALF * K * 2;
    const size_t tstep = 2 * hstep;
    const unsigned ldsw = (unsigned)wid * 1024u;
    const int aoff = lds_byte(wr * 64 + fr, fq * 8), boff = lds_byte(wc * 32 + fr, fq * 8);
#define PG8_SA(b, h) (((b) * 2 + (h)) * HTB)
#define PG8_SB(b, h) ((4 + (b) * 2 + (h)) * HTB)
#define PG8_STAGE(bufoff, gbase, voff) do { _Pragma("unroll") for (int _i = 0; _i < 2; ++_i) \
        __builtin_amdgcn_global_load_lds((const unsigned*)((const char*)(gbase) + (voff)[_i]), (PG8_LAS unsigned*)(lds + (bufoff) + ldsw + _i * 8192), 16, 0, 0); } while (0)
#define PG8_LDA(dst, b, h) do { _Pragma("unroll") for (int m = 0; m < 4; ++m) _Pragma("unroll") for (int k = 0; k < 2; ++k) dst[m][k] = *(const PG8_LAS bf16x8*)(lds + PG8_SA(b, h) + aoff + m * 2048 + k * 1024); } while (0)
#define PG8_LDB(dst, b, h) do { _Pragma("unroll") for (int n = 0; n < 2; ++n) _Pragma("unroll") for (int k = 0; k < 2; ++k) dst[n][k] = *(const PG8_LAS bf16x8*)(lds + PG8_SB(b, h) + boff + n * 2048 + k * 1024); } while (0)
#define PG8_MMA(ai, bj, At, Bt) do { __builtin_amdgcn_s_setprio(1); _Pragma("unroll") for (int m = 0; m < 4; ++m) _Pragma("unroll") for (int n = 0; n < 2; ++n) _Pragma("unroll") for (int k = 0; k < 2; ++k) \
        acc[ai][bj][m][n] = __builtin_amdgcn_mfma_f32_16x16x32_bf16(Bt[n][k], At[m][k], acc[ai][bj][m][n], 0, 0, 0); __builtin_amdgcn_s_setprio(0); } while (0)
#define PG8_WAIT_V(n) asm volatile("s_waitcnt vmcnt(" #n ")" ::: "memory")
#define PG8_WAIT_L(n) asm volatile("s_waitcnt lgkmcnt(" #n ")" ::: "memory")
#define PG8_BAR __builtin_amdgcn_s_barrier()
#define PG8_SCHED __builtin_amdgcn_sched_barrier(0)
    Unit cur, nxt; int ui = 0;
    if (!S.next(0, cur)) return;
    f32x4 acc[2][2][4][2];
#pragma unroll
    for (int a = 0; a < 2; ++a)
#pragma unroll
        for (int b = 0; b < 2; ++b)
#pragma unroll
            for (int m = 0; m < 4; ++m)
#pragma unroll
                for (int n = 0; n < 2; ++n) acc[a][b][m][n] = (f32x4){0.f, 0.f, 0.f, 0.f};
    bf16x8 At[4][2], B0[2][2], B1[2][2];
    const char* cA = (const char*)g.A + (size_t)cur.pm * tstep; const char* cB = (const char*)g.Bt + (size_t)cur.pn * tstep;
    S.a_ready(cur);
    if constexpr (SP2) {
        PG8_STAGE(PG8_SB(0, 0), cB, voffB); PG8_STAGE(PG8_SB(0, 1), cB + hstep, voffB); PG8_STAGE(PG8_SA(0, 0), cA, voffA); PG8_STAGE(PG8_SA(0, 1), cA + hstep, voffA);
        if (wr == 1) PG8_BAR;
        PG8_WAIT_V(2); PG8_BAR;
        PG8_STAGE(PG8_SB(1, 0), cB + kstep, voffB); PG8_STAGE(PG8_SA(1, 0), cA + kstep, voffA); PG8_STAGE(PG8_SB(1, 1), cB + hstep + kstep, voffB);
        PG8_WAIT_V(6); PG8_BAR;
    } else {
        PG8_STAGE(PG8_SB(0, 0), cB, voffB); PG8_STAGE(PG8_SA(0, 0), cA, voffA); PG8_STAGE(PG8_SB(0, 1), cB + hstep, voffB); PG8_STAGE(PG8_SA(0, 1), cA + hstep, voffA);
        if (wr == 1) PG8_BAR;
        PG8_WAIT_V(4); PG8_BAR;
        PG8_STAGE(PG8_SB(1, 0), cB + kstep, voffB); PG8_STAGE(PG8_SA(1, 0), cA + kstep, voffA); PG8_STAGE(PG8_SB(1, 1), cB + hstep + kstep, voffB);
        PG8_WAIT_V(6); PG8_BAR;
    }
    for (;;) {
        const bool has_next = S.next(ui + 1, nxt);
        const char* nA = has_next ? (const char*)g.A + (size_t)nxt.pm * tstep : cA; const char* nB = has_next ? (const char*)g.Bt + (size_t)nxt.pn * tstep : cB;
        for (int t = 0; t < nt; t += 2) {
            const bool last = (t == nt - 2);
            const char* a1 = cA + (size_t)(t + 1) * kstep;
            const char* a2 = last ? nA : cA + (size_t)(t + 2) * kstep; const char* b2 = last ? nB : cB + (size_t)(t + 2) * kstep;
            const char* a3 = a2 + kstep; const char* b3 = b2 + kstep;
            if (last && has_next) S.a_ready(nxt);
            if constexpr (SP2) {
            PG8_LDB(B0, 0, 0); PG8_LDB(B1, 0, 1); PG8_SCHED; PG8_LDA(At, 0, 0); PG8_STAGE(PG8_SA(1, 1), a1 + hstep, voffA);
            PG8_WAIT_V(8); PG8_WAIT_L(0); PG8_BAR; PG8_MMA(0, 0, At, B0); PG8_MMA(0, 1, At, B1); PG8_BAR; PG8_SCHED;
            PG8_LDA(At, 0, 1); PG8_STAGE(PG8_SB(0, 0), b2, voffB); PG8_STAGE(PG8_SB(0, 1), b2 + hstep, voffB); PG8_STAGE(PG8_SA(0, 0), a2, voffA);
            PG8_WAIT_V(8); PG8_WAIT_L(0); PG8_BAR; PG8_MMA(1, 0, At, B0); PG8_MMA(1, 1, At, B1); PG8_BAR; PG8_SCHED;
            PG8_LDB(B0, 1, 0); PG8_LDB(B1, 1, 1); PG8_SCHED; PG8_LDA(At, 1, 0); PG8_STAGE(PG8_SA(0, 1), a2 + hstep, voffA);
            PG8_WAIT_V(8); PG8_WAIT_L(0); PG8_BAR; PG8_MMA(0, 0, At, B0); PG8_MMA(0, 1, At, B1); PG8_BAR; PG8_SCHED;
            PG8_LDA(At, 1, 1); PG8_STAGE(PG8_SB(1, 0), b3, voffB); PG8_STAGE(PG8_SB(1, 1), b3 + hstep, voffB); PG8_STAGE(PG8_SA(1, 0), a3, voffA);
            PG8_WAIT_V(8); PG8_WAIT_L(0); PG8_BAR; PG8_MMA(1, 0, At, B0); PG8_MMA(1, 1, At, B1); PG8_BAR; PG8_SCHED;
            } else {
            PG8_LDB(B0, 0, 0); PG8_SCHED; PG8_LDA(At, 0, 0); PG8_STAGE(PG8_SA(1, 1), a1 + hstep, voffA);
            PG8_WAIT_L(8); PG8_BAR; PG8_WAIT_L(0); PG8_MMA(0, 0, At, B0); PG8_BAR; PG8_SCHED;
            PG8_LDB(B1, 0, 1); PG8_STAGE(PG8_SB(0, 0), b2, voffB);
            PG8_BAR; PG8_WAIT_L(0); PG8_MMA(0, 1, At, B1); PG8_BAR;
            PG8_LDA(At, 0, 1); PG8_STAGE(PG8_SA(0, 0), a2, voffA);
            PG8_BAR; PG8_WAIT_L(0); PG8_MMA(1, 0, At, B0); PG8_BAR; PG8_SCHED;
            PG8_STAGE(PG8_SB(0, 1), b2 + hstep, voffB);
            PG8_WAIT_V(6); PG8_BAR; PG8_MMA(1, 1, At, B1); PG8_BAR;
            PG8_LDB(B0, 1, 0); PG8_SCHED; PG8_LDA(At, 1, 0); PG8_STAGE(PG8_SA(0, 1), a2 + hstep, voffA);
            PG8_WAIT_L(8); PG8_BAR; PG8_WAIT_L(0); PG8_MMA(0, 0, At, B0); PG8_BAR; PG8_SCHED;
            PG8_LDB(B1, 1, 1); PG8_STAGE(PG8_SB(1, 0), b3, voffB);
            PG8_BAR; PG8_WAIT_L(0); PG8_MMA(0, 1, At, B1); PG8_BAR;
            PG8_LDA(At, 1, 1); PG8_STAGE(PG8_SA(1, 0), a3, voffA);
            PG8_BAR; PG8_WAIT_L(0); PG8_MMA(1, 0, At, B0); PG8_BAR; PG8_SCHED;
            PG8_STAGE(PG8_SB(1, 1), b3 + hstep, voffB);
            PG8_WAIT_V(6); PG8_BAR; PG8_MMA(1, 1, At, B1); PG8_BAR;
            }
        }
        if constexpr (ALIGN_EPI) { if (wr == 0) PG8_BAR; }
        if constexpr (!Epi::AFTER_DRAIN) { E(acc, cur, wr, wc, fr, fq); S.done(cur); }
        if (!has_next) break;
#pragma unroll
        for (int a = 0; a < 2; ++a)
#pragma unroll
            for (int b = 0; b < 2; ++b)
#pragma unroll
                for (int m = 0; m < 4; ++m)
#pragma unroll
                    for (int n = 0; n < 2; ++n) acc[a][b][m][n] = (f32x4){0.f, 0.f, 0.f, 0.f};
        cur = nxt; cA = nA; cB = nB; ++ui;
        if constexpr (ALIGN_EPI) { if (wr == 1) PG8_BAR; }
    }
    PG8_WAIT_V(0);
    if constexpr (!ALIGN_EPI) { if (wr == 0) PG8_BAR; }
    PG8_BAR;
    if constexpr (Epi::AFTER_DRAIN) { E.fused(acc, cur, wr, wc, fr, fq, lds, wid, lane); S.done(cur); }
#undef PG8_SA
#undef PG8_SB
#undef PG8_STAGE
#undef PG8_LDA
#undef PG8_LDB
#undef PG8_MMA
#undef PG8_WAIT_V
#undef PG8_WAIT_L
#undef PG8_BAR
#undef PG8_SCHED
}
}

#ifndef MK_N_LAUNCHES
#define MK_N_LAUNCHES 1
#endif
constexpr int N_PHASES = 5, N_LAUNCHES = MK_N_LAUNCHES;
constexpr int NWAVES = 8;
constexpr int D = 1024, NP = 8, TP = 2048, NS = 128, TS = 8, NROWP = NP * TP, NROWS = NS * TS, NTOK = NROWP + NROWS;
constexpr int DIN = 5136, DINP = 5120, DMIX = 2048, HK = 128, HV = 256, NH = 4;
constexpr int C_XL = 0, C_ZL = 1024, C_Q = 2048, C_K = 2560, C_V = 3072, C_ZG = 4096;
constexpr float EPS = 1e-6f;
constexpr size_t O_YP = 0, O_YS = 16777216, O_HP = 17825792, O_CP = 17833984, O_GP = 17858560, O_HS = 18907136, O_CS = 19038208, O_GS = 19431424, O_END = 36208640;
constexpr size_t MiB = 1u << 20;
constexpr size_t WS_CTL = 0, CTL_ZERO_BYTES = 1 * MiB;
constexpr size_t WS_WINT = 2 * MiB, WS_WOUT = 12 * MiB, WS_RGK = 16 * MiB, WS_PART = 18 * MiB, WS_XN = 20 * MiB, WS_PROJ = 54 * MiB, WS_END = 224 * MiB;
static_assert(WS_WINT + (size_t)DINP * D * 2 <= WS_WOUT && WS_WOUT + (size_t)D * DMIX * 2 <= WS_RGK && WS_RGK + (size_t)NTOK * 16 * 4 <= WS_PART && WS_PART + (size_t)16 * NTOK * 4 <= WS_XN &&
              WS_XN + (size_t)NTOK * D * 2 <= WS_PROJ && WS_PROJ + (size_t)NTOK * DINP * 2 <= WS_END, "d_ws map");
constexpr int CW_BAR = 4096;
constexpr int RING_OFF = 0, RING_BYTES = 131072, LDSCTL_OFF = RING_BYTES, MISC_OFF = LDSCTL_OFF + 320, LDS_BYTES = 147456;

#define GAS __attribute__((address_space(1)))
#define LAS __attribute__((address_space(3)))
typedef unsigned short bf16;
typedef unsigned v4u __attribute__((ext_vector_type(4)));
typedef unsigned v2u __attribute__((ext_vector_type(2)));
typedef float f32x4 __attribute__((ext_vector_type(4)));
typedef GAS unsigned gu32;
#define RLX_AGENT __ATOMIC_RELAXED, __HIP_MEMORY_SCOPE_AGENT
#define LDS_WAIT() asm volatile("s_waitcnt lgkmcnt(0)" ::: "memory")
#define VM_WAIT() asm volatile("s_waitcnt vmcnt(0)" ::: "memory")
__device__ __forceinline__ unsigned f2bf(float f) { unsigned u = __builtin_bit_cast(unsigned, f); return (u + 0x7fffu + ((u >> 16) & 1u)) >> 16; }
__device__ __forceinline__ unsigned pk2(float lo, float hi) { return f2bf(lo) | (f2bf(hi) << 16); }
__device__ __forceinline__ float bf2f(unsigned b) { return __builtin_bit_cast(float, b << 16); }
__device__ __forceinline__ float bflo(unsigned w) { return __builtin_bit_cast(float, w << 16); }
__device__ __forceinline__ float bfhi(unsigned w) { return __builtin_bit_cast(float, w & 0xffff0000u); }
__device__ __forceinline__ float sigmoidf_(float x) { return 1.f / (1.f + __expf(-x)); }
__device__ __forceinline__ float logsigf_(float x) { return fminf(x, 0.f) - log1pf(__expf(-fabsf(x))); }
#define XB_TMO      128
#define XB_XCNT(j)  (256  + 64 * (j))
#define XB_XSUB(j)  (1280 + 64 * (j))
#define XB_XGEN(j)  (2304 + 64 * (j))
#define XB_TOP      3328
#define XB_TOPGEN   3392
#define XCD_BAR_WORDS 3456
#define XB_SPIN_CAP (1u << 18)

__device__ __forceinline__ unsigned xb_ld(unsigned* p)              { return __hip_atomic_load(p, __ATOMIC_RELAXED, __HIP_MEMORY_SCOPE_AGENT); }
__device__ __forceinline__ unsigned xb_add(unsigned* p, unsigned v) { return __hip_atomic_fetch_add(p, v, __ATOMIC_RELAXED, __HIP_MEMORY_SCOPE_AGENT); }
__device__ __forceinline__ unsigned xb_xcc_id() { return (unsigned)__builtin_amdgcn_s_getreg((3 << 11) | 20) & 0xFu; }
#define XB_SPIN(cond, bar) do { unsigned _sp = 0; while (cond) { __builtin_amdgcn_s_sleep(1); \
    if ((++_sp & 255u) == 0u) { if (xb_ld(&(bar)[XB_TMO])) break; if (_sp > XB_SPIN_CAP) { atomicAdd(&(bar)[XB_TMO], 1u); break; } } } } while (0)

struct XcdBarrier {
    unsigned* bar; unsigned x;
    volatile LAS unsigned* st;
};

__device__ __forceinline__ XcdBarrier xcd_barrier_post(unsigned* bar, volatile LAS unsigned* st) {
    XcdBarrier b; b.bar = bar; b.x = xb_xcc_id(); b.st = st;
    if (threadIdx.x == 0) (void)xb_add(&bar[XB_XCNT(b.x)], 1u);
    return b;
}
__device__ __forceinline__ void xcd_barrier_complete(unsigned* bar, unsigned x, unsigned& nloc, unsigned& nx) {
    const unsigned G = gridDim.x * gridDim.y * gridDim.z;
    unsigned sum, cnt, mine, sp = 0u;
    for (;;) {
        sum = 0u; cnt = 0u; mine = 0u;
#pragma unroll
        for (unsigned j = 0; j < 16; ++j) { const unsigned c = xb_ld(&bar[XB_XCNT(j)]); sum += c; cnt += (c > 0u) ? 1u : 0u; mine = (j == x) ? c : mine; }
        if (sum == G) break;
        __builtin_amdgcn_s_sleep(1);
        if ((++sp & 255u) == 0u) { if (xb_ld(&bar[XB_TMO])) break; if (sp > XB_SPIN_CAP) { atomicAdd(&bar[XB_TMO], 1u); break; } }
    }
    nloc = mine > 0u ? mine : 1u; nx = cnt > 0u ? cnt : 1u;
}

__device__ __forceinline__ void xcd_barrier(const XcdBarrier& b) {
    asm volatile("s_waitcnt vmcnt(0)" ::: "memory");
    __syncthreads();
    if (threadIdx.x == 0) {
        unsigned* bar = b.bar;
        __builtin_amdgcn_s_waitcnt(0);
        unsigned nloc = b.st[0], nx = b.st[1];
        if (nloc == 0u) { xcd_barrier_complete(bar, b.x, nloc, nx); b.st[0] = nloc; b.st[1] = nx; }
        const unsigned old = xb_add(&bar[XB_XSUB(b.x)], 1u);
        const unsigned gen = old / nloc;
        if (old + 1u == (gen + 1u) * nloc) {
            __builtin_amdgcn_fence(__ATOMIC_RELEASE, "agent");
            asm volatile("s_waitcnt vmcnt(0)" ::: "memory");
            const unsigned og = xb_add(&bar[XB_TOP], 1u);
            const unsigned tg = og / nx;
            if (og + 1u == (tg + 1u) * nx) xb_add(&bar[XB_TOPGEN], 1u);
            else XB_SPIN(xb_ld(&bar[XB_TOPGEN]) == tg, bar);
            __builtin_amdgcn_fence(__ATOMIC_ACQUIRE, "agent");
            xb_add(&bar[XB_XGEN(b.x)], 1u);
            asm volatile("s_waitcnt vmcnt(0)" ::: "memory");
        } else {
            XB_SPIN(xb_ld(&bar[XB_XGEN(b.x)]) == gen, bar);
            __builtin_amdgcn_fence(__ATOMIC_ACQUIRE, "agent");
            asm volatile("s_waitcnt vmcnt(0)" ::: "memory");
        }
    }
    __syncthreads();
}

struct Frame {
    LAS unsigned char* lds;
    volatile LAS unsigned* MISC;
    gu32* ctl;
    int tid, lane, wave, vcu, G;
    const float *xp, *xs, *st_h, *st_conv, *st_gla, *g_pre, *w_in, *conv_w, *conv_b, *w_rg, *b_rg, *w_ig, *b_ig, *lam, *w_gk2, *b_gk, *g_head, *w_out, *g_post;
    float* out;
    bf16 *WinT, *WoutT, *XN, *PROJ, *YMIX, *YBF;
    float *RGK, *PART;
};
__device__ __forceinline__ float wave_sum(float v) {
#pragma unroll
    for (int o = 1; o < 64; o <<= 1) v += __shfl_xor(v, o);
    return v;
}

__device__ __forceinline__ void p0_transpose_item(const float* W, int ldw, int K, int nblk, bf16* WT, LAS float* scr, int item, int lane) {
    const int kb = item / nblk, nb = item % nblk, k0 = 64 * kb, n0 = 32 * nb;
#pragma unroll 8
    for (int i = 0; i < 32; ++i) { const int kk = 2 * i + (lane >> 5); scr[kk * 33 + (lane & 31)] = W[(size_t)(k0 + kk) * ldw + n0 + (lane & 31)]; }
    LDS_WAIT(); asm volatile("" ::: "memory");
    const int c = lane & 7;
#pragma unroll
    for (int j = 0; j < 4; ++j) { const int n = (lane >> 3) + 8 * j; const LAS float* s = scr + (8 * c) * 33 + n;
        v4u o; o.x = pk2(s[0 * 33], s[1 * 33]); o.y = pk2(s[2 * 33], s[3 * 33]); o.z = pk2(s[4 * 33], s[5 * 33]); o.w = pk2(s[6 * 33], s[7 * 33]);
        *(GAS v4u*)(WT + (size_t)(n0 + n) * K + k0 + 8 * c) = o; }
    LDS_WAIT(); asm volatile("" ::: "memory");
}
__device__ __forceinline__ void p0_row(const Frame& F, int r, const LAS float* wrt) {
    const float* xrow = r < NROWP ? F.xp + (size_t)r * D : F.xs + (size_t)(r - NROWP) * D;
    const GAS f32x4* xr = (const GAS f32x4*)xrow + F.lane;
    const GAS f32x4* gp = (const GAS f32x4*)F.g_pre + F.lane;
    f32x4 v[4]; float s = 0.f;
#pragma unroll
    for (int j = 0; j < 4; ++j) { v[j] = xr[64 * j]; s += (v[j].x * v[j].x + v[j].y * v[j].y) + (v[j].z * v[j].z + v[j].w * v[j].w); }
    const float rs = rsqrtf(wave_sum(s) * (1.f / D) + EPS);
#pragma unroll
    for (int j = 0; j < 4; ++j) v[j] = v[j] * rs * gp[64 * j];
    GAS unsigned long long* o8 = (GAS unsigned long long*)(F.XN + (size_t)r * D) + F.lane;
#pragma unroll
    for (int j = 0; j < 4; ++j) o8[64 * j] = (unsigned long long)pk2(v[j].x, v[j].y) | ((unsigned long long)pk2(v[j].z, v[j].w) << 32);
    float p[16];
#pragma unroll
    for (int jj = 0; jj < 16; ++jj) { float a = 0.f;
#pragma unroll
        for (int j = 0; j < 4; ++j) { const f32x4 w = *(const LAS f32x4*)(wrt + jj * 1024 + 256 * j + 4 * F.lane); a += (v[j].x * w.x + v[j].y * w.y) + (v[j].z * w.z + v[j].w * w.w); }
        p[jj] = a; if ((jj & 3) == 3) asm volatile("" ::: "memory"); }
    const bool b5 = F.lane & 32, b4 = F.lane & 16, b3 = F.lane & 8, b2 = F.lane & 4;
    float q8[8], q4[4], q2[2], q1;
#pragma unroll
    for (int i = 0; i < 8; ++i) { const float send = b5 ? p[i] : p[i + 8], keep = b5 ? p[i + 8] : p[i]; q8[i] = keep + __shfl_xor(send, 32); }
#pragma unroll
    for (int i = 0; i < 4; ++i) { const float send = b4 ? q8[i] : q8[i + 4], keep = b4 ? q8[i + 4] : q8[i]; q4[i] = keep + __shfl_xor(send, 16); }
#pragma unroll
    for (int i = 0; i < 2; ++i) { const float send = b3 ? q4[i] : q4[i + 2], keep = b3 ? q4[i + 2] : q4[i]; q2[i] = keep + __shfl_xor(send, 8); }
    { const float send = b2 ? q2[0] : q2[1], keep = b2 ? q2[1] : q2[0]; q1 = keep + __shfl_xor(send, 4); }
    q1 += __shfl_xor(q1, 2); q1 += __shfl_xor(q1, 1);
    if ((F.lane & 3) == 0) F.RGK[(size_t)r * 16 + (F.lane >> 2)] = q1;
}
__device__ __forceinline__ void p0_prologue(Frame& F) {
    LAS float* scr = (LAS float*)(F.lds + RING_OFF + F.wave * 16384);
    const int gw = F.vcu * NWAVES + F.wave, NGW = F.G * NWAVES;
    constexpr int I_IN = (D / 64) * (DINP / 32), I_OUT = (DMIX / 64) * (D / 32);
    for (int it = gw; it < I_IN + I_OUT; it += NGW) {
        if (it < I_IN) p0_transpose_item(F.w_in, DIN, D, DINP / 32, F.WinT, scr, it, F.lane);
        else p0_transpose_item(F.w_out, D, DMIX, D / 32, F.WoutT, scr, it - I_IN, F.lane);
    }
    __syncthreads();
    LAS float* wrt = (LAS float*)(F.lds + RING_OFF);
    for (int idx = F.tid; idx < 16 * 1024; idx += NWAVES * 64) { const int k = idx >> 4, j = idx & 15; wrt[j * 1024 + k] = F.w_in[(size_t)k * DIN + DINP + j]; }
    __syncthreads();
    const int rpw = (NTOK + F.G - 1) / F.G;
    const int r1 = min(NTOK, (F.vcu + 1) * rpw);
    for (int r = F.vcu * rpw + F.wave; r < r1; r += NWAVES) p0_row(F, r, wrt);
    __syncthreads();
}

__device__ __forceinline__ float rdlane(float v, int l) { return __builtin_bit_cast(float, __builtin_amdgcn_readlane(__builtin_bit_cast(int, v), l)); }
__device__ __forceinline__ void lru_simple_item(const Frame& F, int kind, int seq, int nb) {
    const int lane = F.lane, c = nb * 64 + lane;
    const int T = kind ? TS : TP; const size_t row0 = kind ? (size_t)NROWP + (size_t)seq * TS : (size_t)seq * TP;
    float wrg[64], wig[64];
#pragma unroll
    for (int d = 0; d < 64; ++d) { wrg[d] = F.w_rg[(size_t)(nb * 64 + d) * 64 + lane]; wig[d] = F.w_ig[(size_t)(nb * 64 + d) * 64 + lane]; }
    const float brg = F.b_rg[c], big = F.b_ig[c], cb = F.conv_b[c], cw0 = F.conv_w[c], cw1 = F.conv_w[1024 + c], cw2 = F.conv_w[2048 + c], cw3 = F.conv_w[3072 + c];
    const float c8 = 8.f * logsigf_(F.lam[c]);
    float h = kind ? F.st_h[(size_t)seq * 1024 + c] : 0.f;
    float xm3 = kind ? F.st_conv[((size_t)seq * 3 + 0) * 1024 + c] : 0.f, xm2 = kind ? F.st_conv[((size_t)seq * 3 + 1) * 1024 + c] : 0.f, xm1 = kind ? F.st_conv[((size_t)seq * 3 + 2) * 1024 + c] : 0.f;
    for (int t0 = 0; t0 < T; t0 += 8) {
        float xv[8], zv[8];
#pragma unroll
        for (int i = 0; i < 8; ++i) { const bf16* pr = F.PROJ + (row0 + t0 + i) * DINP; xv[i] = bf2f(pr[C_XL + c]); zv[i] = bf2f(pr[C_ZL + c]); }
#pragma unroll 1
        for (int i = 0; i < 8; ++i) {
            const float x = xv[i]; const float xc = cb + cw0 * xm3 + cw1 * xm2 + cw2 * xm1 + cw3 * x; xm3 = xm2; xm2 = xm1; xm1 = x;
            float ar = brg, ai = big;
#pragma unroll
            for (int d = 0; d < 64; ++d) { const float xd = rdlane(xc, d); ar += xd * wrg[d]; ai += xd * wig[d]; }
            const float r = sigmoidf_(ar), ig = sigmoidf_(ai);
            const float la = c8 * r, a = __expf(la), u = sqrtf(-expm1f(2.f * la)) * (ig * xc);
            h = a * h + u;
            const float z = zv[i], y = h * z * sigmoidf_(z);
            F.YMIX[(row0 + t0 + i) * DMIX + c] = (bf16)f2bf(y);
        }
    }
    float* ho = F.out + (kind ? O_HS : O_HP) + (size_t)seq * 1024 + c; *ho = h;
    float* co = F.out + (kind ? O_CS : O_CP) + (size_t)seq * 3 * 1024 + c; co[0] = xm3; co[1024] = xm2; co[2048] = xm1;
}
__device__ __forceinline__ void gla_simple_item(const Frame& F, int kind, int seq, int h, int hsel) {
    const int t2 = F.tid & 255, w4 = t2 >> 6;
    const int T = kind ? TS : TP; const size_t row0 = kind ? (size_t)NROWP + (size_t)seq * TS : (size_t)seq * TP;
    LAS float* L = (LAS float*)(F.lds + RING_OFF + hsel * 4096);
    LAS float* al = L, *qs = L + 128, *ks = L + 256, *red = L + 384;
    float S[128];
    const float* s0 = F.st_gla + (((size_t)seq * NH + h) * HK) * HV + t2;
#pragma unroll
    for (int d = 0; d < 128; ++d) S[d] = kind ? s0[(size_t)d * HV] : 0.f;
    float w2[16]; float bg = 0.f;
    if (t2 < 128) { bg = F.b_gk[h * 128 + t2];
#pragma unroll
        for (int j = 0; j < 16; ++j) w2[j] = F.w_gk2[j * 512 + h * 128 + t2]; }
    else {
#pragma unroll
        for (int j = 0; j < 16; ++j) w2[j] = 0.f; }
    const float gh = F.g_head[t2];
    for (int t = 0; t < T; ++t) {
        const size_t row = row0 + t; const bf16* pr = F.PROJ + row * DINP;
        if (t2 < 128) { float z = bg; const float* rg = F.RGK + row * 16;
#pragma unroll
            for (int j = 0; j < 16; ++j) z += rg[j] * w2[j];
            al[t2] = __expf(logsigf_(z) * (1.f / 16.f)); qs[t2] = bf2f(pr[C_Q + h * 128 + t2]) * 0.08838834764831845f; ks[t2] = bf2f(pr[C_K + h * 128 + t2]); }
        const float vv = bf2f(pr[C_V + h * 256 + t2]), zz = bf2f(pr[C_ZG + h * 256 + t2]);
        __syncthreads();
        float o = 0.f;
#pragma unroll
        for (int d4 = 0; d4 < 32; ++d4) { const f32x4 a4 = *(const LAS f32x4*)(al + 4 * d4), k4 = *(const LAS f32x4*)(ks + 4 * d4), q4 = *(const LAS f32x4*)(qs + 4 * d4);
            S[4 * d4 + 0] = a4.x * S[4 * d4 + 0] + k4.x * vv; o += q4.x * S[4 * d4 + 0];
            S[4 * d4 + 1] = a4.y * S[4 * d4 + 1] + k4.y * vv; o += q4.y * S[4 * d4 + 1];
            S[4 * d4 + 2] = a4.z * S[4 * d4 + 2] + k4.z * vv; o += q4.z * S[4 * d4 + 2];
            S[4 * d4 + 3] = a4.w * S[4 * d4 + 3] + k4.w * vv; o += q4.w * S[4 * d4 + 3]; }
        const float ss = wave_sum(o * o);
        if (F.lane == 0) red[w4] = ss;
        __syncthreads();
        const float tot = (red[0] + red[1]) + (red[2] + red[3]);
        const float rs = rsqrtf(tot * (1.f / 256.f) + EPS);
        const float y = o * rs * gh * (zz * sigmoidf_(zz));
        F.YMIX[row * DMIX + 1024 + h * 256 + t2] = (bf16)f2bf(y);
        __syncthreads();
    }
    float* so = F.out + (kind ? O_GS : O_GP) + (((size_t)seq * NH + h) * HK) * HV + t2;
#pragma unroll
    for (int d = 0; d < 128; ++d) so[(size_t)d * HV] = S[d];
}
__device__ __forceinline__ void p2_mix_simple(Frame& F) {
    const int hsel = F.tid >> 8;
    for (int p = F.G - 1 - F.vcu; p < NP * NH / 2; p += F.G) { const int it = 2 * p + hsel; gla_simple_item(F, 0, it >> 2, it & 3, hsel); }
    for (int p = F.vcu; p < NS * NH / 2; p += F.G) { const int it = 2 * p + hsel; gla_simple_item(F, 1, it >> 2, it & 3, hsel); }
    const int gw = F.vcu * NWAVES + F.wave, NGW = F.G * NWAVES;
    for (int i = gw; i < NP * 16 * 16; i += NGW) if ((i & 15) == 0) { const int it = i >> 4; lru_simple_item(F, 0, it >> 4, it & 15); }
    for (int it = gw; it < NS * 16; it += NGW) lru_simple_item(F, 1, it >> 4, it & 15);
}

__device__ __forceinline__ void p4_final(Frame& F) {
    const int gw = F.vcu * NWAVES + F.wave, NGW = F.G * NWAVES;
    const GAS f32x4* gp = (const GAS f32x4*)F.g_post + F.lane;
    f32x4 g[4];
#pragma unroll
    for (int j = 0; j < 4; ++j) g[j] = gp[64 * j];
    for (int r = gw; r < NTOK; r += NGW) {
        const float* xrow = r < NROWP ? F.xp + (size_t)r * D : F.xs + (size_t)(r - NROWP) * D;
        const GAS f32x4* xr = (const GAS f32x4*)xrow + F.lane;
        const GAS v2u* yr = (const GAS v2u*)(F.YBF + (size_t)r * D) + F.lane;
        float ps = F.lane < 16 ? F.PART[(size_t)F.lane * NTOK + r] : 0.f;
        const float rs = rsqrtf(wave_sum(ps) * (1.f / D) + EPS);
        GAS f32x4* orow = (GAS f32x4*)(F.out + (size_t)r * D) + F.lane;
#pragma unroll
        for (int j = 0; j < 4; ++j) { const f32x4 x = xr[64 * j]; const v2u y = yr[64 * j];
            f32x4 o; o.x = x.x + bflo(y.x) * rs * g[j].x; o.y = x.y + bfhi(y.x) * rs * g[j].y; o.z = x.z + bflo(y.y) * rs * g[j].z; o.w = x.w + bfhi(y.y) * rs * g[j].w;
            orow[64 * j] = o; }
    }
}

struct Args { const float* in[19]; float* out; unsigned char* ws; int ph_lo, ph_hi, li, pad; };
__global__ void __launch_bounds__(NWAVES * 64, 2) mk_fwd(Args args) {
    extern __shared__ __attribute__((aligned(16))) unsigned char lds[];
    Frame F;
    F.lds = (LAS unsigned char*)lds;
    F.MISC = (volatile LAS unsigned*)(F.lds + MISC_OFF);
    F.tid = threadIdx.x; F.lane = F.tid & 63; F.wave = __builtin_amdgcn_readfirstlane(F.tid >> 6);
    F.G = gridDim.x; { const int bx = blockIdx.x; F.vcu = (F.G % 8 == 0) ? (bx % 8) * (F.G / 8) + bx / 8 : bx; }
    unsigned char* ws = args.ws;
    F.ctl = (gu32*)(ws + WS_CTL);
    F.xp = args.in[0]; F.xs = args.in[1]; F.st_h = args.in[2]; F.st_conv = args.in[3]; F.st_gla = args.in[4]; F.g_pre = args.in[5]; F.w_in = args.in[6];
    F.conv_w = args.in[7]; F.conv_b = args.in[8]; F.w_rg = args.in[9]; F.b_rg = args.in[10]; F.w_ig = args.in[11]; F.b_ig = args.in[12]; F.lam = args.in[13];
    F.w_gk2 = args.in[14]; F.b_gk = args.in[15]; F.g_head = args.in[16]; F.w_out = args.in[17]; F.g_post = args.in[18];
    F.out = args.out;
    F.WinT = (bf16*)(ws + WS_WINT); F.WoutT = (bf16*)(ws + WS_WOUT); F.XN = (bf16*)(ws + WS_XN); F.PROJ = (bf16*)(ws + WS_PROJ);
    F.YMIX = (bf16*)args.out;
    F.YBF = (bf16*)(ws + WS_XN);
    F.RGK = (float*)(ws + WS_RGK); F.PART = (float*)(ws + WS_PART);
    for (int u = F.tid; u < (LDS_BYTES - LDSCTL_OFF) / 4; u += NWAVES * 64) ((LAS unsigned*)(F.lds + LDSCTL_OFF))[u] = 0u;
    __syncthreads();
    XcdBarrier bar; bar.bar = (unsigned*)(F.ctl + CW_BAR); bar.x = 0; bar.st = nullptr;
    if (N_LAUNCHES == 1) bar = xcd_barrier_post((unsigned*)(F.ctl + CW_BAR), F.MISC + 8);
#define GRID_BAR() do { if (N_LAUNCHES == 1) xcd_barrier(bar); } while (0)
    const int lo = args.ph_lo, hi = args.ph_hi;
#ifndef PH_MASK
#define PH_MASK 31
#endif
#define IN(k) (lo <= (k) && (k) < hi && ((PH_MASK >> (k)) & 1))
#define BOTH(k) (IN(k) && IN((k) + 1))
    if (IN(0)) { p0_prologue(F); if (BOTH(0)) GRID_BAR(); }
    if (IN(1)) {
        pg8::Gemm g{F.XN, F.WinT, NTOK, DINP, D}; pg8::StaticOrder S; S.init(NTOK, DINP, F.G, (int)blockIdx.x);
        pg8::EpiProj E{F.PROJ, DINP};
        pg8::gemm_phase<pg8::EpiProj, pg8::StaticOrder, true, true>(F.lds + RING_OFF, g, S, E);
        if (BOTH(1)) GRID_BAR();
    }
    if (IN(2)) { p2_mix_simple(F); if (BOTH(2)) GRID_BAR(); }
    if (IN(3)) {
        pg8::Gemm g{F.YMIX, F.WoutT, NTOK, D, DMIX}; pg8::StaticOrder S; S.init(NTOK, D, F.G, (int)blockIdx.x);
        pg8::EpiY E{F.YBF, D, F.PART, NTOK};
        pg8::gemm_phase<pg8::EpiY, pg8::StaticOrder, true, true>(F.lds + RING_OFF, g, S, E);
        if (BOTH(3)) GRID_BAR();
    }
    if (IN(4)) { p4_final(F); }
#undef IN
#undef BOTH
}

extern "C" void kernel_launch(void* const* d_in, const int* in_sizes, int n_in, void* d_out, int out_size, void* d_ws, size_t ws_size, hipStream_t stream) {
    static int grid = 0;
    if (grid == 0) {
        if (n_in != 19 || in_sizes[0] != NROWP * D || in_sizes[6] != D * DIN || (size_t)out_size != O_END || ws_size < WS_END) {
            fprintf(stderr, "kernel_launch: unexpected shapes: n_in %d in0 %d in6 %d out %d ws %zu; nothing launched\n", n_in, n_in > 0 ? in_sizes[0] : -1, n_in > 6 ? in_sizes[6] : -1, out_size, ws_size); grid = -1; return; }
        int dev = 0, cus = 0, per_cu = 0;
        if (hipGetDevice(&dev) != hipSuccess || hipDeviceGetAttribute(&cus, hipDeviceAttributeMultiprocessorCount, dev) != hipSuccess) { grid = -1; return; }
        if (hipFuncSetAttribute((const void*)mk_fwd, hipFuncAttributeMaxDynamicSharedMemorySize, LDS_BYTES) != hipSuccess) { fprintf(stderr, "kernel_launch: hipFuncSetAttribute failed\n"); grid = -1; return; }
        if (hipOccupancyMaxActiveBlocksPerMultiprocessor(&per_cu, (const void*)mk_fwd, NWAVES * 64, LDS_BYTES) != hipSuccess || per_cu < 1)
            fprintf(stderr, "kernel_launch: note: occupancy query reports %d workgroups per CU\n", per_cu);
        (void)hipGetLastError();
        grid = cus;
    }
    if (grid < 0) return;
    if (hipMemsetAsync((char*)d_ws + WS_CTL, 0, CTL_ZERO_BYTES, stream) != hipSuccess) { fprintf(stderr, "kernel_launch: hipMemsetAsync failed\n"); return; }
    Args a{};
    for (int i = 0; i < 19; ++i) a.in[i] = (const float*)d_in[i];
    a.out = (float*)d_out; a.ws = (unsigned char*)d_ws;
    for (int li = 0; li < N_LAUNCHES; ++li) {
        a.ph_lo = (N_LAUNCHES == 1) ? 0 : li; a.ph_hi = (N_LAUNCHES == 1) ? N_PHASES : li + 1; a.li = li;
        hipLaunchKernelGGL(mk_fwd, dim3(grid), dim3(NWAVES * 64), LDS_BYTES, stream, a);
        const hipError_t le = hipPeekAtLastError();
        if (le != hipSuccess) { fprintf(stderr, "kernel_launch: launch %d failed: %s\n", li, hipGetErrorName(le)); break; }
    }
}
```

```cpp
#define MK_N_LAUNCHES 1
#include <hip/hip_runtime.h>
#include <cstdio>
#include <cstdint>
namespace pg8 {
#define PG8_LAS __attribute__((address_space(3)))
typedef unsigned short bf16_t;
typedef short bf16x8 __attribute__((ext_vector_type(8)));
typedef float f32x4 __attribute__((ext_vector_type(4)));
typedef unsigned u32x4 __attribute__((ext_vector_type(4)));
constexpr int BM = 256, BK = 64, HALF = 128, HTB = HALF * BK * 2  , STAGE_BYTES = 8 * HTB, NXCD = 8, WGM = 8;

__host__ __device__ __forceinline__ int lds_byte(int r, int c) { const int st = (r >> 4) * 2 + (c >> 5), rr = r & 15, cc = c & 31, ob = rr * 64 + cc * 2; return st * 1024 + (ob ^ (((ob >> 9) & 1) << 5)); }
__host__ __device__ __forceinline__ void stage_rc(int b, int& R, int& C) { const int st = b / 1024, sb = b % 1024, swz = sb ^ (((sb >> 9) & 1) << 5); R = (st >> 1) * 16 + swz / 64; C = (st & 1) * 32 + (swz % 64) / 2; }
__host__ __device__ __forceinline__ int perm32(int rho) { const int n = rho >> 4, i = rho & 15; return 8 * (i >> 2) + 4 * n + (i & 3); }

struct Unit { int pm, pn; };
struct Gemm { const bf16_t* A; const bf16_t* Bt; int M, N, K; };

struct StaticOrder {
    int nM, nN, nwg, G, c;
    __host__ __device__ void init(int M, int N, int G_, int c_) { nM = M / BM; nN = N / BM; nwg = nM * nN; G = G_; c = c_; }
    __host__ __device__ bool next(int i, Unit& u) const {
        const long L = (long)i * G + c; if (L >= nwg) return false;
        int wgid = (int)L; { const int q = nwg / NXCD, r = nwg % NXCD, xcd = wgid % NXCD, off = wgid / NXCD; wgid = (xcd < r ? xcd * (q + 1) : r * (q + 1) + (xcd - r) * q) + off; }
        const int nig = WGM * nN, gid = wgid / nig, fm = gid * WGM, gsz = (nM - fm) < WGM ? (nM - fm) : WGM;
        u.pm = fm + ((wgid % nig) % gsz); u.pn = (wgid % nig) / gsz; return true;
    }
    __device__ __forceinline__ void a_ready(const Unit&) const {}
    __device__ __forceinline__ void done(const Unit&) const {}
};
__device__ __forceinline__ unsigned cvt_pk_bf16(float lo, float hi) { unsigned r; asm volatile("v_cvt_pk_bf16_f32 %0, %1, %2" : "=v"(r) : "v"(lo), "v"(hi)); return r; }
typedef float f32x2 __attribute__((ext_vector_type(2)));
struct EpiProj {
    static constexpr bool PERM = true, AFTER_DRAIN = false;
    bf16_t* O; int ldc;
    __device__ __forceinline__ void operator()(const f32x4 (&acc)[2][2][4][2], const Unit& u, int wr, int wc, int fr, int fq) const {
        const int row0 = u.pm * BM + wr * 64 + fr; const int col0 = u.pn * BM + wc * 32 + 8 * fq;
#pragma unroll
        for (int ai = 0; ai < 2; ++ai)
#pragma unroll
            for (int m = 0; m < 4; ++m) { bf16_t* rowp = O + (size_t)(row0 + ai * HALF + m * 16) * ldc + col0;
#pragma unroll
                for (int bj = 0; bj < 2; ++bj) { const f32x4 v0 = acc[ai][bj][m][0], v1 = acc[ai][bj][m][1];
                    u32x4 w; w.x = cvt_pk_bf16(v0[0], v0[1]); w.y = cvt_pk_bf16(v0[2], v0[3]); w.z = cvt_pk_bf16(v1[0], v1[1]); w.w = cvt_pk_bf16(v1[2], v1[3]);
                    *(u32x4*)(rowp + bj * HALF) = w; } }
    }
};
struct EpiY {
    static constexpr bool PERM = true, AFTER_DRAIN = false;
    bf16_t* O; int ldc; float* part; int M;
    __device__ __forceinline__ void operator()(const f32x4 (&acc)[2][2][4][2], const Unit& u, int wr, int wc, int fr, int fq) const {
        const int row0 = u.pm * BM + wr * 64 + fr; const int col0 = u.pn * BM + wc * 32 + 8 * fq;
#pragma unroll
        for (int ai = 0; ai < 2; ++ai)
#pragma unroll
            for (int m = 0; m < 4; ++m) { const int row = row0 + ai * HALF + m * 16; bf16_t* rowp = O + (size_t)row * ldc + col0; float ss = 0.f;
#pragma unroll
                for (int bj = 0; bj < 2; ++bj) { const f32x4 v0 = acc[ai][bj][m][0], v1 = acc[ai][bj][m][1];
                    ss += (v0[0] * v0[0] + v0[1] * v0[1]) + (v0[2] * v0[2] + v0[3] * v0[3]); ss += (v1[0] * v1[0] + v1[1] * v1[1]) + (v1[2] * v1[2] + v1[3] * v1[3]);
                    u32x4 w; w.x = cvt_pk_bf16(v0[0], v0[1]); w.y = cvt_pk_bf16(v0[2], v0[3]); w.z = cvt_pk_bf16(v1[0], v1[1]); w.w = cvt_pk_bf16(v1[2], v1[3]);
                    *(u32x4*)(rowp + bj * HALF) = w; }
                ss += __shfl_xor(ss, 16); ss += __shfl_xor(ss, 32);
                if (fq == 0) part[(size_t)(u.pn * 4 + wc) * M + row] = ss; }
    }
};
template <class Epi, class Sched, bool ALIGN_EPI = false, bool SP2 = false>
__device__ __forceinline__ void gemm_phase(PG8_LAS unsigned char* lds, const Gemm g, const Sched& S, const Epi& E) {
    const int tid = threadIdx.x, wid = __builtin_amdgcn_readfirstlane(tid >> 6), lane = tid & 63, wr = wid >> 2, wc = wid & 3, fr = lane & 15, fq = lane >> 4;
    const int K = g.K, nt = K / BK;
    unsigned voffA[2], voffB[2];
#pragma unroll
    for (int i = 0; i < 2; ++i) { int R, C; stage_rc(tid * 16 + i * 8192, R, C); const int Rb = Epi::PERM ? ((R & ~31) + perm32(R & 31)) : R;
        voffA[i] = (unsigned)(R * K + C) * 2u; voffB[i] = (unsigned)(Rb * K + C) * 2u; }
    const size_t kstep = (size_t)(BK * 2);
    const size_t hstep = (size_t)HALF * K * 2;
    const size_t tstep = 2 * hstep;
    const unsigned ldsw = (unsigned)wid * 1024u;
    const int aoff = lds_byte(wr * 64 + fr, fq * 8), boff = lds_byte(wc * 32 + fr, fq * 8);
#define PG8_SA(b, h) (((b) * 2 + (h)) * HTB)
#define PG8_SB(b, h) ((4 + (b) * 2 + (h)) * HTB)
#define PG8_STAGE(bufoff, gbase, voff) do { _Pragma("unroll") for (int _i = 0; _i < 2; ++_i) \
        __builtin_amdgcn_global_load_lds((const unsigned*)((const char*)(gbase) + (voff)[_i]), (PG8_LAS unsigned*)(lds + (bufoff) + ldsw + _i * 8192), 16, 0, 0); } while (0)
#define PG8_LDA(dst, b, h) do { _Pragma("unroll") for (int m = 0; m < 4; ++m) _Pragma("unroll") for (int k = 0; k < 2; ++k) dst[m][k] = *(const PG8_LAS bf16x8*)(lds + PG8_SA(b, h) + aoff + m * 2048 + k * 1024); } while (0)
#define PG8_LDB(dst, b, h) do { _Pragma("unroll") for (int n = 0; n < 2; ++n) _Pragma("unroll") for (int k = 0; k < 2; ++k) dst[n][k] = *(const PG8_LAS bf16x8*)(lds + PG8_SB(b, h) + boff + n * 2048 + k * 1024); } while (0)
#define PG8_MMA(ai, bj, At, Bt) do { __builtin_amdgcn_s_setprio(1); _Pragma("unroll") for (int m = 0; m < 4; ++m) _Pragma("unroll") for (int n = 0; n < 2; ++n) _Pragma("unroll") for (int k = 0; k < 2; ++k) \
        acc[ai][bj][m][n] = __builtin_amdgcn_mfma_f32_16x16x32_bf16(Bt[n][k], At[m][k], acc[ai][bj][m][n], 0, 0, 0); __builtin_amdgcn_s_setprio(0); } while (0)
#define PG8_WAIT_V(n) asm volatile("s_waitcnt vmcnt(" #n ")" ::: "memory")
#define PG8_WAIT_L(n) asm volatile("s_waitcnt lgkmcnt(" #n ")" ::: "memory")
#define PG8_BAR __builtin_amdgcn_s_barrier()
#define PG8_SCHED __builtin_amdgcn_sched_barrier(0)
    Unit cur, nxt; int ui = 0;
    if (!S.next(0, cur)) return;
    f32x4 acc[2][2][4][2];
#pragma unroll
    for (int a = 0; a < 2; ++a)
#pragma unroll
        for (int b = 0; b < 2; ++b)
#pragma unroll
            for (int m = 0; m < 4; ++m)
#pragma unroll
                for (int n = 0; n < 2; ++n) acc[a][b][m][n] = (f32x4){0.f, 0.f, 0.f, 0.f};
    bf16x8 At[4][2], B0[2][2], B1[2][2];
    const char* cA = (const char*)g.A + (size_t)cur.pm * tstep; const char* cB = (const char*)g.Bt + (size_t)cur.pn * tstep;
    S.a_ready(cur);
    if constexpr (SP2) {
        PG8_STAGE(PG8_SB(0, 0), cB, voffB); PG8_STAGE(PG8_SB(0, 1), cB + hstep, voffB); PG8_STAGE(PG8_SA(0, 0), cA, voffA); PG8_STAGE(PG8_SA(0, 1), cA + hstep, voffA);
        if (wr == 1) PG8_BAR;
        PG8_WAIT_V(2); PG8_BAR;
        PG8_STAGE(PG8_SB(1, 0), cB + kstep, voffB); PG8_STAGE(PG8_SA(1, 0), cA + kstep, voffA); PG8_STAGE(PG8_SB(1, 1), cB + hstep + kstep, voffB);
        PG8_WAIT_V(6); PG8_BAR;
    } else {
        PG8_STAGE(PG8_SB(0, 0), cB, voffB); PG8_STAGE(PG8_SA(0, 0), cA, voffA); PG8_STAGE(PG8_SB(0, 1), cB + hstep, voffB); PG8_STAGE(PG8_SA(0, 1), cA + hstep, voffA);
        if (wr == 1) PG8_BAR;
        PG8_WAIT_V(4); PG8_BAR;
        PG8_STAGE(PG8_SB(1, 0), cB + kstep, voffB); PG8_STAGE(PG8_SA(1, 0), cA + kstep, voffA); PG8_STAGE(PG8_SB(1, 1), cB + hstep + kstep, voffB);
        PG8_WAIT_V(6); PG8_BAR;
    }
    for (;;) {
        const bool has_next = S.next(ui + 1, nxt);
        const char* nA = has_next ? (const char*)g.A + (size_t)nxt.pm * tstep : cA; const char* nB = has_next ? (const char*)g.Bt + (size_t)nxt.pn * tstep : cB;
        for (int t = 0; t < nt; t += 2) {
            const bool last = (t == nt - 2);
            const char* a1 = cA + (size_t)(t + 1) * kstep;
            const char* a2 = last ? nA : cA + (size_t)(t + 2) * kstep; const char* b2 = last ? nB : cB + (size_t)(t + 2) * kstep;
            const char* a3 = a2 + kstep; const char* b3 = b2 + kstep;
            if (last && has_next) S.a_ready(nxt);
            if constexpr (SP2) {
            PG8_LDB(B0, 0, 0); PG8_LDB(B1, 0, 1); PG8_SCHED; PG8_LDA(At, 0, 0); PG8_STAGE(PG8_SA(1, 1), a1 + hstep, voffA);
            PG8_WAIT_V(8); PG8_WAIT_L(0); PG8_BAR; PG8_MMA(0, 0, At, B0); PG8_MMA(0, 1, At, B1); PG8_BAR; PG8_SCHED;
            PG8_LDA(At, 0, 1); PG8_STAGE(PG8_SB(0, 0), b2, voffB); PG8_STAGE(PG8_SB(0, 1), b2 + hstep, voffB); PG8_STAGE(PG8_SA(0, 0), a2, voffA);
            PG8_WAIT_V(8); PG8_WAIT_L(0); PG8_BAR; PG8_MMA(1, 0, At, B0); PG8_MMA(1, 1, At, B1); PG8_BAR; PG8_SCHED;
            PG8_LDB(B0, 1, 0); PG8_LDB(B1, 1, 1); PG8_SCHED; PG8_LDA(At, 1, 0); PG8_STAGE(PG8_SA(0, 1), a2 + hstep, voffA);
            PG8_WAIT_V(8); PG8_WAIT_L(0); PG8_BAR; PG8_MMA(0, 0, At, B0); PG8_MMA(0, 1, At, B1); PG8_BAR; PG8_SCHED;
            PG8_LDA(At, 1, 1); PG8_STAGE(PG8_SB(1, 0), b3, voffB); PG8_STAGE(PG8_SB(1, 1), b3 + hstep, voffB); PG8_STAGE(PG8_SA(1, 0), a3, voffA);
            PG8_WAIT_V(8); PG8_WAIT_L(0); PG8_BAR; PG8_MMA(1, 0, At, B0); PG8_MMA(1, 1, At, B1); PG8_BAR; PG8_SCHED;
            } else {
            PG8_LDB(B0, 0, 0); PG8_SCHED; PG8_LDA(At, 0, 0); PG8_STAGE(PG8_SA(1, 1), a1 + hstep, voffA);
            PG8_WAIT_L(8); PG8_BAR; PG8_WAIT_L(0); PG8_MMA(0, 0, At, B0); PG8_BAR; PG8_SCHED;
            PG8_LDB(B1, 0, 1); PG8_STAGE(PG8_SB(0, 0), b2, voffB);
            PG8_BAR; PG8_WAIT_L(0); PG8_MMA(0, 1, At, B1); PG8_BAR;
            PG8_LDA(At, 0, 1); PG8_STAGE(PG8_SA(0, 0), a2, voffA);
            PG8_BAR; PG8_WAIT_L(0); PG8_MMA(1, 0, At, B0); PG8_BAR; PG8_SCHED;
            PG8_STAGE(PG8_SB(0, 1), b2 + hstep, voffB);
            PG8_WAIT_V(6); PG8_BAR; PG8_MMA(1, 1, At, B1); PG8_BAR;
            PG8_LDB(B0, 1, 0); PG8_SCHED; PG8_LDA(At, 1, 0); PG8_STAGE(PG8_SA(0, 1), a2 + hstep, voffA);
            PG8_WAIT_L(8); PG8_BAR; PG8_WAIT_L(0); PG8_MMA(0, 0, At, B0); PG8_BAR; PG8_SCHED;
            PG8_LDB(B1, 1, 1); PG8_STAGE(PG8_SB(1, 0), b3, voffB);
            PG8_BAR; PG8_WAIT_L(0); PG8_MMA(0, 1, At, B1); PG8_BAR;
            PG8_LDA(At, 1, 1); PG8_STAGE(PG8_SA(1, 0), a3, voffA);
            PG8_BAR; PG8_WAIT_L(0); PG8_MMA(1, 0, At, B0); PG8_BAR; PG8_SCHED;
            PG8_STAGE(PG8_SB(1, 1), b3 + hstep, voffB);
            PG8_WAIT_V(6); PG8_BAR; PG8_MMA(1, 1, At, B1); PG8_BAR;
            }
        }
        if constexpr (ALIGN_EPI) { if (wr == 0) PG8_BAR; }
        if constexpr (!Epi::AFTER_DRAIN) { E(acc, cur, wr, wc, fr, fq); S.done(cur); }
        if (!has_next) break;
#pragma unroll
        for (int a = 0; a < 2; ++a)
#pragma unroll
            for (int b = 0; b < 2; ++b)
#pragma unroll
                for (int m = 0; m < 4; ++m)
#pragma unroll
                    for (int n = 0; n < 2; ++n) acc[a][b][m][n] = (f32x4){0.f, 0.f, 0.f, 0.f};
        cur = nxt; cA = nA; cB = nB; ++ui;
        if constexpr (ALIGN_EPI) { if (wr == 1) PG8_BAR; }
    }
    PG8_WAIT_V(0);
    if constexpr (!ALIGN_EPI) { if (wr == 0) PG8_BAR; }
    PG8_BAR;
    if constexpr (Epi::AFTER_DRAIN) { E.fused(acc, cur, wr, wc, fr, fq, lds, wid, lane); S.done(cur); }
#undef PG8_SA
#undef PG8_SB
#undef PG8_STAGE
#undef PG8_LDA
#undef PG8_LDB
#undef PG8_MMA
#undef PG8_WAIT_V
#undef PG8_WAIT_L
#undef PG8_BAR
#undef PG8_SCHED
}
}

#ifndef MK_N_LAUNCHES
#define MK_N_LAUNCHES 1
#endif
constexpr int N_PHASES = 5, N_LAUNCHES = MK_N_LAUNCHES;
constexpr int NWAVES = 8;
constexpr int D = 1024, NP = 8, TP = 2048, NS = 128, TS = 8, NROWP = NP * TP, NROWS = NS * TS, NTOK = NROWP + NROWS;
constexpr int DIN = 5136, DINP = 5120, DMIX = 2048, HK = 128, HV = 256, NH = 4;
constexpr int C_XL = 0, C_ZL = 1024, C_Q = 2048, C_K = 2560, C_V = 3072, C_ZG = 4096;
constexpr float EPS = 1e-6f;
constexpr size_t O_YP = 0, O_YS = 16777216, O_HP = 17825792, O_CP = 17833984, O_GP = 17858560, O_HS = 18907136, O_CS = 19038208, O_GS = 19431424, O_END = 36208640;
constexpr size_t MiB = 1u << 20;
constexpr size_t WS_CTL = 0, CTL_ZERO_BYTES = 1 * MiB;
constexpr size_t WS_WINT = 2 * MiB, WS_WOUT = 12 * MiB, WS_RGK = 16 * MiB, WS_PART = 18 * MiB, WS_XN = 20 * MiB, WS_PROJ = 54 * MiB, WS_END = 224 * MiB;
static_assert(WS_WINT + (size_t)DINP * D * 2 <= WS_WOUT && WS_WOUT + (size_t)D * DMIX * 2 <= WS_RGK && WS_RGK + (size_t)NTOK * 16 * 4 <= WS_PART && WS_PART + (size_t)16 * NTOK * 4 <= WS_XN &&
              WS_XN + (size_t)NTOK * D * 2 <= WS_PROJ && WS_PROJ + (size_t)NTOK * DINP * 2 <= WS_END, "d_ws map");
constexpr int CW_BAR = 4096;
constexpr int RING_OFF = 0, RING_BYTES = 131072, LDSCTL_OFF = RING_BYTES, MISC_OFF = LDSCTL_OFF + 320, LDS_BYTES = 147456;

#define GAS __attribute__((address_space(1)))
#define LAS __attribute__((address_space(3)))
typedef unsigned short bf16;
typedef unsigned v4u __attribute__((ext_vector_type(4)));
typedef unsigned v2u __attribute__((ext_vector_type(2)));
typedef float f32x4 __attribute__((ext_vector_type(4)));
typedef GAS unsigned gu32;
#define RLX_AGENT __ATOMIC_RELAXED, __HIP_MEMORY_SCOPE_AGENT
#define LDS_WAIT() asm volatile("s_waitcnt lgkmcnt(0)" ::: "memory")
#define VM_WAIT() asm volatile("s_waitcnt vmcnt(0)" ::: "memory")
__device__ __forceinline__ unsigned f2bf(float f) { unsigned u = __builtin_bit_cast(unsigned, f); return (u + 0x7fffu + ((u >> 16) & 1u)) >> 16; }
__device__ __forceinline__ unsigned pk2(float lo, float hi) { return f2bf(lo) | (f2bf(hi) << 16); }
__device__ __forceinline__ float bf2f(unsigned b) { return __builtin_bit_cast(float, b << 16); }
__device__ __forceinline__ float bflo(unsigned w) { return __builtin_bit_cast(float, w << 16); }
__device__ __forceinline__ float bfhi(unsigned w) { return __builtin_bit_cast(float, w & 0xffff0000u); }
__device__ __forceinline__ float sigmoidf_(float x) { return 1.f / (1.f + __expf(-x)); }
__device__ __forceinline__ float logsigf_(float x) { return fminf(x, 0.f) - log1pf(__expf(-fabsf(x))); }
#define XB_TMO      128
#define XB_XCNT(j)  (256  + 64 * (j))
#define XB_XSUB(j)  (1280 + 64 * (j))
#define XB_XGEN(j)  (2304 + 64 * (j))
#define XB_TOP      3328
#define XB_TOPGEN   3392
#define XCD_BAR_WORDS 3456
#define XB_SPIN_CAP (1u << 18)

__device__ __forceinline__ unsigned xb_ld(unsigned* p)              { return __hip_atomic_load(p, __ATOMIC_RELAXED, __HIP_MEMORY_SCOPE_AGENT); }
__device__ __forceinline__ unsigned xb_add(unsigned* p, unsigned v) { return __hip_atomic_fetch_add(p, v, __ATOMIC_RELAXED, __HIP_MEMORY_SCOPE_AGENT); }
__device__ __forceinline__ unsigned xb_xcc_id() { return (unsigned)__builtin_amdgcn_s_getreg((3 << 11) | 20) & 0xFu; }
#define XB_SPIN(cond, bar) do { unsigned _sp = 0; while (cond) { __builtin_amdgcn_s_sleep(1); \
    if ((++_sp & 255u) == 0u) { if (xb_ld(&(bar)[XB_TMO])) break; if (_sp > XB_SPIN_CAP) { atomicAdd(&(bar)[XB_TMO], 1u); break; } } } } while (0)

struct XcdBarrier {
    unsigned* bar; unsigned x;
    volatile LAS unsigned* st;
};

__device__ __forceinline__ XcdBarrier xcd_barrier_post(unsigned* bar, volatile LAS unsigned* st) {
    XcdBarrier b; b.bar = bar; b.x = xb_xcc_id(); b.st = st;
    if (threadIdx.x == 0) (void)xb_add(&bar[XB_XCNT(b.x)], 1u);
    return b;
}
__device__ __forceinline__ void xcd_barrier_complete(unsigned* bar, unsigned x, unsigned& nloc, unsigned& nx) {
    const unsigned G = gridDim.x * gridDim.y * gridDim.z;
    unsigned sum, cnt, mine, sp = 0u;
    for (;;) {
        sum = 0u; cnt = 0u; mine = 0u;
#pragma unroll
        for (unsigned j = 0; j < 16; ++j) { const unsigned c = xb_ld(&bar[XB_XCNT(j)]); sum += c; cnt += (c > 0u) ? 1u : 0u; mine = (j == x) ? c : mine; }
        if (sum == G) break;
        __builtin_amdgcn_s_sleep(1);
        if ((++sp & 255u) == 0u) { if (xb_ld(&bar[XB_TMO])) break; if (sp > XB_SPIN_CAP) { atomicAdd(&bar[XB_TMO], 1u); break; } }
    }
    nloc = mine > 0u ? mine : 1u; nx = cnt > 0u ? cnt : 1u;
}

__device__ __forceinline__ void xcd_barrier(const XcdBarrier& b) {
    asm volatile("s_waitcnt vmcnt(0)" ::: "memory");
    __syncthreads();
    if (threadIdx.x == 0) {
        unsigned* bar = b.bar;
        __builtin_amdgcn_s_waitcnt(0);
        unsigned nloc = b.st[0], nx = b.st[1];
        if (nloc == 0u) { xcd_barrier_complete(bar, b.x, nloc, nx); b.st[0] = nloc; b.st[1] = nx; }
        const unsigned old = xb_add(&bar[XB_XSUB(b.x)], 1u);
        const unsigned gen = old / nloc;
        if (old + 1u == (gen + 1u) * nloc) {
            __builtin_amdgcn_fence(__ATOMIC_RELEASE, "agent");
            asm volatile("s_waitcnt vmcnt(0)" ::: "memory");
            const unsigned og = xb_add(&bar[XB_TOP], 1u);
            const unsigned tg = og / nx;
            if (og + 1u == (tg + 1u) * nx) xb_add(&bar[XB_TOPGEN], 1u);
            else XB_SPIN(xb_ld(&bar[XB_TOPGEN]) == tg, bar);
            __builtin_amdgcn_fence(__ATOMIC_ACQUIRE, "agent");
            xb_add(&bar[XB_XGEN(b.x)], 1u);
            asm volatile("s_waitcnt vmcnt(0)" ::: "memory");
        } else {
            XB_SPIN(xb_ld(&bar[XB_XGEN(b.x)]) == gen, bar);
            __builtin_amdgcn_fence(__ATOMIC_ACQUIRE, "agent");
            asm volatile("s_waitcnt vmcnt(0)" ::: "memory");
        }
    }
    __syncthreads();
}

struct Frame {
    LAS unsigned char* lds;
    volatile LAS unsigned* MISC;
    gu32* ctl;
    int tid, lane, wave, vcu, G;
    const float *xp, *xs, *st_h, *st_conv, *st_gla, *g_pre, *w_in, *conv_w, *conv_b, *w_rg, *b_rg, *w_ig, *b_ig, *lam, *w_gk2, *b_gk, *g_head, *w_out, *g_post;
    float* out;
    bf16 *WinT, *WoutT, *XN, *PROJ, *YMIX, *YBF;
    float *RGK, *PART;
};
__device__ __forceinline__ float wave_sum(float v) {
#pragma unroll
    for (int o = 1; o < 64; o <<= 1) v += __shfl_xor(v, o);
    return v;
}

__device__ __forceinline__ void p0_transpose_item(const float* W, int ldw, int K, int nblk, bf16* WT, LAS float* scr, int item, int lane) {
    const int kb = item / nblk, nb = item % nblk, k0 = 64 * kb, n0 = 32 * nb;
#pragma unroll 8
    for (int i = 0; i < 32; ++i) { const int kk = 2 * i + (lane >> 5); scr[kk * 33 + (lane & 31)] = W[(size_t)(k0 + kk) * ldw + n0 + (lane & 31)]; }
    LDS_WAIT(); asm volatile("" ::: "memory");
    const int c = lane & 7;
#pragma unroll
    for (int j = 0; j < 4; ++j) { const int n = (lane >> 3) + 8 * j; const LAS float* s = scr + (8 * c) * 33 + n;
        v4u o; o.x = pk2(s[0 * 33], s[1 * 33]); o.y = pk2(s[2 * 33], s[3 * 33]); o.z = pk2(s[4 * 33], s[5 * 33]); o.w = pk2(s[6 * 33], s[7 * 33]);
        *(GAS v4u*)(WT + (size_t)(n0 + n) * K + k0 + 8 * c) = o; }
    LDS_WAIT(); asm volatile("" ::: "memory");
}
__device__ __forceinline__ void p0_row(const Frame& F, int r, const LAS float* wrt) {
    const float* xrow = r < NROWP ? F.xp + (size_t)r * D : F.xs + (size_t)(r - NROWP) * D;
    const GAS f32x4* xr = (const GAS f32x4*)xrow + F.lane;
    const GAS f32x4* gp = (const GAS f32x4*)F.g_pre + F.lane;
    f32x4 v[4]; float s = 0.f;
#pragma unroll
    for (int j = 0; j < 4; ++j) { v[j] = xr[64 * j]; s += (v[j].x * v[j].x + v[j].y * v[j].y) + (v[j].z * v[j].z + v[j].w * v[j].w); }
    const float rs = rsqrtf(wave_sum(s) * (1.f / D) + EPS);
#pragma unroll
    for (int j = 0; j < 4; ++j) v[j] = v[j] * rs * gp[64 * j];
    GAS unsigned long long* o8 = (GAS unsigned long long*)(F.XN + (size_t)r * D) + F.lane;
#pragma unroll
    for (int j = 0; j < 4; ++j) o8[64 * j] = (unsigned long long)pk2(v[j].x, v[j].y) | ((unsigned long long)pk2(v[j].z, v[j].w) << 32);
    float p[16];
#pragma unroll
    for (int jj = 0; jj < 16; ++jj) { float a = 0.f;
#pragma unroll
        for (int j = 0; j < 4; ++j) { const f32x4 w = *(const LAS f32x4*)(wrt + jj * 1024 + 256 * j + 4 * F.lane); a += (v[j].x * w.x + v[j].y * w.y) + (v[j].z * w.z + v[j].w * w.w); }
        p[jj] = a; if ((jj & 3) == 3) asm volatile("" ::: "memory"); }
    const bool b5 = F.lane & 32, b4 = F.lane & 16, b3 = F.lane & 8, b2 = F.lane & 4;
    float q8[8], q4[4], q2[2], q1;
#pragma unroll
    for (int i = 0; i < 8; ++i) { const float send = b5 ? p[i] : p[i + 8], keep = b5 ? p[i + 8] : p[i]; q8[i] = keep + __shfl_xor(send, 32); }
#pragma unroll
    for (int i = 0; i < 4; ++i) { const float send = b4 ? q8[i] : q8[i + 4], keep = b4 ? q8[i + 4] : q8[i]; q4[i] = keep + __shfl_xor(send, 16); }
#pragma unroll
    for (int i = 0; i < 2; ++i) { const float send = b3 ? q4[i] : q4[i + 2], keep = b3 ? q4[i + 2] : q4[i]; q2[i] = keep + __shfl_xor(send, 8); }
    { const float send = b2 ? q2[0] : q2[1], keep = b2 ? q2[1] : q2[0]; q1 = keep + __shfl_xor(send, 4); }
    q1 += __shfl_xor(q1, 2); q1 += __shfl_xor(q1, 1);
    if ((F.lane & 3) == 0) F.RGK[(size_t)r * 16 + (F.lane >> 2)] = q1;
}
__device__ __forceinline__ void p0_prologue(Frame& F) {
    LAS float* scr = (LAS float*)(F.lds + RING_OFF + F.wave * 16384);
    const int gw = F.vcu * NWAVES + F.wave, NGW = F.G * NWAVES;
    constexpr int I_IN = (D / 64) * (DINP / 32), I_OUT = (DMIX / 64) * (D / 32);
    for (int it = gw; it < I_IN + I_OUT; it += NGW) {
        if (it < I_IN) p0_transpose_item(F.w_in, DIN, D, DINP / 32, F.WinT, scr, it, F.lane);
        else p0_transpose_item(F.w_out, D, DMIX, D / 32, F.WoutT, scr, it - I_IN, F.lane);
    }
    __syncthreads();
    LAS float* wrt = (LAS float*)(F.lds + RING_OFF);
    for (int idx = F.tid; idx < 16 * 1024; idx += NWAVES * 64) { const int k = idx >> 4, j = idx & 15; wrt[j * 1024 + k] = F.w_in[(size_t)k * DIN + DINP + j]; }
    __syncthreads();
    const int rpw = (NTOK + F.G - 1) / F.G;
    const int r1 = min(NTOK, (F.vcu + 1) * rpw);
    for (int r = F.vcu * rpw + F.wave; r < r1; r += NWAVES) p0_row(F, r, wrt);
    __syncthreads();
}

__device__ __forceinline__ float rdlane(float v, int l) { return __builtin_bit_cast(float, __builtin_amdgcn_readlane(__builtin_bit_cast(int, v), l)); }
__device__ __forceinline__ void lru_simple_item(const Frame& F, int kind, int seq, int nb) {
    const int lane = F.lane, c = nb * 64 + lane;
    const int T = kind ? TS : TP; const size_t row0 = kind ? (size_t)NROWP + (size_t)seq * TS : (size_t)seq * TP;
    float wrg[64], wig[64];
#pragma unroll
    for (int d = 0; d < 64; ++d) { wrg[d] = F.w_rg[(size_t)(nb * 64 + d) * 64 + lane]; wig[d] = F.w_ig[(size_t)(nb * 64 + d) * 64 + lane]; }
    const float brg = F.b_rg[c], big = F.b_ig[c], cb = F.conv_b[c], cw0 = F.conv_w[c], cw1 = F.conv_w[1024 + c], cw2 = F.conv_w[2048 + c], cw3 = F.conv_w[3072 + c];
    const float c8 = 8.f * logsigf_(F.lam[c]);
    float h = kind ? F.st_h[(size_t)seq * 1024 + c] : 0.f;
    float xm3 = kind ? F.st_conv[((size_t)seq * 3 + 0) * 1024 + c] : 0.f, xm2 = kind ? F.st_conv[((size_t)seq * 3 + 1) * 1024 + c] : 0.f, xm1 = kind ? F.st_conv[((size_t)seq * 3 + 2) * 1024 + c] : 0.f;
    for (int t0 = 0; t0 < T; t0 += 8) {
        float xv[8], zv[8];
#pragma unroll
        for (int i = 0; i < 8; ++i) { const bf16* pr = F.PROJ + (row0 + t0 + i) * DINP; xv[i] = bf2f(pr[C_XL + c]); zv[i] = bf2f(pr[C_ZL + c]); }
#pragma unroll 1
        for (int i = 0; i < 8; ++i) {
            const float x = xv[i]; const float xc = cb + cw0 * xm3 + cw1 * xm2 + cw2 * xm1 + cw3 * x; xm3 = xm2; xm2 = xm1; xm1 = x;
            float ar = brg, ai = big;
#pragma unroll
            for (int d = 0; d < 64; ++d) { const float xd = rdlane(xc, d); ar += xd * wrg[d]; ai += xd * wig[d]; }
            const float r = sigmoidf_(ar), ig = sigmoidf_(ai);
            const float la = c8 * r, a = __expf(la), u = sqrtf(-expm1f(2.f * la)) * (ig * xc);
            h = a * h + u;
            const float z = zv[i], y = h * z * sigmoidf_(z);
            F.YMIX[(row0 + t0 + i) * DMIX + c] = (bf16)f2bf(y);
        }
    }
    float* ho = F.out + (kind ? O_HS : O_HP) + (size_t)seq * 1024 + c; *ho = h;
    float* co = F.out + (kind ? O_CS : O_CP) + (size_t)seq * 3 * 1024 + c; co[0] = xm3; co[1024] = xm2; co[2048] = xm1;
}
__device__ __forceinline__ void gla_simple_item(const Frame& F, int kind, int seq, int h, int hsel) {
    const int t2 = F.tid & 255, w4 = t2 >> 6;
    const int T = kind ? TS : TP; const size_t row0 = kind ? (size_t)NROWP + (size_t)seq * TS : (size_t)seq * TP;
    LAS float* L = (LAS float*)(F.lds + RING_OFF + hsel * 4096);
    LAS float* al = L, *qs = L + 128, *ks = L + 256, *red = L + 384;
    float S[128];
    const float* s0 = F.st_gla + (((size_t)seq * NH + h) * HK) * HV + t2;
#pragma unroll
    for (int d = 0; d < 128; ++d) S[d] = kind ? s0[(size_t)d * HV] : 0.f;
    float w2[16]; float bg = 0.f;
    if (t2 < 128) { bg = F.b_gk[h * 128 + t2];
#pragma unroll
        for (int j = 0; j < 16; ++j) w2[j] = F.w_gk2[j * 512 + h * 128 + t2]; }
    else {
#pragma unroll
        for (int j = 0; j < 16; ++j) w2[j] = 0.f; }
    const float gh = F.g_head[t2];
    for (int t = 0; t < T; ++t) {
        const size_t row = row0 + t; const bf16* pr = F.PROJ + row * DINP;
        if (t2 < 128) { float z = bg; const float* rg = F.RGK + row * 16;
#pragma unroll
            for (int j = 0; j < 16; ++j) z += rg[j] * w2[j];
            al[t2] = __expf(logsigf_(z) * (1.f / 16.f)); qs[t2] = bf2f(pr[C_Q + h * 128 + t2]) * 0.08838834764831845f; ks[t2] = bf2f(pr[C_K + h * 128 + t2]); }
        const float vv = bf2f(pr[C_V + h * 256 + t2]), zz = bf2f(pr[C_ZG + h * 256 + t2]);
        __syncthreads();
        float o = 0.f;
#pragma unroll
        for (int d4 = 0; d4 < 32; ++d4) { const f32x4 a4 = *(const LAS f32x4*)(al + 4 * d4), k4 = *(const LAS f32x4*)(ks + 4 * d4), q4 = *(const LAS f32x4*)(qs + 4 * d4);
            S[4 * d4 + 0] = a4.x * S[4 * d4 + 0] + k4.x * vv; o += q4.x * S[4 * d4 + 0];
            S[4 * d4 + 1] = a4.y * S[4 * d4 + 1] + k4.y * vv; o += q4.y * S[4 * d4 + 1];
            S[4 * d4 + 2] = a4.z * S[4 * d4 + 2] + k4.z * vv; o += q4.z * S[4 * d4 + 2];
            S[4 * d4 + 3] = a4.w * S[4 * d4 + 3] + k4.w * vv; o += q4.w * S[4 * d4 + 3]; }
        const float ss = wave_sum(o * o);
        if (F.lane == 0) red[w4] = ss;
        __syncthreads();
        const float tot = (red[0] + red[1]) + (red[2] + red[3]);
        const float rs = rsqrtf(tot * (1.f / 256.f) + EPS);
        const float y = o * rs * gh * (zz * sigmoidf_(zz));
        F.YMIX[row * DMIX + 1024 + h * 256 + t2] = (bf16)f2bf(y);
        __syncthreads();
    }
    float* so = F.out + (kind ? O_GS : O_GP) + (((size_t)seq * NH + h) * HK) * HV + t2;
#pragma unroll
    for (int d = 0; d < 128; ++d) so[(size_t)d * HV] = S[d];
}
__device__ __forceinline__ void p2_mix_simple(Frame& F) {
    const int hsel = F.tid >> 8;
    for (int p = F.G - 1 - F.vcu; p < NP * NH / 2; p += F.G) { const int it = 2 * p + hsel; gla_simple_item(F, 0, it >> 2, it & 3, hsel); }
    for (int p = F.vcu; p < NS * NH / 2; p += F.G) { const int it = 2 * p + hsel; gla_simple_item(F, 1, it >> 2, it & 3, hsel); }
    const int gw = F.vcu * NWAVES + F.wave, NGW = F.G * NWAVES;
    for (int i = gw; i < NP * 16 * 16; i += NGW) if ((i & 15) == 0) { const int it = i >> 4; lru_simple_item(F, 0, it >> 4, it & 15); }
    for (int it = gw; it < NS * 16; it += NGW) lru_simple_item(F, 1, it >> 4, it & 15);
}

__device__ __forceinline__ void p4_final(Frame& F) {
    const int gw = F.vcu * NWAVES + F.wave, NGW = F.G * NWAVES;
    const GAS f32x4* gp = (const GAS f32x4*)F.g_post + F.lane;
    f32x4 g[4];
#pragma unroll
    for (int j = 0; j < 4; ++j) g[j] = gp[64 * j];
    for (int r = gw; r < NTOK; r += NGW) {
        const float* xrow = r < NROWP ? F.xp + (size_t)r * D : F.xs + (size_t)(r - NROWP) * D;
        const GAS f32x4* xr = (const GAS f32x4*)xrow + F.lane;
        const GAS v2u* yr = (const GAS v2u*)(F.YBF + (size_t)r * D) + F.lane;
        float ps = F.lane < 16 ? F.PART[(size_t)F.lane * NTOK + r] : 0.f;
        const float rs = rsqrtf(wave_sum(ps) * (1.f / D) + EPS);
        GAS f32x4* orow = (GAS f32x4*)(F.out + (size_t)r * D) + F.lane;
#pragma unroll
        for (int j = 0; j < 4; ++j) { const f32x4 x = xr[64 * j]; const v2u y = yr[64 * j];
            f32x4 o; o.x = x.x + bflo(y.x) * rs * g[j].x; o.y = x.y + bfhi(y.x) * rs * g[j].y; o.z = x.z + bflo(y.y) * rs * g[j].z; o.w = x.w + bfhi(y.y) * rs * g[j].w;
            orow[64 * j] = o; }
    }
}

struct Args { const float* in[19]; float* out; unsigned char* ws; int ph_lo, ph_hi, li, pad; };
__global__ void __launch_bounds__(NWAVES * 64, 2) mk_fwd(Args args) {
    extern __shared__ __attribute__((aligned(16))) unsigned char lds[];
    Frame F;
    F.lds = (LAS unsigned char*)lds;
    F.MISC = (volatile LAS unsigned*)(F.lds + MISC_OFF);
    F.tid = threadIdx.x; F.lane = F.tid & 63; F.wave = __builtin_amdgcn_readfirstlane(F.tid >> 6);
    F.G = gridDim.x; { const int bx = blockIdx.x; F.vcu = (F.G % 8 == 0) ? (bx % 8) * (F.G / 8) + bx / 8 : bx; }
    unsigned char* ws = args.ws;
    F.ctl = (gu32*)(ws + WS_CTL);
    F.xp = args.in[0]; F.xs = args.in[1]; F.st_h = args.in[2]; F.st_conv = args.in[3]; F.st_gla = args.in[4]; F.g_pre = args.in[5]; F.w_in = args.in[6];
    F.conv_w = args.in[7]; F.conv_b = args.in[8]; F.w_rg = args.in[9]; F.b_rg = args.in[10]; F.w_ig = args.in[11]; F.b_ig = args.in[12]; F.lam = args.in[13];
    F.w_gk2 = args.in[14]; F.b_gk = args.in[15]; F.g_head = args.in[16]; F.w_out = args.in[17]; F.g_post = args.in[18];
    F.out = args.out;
    F.WinT = (bf16*)(ws + WS_WINT); F.WoutT = (bf16*)(ws + WS_WOUT); F.XN = (bf16*)(ws + WS_XN); F.PROJ = (bf16*)(ws + WS_PROJ);
    F.YMIX = (bf16*)args.out;
    F.YBF = (bf16*)(ws + WS_XN);
    F.RGK = (float*)(ws + WS_RGK); F.PART = (float*)(ws + WS_PART);
    for (int u = F.tid; u < (LDS_BYTES - LDSCTL_OFF) / 4; u += NWAVES * 64) ((LAS unsigned*)(F.lds + LDSCTL_OFF))[u] = 0u;
    __syncthreads();
    XcdBarrier bar; bar.bar = (unsigned*)(F.ctl + CW_BAR); bar.x = 0; bar.st = nullptr;
    if (N_LAUNCHES == 1) bar = xcd_barrier_post((unsigned*)(F.ctl + CW_BAR), F.MISC + 8);
#define GRID_BAR() do { if (N_LAUNCHES == 1) xcd_barrier(bar); } while (0)
    const int lo = args.ph_lo, hi = args.ph_hi;
#ifndef PH_MASK
#define PH_MASK 31
#endif
#define IN(k) (lo <= (k) && (k) < hi && ((PH_MASK >> (k)) & 1))
#define BOTH(k) (IN(k) && IN((k) + 1))
    if (IN(0)) { p0_prologue(F); if (BOTH(0)) GRID_BAR(); }
    if (IN(1)) {
        pg8::Gemm g{F.XN, F.WinT, NTOK, DINP, D}; pg8::StaticOrder S; S.init(NTOK, DINP, F.G, (int)blockIdx.x);
        pg8::EpiProj E{F.PROJ, DINP};
        pg8::gemm_phase<pg8::EpiProj, pg8::StaticOrder, true, true>(F.lds + RING_OFF, g, S, E);
        if (BOTH(1)) GRID_BAR();
    }
    if (IN(2)) { p2_mix_simple(F); if (BOTH(2)) GRID_BAR(); }
    if (IN(3)) {
        pg8::Gemm g{F.YMIX, F.WoutT, NTOK, D, DMIX}; pg8::StaticOrder S; S.init(NTOK, D, F.G, (int)blockIdx.x);
        pg8::EpiY E{F.YBF, D, F.PART, NTOK};
        pg8::gemm_phase<pg8::EpiY, pg8::StaticOrder, true, true>(F.lds + RING_OFF, g, S, E);
        if (BOTH(3)) GRID_BAR();
    }
    if (IN(4)) { p4_final(F); }
#undef IN
#undef BOTH
}

extern "C" void kernel_launch(void* const* d_in, const int* in_sizes, int n_in, void* d_out, int out_size, void* d_ws, size_t ws_size, hipStream_t stream) {
    static int grid = 0;
    if (grid == 0) {
        if (n_in != 19 || in_sizes[0] != NROWP * D || in_sizes[6] != D * DIN || (size_t)out_size != O_END || ws_size < WS_END) {
            fprintf(stderr, "kernel_launch: unexpected shapes: n_in %d in0 %d in6 %d out %d ws %zu; nothing launched\n", n_in, n_in > 0 ? in_sizes[0] : -1, n_in > 6 ? in_sizes[6] : -1, out_size, ws_size); grid = -1; return; }
        int dev = 0, cus = 0, per_cu = 0;
        if (hipGetDevice(&dev) != hipSuccess || hipDeviceGetAttribute(&cus, hipDeviceAttributeMultiprocessorCount, dev) != hipSuccess) { grid = -1; return; }
        if (hipFuncSetAttribute((const void*)mk_fwd, hipFuncAttributeMaxDynamicSharedMemorySize, LDS_BYTES) != hipSuccess) { fprintf(stderr, "kernel_launch: hipFuncSetAttribute failed\n"); grid = -1; return; }
        if (hipOccupancyMaxActiveBlocksPerMultiprocessor(&per_cu, (const void*)mk_fwd, NWAVES * 64, LDS_BYTES) != hipSuccess || per_cu < 1)
            fprintf(stderr, "kernel_launch: note: occupancy query reports %d workgroups per CU\n", per_cu);
        (void)hipGetLastError();
        grid = cus;
    }
    if (grid < 0) return;
    if (hipMemsetAsync((char*)d_ws + WS_CTL, 0, CTL_ZERO_BYTES, stream) != hipSuccess) { fprintf(stderr, "kernel_launch: hipMemsetAsync failed\n"); return; }
    Args a{};
    for (int i = 0; i < 19; ++i) a.in[i] = (const float*)d_in[i];
    a.out = (float*)d_out; a.ws = (unsigned char*)d_ws;
    for (int li = 0; li < N_LAUNCHES; ++li) {
        a.ph_lo = (N_LAUNCHES == 1) ? 0 : li; a.ph_hi = (N_LAUNCHES == 1) ? N_PHASES : li + 1; a.li = li;
        hipLaunchKernelGGL(mk_fwd, dim3(grid), dim3(NWAVES * 64), LDS_BYTES, stream, a);
        const hipError_t le = hipPeekAtLastError();
        if (le != hipSuccess) { fprintf(stderr, "kernel_launch: launch %d failed: %s\n", li, hipGetErrorName(le)); break; }
    }
}
```

```cpp
#define MK_N_LAUNCHES 1
#include <hip/hip_runtime.h>
#include <cstdio>
#include <cstdint>
namespace pg8 {
#define PG8_LAS __attribute__((address_space(3)))
typedef unsigned short bf16_t;
typedef short bf16x8 __attribute__((ext_vector_type(8)));
typedef float f32x4 __attribute__((ext_vector_type(4)));
typedef unsigned u32x4 __attribute__((ext_vector_type(4)));
constexpr int BM = 256, BK = 64, HALF = 128, HTB = HALF * BK * 2  , STAGE_BYTES = 8 * HTB, NXCD = 8, WGM = 8;

__host__ __device__ __forceinline__ int lds_byte(int r, int c) { const int st = (r >> 4) * 2 + (c >> 5), rr = r & 15, cc = c & 31, ob = rr * 64 + cc * 2; return st * 1024 + (ob ^ (((ob >> 9) & 1) << 5)); }
__host__ __device__ __forceinline__ void stage_rc(int b, int& R, int& C) { const int st = b / 1024, sb = b % 1024, swz = sb ^ (((sb >> 9) & 1) << 5); R = (st >> 1) * 16 + swz / 64; C = (st & 1) * 32 + (swz % 64) / 2; }
__host__ __device__ __forceinline__ int perm32(int rho) { const int n = rho >> 4, i = rho & 15; return 8 * (i >> 2) + 4 * n + (i & 3); }

struct Unit { int pm, pn; };
struct Gemm { const bf16_t* A; const bf16_t* Bt; int M, N, K; };

struct StaticOrder {
    int nM, nN, nwg, G, c;
    __host__ __device__ void init(int M, int N, int G_, int c_) { nM = M / BM; nN = N / BM; nwg = nM * nN; G = G_; c = c_; }
    __host__ __device__ bool next(int i, Unit& u) const {
        const long L = (long)i * G + c; if (L >= nwg) return false;
        int wgid = (int)L; { const int q = nwg / NXCD, r = nwg % NXCD, xcd = wgid % NXCD, off = wgid / NXCD; wgid = (xcd < r ? xcd * (q + 1) : r * (q + 1) + (xcd - r) * q) + off; }
        const int nig = WGM * nN, gid = wgid / nig, fm = gid * WGM, gsz = (nM - fm) < WGM ? (nM - fm) : WGM;
        u.pm = fm + ((wgid % nig) % gsz); u.pn = (wgid % nig) / gsz; return true;
    }
    __device__ __forceinline__ void a_ready(const Unit&) const {}
    __device__ __forceinline__ void done(const Unit&) const {}
};
__device__ __forceinline__ unsigned cvt_pk_bf16(float lo, float hi) { unsigned r; asm volatile("v_cvt_pk_bf16_f32 %0, %1, %2" : "=v"(r) : "v"(lo), "v"(hi)); return r; }
typedef float f32x2 __attribute__((ext_vector_type(2)));
struct EpiProj {
    static constexpr bool PERM = true, AFTER_DRAIN = false;
    bf16_t* O; int ldc; const float* bcum;
    __device__ __forceinline__ void operator()(const f32x4 (&acc)[2][2][4][2], const Unit& u, int wr, int wc, int fr, int fq) const {
        const int row0 = u.pm * BM + wr * 64 + fr; const int col0 = u.pn * BM + wc * 32 + 8 * fq;
        const int gk = (u.pn >= 8 && u.pn < 12) ? (u.pn < 10 ? 1 : 2) : 0;
        const float sgn = gk == 1 ? 1.4426950408889634f : -1.4426950408889634f, sc = gk == 1 ? 0.08838834764831845f : 1.f;
#pragma unroll
        for (int ai = 0; ai < 2; ++ai)
#pragma unroll
            for (int m = 0; m < 4; ++m) { const int row = row0 + ai * HALF + m * 16; bf16_t* rowp = O + (size_t)row * ldc + col0;
#pragma unroll
                for (int bj = 0; bj < 2; ++bj) { f32x4 v0 = acc[ai][bj][m][0], v1 = acc[ai][bj][m][1];
                    if (gk) { const float* bp = bcum + (size_t)row * 512 + (col0 + bj * HALF - (gk == 1 ? 2048 : 2560)); const f32x4 b0 = *(const f32x4*)bp, b1 = *(const f32x4*)(bp + 4);
                        v0[0] *= sc * __builtin_amdgcn_exp2f(sgn * b0[0]); v0[1] *= sc * __builtin_amdgcn_exp2f(sgn * b0[1]); v0[2] *= sc * __builtin_amdgcn_exp2f(sgn * b0[2]); v0[3] *= sc * __builtin_amdgcn_exp2f(sgn * b0[3]);
                        v1[0] *= sc * __builtin_amdgcn_exp2f(sgn * b1[0]); v1[1] *= sc * __builtin_amdgcn_exp2f(sgn * b1[1]); v1[2] *= sc * __builtin_amdgcn_exp2f(sgn * b1[2]); v1[3] *= sc * __builtin_amdgcn_exp2f(sgn * b1[3]); }
                    u32x4 w; w.x = cvt_pk_bf16(v0[0], v0[1]); w.y = cvt_pk_bf16(v0[2], v0[3]); w.z = cvt_pk_bf16(v1[0], v1[1]); w.w = cvt_pk_bf16(v1[2], v1[3]);
                    *(u32x4*)(rowp + bj * HALF) = w; } }
    }
};
struct EpiY {
    static constexpr bool PERM = true, AFTER_DRAIN = false;
    bf16_t* O; int ldc; float* part; int M;
    __device__ __forceinline__ void operator()(const f32x4 (&acc)[2][2][4][2], const Unit& u, int wr, int wc, int fr, int fq) const {
        const int row0 = u.pm * BM + wr * 64 + fr; const int col0 = u.pn * BM + wc * 32 + 8 * fq;
#pragma unroll
        for (int ai = 0; ai < 2; ++ai)
#pragma unroll
            for (int m = 0; m < 4; ++m) { const int row = row0 + ai * HALF + m * 16; bf16_t* rowp = O + (size_t)row * ldc + col0; float ss = 0.f;
#pragma unroll
                for (int bj = 0; bj < 2; ++bj) { const f32x4 v0 = acc[ai][bj][m][0], v1 = acc[ai][bj][m][1];
                    ss += (v0[0] * v0[0] + v0[1] * v0[1]) + (v0[2] * v0[2] + v0[3] * v0[3]); ss += (v1[0] * v1[0] + v1[1] * v1[1]) + (v1[2] * v1[2] + v1[3] * v1[3]);
                    u32x4 w; w.x = cvt_pk_bf16(v0[0], v0[1]); w.y = cvt_pk_bf16(v0[2], v0[3]); w.z = cvt_pk_bf16(v1[0], v1[1]); w.w = cvt_pk_bf16(v1[2], v1[3]);
                    *(u32x4*)(rowp + bj * HALF) = w; }
                ss += __shfl_xor(ss, 16); ss += __shfl_xor(ss, 32);
                if (fq == 0) part[(size_t)(u.pn * 4 + wc) * M + row] = ss; }
    }
};
template <class Epi, class Sched, bool ALIGN_EPI = false, bool SP2 = false>
__device__ __forceinline__ void gemm_phase(PG8_LAS unsigned char* lds, const Gemm g, const Sched& S, const Epi& E) {
    const int tid = threadIdx.x, wid = __builtin_amdgcn_readfirstlane(tid >> 6), lane = tid & 63, wr = wid >> 2, wc = wid & 3, fr = lane & 15, fq = lane >> 4;
    const int K = g.K, nt = K / BK;
    unsigned voffA[2], voffB[2];
#pragma unroll
    for (int i = 0; i < 2; ++i) { int R, C; stage_rc(tid * 16 + i * 8192, R, C); const int Rb = Epi::PERM ? ((R & ~31) + perm32(R & 31)) : R;
        voffA[i] = (unsigned)(R * K + C) * 2u; voffB[i] = (unsigned)(Rb * K + C) * 2u; }
    const size_t kstep = (size_t)(BK * 2);
    const size_t hstep = (size_t)HALF * K * 2;
    const size_t tstep = 2 * hstep;
    const unsigned ldsw = (unsigned)wid * 1024u;
    const int aoff = lds_byte(wr * 64 + fr, fq * 8), boff = lds_byte(wc * 32 + fr, fq * 8);
#define PG8_SA(b, h) (((b) * 2 + (h)) * HTB)
#define PG8_SB(b, h) ((4 + (b) * 2 + (h)) * HTB)
#define PG8_STAGE(bufoff, gbase, voff) do { _Pragma("unroll") for (int _i = 0; _i < 2; ++_i) \
        __builtin_amdgcn_global_load_lds((const unsigned*)((const char*)(gbase) + (voff)[_i]), (PG8_LAS unsigned*)(lds + (bufoff) + ldsw + _i * 8192), 16, 0, 0); } while (0)
#define PG8_LDA(dst, b, h) do { _Pragma("unroll") for (int m = 0; m < 4; ++m) _Pragma("unroll") for (int k = 0; k < 2; ++k) dst[m][k] = *(const PG8_LAS bf16x8*)(lds + PG8_SA(b, h) + aoff + m * 2048 + k * 1024); } while (0)
#define PG8_LDB(dst, b, h) do { _Pragma("unroll") for (int n = 0; n < 2; ++n) _Pragma("unroll") for (int k = 0; k < 2; ++k) dst[n][k] = *(const PG8_LAS bf16x8*)(lds + PG8_SB(b, h) + boff + n * 2048 + k * 1024); } while (0)
#define PG8_MMA(ai, bj, At, Bt) do { __builtin_amdgcn_s_setprio(1); _Pragma("unroll") for (int m = 0; m < 4; ++m) _Pragma("unroll") for (int n = 0; n < 2; ++n) _Pragma("unroll") for (int k = 0; k < 2; ++k) \
        acc[ai][bj][m][n] = __builtin_amdgcn_mfma_f32_16x16x32_bf16(Bt[n][k], At[m][k], acc[ai][bj][m][n], 0, 0, 0); __builtin_amdgcn_s_setprio(0); } while (0)
#define PG8_WAIT_V(n) asm volatile("s_waitcnt vmcnt(" #n ")" ::: "memory")
#define PG8_WAIT_L(n) asm volatile("s_waitcnt lgkmcnt(" #n ")" ::: "memory")
#define PG8_BAR __builtin_amdgcn_s_barrier()
#define PG8_SCHED __builtin_amdgcn_sched_barrier(0)
    Unit cur, nxt; int ui = 0;
    if (!S.next(0, cur)) return;
    f32x4 acc[2][2][4][2];
#pragma unroll
    for (int a = 0; a < 2; ++a)
#pragma unroll
        for (int b = 0; b < 2; ++b)
#pragma unroll
            for (int m = 0; m < 4; ++m)
#pragma unroll
                for (int n = 0; n < 2; ++n) acc[a][b][m][n] = (f32x4){0.f, 0.f, 0.f, 0.f};
    bf16x8 At[4][2], B0[2][2], B1[2][2];
    const char* cA = (const char*)g.A + (size_t)cur.pm * tstep; const char* cB = (const char*)g.Bt + (size_t)cur.pn * tstep;
    S.a_ready(cur);
    if constexpr (SP2) {
        PG8_STAGE(PG8_SB(0, 0), cB, voffB); PG8_STAGE(PG8_SB(0, 1), cB + hstep, voffB); PG8_STAGE(PG8_SA(0, 0), cA, voffA); PG8_STAGE(PG8_SA(0, 1), cA + hstep, voffA);
        if (wr == 1) PG8_BAR;
        PG8_WAIT_V(2); PG8_BAR;
        PG8_STAGE(PG8_SB(1, 0), cB + kstep, voffB); PG8_STAGE(PG8_SA(1, 0), cA + kstep, voffA); PG8_STAGE(PG8_SB(1, 1), cB + hstep + kstep, voffB);
        PG8_WAIT_V(6); PG8_BAR;
    } else {
        PG8_STAGE(PG8_SB(0, 0), cB, voffB); PG8_STAGE(PG8_SA(0, 0), cA, voffA); PG8_STAGE(PG8_SB(0, 1), cB + hstep, voffB); PG8_STAGE(PG8_SA(0, 1), cA + hstep, voffA);
        if (wr == 1) PG8_BAR;
        PG8_WAIT_V(4); PG8_BAR;
        PG8_STAGE(PG8_SB(1, 0), cB + kstep, voffB); PG8_STAGE(PG8_SA(1, 0), cA + kstep, voffA); PG8_STAGE(PG8_SB(1, 1), cB + hstep + kstep, voffB);
        PG8_WAIT_V(6); PG8_BAR;
    }
    for (;;) {
        const bool has_next = S.next(ui + 1, nxt);
        const char* nA = has_next ? (const char*)g.A + (size_t)nxt.pm * tstep : cA; const char* nB = has_next ? (const char*)g.Bt + (size_t)nxt.pn * tstep : cB;
        for (int t = 0; t < nt; t += 2) {
            const bool last = (t == nt - 2);
            const char* a1 = cA + (size_t)(t + 1) * kstep;
            const char* a2 = last ? nA : cA + (size_t)(t + 2) * kstep; const char* b2 = last ? nB : cB + (size_t)(t + 2) * kstep;
            const char* a3 = a2 + kstep; const char* b3 = b2 + kstep;
            if (last && has_next) S.a_ready(nxt);
            if constexpr (SP2) {
            PG8_LDB(B0, 0, 0); PG8_LDB(B1, 0, 1); PG8_SCHED; PG8_LDA(At, 0, 0); PG8_STAGE(PG8_SA(1, 1), a1 + hstep, voffA);
            PG8_WAIT_V(8); PG8_WAIT_L(0); PG8_BAR; PG8_MMA(0, 0, At, B0); PG8_MMA(0, 1, At, B1); PG8_BAR; PG8_SCHED;
            PG8_LDA(At, 0, 1); PG8_STAGE(PG8_SB(0, 0), b2, voffB); PG8_STAGE(PG8_SB(0, 1), b2 + hstep, voffB); PG8_STAGE(PG8_SA(0, 0), a2, voffA);
            PG8_WAIT_V(8); PG8_WAIT_L(0); PG8_BAR; PG8_MMA(1, 0, At, B0); PG8_MMA(1, 1, At, B1); PG8_BAR; PG8_SCHED;
            PG8_LDB(B0, 1, 0); PG8_LDB(B1, 1, 1); PG8_SCHED; PG8_LDA(At, 1, 0); PG8_STAGE(PG8_SA(0, 1), a2 + hstep, voffA);
            PG8_WAIT_V(8); PG8_WAIT_L(0); PG8_BAR; PG8_MMA(0, 0, At, B0); PG8_MMA(0, 1, At, B1); PG8_BAR; PG8_SCHED;
            PG8_LDA(At, 1, 1); PG8_STAGE(PG8_SB(1, 0), b3, voffB); PG8_STAGE(PG8_SB(1, 1), b3 + hstep, voffB); PG8_STAGE(PG8_SA(1, 0), a3, voffA);
            PG8_WAIT_V(8); PG8_WAIT_L(0); PG8_BAR; PG8_MMA(1, 0, At, B0); PG8_MMA(1, 1, At, B1); PG8_BAR; PG8_SCHED;
            } else {
            PG8_LDB(B0, 0, 0); PG8_SCHED; PG8_LDA(At, 0, 0); PG8_STAGE(PG8_SA(1, 1), a1 + hstep, voffA);
            PG8_WAIT_L(8); PG8_BAR; PG8_WAIT_L(0); PG8_MMA(0, 0, At, B0); PG8_BAR; PG8_SCHED;
            PG8_LDB(B1, 0, 1); PG8_STAGE(PG8_SB(0, 0), b2, voffB);
            PG8_BAR; PG8_WAIT_L(0); PG8_MMA(0, 1, At, B1); PG8_BAR;
            PG8_LDA(At, 0, 1); PG8_STAGE(PG8_SA(0, 0), a2, voffA);
            PG8_BAR; PG8_WAIT_L(0); PG8_MMA(1, 0, At, B0); PG8_BAR; PG8_SCHED;
            PG8_STAGE(PG8_SB(0, 1), b2 + hstep, voffB);
            PG8_WAIT_V(6); PG8_BAR; PG8_MMA(1, 1, At, B1); PG8_BAR;
            PG8_LDB(B0, 1, 0); PG8_SCHED; PG8_LDA(At, 1, 0); PG8_STAGE(PG8_SA(0, 1), a2 + hstep, voffA);
            PG8_WAIT_L(8); PG8_BAR; PG8_WAIT_L(0); PG8_MMA(0, 0, At, B0); PG8_BAR; PG8_SCHED;
            PG8_LDB(B1, 1, 1); PG8_STAGE(PG8_SB(1, 0), b3, voffB);
            PG8_BAR; PG8_WAIT_L(0); PG8_MMA(0, 1, At, B1); PG8_BAR;
            PG8_LDA(At, 1, 1); PG8_STAGE(PG8_SA(1, 0), a3, voffA);
            PG8_BAR; PG8_WAIT_L(0); PG8_MMA(1, 0, At, B0); PG8_BAR; PG8_SCHED;
            PG8_STAGE(PG8_SB(1, 1), b3 + hstep, voffB);
            PG8_WAIT_V(6); PG8_BAR; PG8_MMA(1, 1, At, B1); PG8_BAR;
            }
        }
        if constexpr (ALIGN_EPI) { if (wr == 0) PG8_BAR; }
        if constexpr (!Epi::AFTER_DRAIN) { E(acc, cur, wr, wc, fr, fq); S.done(cur); }
        if (!has_next) break;
#pragma unroll
        for (int a = 0; a < 2; ++a)
#pragma unroll
            for (int b = 0; b < 2; ++b)
#pragma unroll
                for (int m = 0; m < 4; ++m)
#pragma unroll
                    for (int n = 0; n < 2; ++n) acc[a][b][m][n] = (f32x4){0.f, 0.f, 0.f, 0.f};
        cur = nxt; cA = nA; cB = nB; ++ui;
        if constexpr (ALIGN_EPI) { if (wr == 1) PG8_BAR; }
    }
    PG8_WAIT_V(0);
    if constexpr (!ALIGN_EPI) { if (wr == 0) PG8_BAR; }
    PG8_BAR;
    if constexpr (Epi::AFTER_DRAIN) { E.fused(acc, cur, wr, wc, fr, fq, lds, wid, lane); S.done(cur); }
#undef PG8_SA
#undef PG8_SB
#undef PG8_STAGE
#undef PG8_LDA
#undef PG8_LDB
#undef PG8_MMA
#undef PG8_WAIT_V
#undef PG8_WAIT_L
#undef PG8_BAR
#undef PG8_SCHED
}
}

#ifndef MK_N_LAUNCHES
#define MK_N_LAUNCHES 1
#endif
constexpr int N_PHASES = 5, N_LAUNCHES = MK_N_LAUNCHES;
constexpr int NWAVES = 8;
constexpr int D = 1024, NP = 8, TP = 2048, NS = 128, TS = 8, NROWP = NP * TP, NROWS = NS * TS, NTOK = NROWP + NROWS;
constexpr int DIN = 5136, DINP = 5120, DMIX = 2048, HK = 128, HV = 256, NH = 4;
constexpr int C_XL = 0, C_ZL = 1024, C_Q = 2048, C_K = 2560, C_V = 3072, C_ZG = 4096;
constexpr float EPS = 1e-6f;
constexpr size_t O_YP = 0, O_YS = 16777216, O_HP = 17825792, O_CP = 17833984, O_GP = 17858560, O_HS = 18907136, O_CS = 19038208, O_GS = 19431424, O_END = 36208640;
constexpr size_t MiB = 1u << 20;
constexpr size_t WS_CTL = 0, CTL_ZERO_BYTES = 1 * MiB;
constexpr size_t WS_WINT = 2 * MiB, WS_WOUT = 12 * MiB, WS_RGK = 16 * MiB, WS_PART = 18 * MiB, WS_DEC = 19 * MiB + 256 * 1024, WS_XN = 20 * MiB, WS_PROJ = 54 * MiB, WS_END = 224 * MiB;
static_assert(WS_DEC + (size_t)(NP * (TP / 64) + NS) * 512 * 4 <= WS_XN && WS_PART + (size_t)16 * NTOK * 4 <= WS_DEC, "d_ws map (DEC)");
static_assert(WS_WINT + (size_t)DINP * D * 2 <= WS_WOUT && WS_WOUT + (size_t)D * DMIX * 2 <= WS_RGK && WS_RGK + (size_t)NTOK * 16 * 4 <= WS_PART && WS_PART + (size_t)16 * NTOK * 4 <= WS_XN &&
              WS_XN + (size_t)NTOK * D * 2 <= WS_PROJ && WS_PROJ + (size_t)NTOK * DINP * 2 <= WS_END, "d_ws map");
constexpr int CW_BAR = 4096;
constexpr int RING_OFF = 0, RING_BYTES = 162816, LDSCTL_OFF = RING_BYTES, MISC_OFF = LDSCTL_OFF + 320, LDS_BYTES = 163840;

#define GAS __attribute__((address_space(1)))
#define LAS __attribute__((address_space(3)))
typedef unsigned short bf16;
typedef unsigned v4u __attribute__((ext_vector_type(4)));
typedef unsigned v2u __attribute__((ext_vector_type(2)));
typedef float f32x4 __attribute__((ext_vector_type(4)));
typedef GAS unsigned gu32;
#define RLX_AGENT __ATOMIC_RELAXED, __HIP_MEMORY_SCOPE_AGENT
#define LDS_WAIT() asm volatile("s_waitcnt lgkmcnt(0)" ::: "memory")
#define VM_WAIT() asm volatile("s_waitcnt vmcnt(0)" ::: "memory")
__device__ __forceinline__ unsigned f2bf(float f) { unsigned u = __builtin_bit_cast(unsigned, f); return (u + 0x7fffu + ((u >> 16) & 1u)) >> 16; }
__device__ __forceinline__ unsigned pk2(float lo, float hi) { return f2bf(lo) | (f2bf(hi) << 16); }
__device__ __forceinline__ float bf2f(unsigned b) { return __builtin_bit_cast(float, b << 16); }
__device__ __forceinline__ float bflo(unsigned w) { return __builtin_bit_cast(float, w << 16); }
__device__ __forceinline__ float bfhi(unsigned w) { return __builtin_bit_cast(float, w & 0xffff0000u); }
__device__ __forceinline__ float sigmoidf_(float x) { return 1.f / (1.f + __expf(-x)); }
__device__ __forceinline__ float logsigf_(float x) { return fminf(x, 0.f) - log1pf(__expf(-fabsf(x))); }
#define XB_TMO      128
#define XB_XCNT(j)  (256  + 64 * (j))
#define XB_XSUB(j)  (1280 + 64 * (j))
#define XB_XGEN(j)  (2304 + 64 * (j))
#define XB_TOP      3328
#define XB_TOPGEN   3392
#define XCD_BAR_WORDS 3456
#define XB_SPIN_CAP (1u << 18)

__device__ __forceinline__ unsigned xb_ld(unsigned* p)              { return __hip_atomic_load(p, __ATOMIC_RELAXED, __HIP_MEMORY_SCOPE_AGENT); }
__device__ __forceinline__ unsigned xb_add(unsigned* p, unsigned v) { return __hip_atomic_fetch_add(p, v, __ATOMIC_RELAXED, __HIP_MEMORY_SCOPE_AGENT); }
__device__ __forceinline__ unsigned xb_xcc_id() { return (unsigned)__builtin_amdgcn_s_getreg((3 << 11) | 20) & 0xFu; }
#define XB_SPIN(cond, bar) do { unsigned _sp = 0; while (cond) { __builtin_amdgcn_s_sleep(1); \
    if ((++_sp & 255u) == 0u) { if (xb_ld(&(bar)[XB_TMO])) break; if (_sp > XB_SPIN_CAP) { atomicAdd(&(bar)[XB_TMO], 1u); break; } } } } while (0)

struct XcdBarrier {
    unsigned* bar; unsigned x;
    volatile LAS unsigned* st;
};

__device__ __forceinline__ XcdBarrier xcd_barrier_post(unsigned* bar, volatile LAS unsigned* st) {
    XcdBarrier b; b.bar = bar; b.x = xb_xcc_id(); b.st = st;
    if (threadIdx.x == 0) (void)xb_add(&bar[XB_XCNT(b.x)], 1u);
    return b;
}
__device__ __forceinline__ void xcd_barrier_complete(unsigned* bar, unsigned x, unsigned& nloc, unsigned& nx) {
    const unsigned G = gridDim.x * gridDim.y * gridDim.z;
    unsigned sum, cnt, mine, sp = 0u;
    for (;;) {
        sum = 0u; cnt = 0u; mine = 0u;
#pragma unroll
        for (unsigned j = 0; j < 16; ++j) { const unsigned c = xb_ld(&bar[XB_XCNT(j)]); sum += c; cnt += (c > 0u) ? 1u : 0u; mine = (j == x) ? c : mine; }
        if (sum == G) break;
        __builtin_amdgcn_s_sleep(1);
        if ((++sp & 255u) == 0u) { if (xb_ld(&bar[XB_TMO])) break; if (sp > XB_SPIN_CAP) { atomicAdd(&bar[XB_TMO], 1u); break; } }
    }
    nloc = mine > 0u ? mine : 1u; nx = cnt > 0u ? cnt : 1u;
}

__device__ __forceinline__ void xcd_barrier(const XcdBarrier& b) {
    asm volatile("s_waitcnt vmcnt(0)" ::: "memory");
    __syncthreads();
    if (threadIdx.x == 0) {
        unsigned* bar = b.bar;
        __builtin_amdgcn_s_waitcnt(0);
        unsigned nloc = b.st[0], nx = b.st[1];
        if (nloc == 0u) { xcd_barrier_complete(bar, b.x, nloc, nx); b.st[0] = nloc; b.st[1] = nx; }
        const unsigned old = xb_add(&bar[XB_XSUB(b.x)], 1u);
        const unsigned gen = old / nloc;
        if (old + 1u == (gen + 1u) * nloc) {
            __builtin_amdgcn_fence(__ATOMIC_RELEASE, "agent");
            asm volatile("s_waitcnt vmcnt(0)" ::: "memory");
            const unsigned og = xb_add(&bar[XB_TOP], 1u);
            const unsigned tg = og / nx;
            if (og + 1u == (tg + 1u) * nx) xb_add(&bar[XB_TOPGEN], 1u);
            else XB_SPIN(xb_ld(&bar[XB_TOPGEN]) == tg, bar);
            __builtin_amdgcn_fence(__ATOMIC_ACQUIRE, "agent");
            xb_add(&bar[XB_XGEN(b.x)], 1u);
            asm volatile("s_waitcnt vmcnt(0)" ::: "memory");
        } else {
            XB_SPIN(xb_ld(&bar[XB_XGEN(b.x)]) == gen, bar);
            __builtin_amdgcn_fence(__ATOMIC_ACQUIRE, "agent");
            asm volatile("s_waitcnt vmcnt(0)" ::: "memory");
        }
    }
    __syncthreads();
}

struct Frame {
    LAS unsigned char* lds;
    volatile LAS unsigned* MISC;
    gu32* ctl;
    int tid, lane, wave, vcu, G;
    const float *xp, *xs, *st_h, *st_conv, *st_gla, *g_pre, *w_in, *conv_w, *conv_b, *w_rg, *b_rg, *w_ig, *b_ig, *lam, *w_gk2, *b_gk, *g_head, *w_out, *g_post;
    float* out;
    bf16 *WinT, *WoutT, *XN, *PROJ, *YMIX, *YBF;
    float *RGK, *PART, *BCUM, *DEC, *PSS;
};
__device__ __forceinline__ float wave_sum(float v) {
#pragma unroll
    for (int o = 1; o < 64; o <<= 1) v += __shfl_xor(v, o);
    return v;
}

__device__ __forceinline__ void p0_transpose_item(const float* W, int ldw, int K, int nblk, bf16* WT, LAS float* scr, int item, int lane) {
    const int kb = item / nblk, nb = item % nblk, k0 = 64 * kb, n0 = 32 * nb;
#pragma unroll 8
    for (int i = 0; i < 32; ++i) { const int kk = 2 * i + (lane >> 5); scr[kk * 33 + (lane & 31)] = W[(size_t)(k0 + kk) * ldw + n0 + (lane & 31)]; }
    LDS_WAIT(); asm volatile("" ::: "memory");
    const int c = lane & 7;
#pragma unroll
    for (int j = 0; j < 4; ++j) { const int n = (lane >> 3) + 8 * j; const LAS float* s = scr + (8 * c) * 33 + n;
        v4u o; o.x = pk2(s[0 * 33], s[1 * 33]); o.y = pk2(s[2 * 33], s[3 * 33]); o.z = pk2(s[4 * 33], s[5 * 33]); o.w = pk2(s[6 * 33], s[7 * 33]);
        *(GAS v4u*)(WT + (size_t)(n0 + n) * K + k0 + 8 * c) = o; }
    LDS_WAIT(); asm volatile("" ::: "memory");
}
__device__ __forceinline__ void p0_row(const Frame& F, int r, const LAS float* wrt, LAS float* rgrow) {
    const float* xrow = r < NROWP ? F.xp + (size_t)r * D : F.xs + (size_t)(r - NROWP) * D;
    const GAS f32x4* xr = (const GAS f32x4*)xrow + F.lane;
    const GAS f32x4* gp = (const GAS f32x4*)F.g_pre + F.lane;
    f32x4 v[4]; float s = 0.f;
#pragma unroll
    for (int j = 0; j < 4; ++j) { v[j] = xr[64 * j]; s += (v[j].x * v[j].x + v[j].y * v[j].y) + (v[j].z * v[j].z + v[j].w * v[j].w); }
    const float rs = rsqrtf(wave_sum(s) * (1.f / D) + EPS);
#pragma unroll
    for (int j = 0; j < 4; ++j) v[j] = v[j] * rs * gp[64 * j];
    GAS unsigned long long* o8 = (GAS unsigned long long*)(F.XN + (size_t)r * D) + F.lane;
#pragma unroll
    for (int j = 0; j < 4; ++j) o8[64 * j] = (unsigned long long)pk2(v[j].x, v[j].y) | ((unsigned long long)pk2(v[j].z, v[j].w) << 32);
    float p[16];
#pragma unroll
    for (int jj = 0; jj < 16; ++jj) { float a = 0.f;
#pragma unroll
        for (int j = 0; j < 4; ++j) { const f32x4 w = *(const LAS f32x4*)(wrt + jj * 1024 + 256 * j + 4 * F.lane); a += (v[j].x * w.x + v[j].y * w.y) + (v[j].z * w.z + v[j].w * w.w); }
        p[jj] = a; if ((jj & 3) == 3) asm volatile("" ::: "memory"); }
    const bool b5 = F.lane & 32, b4 = F.lane & 16, b3 = F.lane & 8, b2 = F.lane & 4;
    float q8[8], q4[4], q2[2], q1;
#pragma unroll
    for (int i = 0; i < 8; ++i) { const float send = b5 ? p[i] : p[i + 8], keep = b5 ? p[i + 8] : p[i]; q8[i] = keep + __shfl_xor(send, 32); }
#pragma unroll
    for (int i = 0; i < 4; ++i) { const float send = b4 ? q8[i] : q8[i + 4], keep = b4 ? q8[i + 4] : q8[i]; q4[i] = keep + __shfl_xor(send, 16); }
#pragma unroll
    for (int i = 0; i < 2; ++i) { const float send = b3 ? q4[i] : q4[i + 2], keep = b3 ? q4[i + 2] : q4[i]; q2[i] = keep + __shfl_xor(send, 8); }
    { const float send = b2 ? q2[0] : q2[1], keep = b2 ? q2[1] : q2[0]; q1 = keep + __shfl_xor(send, 4); }
    q1 += __shfl_xor(q1, 2); q1 += __shfl_xor(q1, 1);
    if ((F.lane & 3) == 0) rgrow[F.lane >> 2] = q1;
}
__device__ __forceinline__ void p0_prologue(Frame& F) {
    LAS float* scr = (LAS float*)(F.lds + RING_OFF + F.wave * 16384);
    const int gw = F.vcu * NWAVES + F.wave, NGW = F.G * NWAVES;
    constexpr int I_IN = (D / 64) * (DINP / 32), I_OUT = (DMIX / 64) * (D / 32);
    for (int it = gw; it < I_IN + I_OUT; it += NGW) {
        if (it < I_IN) p0_transpose_item(F.w_in, DIN, D, DINP / 32, F.WinT, scr, it, F.lane);
        else p0_transpose_item(F.w_out, D, DMIX, D / 32, F.WoutT, scr, it - I_IN, F.lane);
    }
    __syncthreads();
    LAS float* wrt = (LAS float*)(F.lds + RING_OFF);
    for (int idx = F.tid; idx < 16 * 1024; idx += NWAVES * 64) { const int k = idx >> 4, j = idx & 15; wrt[j * 1024 + k] = F.w_in[(size_t)k * DIN + DINP + j]; }
    __syncthreads();
    LAS float* rgl = (LAS float*)(F.lds + RING_OFF + 65536);
    float w2[16];
#pragma unroll
    for (int j = 0; j < 16; ++j) w2[j] = F.w_gk2[j * 512 + F.tid];
    const float bg = F.b_gk[F.tid];
    for (int it = F.vcu; it < NP * (TP / 64) + NS; it += F.G) {
        const int nrow = it < NP * (TP / 64) ? 64 : TS; const int r0 = it < NP * (TP / 64) ? it * 64 : NROWP + (it - NP * (TP / 64)) * TS;
        for (int r = F.wave; r < nrow; r += NWAVES) p0_row(F, r0 + r, wrt, rgl + r * 16);
        __syncthreads();
        float cum = 0.f;
        for (int t = 0; t < nrow; ++t) { float z = bg;
#pragma unroll
            for (int j4 = 0; j4 < 4; ++j4) { const f32x4 rg = *(const LAS f32x4*)(rgl + t * 16 + 4 * j4); z += (rg.x * w2[4 * j4] + rg.y * w2[4 * j4 + 1]) + (rg.z * w2[4 * j4 + 2] + rg.w * w2[4 * j4 + 3]); }
            cum += logsigf_(z) * (1.f / 16.f);
            F.BCUM[(size_t)(r0 + t) * 512 + F.tid] = cum; }
        F.DEC[(size_t)it * 512 + F.tid] = __expf(cum);
        __syncthreads();
    }
}

__device__ __forceinline__ float rdlane(float v, int l) { return __builtin_bit_cast(float, __builtin_amdgcn_readlane(__builtin_bit_cast(int, v), l)); }
__device__ __forceinline__ void lru_simple_item(const Frame& F, int kind, int seq, int nb) {
    const int lane = F.lane, c = nb * 64 + lane;
    const int T = kind ? TS : TP; const size_t row0 = kind ? (size_t)NROWP + (size_t)seq * TS : (size_t)seq * TP;
    float wrg[64], wig[64];
#pragma unroll
    for (int d = 0; d < 64; ++d) { wrg[d] = F.w_rg[(size_t)(nb * 64 + d) * 64 + lane]; wig[d] = F.w_ig[(size_t)(nb * 64 + d) * 64 + lane]; }
    const float brg = F.b_rg[c], big = F.b_ig[c], cb = F.conv_b[c], cw0 = F.conv_w[c], cw1 = F.conv_w[1024 + c], cw2 = F.conv_w[2048 + c], cw3 = F.conv_w[3072 + c];
    const float c8 = 8.f * logsigf_(F.lam[c]);
    float h = kind ? F.st_h[(size_t)seq * 1024 + c] : 0.f;
    float xm3 = kind ? F.st_conv[((size_t)seq * 3 + 0) * 1024 + c] : 0.f, xm2 = kind ? F.st_conv[((size_t)seq * 3 + 1) * 1024 + c] : 0.f, xm1 = kind ? F.st_conv[((size_t)seq * 3 + 2) * 1024 + c] : 0.f;
    for (int t0 = 0; t0 < T; t0 += 8) {
        float xv[8], zv[8];
#pragma unroll
        for (int i = 0; i < 8; ++i) { const bf16* pr = F.PROJ + (row0 + t0 + i) * DINP; xv[i] = bf2f(pr[C_XL + c]); zv[i] = bf2f(pr[C_ZL + c]); }
#pragma unroll 1
        for (int i = 0; i < 8; ++i) {
            const float x = xv[i]; const float xc = cb + cw0 * xm3 + cw1 * xm2 + cw2 * xm1 + cw3 * x; xm3 = xm2; xm2 = xm1; xm1 = x;
            float ar = brg, ai = big;
#pragma unroll
            for (int d = 0; d < 64; ++d) { const float xd = rdlane(xc, d); ar += xd * wrg[d]; ai += xd * wig[d]; }
            const float r = sigmoidf_(ar), ig = sigmoidf_(ai);
            const float la = c8 * r, a = __expf(la), u = sqrtf(-expm1f(2.f * la)) * (ig * xc);
            h = a * h + u;
            const float z = zv[i], y = h * z * sigmoidf_(z);
            F.YMIX[(row0 + t0 + i) * DMIX + c] = (bf16)f2bf(y);
        }
    }
    float* ho = F.out + (kind ? O_HS : O_HP) + (size_t)seq * 1024 + c; *ho = h;
    float* co = F.out + (kind ? O_CS : O_CP) + (size_t)seq * 3 * 1024 + c; co[0] = xm3; co[1024] = xm2; co[2048] = xm1;
}
__device__ __forceinline__ void gla_simple_item(const Frame& F, int kind, int seq, int h, int hsel) {
    int t2 = F.tid & 255; asm volatile("" : "+v"(t2)); const int w4 = t2 >> 6;
    const int T = kind ? TS : TP; const size_t row0 = kind ? (size_t)NROWP + (size_t)seq * TS : (size_t)seq * TP;
    LAS float* L = (LAS float*)(F.lds + RING_OFF + hsel * 4096);
    LAS float* al = L, *qs = L + 128, *ks = L + 256, *red = L + 384;
    float S[128];
    const float* s0 = F.st_gla + (((size_t)seq * NH + h) * HK) * HV + t2;
#pragma unroll
    for (int d = 0; d < 128; ++d) S[d] = kind ? s0[(size_t)d * HV] : 0.f;
    const float gh = F.g_head[t2];
    for (int t = 0; t < T; ++t) {
        const size_t row = row0 + t; const bf16* pr = F.PROJ + row * DINP;
        if (t2 < 128) { const bool cbeg = kind ? false : ((t & 63) == 0 && t > 0); const size_t ci = (size_t)(seq * (TP / 64) + (t >> 6) - 1);
            al[t2] = cbeg ? F.DEC[ci * 512 + h * 128 + t2] : 1.f; qs[t2] = bf2f(pr[C_Q + h * 128 + t2]); ks[t2] = bf2f(pr[C_K + h * 128 + t2]); }
        const float vv = bf2f(pr[C_V + h * 256 + t2]), zz = bf2f(pr[C_ZG + h * 256 + t2]);
        __syncthreads();
        float o = 0.f;
#pragma unroll
        for (int d4 = 0; d4 < 32; ++d4) { const f32x4 a4 = *(const LAS f32x4*)(al + 4 * d4), k4 = *(const LAS f32x4*)(ks + 4 * d4), q4 = *(const LAS f32x4*)(qs + 4 * d4);
            S[4 * d4 + 0] = a4.x * S[4 * d4 + 0] + k4.x * vv; o += q4.x * S[4 * d4 + 0];
            S[4 * d4 + 1] = a4.y * S[4 * d4 + 1] + k4.y * vv; o += q4.y * S[4 * d4 + 1];
            S[4 * d4 + 2] = a4.z * S[4 * d4 + 2] + k4.z * vv; o += q4.z * S[4 * d4 + 2];
            S[4 * d4 + 3] = a4.w * S[4 * d4 + 3] + k4.w * vv; o += q4.w * S[4 * d4 + 3]; }
        const float ss = wave_sum(o * o);
        if (F.lane == 0) red[w4] = ss;
        __syncthreads();
        const float tot = (red[0] + red[1]) + (red[2] + red[3]);
        const float rs = rsqrtf(tot * (1.f / 256.f) + EPS);
        const float y = o * rs * gh * (zz * sigmoidf_(zz));
        F.YMIX[row * DMIX + 1024 + h * 256 + t2] = (bf16)f2bf(y);
        __syncthreads();
    }
    if (t2 < 128) al[t2] = F.DEC[(kind ? (size_t)(NP * (TP / 64) + seq) : (size_t)(seq * (TP / 64) + TP / 64 - 1)) * 512 + h * 128 + t2];
    __syncthreads();
    float* so = F.out + (kind ? O_GS : O_GP) + (((size_t)seq * NH + h) * HK) * HV + t2;
#pragma unroll
    for (int d = 0; d < 128; ++d) so[(size_t)d * HV] = S[d] * al[d];
    __syncthreads();
}


typedef short bf16x8_t __attribute__((ext_vector_type(8)));
typedef float f32x16 __attribute__((ext_vector_type(16)));
constexpr int LRU_XL_ROWS = 44;
constexpr int LRU_XL_OFF = 0, LRU_XL_WB = LRU_XL_ROWS * 128;
constexpr int LRU_ZL_OFF = LRU_XL_OFF + 8 * LRU_XL_WB, LRU_ZL_WB = 32 * 128;
constexpr int LRU_XC_OFF = LRU_ZL_OFF + 8 * LRU_ZL_WB, LRU_XC_WB = 32 * 144;
constexpr int LRU_SL_OFF = LRU_XC_OFF + 8 * LRU_XC_WB;
constexpr int LRU_HC_OFF = LRU_SL_OFF + 2 * 8 * 2 * 64 * 4;
constexpr int LRU_WG_OFF = LRU_HC_OFF + 2 * 64 * 4;
constexpr int LRU_END = LRU_WG_OFF + 128 * 144;
static_assert(LRU_END <= RING_BYTES, "LRU LDS map");
#define L2E 1.4426950408889634f
template <int KIND>
__device__ __forceinline__ void lru_item(const Frame& F, int sg, int nb) {
    int lane = F.lane; asm volatile("" : "+v"(lane));
    const int wave = F.wave, cl = lane & 31, hh = lane >> 5;
    LAS unsigned char* XLw = F.lds + RING_OFF + LRU_XL_OFF + wave * LRU_XL_WB;
    LAS unsigned char* ZLw = F.lds + RING_OFF + LRU_ZL_OFF + wave * LRU_ZL_WB;
    LAS unsigned char* XCw = F.lds + RING_OFF + LRU_XC_OFF + wave * LRU_XC_WB;
    LAS float* SL = (LAS float*)(F.lds + RING_OFF + LRU_SL_OFF);
    LAS float* HC = (LAS float*)(F.lds + RING_OFF + LRU_HC_OFF);
    LAS unsigned char* WGl = F.lds + RING_OFF + LRU_WG_OFF;
    __syncthreads();
    { const int col = F.tid & 127, kq = F.tid >> 7; const float* W = ((col >> 6) ? F.w_ig : F.w_rg) + (size_t)nb * 4096 + (size_t)(16 * kq) * 64 + (col & 63);
      v4u p0, p1;
      p0.x = pk2(-L2E * W[0 * 64], -L2E * W[1 * 64]); p0.y = pk2(-L2E * W[2 * 64], -L2E * W[3 * 64]); p0.z = pk2(-L2E * W[4 * 64], -L2E * W[5 * 64]); p0.w = pk2(-L2E * W[6 * 64], -L2E * W[7 * 64]);
      p1.x = pk2(-L2E * W[8 * 64], -L2E * W[9 * 64]); p1.y = pk2(-L2E * W[10 * 64], -L2E * W[11 * 64]); p1.z = pk2(-L2E * W[12 * 64], -L2E * W[13 * 64]); p1.w = pk2(-L2E * W[14 * 64], -L2E * W[15 * 64]);
      *(LAS v4u*)(WGl + col * 144 + (16 * kq) * 2) = p0; *(LAS v4u*)(WGl + col * 144 + (16 * kq + 8) * 2) = p1; }
    constexpr int NR = KIND ? 1 : 8;
    const size_t rowbase = KIND ? (size_t)NROWP + (size_t)sg * 256 : (size_t)sg * TP;
    if (KIND == 0) { if (F.tid < 64) HC[F.tid] = 0.f; }
    for (int r = 0; r < NR; ++r) {
        const int par = r & 1;
        const size_t srow = rowbase + (size_t)r * 256 + wave * 32;
        __syncthreads();
        if (KIND == 0) {
#pragma unroll
            for (int q = 0; q < 5; ++q) { const int p = lane + 64 * q; const int row = p >> 3, pc = p & 7;
                if (row < 35) { const long tok = (long)r * 256 + wave * 32 + row - 3; v4u v = (v4u){0u, 0u, 0u, 0u};
                    if (tok >= 0) v = *(const GAS v4u*)(F.PROJ + (rowbase + tok) * DINP + C_XL + nb * 64 + pc * 8);
                    *(LAS v4u*)(XLw + row * 128 + pc * 16) = v; } }
        } else {
#pragma unroll
            for (int q = 0; q < 6; ++q) { const int p = lane + 64 * q; const int row = p >> 3, pc = p & 7;
                if (row < 44) { const int sq = row / 11, rr = row - sq * 11; const int seq = sg * 32 + wave * 4 + sq; v4u v;
                    if (rr < 3) { const float* sp = F.st_conv + ((size_t)seq * 3 + rr) * 1024 + nb * 64 + pc * 8; const f32x4 a = *(const GAS f32x4*)sp, b = *(const GAS f32x4*)(sp + 4);
                        v.x = pk2(a.x, a.y); v.y = pk2(a.z, a.w); v.z = pk2(b.x, b.y); v.w = pk2(b.z, b.w); }
                    else v = *(const GAS v4u*)(F.PROJ + ((size_t)NROWP + (size_t)seq * 8 + rr - 3) * DINP + C_XL + nb * 64 + pc * 8);
                    *(LAS v4u*)(XLw + row * 128 + pc * 16) = v; } }
        }
#pragma unroll
        for (int q = 0; q < 4; ++q) { const int p = lane + 64 * q; const int row = p >> 3, pc = p & 7;
            *(LAS v4u*)(ZLw + row * 128 + pc * 16) = *(const GAS v4u*)(F.PROJ + (srow + row) * DINP + C_ZL + nb * 64 + pc * 8); }
#pragma unroll
        for (int ct = 0; ct < 2; ++ct) {
            const int cg = nb * 64 + 32 * ct + cl; float cw[4]; const float cb = F.conv_b[cg];
#pragma unroll
            for (int j = 0; j < 4; ++j) cw[j] = F.conv_w[j * 1024 + cg];
            const LAS unsigned short* xl = (const LAS unsigned short*)XLw + 32 * ct + cl;
#pragma unroll
            for (int g = 0; g < 4; ++g) { const int rb = KIND ? g * 11 + 4 * hh : 8 * g + 4 * hh; float xr[7];
#pragma unroll
                for (int e = 0; e < 7; ++e) xr[e] = bf2f(xl[(rb + e) * 64]);
#pragma unroll
                for (int e = 0; e < 4; ++e) { const float v = cb + cw[0] * xr[e] + cw[1] * xr[e + 1] + cw[2] * xr[e + 2] + cw[3] * xr[e + 3];
                    *(LAS unsigned short*)(XCw + (8 * g + 4 * hh + e) * 144 + (32 * ct + cl) * 2) = (unsigned short)f2bf(v); } }
        }
        asm volatile("" ::: "memory");
        bf16x8_t Af[4];
#pragma unroll
        for (int s = 0; s < 4; ++s) Af[s] = *(const LAS bf16x8_t*)(XCw + cl * 144 + (16 * s + 8 * hh) * 2);
        float At_[2], Ut_[2];
        float Aloc[2][16], Hloc[2][16], AGk[2][4], UGk[2][4];
#pragma unroll
        for (int ct = 0; ct < 2; ++ct) {
            f32x16 ar, ai; const int cg = nb * 64 + 32 * ct + cl;
            const float brg = -L2E * F.b_rg[cg], big = -L2E * F.b_ig[cg], c8 = 8.f * L2E * logsigf_(F.lam[cg]);
#pragma unroll
            for (int i = 0; i < 16; ++i) { ar[i] = brg; ai[i] = big; }
#pragma unroll
            for (int s = 0; s < 4; ++s) {
                const bf16x8_t b0 = *(const LAS bf16x8_t*)(WGl + (32 * ct + cl) * 144 + (16 * s + 8 * hh) * 2), b1 = *(const LAS bf16x8_t*)(WGl + (64 + 32 * ct + cl) * 144 + (16 * s + 8 * hh) * 2);
                ar = __builtin_amdgcn_mfma_f32_32x32x16_bf16(Af[s], b0, ar, 0, 0, 0); ai = __builtin_amdgcn_mfma_f32_32x32x16_bf16(Af[s], b1, ai, 0, 0, 0); }
            float AG[4], UG[4];
#pragma unroll
            for (int g = 0; g < 4; ++g) { float Ap = 1.f, Hp = 0.f;
#pragma unroll
                for (int e = 0; e < 4; ++e) { const int i = 4 * g + e;
                    const float rr = __builtin_amdgcn_rcpf(1.f + __builtin_amdgcn_exp2f(ar[i])), ig = __builtin_amdgcn_rcpf(1.f + __builtin_amdgcn_exp2f(ai[i]));
                    const float a = __builtin_amdgcn_exp2f(c8 * rr);
                    const float xcv = bf2f(*(const LAS unsigned short*)(XCw + (8 * g + 4 * hh + e) * 144 + (32 * ct + cl) * 2));
                    const float u = __builtin_amdgcn_sqrtf(fmaxf(1.f - a * a, 0.f)) * (ig * xcv);
                    Hp = a * Hp + u; Ap = a * Ap; Aloc[ct][i] = Ap; Hloc[ct][i] = Hp; }
                AG[g] = Ap; UG[g] = Hp; }
            float At = 1.f, Ut = 0.f;
#pragma unroll
            for (int g = 0; g < 4; ++g) { const float pA = __shfl_xor(AG[g], 32), pU = __shfl_xor(UG[g], 32);
                const float a0 = hh ? pA : AG[g], u0 = hh ? pU : UG[g], a1 = hh ? AG[g] : pA, u1 = hh ? UG[g] : pU;
                Ut = a0 * Ut + u0; At = a0 * At; Ut = a1 * Ut + u1; At = a1 * At; AGk[ct][g] = AG[g]; UGk[ct][g] = UG[g]; }
            At_[ct] = At; Ut_[ct] = Ut;
            asm volatile("" ::: "memory");
        }
        float hin[2] = {0.f, 0.f};
        if (KIND == 0) {
            if (hh == 0) {
#pragma unroll
                for (int ct = 0; ct < 2; ++ct) { SL[((par * 8 + wave) * 2 + 0) * 64 + 32 * ct + cl] = At_[ct]; SL[((par * 8 + wave) * 2 + 1) * 64 + 32 * ct + cl] = Ut_[ct]; } }
            __syncthreads();
#pragma unroll
            for (int ct = 0; ct < 2; ++ct) { float hs = HC[par * 64 + 32 * ct + cl];
                for (int w2 = 0; w2 < wave; ++w2) hs = SL[((par * 8 + w2) * 2 + 0) * 64 + 32 * ct + cl] * hs + SL[((par * 8 + w2) * 2 + 1) * 64 + 32 * ct + cl];
                hin[ct] = hs;
                if (wave == 7 && hh == 0) HC[(par ^ 1) * 64 + 32 * ct + cl] = At_[ct] * hs + Ut_[ct]; }
        }
#pragma unroll
        for (int ct = 0; ct < 2; ++ct) {
            float hst[4]; float hs = hin[ct];
#pragma unroll
            for (int g = 0; g < 4; ++g) { const float pA = __shfl_xor(AGk[ct][g], 32), pU = __shfl_xor(UGk[ct][g], 32);
                const float a0 = hh ? pA : AGk[ct][g], u0 = hh ? pU : UGk[ct][g], a1 = hh ? AGk[ct][g] : pA, u1 = hh ? UGk[ct][g] : pU;
                if (KIND == 1) hs = F.st_h[(size_t)(sg * 32 + wave * 4 + g) * 1024 + nb * 64 + 32 * ct + cl];
                const float hs0 = hs; hs = a0 * hs + u0;
                hst[g] = hh ? hs : hs0; hs = a1 * hs + u1;
                if (KIND == 1 && hh == 0) F.out[O_HS + (size_t)(sg * 32 + wave * 4 + g) * 1024 + nb * 64 + 32 * ct + cl] = hs;
            }
            if (KIND == 0 && r == NR - 1 && wave == 7 && hh == 0) F.out[O_HP + (size_t)sg * 1024 + nb * 64 + 32 * ct + cl] = hs;
            LAS unsigned short* zl = (LAS unsigned short*)ZLw + 32 * ct + cl;
#pragma unroll
            for (int i = 0; i < 16; ++i) { const int ti = (i & 3) + 8 * (i >> 2) + 4 * hh;
                const float hv = Aloc[ct][i] * hst[i >> 2] + Hloc[ct][i];
                const float z = bf2f(zl[ti * 64]);
                const float y = hv * z * __builtin_amdgcn_rcpf(1.f + __builtin_amdgcn_exp2f(-L2E * z));
                zl[ti * 64] = (unsigned short)f2bf(y); }
        }
#pragma unroll
        for (int q = 0; q < 4; ++q) { const int p = lane + 64 * q; const int row = p >> 3, pc = p & 7;
            *(GAS v4u*)(F.YMIX + (srow + row) * DMIX + nb * 64 + pc * 8) = *(const LAS v4u*)(ZLw + row * 128 + pc * 16); }
        if (KIND == 0) {
            if (r == NR - 1 && wave == 7) { for (int e = lane; e < 192; e += 64) { const int j = e >> 6, c = e & 63;
                F.out[O_CP + ((size_t)sg * 3 + j) * 1024 + nb * 64 + c] = bf2f(((const LAS unsigned short*)XLw)[(32 + j) * 64 + c]); } }
        } else {
            for (int e = lane; e < 4 * 192; e += 64) { const int sq = e / 192, j = (e % 192) >> 6, c = e & 63;
                F.out[O_CS + ((size_t)(sg * 32 + wave * 4 + sq) * 3 + j) * 1024 + nb * 64 + c] = bf2f(((const LAS unsigned short*)XLw)[(sq * 11 + 8 + j) * 64 + c]); }
        }
    }
    __syncthreads();
}


constexpr int GL_QT = 0, GL_KT = 17408, GL_KTT = 34816, GL_VT = 53248, GL_AT = 62464, GL_SBT = 71680, GL_OP = 89088, GL_END = 105472;
static_assert(GL_END <= RING_BYTES, "GLA LDS map");
__device__ __forceinline__ void gla_item(const Frame& F, int b, int h, int vs) {
    int tid = F.tid; asm volatile("" : "+v"(tid));
    const int lane = tid & 63, wave = F.wave, cl = lane & 31, hh = lane >> 5;
    LAS unsigned char* L = F.lds + RING_OFF;
    const int tokc = tid & 63;
    const int dt = wave >> 1, vt = wave & 1;
    const int ovt = wave & 1, oct = (wave >> 1) & 1, ohalf = wave >> 2;
    const size_t row0 = (size_t)b * TP;
    f32x16 Sacc;
#pragma unroll
    for (int i = 0; i < 16; ++i) Sacc[i] = 0.f;
    v4u pq[2], pk[2], pv; v2u zn[4], zc[4]; f32x4 dn[4], dc[4];
    float gh[16];
#pragma unroll
    for (int i = 0; i < 16; ++i) gh[i] = F.g_head[vs * 64 + 32 * ovt + (i & 3) + 8 * (i >> 2) + 4 * hh];
#define GL_LOAD(n) do { const bf16* pr = F.PROJ + (row0 + (size_t)(n) * 64 + tokc) * DINP; \
        pq[0] = *(const GAS v4u*)(pr + C_Q + h * 128 + wave * 8); pq[1] = *(const GAS v4u*)(pr + C_Q + h * 128 + (wave + 8) * 8); \
        pk[0] = *(const GAS v4u*)(pr + C_K + h * 128 + wave * 8); pk[1] = *(const GAS v4u*)(pr + C_K + h * 128 + (wave + 8) * 8); \
        pv = *(const GAS v4u*)(pr + C_V + h * 256 + vs * 64 + wave * 8); \
        const bf16* zr = F.PROJ + (row0 + (size_t)(n) * 64 + 32 * oct + cl) * DINP + C_ZG + h * 256 + vs * 64 + 32 * ovt + 4 * hh; \
        _Pragma("unroll") for (int g = 0; g < 4; ++g) zn[g] = *(const GAS v2u*)(zr + 8 * g); \
        const float* dp = F.DEC + ((size_t)(b * (TP / 64) + (n))) * 512 + h * 128 + 32 * dt + 4 * hh; \
        _Pragma("unroll") for (int g = 0; g < 4; ++g) dn[g] = *(const GAS f32x4*)(dp + 8 * g); } while (0)
#define GL_PUT16(base, stride, r0, W4_) do { \
        *(LAS unsigned short*)((base) + ((r0) + 0) * (stride) + 2 * tokc) = (unsigned short)((W4_).x); *(LAS unsigned short*)((base) + ((r0) + 1) * (stride) + 2 * tokc) = (unsigned short)((W4_).x >> 16); \
        *(LAS unsigned short*)((base) + ((r0) + 2) * (stride) + 2 * tokc) = (unsigned short)((W4_).y); *(LAS unsigned short*)((base) + ((r0) + 3) * (stride) + 2 * tokc) = (unsigned short)((W4_).y >> 16); \
        *(LAS unsigned short*)((base) + ((r0) + 4) * (stride) + 2 * tokc) = (unsigned short)((W4_).z); *(LAS unsigned short*)((base) + ((r0) + 5) * (stride) + 2 * tokc) = (unsigned short)((W4_).z >> 16); \
        *(LAS unsigned short*)((base) + ((r0) + 6) * (stride) + 2 * tokc) = (unsigned short)((W4_).w); *(LAS unsigned short*)((base) + ((r0) + 7) * (stride) + 2 * tokc) = (unsigned short)((W4_).w >> 16); } while (0)
#define GL_STAGE() do { \
        *(LAS v4u*)(L + GL_QT + tokc * 272 + wave * 16) = pq[0]; *(LAS v4u*)(L + GL_QT + tokc * 272 + (wave + 8) * 16) = pq[1]; \
        *(LAS v4u*)(L + GL_KT + tokc * 272 + wave * 16) = pk[0]; *(LAS v4u*)(L + GL_KT + tokc * 272 + (wave + 8) * 16) = pk[1]; \
        GL_PUT16(L + GL_KTT, 144, 8 * wave, pk[0]); GL_PUT16(L + GL_KTT, 144, 8 * (wave + 8), pk[1]); GL_PUT16(L + GL_VT, 144, 8 * wave, pv); \
        _Pragma("unroll") for (int g = 0; g < 4; ++g) { zc[g] = zn[g]; dc[g] = dn[g]; } } while (0)
#define GL_FRAG(base, stride, row, ks) (*(const LAS bf16x8_t*)((base) + (row) * (stride) + (16 * (ks) + 8 * hh) * 2))
#define GL_UPD() do { _Pragma("unroll") for (int ks = 0; ks < 4; ++ks) \
            Sacc = __builtin_amdgcn_mfma_f32_32x32x16_bf16(GL_FRAG(L + GL_KTT, 144, 32 * dt + cl, ks), GL_FRAG(L + GL_VT, 144, 32 * vt + cl, ks), Sacc, 0, 0, 0); \
        _Pragma("unroll") for (int i = 0; i < 16; ++i) Sacc[i] *= dc[i >> 2][i & 3]; } while (0)
    __syncthreads();
    GL_LOAD(0); GL_STAGE(); GL_LOAD(1);
    for (int n = 0; n < TP / 64; ++n) {
        __syncthreads();
#pragma unroll
        for (int g = 0; g < 4; ++g) { v2u w; w.x = pk2(Sacc[4 * g], Sacc[4 * g + 1]); w.y = pk2(Sacc[4 * g + 2], Sacc[4 * g + 3]);
            *(LAS v2u*)(L + GL_SBT + (32 * vt + cl) * 272 + (32 * dt + 8 * g + 4 * hh) * 2) = w; }
        if (wave < 3) {
            const int st = wave >> 1, ct = (wave + 1) >> 1;
            f32x16 a;
#pragma unroll
            for (int i = 0; i < 16; ++i) a[i] = 0.f;
#pragma unroll
            for (int ks = 0; ks < 8; ++ks) a = __builtin_amdgcn_mfma_f32_32x32x16_bf16(GL_FRAG(L + GL_KT, 272, 32 * st + cl, ks), GL_FRAG(L + GL_QT, 272, 32 * ct + cl, ks), a, 0, 0, 0);
            if (st == ct) {
#pragma unroll
                for (int i = 0; i < 16; ++i) { const int sl = (i & 3) + 8 * (i >> 2) + 4 * hh; a[i] = sl <= cl ? a[i] : 0.f; } }
#pragma unroll
            for (int g = 0; g < 4; ++g) { v2u w; w.x = pk2(a[4 * g], a[4 * g + 1]); w.y = pk2(a[4 * g + 2], a[4 * g + 3]);
                *(LAS v2u*)(L + GL_AT + (32 * ct + cl) * 144 + (32 * st + 8 * g + 4 * hh) * 2) = w; }
        } else GL_UPD();
        __syncthreads();
        if (wave < 3) GL_UPD();
        f32x16 o;
#pragma unroll
        for (int i = 0; i < 16; ++i) o[i] = 0.f;
        if (ohalf == 0) {
            const int nks = oct ? 4 : 2;
            for (int ks = 0; ks < nks; ++ks) o = __builtin_amdgcn_mfma_f32_32x32x16_bf16(GL_FRAG(L + GL_VT, 144, 32 * ovt + cl, ks), GL_FRAG(L + GL_AT, 144, 32 * oct + cl, ks), o, 0, 0, 0);
#pragma unroll
            for (int ks = 0; ks < 2; ++ks) o = __builtin_amdgcn_mfma_f32_32x32x16_bf16(GL_FRAG(L + GL_SBT, 272, 32 * ovt + cl, ks), GL_FRAG(L + GL_QT, 272, 32 * oct + cl, ks), o, 0, 0, 0);
        } else {
#pragma unroll
            for (int ks = 2; ks < 8; ++ks) o = __builtin_amdgcn_mfma_f32_32x32x16_bf16(GL_FRAG(L + GL_SBT, 272, 32 * ovt + cl, ks), GL_FRAG(L + GL_QT, 272, 32 * oct + cl, ks), o, 0, 0, 0);
#pragma unroll
            for (int i = 0; i < 16; ++i) *(LAS float*)(L + GL_OP + (wave & 3) * 4096 + i * 256 + lane * 4) = o[i];
        }
        __syncthreads();
        if (ohalf == 0) {
            float ss = 0.f;
#pragma unroll
            for (int i = 0; i < 16; ++i) { o[i] += *(const LAS float*)(L + GL_OP + wave * 4096 + i * 256 + lane * 4); ss += o[i] * o[i]; }
            ss += __shfl_xor(ss, 32);
            const size_t row = row0 + (size_t)n * 64 + 32 * oct + cl;
            if (hh == 0) F.PSS[(row * 4 + h) * 8 + vs * 2 + ovt] = ss;
            bf16* yp = F.YMIX + row * DMIX + 1024 + h * 256 + vs * 64 + 32 * ovt + 4 * hh;
#pragma unroll
            for (int g = 0; g < 4; ++g) { float yv[4];
#pragma unroll
                for (int e = 0; e < 4; ++e) { const float z = (e & 1) ? bfhi((e >> 1) ? zc[g].y : zc[g].x) : bflo((e >> 1) ? zc[g].y : zc[g].x);
                    yv[e] = o[4 * g + e] * gh[4 * g + e] * z * __builtin_amdgcn_rcpf(1.f + __builtin_amdgcn_exp2f(-L2E * z)); }
                v2u w; w.x = pk2(yv[0], yv[1]); w.y = pk2(yv[2], yv[3]); *(GAS v2u*)(yp + 8 * g) = w; }
        }
        if (n + 1 < TP / 64) { GL_STAGE(); if (n + 2 < TP / 64) GL_LOAD(n + 2); }
    }
    float* so = F.out + O_GP + (((size_t)b * NH + h) * HK + 32 * dt) * HV + vs * 64 + 32 * vt + cl;
#pragma unroll
    for (int i = 0; i < 16; ++i) so[(size_t)((i & 3) + 8 * (i >> 2) + 4 * hh) * HV] = Sacc[i];
    __syncthreads();
#undef GL_LOAD
#undef GL_PUT16
#undef GL_STAGE
#undef GL_FRAG
#undef GL_UPD
}
__device__ __forceinline__ void p2b_norm(Frame& F) {
    const int gw = F.vcu * NWAVES + F.wave, NGW = F.G * NWAVES;
    for (int r = gw; r < NROWP; r += NGW) {
        const int hd = F.lane >> 4;
        const float* ps = F.PSS + ((size_t)r * 4 + hd) * 8; const f32x4 a = *(const GAS f32x4*)ps, b2 = *(const GAS f32x4*)(ps + 4);
        const float rs = rsqrtf(((a.x + a.y) + (a.z + a.w) + (b2.x + b2.y) + (b2.z + b2.w)) * (1.f / 256.f) + EPS);
        GAS v4u* yp = (GAS v4u*)(F.YMIX + (size_t)r * DMIX + 1024 + F.lane * 16);
#pragma unroll
        for (int q = 0; q < 2; ++q) { v4u w = yp[q];
            w.x = pk2(bflo(w.x) * rs, bfhi(w.x) * rs); w.y = pk2(bflo(w.y) * rs, bfhi(w.y) * rs); w.z = pk2(bflo(w.z) * rs, bfhi(w.z) * rs); w.w = pk2(bflo(w.w) * rs, bfhi(w.w) * rs); yp[q] = w; }
    }
}

__device__ __forceinline__ void p2_mix_simple(Frame& F) {
    const int hsel = F.tid >> 8;
    for (int it = F.vcu; it < 2 * NP * 16; it += F.G) {
        if (it < NP * 16) lru_item<0>(F, it >> 4, it & 15);
        else { const int g = it - NP * 16; gla_item(F, g >> 4, (g >> 2) & 3, g & 3); }
    }
    for (int it = F.vcu; it < 4 * 16; it += F.G) lru_item<1>(F, it >> 4, it & 15);
    for (int p = F.vcu; p < NS * NH / 2; p += F.G) { const int it = 2 * p + hsel; gla_simple_item(F, 1, it >> 2, it & 3, hsel); }
}

__device__ __forceinline__ void p4_final(Frame& F) {
    const int gw = F.vcu * NWAVES + F.wave, NGW = F.G * NWAVES;
    const GAS f32x4* gp = (const GAS f32x4*)F.g_post + F.lane;
    f32x4 g[4];
#pragma unroll
    for (int j = 0; j < 4; ++j) g[j] = gp[64 * j];
    for (int r = gw; r < NTOK; r += NGW) {
        const float* xrow = r < NROWP ? F.xp + (size_t)r * D : F.xs + (size_t)(r - NROWP) * D;
        const GAS f32x4* xr = (const GAS f32x4*)xrow + F.lane;
        const GAS v2u* yr = (const GAS v2u*)(F.YBF + (size_t)r * D) + F.lane;
        float ps = F.lane < 16 ? F.PART[(size_t)F.lane * NTOK + r] : 0.f;
        const float rs = rsqrtf(wave_sum(ps) * (1.f / D) + EPS);
        GAS f32x4* orow = (GAS f32x4*)(F.out + (size_t)r * D) + F.lane;
#pragma unroll
        for (int j = 0; j < 4; ++j) { const f32x4 x = xr[64 * j]; const v2u y = yr[64 * j];
            f32x4 o; o.x = x.x + bflo(y.x) * rs * g[j].x; o.y = x.y + bfhi(y.x) * rs * g[j].y; o.z = x.z + bflo(y.y) * rs * g[j].z; o.w = x.w + bfhi(y.y) * rs * g[j].w;
            orow[64 * j] = o; }
    }
}


struct Args { const float* in[19]; float* out; unsigned char* ws; int ph_lo, ph_hi, li, pad; };
__global__ void __launch_bounds__(NWAVES * 64, 2) mk_fwd(Args args) {
    extern __shared__ __attribute__((aligned(16))) unsigned char lds[];
    Frame F;
    F.lds = (LAS unsigned char*)lds;
    F.MISC = (volatile LAS unsigned*)(F.lds + MISC_OFF);
    F.tid = threadIdx.x; F.lane = F.tid & 63; F.wave = __builtin_amdgcn_readfirstlane(F.tid >> 6);
    F.G = gridDim.x; { const int bx = blockIdx.x; F.vcu = (F.G % 8 == 0) ? (bx % 8) * (F.G / 8) + bx / 8 : bx; }
    unsigned char* ws = args.ws;
    F.ctl = (gu32*)(ws + WS_CTL);
    F.xp = args.in[0]; F.xs = args.in[1]; F.st_h = args.in[2]; F.st_conv = args.in[3]; F.st_gla = args.in[4]; F.g_pre = args.in[5]; F.w_in = args.in[6];
    F.conv_w = args.in[7]; F.conv_b = args.in[8]; F.w_rg = args.in[9]; F.b_rg = args.in[10]; F.w_ig = args.in[11]; F.b_ig = args.in[12]; F.lam = args.in[13];
    F.w_gk2 = args.in[14]; F.b_gk = args.in[15]; F.g_head = args.in[16]; F.w_out = args.in[17]; F.g_post = args.in[18];
    F.out = args.out;
    F.WinT = (bf16*)(ws + WS_WINT); F.WoutT = (bf16*)(ws + WS_WOUT); F.XN = (bf16*)(ws + WS_XN); F.PROJ = (bf16*)(ws + WS_PROJ);
    F.YMIX = (bf16*)args.out;
    F.YBF = (bf16*)(ws + WS_XN);
    F.RGK = (float*)(ws + WS_RGK); F.PART = (float*)(ws + WS_PART); F.DEC = (float*)(ws + WS_DEC); F.PSS = (float*)(ws + WS_RGK);
    F.BCUM = args.out + O_GS;
    for (int u = F.tid; u < (LDS_BYTES - LDSCTL_OFF) / 4; u += NWAVES * 64) ((LAS unsigned*)(F.lds + LDSCTL_OFF))[u] = 0u;
    __syncthreads();
    XcdBarrier bar; bar.bar = (unsigned*)(F.ctl + CW_BAR); bar.x = 0; bar.st = nullptr;
    if (N_LAUNCHES == 1) bar = xcd_barrier_post((unsigned*)(F.ctl + CW_BAR), F.MISC + 8);
#define GRID_BAR() do { if (N_LAUNCHES == 1) xcd_barrier(bar); } while (0)
    const int lo = args.ph_lo, hi = args.ph_hi;
#ifndef PH_MASK
#define PH_MASK 31
#endif
#define IN(k) (lo <= (k) && (k) < hi && ((PH_MASK >> (k)) & 1))
#define BOTH(k) (IN(k) && IN((k) + 1))
    if (IN(0)) { p0_prologue(F); if (BOTH(0)) GRID_BAR(); }
    if (IN(1)) {
        pg8::Gemm g{F.XN, F.WinT, NTOK, DINP, D}; pg8::StaticOrder S; S.init(NTOK, DINP, F.G, (int)blockIdx.x);
        pg8::EpiProj E{F.PROJ, DINP, F.BCUM};
        pg8::gemm_phase<pg8::EpiProj, pg8::StaticOrder, true, true>(F.lds + RING_OFF, g, S, E);
        if (BOTH(1)) GRID_BAR();
    }
    if (IN(2)) { p2_mix_simple(F); GRID_BAR(); p2b_norm(F); if (BOTH(2)) GRID_BAR(); }
    if (IN(3)) {
        pg8::Gemm g{F.YMIX, F.WoutT, NTOK, D, DMIX}; pg8::StaticOrder S; S.init(NTOK, D, F.G, (int)blockIdx.x);
        pg8::EpiY E{F.YBF, D, F.PART, NTOK};
        pg8::gemm_phase<pg8::EpiY, pg8::StaticOrder, true, true>(F.lds + RING_OFF, g, S, E);
        if (BOTH(3)) GRID_BAR();
    }
    if (IN(4)) { p4_final(F); }
#undef IN
#undef BOTH
}

extern "C" void kernel_launch(void* const* d_in, const int* in_sizes, int n_in, void* d_out, int out_size, void* d_ws, size_t ws_size, hipStream_t stream) {
    static int grid = 0;
    if (grid == 0) {
        if (n_in != 19 || in_sizes[0] != NROWP * D || in_sizes[6] != D * DIN || (size_t)out_size != O_END || ws_size < WS_END) {
            fprintf(stderr, "kernel_launch: unexpected shapes: n_in %d in0 %d in6 %d out %d ws %zu; nothing launched\n", n_in, n_in > 0 ? in_sizes[0] : -1, n_in > 6 ? in_sizes[6] : -1, out_size, ws_size); grid = -1; return; }
        int dev = 0, cus = 0, per_cu = 0;
        if (hipGetDevice(&dev) != hipSuccess || hipDeviceGetAttribute(&cus, hipDeviceAttributeMultiprocessorCount, dev) != hipSuccess) { grid = -1; return; }
        if (hipFuncSetAttribute((const void*)mk_fwd, hipFuncAttributeMaxDynamicSharedMemorySize, LDS_BYTES) != hipSuccess) { fprintf(stderr, "kernel_launch: hipFuncSetAttribute failed\n"); grid = -1; return; }
        if (hipOccupancyMaxActiveBlocksPerMultiprocessor(&per_cu, (const void*)mk_fwd, NWAVES * 64, LDS_BYTES) != hipSuccess || per_cu < 1)
            fprintf(stderr, "kernel_launch: note: occupancy query reports %d workgroups per CU\n", per_cu);
        (void)hipGetLastError();
        grid = cus;
    }
    if (grid < 0) return;
    if (hipMemsetAsync((char*)d_ws + WS_CTL, 0, CTL_ZERO_BYTES, stream) != hipSuccess) { fprintf(stderr, "kernel_launch: hipMemsetAsync failed\n"); return; }
    Args a{};
    for (int i = 0; i < 19; ++i) a.in[i] = (const float*)d_in[i];
    a.out = (float*)d_out; a.ws = (unsigned char*)d_ws;
    for (int li = 0; li < N_LAUNCHES; ++li) {
        a.ph_lo = (N_LAUNCHES == 1) ? 0 : li; a.ph_hi = (N_LAUNCHES == 1) ? N_PHASES : li + 1; a.li = li;
        hipLaunchKernelGGL(mk_fwd, dim3(grid), dim3(NWAVES * 64), LDS_BYTES, stream, a);
        const hipError_t le = hipPeekAtLastError();
        if (le != hipSuccess) { fprintf(stderr, "kernel_launch: launch %d failed: %s\n", li, hipGetErrorName(le)); break; }
    }
}
```

```cpp
#define MK_N_LAUNCHES 1
#include <hip/hip_runtime.h>
#include <cstdio>
#include <cstdint>
namespace pg8 {
#define PG8_LAS __attribute__((address_space(3)))
typedef unsigned short bf16_t;
typedef short bf16x8 __attribute__((ext_vector_type(8)));
typedef float f32x4 __attribute__((ext_vector_type(4)));
typedef unsigned u32x4 __attribute__((ext_vector_type(4)));
constexpr int BM = 256, BK = 64, HALF = 128, HTB = HALF * BK * 2  , STAGE_BYTES = 8 * HTB, NXCD = 8, WGM = 8;

__host__ __device__ __forceinline__ int lds_byte(int r, int c) { const int st = (r >> 4) * 2 + (c >> 5), rr = r & 15, cc = c & 31, ob = rr * 64 + cc * 2; return st * 1024 + (ob ^ (((ob >> 9) & 1) << 5)); }
__host__ __device__ __forceinline__ void stage_rc(int b, int& R, int& C) { const int st = b / 1024, sb = b % 1024, swz = sb ^ (((sb >> 9) & 1) << 5); R = (st >> 1) * 16 + swz / 64; C = (st & 1) * 32 + (swz % 64) / 2; }
__host__ __device__ __forceinline__ int perm32(int rho) { const int n = rho >> 4, i = rho & 15; return 8 * (i >> 2) + 4 * n + (i & 3); }

struct Unit { int pm, pn; };
struct Gemm { const bf16_t* A; const bf16_t* Bt; int M, N, K; };

struct StaticOrder {
    int nM, nN, nwg, G, c;
    __host__ __device__ void init(int M, int N, int G_, int c_) { nM = M / BM; nN = N / BM; nwg = nM * nN; G = G_; c = c_; }
    __host__ __device__ bool next(int i, Unit& u) const {
        const long L = (long)i * G + c; if (L >= nwg) return false;
        int wgid = (int)L; { const int q = nwg / NXCD, r = nwg % NXCD, xcd = wgid % NXCD, off = wgid / NXCD; wgid = (xcd < r ? xcd * (q + 1) : r * (q + 1) + (xcd - r) * q) + off; }
        const int nig = WGM * nN, gid = wgid / nig, fm = gid * WGM, gsz = (nM - fm) < WGM ? (nM - fm) : WGM;
        u.pm = fm + ((wgid % nig) % gsz); u.pn = (wgid % nig) / gsz; return true;
    }
    __device__ __forceinline__ void a_ready(const Unit&) const {}
    __device__ __forceinline__ void done(const Unit&) const {}
};
__device__ __forceinline__ unsigned cvt_pk_bf16(float lo, float hi) { unsigned r; asm volatile("v_cvt_pk_bf16_f32 %0, %1, %2" : "=v"(r) : "v"(lo), "v"(hi)); return r; }
typedef float f32x2 __attribute__((ext_vector_type(2)));
struct EpiProj {
    static constexpr bool PERM = true, AFTER_DRAIN = false;
    bf16_t* O; int ldc; const float* bcum;
    __device__ __forceinline__ void operator()(const f32x4 (&acc)[2][2][4][2], const Unit& u, int wr, int wc, int fr, int fq) const {
        const int row0 = u.pm * BM + wr * 64 + fr; const int col0 = u.pn * BM + wc * 32 + 8 * fq;
        const int gk = (u.pn >= 8 && u.pn < 12) ? (u.pn < 10 ? 1 : 2) : (((u.pn >= 4 && u.pn < 8) || u.pn >= 16) ? 3 : 0);
        const float sgn = gk == 1 ? 1.4426950408889634f : -1.4426950408889634f, sc = gk == 1 ? 0.08838834764831845f : 1.f;
#pragma unroll
        for (int ai = 0; ai < 2; ++ai)
#pragma unroll
            for (int m = 0; m < 4; ++m) { const int row = row0 + ai * HALF + m * 16; bf16_t* rowp = O + (size_t)row * ldc + col0;
#pragma unroll
                for (int bj = 0; bj < 2; ++bj) { f32x4 v0 = acc[ai][bj][m][0], v1 = acc[ai][bj][m][1];
                    if (gk == 3) {
#pragma unroll
                        for (int e = 0; e < 4; ++e) { v0[e] *= __builtin_amdgcn_rcpf(1.f + __builtin_amdgcn_exp2f(-1.4426950408889634f * v0[e])); v1[e] *= __builtin_amdgcn_rcpf(1.f + __builtin_amdgcn_exp2f(-1.4426950408889634f * v1[e])); } }
                    else if (gk) { const float* bp = bcum + (size_t)row * 512 + (col0 + bj * HALF - (gk == 1 ? 2048 : 2560)); const f32x4 b0 = *(const f32x4*)bp, b1 = *(const f32x4*)(bp + 4);
                        v0[0] *= sc * __builtin_amdgcn_exp2f(sgn * b0[0]); v0[1] *= sc * __builtin_amdgcn_exp2f(sgn * b0[1]); v0[2] *= sc * __builtin_amdgcn_exp2f(sgn * b0[2]); v0[3] *= sc * __builtin_amdgcn_exp2f(sgn * b0[3]);
                        v1[0] *= sc * __builtin_amdgcn_exp2f(sgn * b1[0]); v1[1] *= sc * __builtin_amdgcn_exp2f(sgn * b1[1]); v1[2] *= sc * __builtin_amdgcn_exp2f(sgn * b1[2]); v1[3] *= sc * __builtin_amdgcn_exp2f(sgn * b1[3]); }
                    u32x4 w; w.x = cvt_pk_bf16(v0[0], v0[1]); w.y = cvt_pk_bf16(v0[2], v0[3]); w.z = cvt_pk_bf16(v1[0], v1[1]); w.w = cvt_pk_bf16(v1[2], v1[3]);
                    *(u32x4*)(rowp + bj * HALF) = w; } }
    }
};
struct EpiY {
    static constexpr bool PERM = true, AFTER_DRAIN = false;
    bf16_t* O; int ldc; float* part; int M;
    __device__ __forceinline__ void operator()(const f32x4 (&acc)[2][2][4][2], const Unit& u, int wr, int wc, int fr, int fq) const {
        const int row0 = u.pm * BM + wr * 64 + fr; const int col0 = u.pn * BM + wc * 32 + 8 * fq;
#pragma unroll
        for (int ai = 0; ai < 2; ++ai)
#pragma unroll
            for (int m = 0; m < 4; ++m) { const int row = row0 + ai * HALF + m * 16; bf16_t* rowp = O + (size_t)row * ldc + col0; float ss = 0.f;
#pragma unroll
                for (int bj = 0; bj < 2; ++bj) { const f32x4 v0 = acc[ai][bj][m][0], v1 = acc[ai][bj][m][1];
                    ss += (v0[0] * v0[0] + v0[1] * v0[1]) + (v0[2] * v0[2] + v0[3] * v0[3]); ss += (v1[0] * v1[0] + v1[1] * v1[1]) + (v1[2] * v1[2] + v1[3] * v1[3]);
                    u32x4 w; w.x = cvt_pk_bf16(v0[0], v0[1]); w.y = cvt_pk_bf16(v0[2], v0[3]); w.z = cvt_pk_bf16(v1[0], v1[1]); w.w = cvt_pk_bf16(v1[2], v1[3]);
                    *(u32x4*)(rowp + bj * HALF) = w; }
                ss += __shfl_xor(ss, 16); ss += __shfl_xor(ss, 32);
                if (fq == 0) part[(size_t)(u.pn * 4 + wc) * M + row] = ss; }
    }
};
template <class Epi, class Sched, bool ALIGN_EPI = false, bool SP2 = false>
__device__ __forceinline__ void gemm_phase(PG8_LAS unsigned char* lds, const Gemm g, const Sched& S, const Epi& E) {
    const int tid = threadIdx.x, wid = __builtin_amdgcn_readfirstlane(tid >> 6), lane = tid & 63, wr = wid >> 2, wc = wid & 3, fr = lane & 15, fq = lane >> 4;
    const int K = g.K, nt = K / BK;
    unsigned voffA[2], voffB[2];
#pragma unroll
    for (int i = 0; i < 2; ++i) { int R, C; stage_rc(tid * 16 + i * 8192, R, C); const int Rb = Epi::PERM ? ((R & ~31) + perm32(R & 31)) : R;
        voffA[i] = (unsigned)(R * K + C) * 2u; voffB[i] = (unsigned)(Rb * K + C) * 2u; }
    const size_t kstep = (size_t)(BK * 2);
    const size_t hstep = (size_t)HALF * K * 2;
    const size_t tstep = 2 * hstep;
    const unsigned ldsw = (unsigned)wid * 1024u;
    const int aoff = lds_byte(wr * 64 + fr, fq * 8), boff = lds_byte(wc * 32 + fr, fq * 8);
#define PG8_SA(b, h) (((b) * 2 + (h)) * HTB)
#define PG8_SB(b, h) ((4 + (b) * 2 + (h)) * HTB)
#define PG8_STAGE(bufoff, gbase, voff) do { _Pragma("unroll") for (int _i = 0; _i < 2; ++_i) \
        __builtin_amdgcn_global_load_lds((const unsigned*)((const char*)(gbase) + (voff)[_i]), (PG8_LAS unsigned*)(lds + (bufoff) + ldsw + _i * 8192), 16, 0, 0); } while (0)
#define PG8_LDA(dst, b, h) do { _Pragma("unroll") for (int m = 0; m < 4; ++m) _Pragma("unroll") for (int k = 0; k < 2; ++k) dst[m][k] = *(const PG8_LAS bf16x8*)(lds + PG8_SA(b, h) + aoff + m * 2048 + k * 1024); } while (0)
#define PG8_LDB(dst, b, h) do { _Pragma("unroll") for (int n = 0; n < 2; ++n) _Pragma("unroll") for (int k = 0; k < 2; ++k) dst[n][k] = *(const PG8_LAS bf16x8*)(lds + PG8_SB(b, h) + boff + n * 2048 + k * 1024); } while (0)
#define PG8_MMA(ai, bj, At, Bt) do { __builtin_amdgcn_s_setprio(1); _Pragma("unroll") for (int m = 0; m < 4; ++m) _Pragma("unroll") for (int n = 0; n < 2; ++n) _Pragma("unroll") for (int k = 0; k < 2; ++k) \
        acc[ai][bj][m][n] = __builtin_amdgcn_mfma_f32_16x16x32_bf16(Bt[n][k], At[m][k], acc[ai][bj][m][n], 0, 0, 0); __builtin_amdgcn_s_setprio(0); } while (0)
#define PG8_WAIT_V(n) asm volatile("s_waitcnt vmcnt(" #n ")" ::: "memory")
#define PG8_WAIT_L(n) asm volatile("s_waitcnt lgkmcnt(" #n ")" ::: "memory")
#define PG8_BAR __builtin_amdgcn_s_barrier()
#define PG8_SCHED __builtin_amdgcn_sched_barrier(0)
    Unit cur, nxt; int ui = 0;
    if (!S.next(0, cur)) return;
    f32x4 acc[2][2][4][2];
#pragma unroll
    for (int a = 0; a < 2; ++a)
#pragma unroll
        for (int b = 0; b < 2; ++b)
#pragma unroll
            for (int m = 0; m < 4; ++m)
#pragma unroll
                for (int n = 0; n < 2; ++n) acc[a][b][m][n] = (f32x4){0.f, 0.f, 0.f, 0.f};
    bf16x8 At[4][2], B0[2][2], B1[2][2];
    const char* cA = (const char*)g.A + (size_t)cur.pm * tstep; const char* cB = (const char*)g.Bt + (size_t)cur.pn * tstep;
    S.a_ready(cur);
    if constexpr (SP2) {
        PG8_STAGE(PG8_SB(0, 0), cB, voffB); PG8_STAGE(PG8_SB(0, 1), cB + hstep, voffB); PG8_STAGE(PG8_SA(0, 0), cA, voffA); PG8_STAGE(PG8_SA(0, 1), cA + hstep, voffA);
        if (wr == 1) PG8_BAR;
        PG8_WAIT_V(2); PG8_BAR;
        PG8_STAGE(PG8_SB(1, 0), cB + kstep, voffB); PG8_STAGE(PG8_SA(1, 0), cA + kstep, voffA); PG8_STAGE(PG8_SB(1, 1), cB + hstep + kstep, voffB);
        PG8_WAIT_V(6); PG8_BAR;
    } else {
        PG8_STAGE(PG8_SB(0, 0), cB, voffB); PG8_STAGE(PG8_SA(0, 0), cA, voffA); PG8_STAGE(PG8_SB(0, 1), cB + hstep, voffB); PG8_STAGE(PG8_SA(0, 1), cA + hstep, voffA);
        if (wr == 1) PG8_BAR;
        PG8_WAIT_V(4); PG8_BAR;
        PG8_STAGE(PG8_SB(1, 0), cB + kstep, voffB); PG8_STAGE(PG8_SA(1, 0), cA + kstep, voffA); PG8_STAGE(PG8_SB(1, 1), cB + hstep + kstep, voffB);
        PG8_WAIT_V(6); PG8_BAR;
    }
    for (;;) {
        const bool has_next = S.next(ui + 1, nxt);
        const char* nA = has_next ? (const char*)g.A + (size_t)nxt.pm * tstep : cA; const char* nB = has_next ? (const char*)g.Bt + (size_t)nxt.pn * tstep : cB;
        for (int t = 0; t < nt; t += 2) {
            const bool last = (t == nt - 2);
            const char* a1 = cA + (size_t)(t + 1) * kstep;
            const char* a2 = last ? nA : cA + (size_t)(t + 2) * kstep; const char* b2 = last ? nB : cB + (size_t)(t + 2) * kstep;
            const char* a3 = a2 + kstep; const char* b3 = b2 + kstep;
            if (last && has_next) S.a_ready(nxt);
            if constexpr (SP2) {
            PG8_LDB(B0, 0, 0); PG8_LDB(B1, 0, 1); PG8_SCHED; PG8_LDA(At, 0, 0); PG8_STAGE(PG8_SA(1, 1), a1 + hstep, voffA);
            PG8_WAIT_V(8); PG8_WAIT_L(0); PG8_BAR; PG8_MMA(0, 0, At, B0); PG8_MMA(0, 1, At, B1); PG8_BAR; PG8_SCHED;
            PG8_LDA(At, 0, 1); PG8_STAGE(PG8_SB(0, 0), b2, voffB); PG8_STAGE(PG8_SB(0, 1), b2 + hstep, voffB); PG8_STAGE(PG8_SA(0, 0), a2, voffA);
            PG8_WAIT_V(8); PG8_WAIT_L(0); PG8_BAR; PG8_MMA(1, 0, At, B0); PG8_MMA(1, 1, At, B1); PG8_BAR; PG8_SCHED;
            PG8_LDB(B0, 1, 0); PG8_LDB(B1, 1, 1); PG8_SCHED; PG8_LDA(At, 1, 0); PG8_STAGE(PG8_SA(0, 1), a2 + hstep, voffA);
            PG8_WAIT_V(8); PG8_WAIT_L(0); PG8_BAR; PG8_MMA(0, 0, At, B0); PG8_MMA(0, 1, At, B1); PG8_BAR; PG8_SCHED;
            PG8_LDA(At, 1, 1); PG8_STAGE(PG8_SB(1, 0), b3, voffB); PG8_STAGE(PG8_SB(1, 1), b3 + hstep, voffB); PG8_STAGE(PG8_SA(1, 0), a3, voffA);
            PG8_WAIT_V(8); PG8_WAIT_L(0); PG8_BAR; PG8_MMA(1, 0, At, B0); PG8_MMA(1, 1, At, B1); PG8_BAR; PG8_SCHED;
            } else {
            PG8_LDB(B0, 0, 0); PG8_SCHED; PG8_LDA(At, 0, 0); PG8_STAGE(PG8_SA(1, 1), a1 + hstep, voffA);
            PG8_WAIT_L(8); PG8_BAR; PG8_WAIT_L(0); PG8_MMA(0, 0, At, B0); PG8_BAR; PG8_SCHED;
            PG8_LDB(B1, 0, 1); PG8_STAGE(PG8_SB(0, 0), b2, voffB);
            PG8_BAR; PG8_WAIT_L(0); PG8_MMA(0, 1, At, B1); PG8_BAR;
            PG8_LDA(At, 0, 1); PG8_STAGE(PG8_SA(0, 0), a2, voffA);
            PG8_BAR; PG8_WAIT_L(0); PG8_MMA(1, 0, At, B0); PG8_BAR; PG8_SCHED;
            PG8_STAGE(PG8_SB(0, 1), b2 + hstep, voffB);
            PG8_WAIT_V(6); PG8_BAR; PG8_MMA(1, 1, At, B1); PG8_BAR;
            PG8_LDB(B0, 1, 0); PG8_SCHED; PG8_LDA(At, 1, 0); PG8_STAGE(PG8_SA(0, 1), a2 + hstep, voffA);
            PG8_WAIT_L(8); PG8_BAR; PG8_WAIT_L(0); PG8_MMA(0, 0, At, B0); PG8_BAR; PG8_SCHED;
            PG8_LDB(B1, 1, 1); PG8_STAGE(PG8_SB(1, 0), b3, voffB);
            PG8_BAR; PG8_WAIT_L(0); PG8_MMA(0, 1, At, B1); PG8_BAR;
            PG8_LDA(At, 1, 1); PG8_STAGE(PG8_SA(1, 0), a3, voffA);
            PG8_BAR; PG8_WAIT_L(0); PG8_MMA(1, 0, At, B0); PG8_BAR; PG8_SCHED;
            PG8_STAGE(PG8_SB(1, 1), b3 + hstep, voffB);
            PG8_WAIT_V(6); PG8_BAR; PG8_MMA(1, 1, At, B1); PG8_BAR;
            }
        }
        if constexpr (ALIGN_EPI) { if (wr == 0) PG8_BAR; }
        if constexpr (!Epi::AFTER_DRAIN) { E(acc, cur, wr, wc, fr, fq); S.done(cur); }
        if (!has_next) break;
#pragma unroll
        for (int a = 0; a < 2; ++a)
#pragma unroll
            for (int b = 0; b < 2; ++b)
#pragma unroll
                for (int m = 0; m < 4; ++m)
#pragma unroll
                    for (int n = 0; n < 2; ++n) acc[a][b][m][n] = (f32x4){0.f, 0.f, 0.f, 0.f};
        cur = nxt; cA = nA; cB = nB; ++ui;
        if constexpr (ALIGN_EPI) { if (wr == 1) PG8_BAR; }
    }
    PG8_WAIT_V(0);
    if constexpr (!ALIGN_EPI) { if (wr == 0) PG8_BAR; }
    PG8_BAR;
    if constexpr (Epi::AFTER_DRAIN) { E.fused(acc, cur, wr, wc, fr, fq, lds, wid, lane); S.done(cur); }
#undef PG8_SA
#undef PG8_SB
#undef PG8_STAGE
#undef PG8_LDA
#undef PG8_LDB
#undef PG8_MMA
#undef PG8_WAIT_V
#undef PG8_WAIT_L
#undef PG8_BAR
#undef PG8_SCHED
}
}

#ifndef MK_N_LAUNCHES
#define MK_N_LAUNCHES 1
#endif
constexpr int N_PHASES = 5, N_LAUNCHES = MK_N_LAUNCHES;
constexpr int NWAVES = 8;
constexpr int D = 1024, NP = 8, TP = 2048, NS = 128, TS = 8, NROWP = NP * TP, NROWS = NS * TS, NTOK = NROWP + NROWS;
constexpr int DIN = 5136, DINP = 5120, DMIX = 2048, HK = 128, HV = 256, NH = 4;
constexpr int C_XL = 0, C_ZL = 1024, C_Q = 2048, C_K = 2560, C_V = 3072, C_ZG = 4096;
constexpr float EPS = 1e-6f;
constexpr size_t O_YP = 0, O_YS = 16777216, O_HP = 17825792, O_CP = 17833984, O_GP = 17858560, O_HS = 18907136, O_CS = 19038208, O_GS = 19431424, O_END = 36208640;
constexpr size_t MiB = 1u << 20;
constexpr size_t WS_CTL = 0, CTL_ZERO_BYTES = 1 * MiB;
constexpr size_t WS_WINT = 2 * MiB, WS_WOUT = 12 * MiB, WS_RGK = 16 * MiB, WS_PART = 18 * MiB, WS_DEC = 19 * MiB + 256 * 1024, WS_XN = 20 * MiB, WS_PROJ = 54 * MiB, WS_END = 224 * MiB;
static_assert(WS_DEC + (size_t)(NP * (TP / 64) + NS) * 512 * 4 <= WS_XN && WS_PART + (size_t)16 * NTOK * 4 <= WS_DEC, "d_ws map (DEC)");
static_assert(WS_WINT + (size_t)DINP * D * 2 <= WS_WOUT && WS_WOUT + (size_t)D * DMIX * 2 <= WS_RGK && WS_RGK + (size_t)NTOK * 16 * 4 <= WS_PART && WS_PART + (size_t)16 * NTOK * 4 <= WS_XN &&
              WS_XN + (size_t)NTOK * D * 2 <= WS_PROJ && WS_PROJ + (size_t)NTOK * DINP * 2 <= WS_END, "d_ws map");
constexpr int CW_BAR = 4096;
constexpr int RING_OFF = 0, RING_BYTES = 162816, LDSCTL_OFF = RING_BYTES, MISC_OFF = LDSCTL_OFF + 320, LDS_BYTES = 163840;

#define GAS __attribute__((address_space(1)))
#define LAS __attribute__((address_space(3)))
typedef unsigned short bf16;
typedef unsigned v4u __attribute__((ext_vector_type(4)));
typedef unsigned v2u __attribute__((ext_vector_type(2)));
typedef float f32x4 __attribute__((ext_vector_type(4)));
typedef GAS unsigned gu32;
#define RLX_AGENT __ATOMIC_RELAXED, __HIP_MEMORY_SCOPE_AGENT
#define LDS_WAIT() asm volatile("s_waitcnt lgkmcnt(0)" ::: "memory")
#define VM_WAIT() asm volatile("s_waitcnt vmcnt(0)" ::: "memory")
__device__ __forceinline__ unsigned f2bf(float f) { unsigned u = __builtin_bit_cast(unsigned, f); return (u + 0x7fffu + ((u >> 16) & 1u)) >> 16; }
__device__ __forceinline__ unsigned pk2(float lo, float hi) { return f2bf(lo) | (f2bf(hi) << 16); }
__device__ __forceinline__ float bf2f(unsigned b) { return __builtin_bit_cast(float, b << 16); }
__device__ __forceinline__ float bflo(unsigned w) { return __builtin_bit_cast(float, w << 16); }
__device__ __forceinline__ float bfhi(unsigned w) { return __builtin_bit_cast(float, w & 0xffff0000u); }
__device__ __forceinline__ float sigmoidf_(float x) { return 1.f / (1.f + __expf(-x)); }
__device__ __forceinline__ float logsigf_(float x) { return fminf(x, 0.f) - log1pf(__expf(-fabsf(x))); }
#define XB_TMO      128
#define XB_XCNT(j)  (256  + 64 * (j))
#define XB_XSUB(j)  (1280 + 64 * (j))
#define XB_XGEN(j)  (2304 + 64 * (j))
#define XB_TOP      3328
#define XB_TOPGEN   3392
#define XCD_BAR_WORDS 3456
#define XB_SPIN_CAP (1u << 18)

__device__ __forceinline__ unsigned xb_ld(unsigned* p)              { return __hip_atomic_load(p, __ATOMIC_RELAXED, __HIP_MEMORY_SCOPE_AGENT); }
__device__ __forceinline__ unsigned xb_add(unsigned* p, unsigned v) { return __hip_atomic_fetch_add(p, v, __ATOMIC_RELAXED, __HIP_MEMORY_SCOPE_AGENT); }
__device__ __forceinline__ unsigned xb_xcc_id() { return (unsigned)__builtin_amdgcn_s_getreg((3 << 11) | 20) & 0xFu; }
#define XB_SPIN(cond, bar) do { unsigned _sp = 0; while (cond) { __builtin_amdgcn_s_sleep(1); \
    if ((++_sp & 255u) == 0u) { if (xb_ld(&(bar)[XB_TMO])) break; if (_sp > XB_SPIN_CAP) { atomicAdd(&(bar)[XB_TMO], 1u); break; } } } } while (0)

struct XcdBarrier {
    unsigned* bar; unsigned x;
    volatile LAS unsigned* st;
};

__device__ __forceinline__ XcdBarrier xcd_barrier_post(unsigned* bar, volatile LAS unsigned* st) {
    XcdBarrier b; b.bar = bar; b.x = xb_xcc_id(); b.st = st;
    if (threadIdx.x == 0) (void)xb_add(&bar[XB_XCNT(b.x)], 1u);
    return b;
}
__device__ __forceinline__ void xcd_barrier_complete(unsigned* bar, unsigned x, unsigned& nloc, unsigned& nx) {
    const unsigned G = gridDim.x * gridDim.y * gridDim.z;
    unsigned sum, cnt, mine, sp = 0u;
    for (;;) {
        sum = 0u; cnt = 0u; mine = 0u;
#pragma unroll
        for (unsigned j = 0; j < 16; ++j) { const unsigned c = xb_ld(&bar[XB_XCNT(j)]); sum += c; cnt += (c > 0u) ? 1u : 0u; mine = (j == x) ? c : mine; }
        if (sum == G) break;
        __builtin_amdgcn_s_sleep(1);
        if ((++sp & 255u) == 0u) { if (xb_ld(&bar[XB_TMO])) break; if (sp > XB_SPIN_CAP) { atomicAdd(&bar[XB_TMO], 1u); break; } }
    }
    nloc = mine > 0u ? mine : 1u; nx = cnt > 0u ? cnt : 1u;
}

__device__ __forceinline__ void xcd_barrier(const XcdBarrier& b) {
    asm volatile("s_waitcnt vmcnt(0)" ::: "memory");
    __syncthreads();
    if (threadIdx.x == 0) {
        unsigned* bar = b.bar;
        __builtin_amdgcn_s_waitcnt(0);
        unsigned nloc = b.st[0], nx = b.st[1];
        if (nloc == 0u) { xcd_barrier_complete(bar, b.x, nloc, nx); b.st[0] = nloc; b.st[1] = nx; }
        const unsigned old = xb_add(&bar[XB_XSUB(b.x)], 1u);
        const unsigned gen = old / nloc;
        if (old + 1u == (gen + 1u) * nloc) {
            __builtin_amdgcn_fence(__ATOMIC_RELEASE, "agent");
            asm volatile("s_waitcnt vmcnt(0)" ::: "memory");
            const unsigned og = xb_add(&bar[XB_TOP], 1u);
            const unsigned tg = og / nx;
            if (og + 1u == (tg + 1u) * nx) xb_add(&bar[XB_TOPGEN], 1u);
            else XB_SPIN(xb_ld(&bar[XB_TOPGEN]) == tg, bar);
            __builtin_amdgcn_fence(__ATOMIC_ACQUIRE, "agent");
            xb_add(&bar[XB_XGEN(b.x)], 1u);
            asm volatile("s_waitcnt vmcnt(0)" ::: "memory");
        } else {
            XB_SPIN(xb_ld(&bar[XB_XGEN(b.x)]) == gen, bar);
            __builtin_amdgcn_fence(__ATOMIC_ACQUIRE, "agent");
            asm volatile("s_waitcnt vmcnt(0)" ::: "memory");
        }
    }
    __syncthreads();
}

struct Frame {
    LAS unsigned char* lds;
    volatile LAS unsigned* MISC;
    gu32* ctl;
    int tid, lane, wave, vcu, G;
    const float *xp, *xs, *st_h, *st_conv, *st_gla, *g_pre, *w_in, *conv_w, *conv_b, *w_rg, *b_rg, *w_ig, *b_ig, *lam, *w_gk2, *b_gk, *g_head, *w_out, *g_post;
    float* out;
    bf16 *WinT, *WoutT, *XN, *PROJ, *YMIX, *YBF;
    float *RGK, *PART, *BCUM, *DEC, *PSS, *C8;
};
__device__ __forceinline__ float wave_sum(float v) {
#pragma unroll
    for (int o = 1; o < 64; o <<= 1) v += __shfl_xor(v, o);
    return v;
}

__device__ __forceinline__ void p0_transpose_item(const float* W, int ldw, int K, int nblk, bf16* WT, LAS float* scr, int item, int lane) {
    const int kb = item / nblk, nb = item % nblk, k0 = 64 * kb, n0 = 32 * nb;
#pragma unroll 8
    for (int i = 0; i < 32; ++i) { const int kk = 2 * i + (lane >> 5); scr[kk * 33 + (lane & 31)] = W[(size_t)(k0 + kk) * ldw + n0 + (lane & 31)]; }
    LDS_WAIT(); asm volatile("" ::: "memory");
    const int c = lane & 7;
#pragma unroll
    for (int j = 0; j < 4; ++j) { const int n = (lane >> 3) + 8 * j; const LAS float* s = scr + (8 * c) * 33 + n;
        v4u o; o.x = pk2(s[0 * 33], s[1 * 33]); o.y = pk2(s[2 * 33], s[3 * 33]); o.z = pk2(s[4 * 33], s[5 * 33]); o.w = pk2(s[6 * 33], s[7 * 33]);
        *(GAS v4u*)(WT + (size_t)(n0 + n) * K + k0 + 8 * c) = o; }
    LDS_WAIT(); asm volatile("" ::: "memory");
}
__device__ __forceinline__ void p0_row(const Frame& F, int r, const LAS float* wrt, LAS float* rgrow) {
    const float* xrow = r < NROWP ? F.xp + (size_t)r * D : F.xs + (size_t)(r - NROWP) * D;
    const GAS f32x4* xr = (const GAS f32x4*)xrow + F.lane;
    const GAS f32x4* gp = (const GAS f32x4*)F.g_pre + F.lane;
    f32x4 v[4]; float s = 0.f;
#pragma unroll
    for (int j = 0; j < 4; ++j) { v[j] = xr[64 * j]; s += (v[j].x * v[j].x + v[j].y * v[j].y) + (v[j].z * v[j].z + v[j].w * v[j].w); }
    const float rs = rsqrtf(wave_sum(s) * (1.f / D) + EPS);
#pragma unroll
    for (int j = 0; j < 4; ++j) v[j] = v[j] * rs * gp[64 * j];
    GAS unsigned long long* o8 = (GAS unsigned long long*)(F.XN + (size_t)r * D) + F.lane;
#pragma unroll
    for (int j = 0; j < 4; ++j) o8[64 * j] = (unsigned long long)pk2(v[j].x, v[j].y) | ((unsigned long long)pk2(v[j].z, v[j].w) << 32);
    float p[16];
#pragma unroll
    for (int jj = 0; jj < 16; ++jj) { float a = 0.f;
#pragma unroll
        for (int j = 0; j < 4; ++j) { const f32x4 w = *(const LAS f32x4*)(wrt + jj * 1024 + 256 * j + 4 * F.lane); a += (v[j].x * w.x + v[j].y * w.y) + (v[j].z * w.z + v[j].w * w.w); }
        p[jj] = a; if ((jj & 3) == 3) asm volatile("" ::: "memory"); }
    const bool b5 = F.lane & 32, b4 = F.lane & 16, b3 = F.lane & 8, b2 = F.lane & 4;
    float q8[8], q4[4], q2[2], q1;
#pragma unroll
    for (int i = 0; i < 8; ++i) { const float send = b5 ? p[i] : p[i + 8], keep = b5 ? p[i + 8] : p[i]; q8[i] = keep + __shfl_xor(send, 32); }
#pragma unroll
    for (int i = 0; i < 4; ++i) { const float send = b4 ? q8[i] : q8[i + 4], keep = b4 ? q8[i + 4] : q8[i]; q4[i] = keep + __shfl_xor(send, 16); }
#pragma unroll
    for (int i = 0; i < 2; ++i) { const float send = b3 ? q4[i] : q4[i + 2], keep = b3 ? q4[i + 2] : q4[i]; q2[i] = keep + __shfl_xor(send, 8); }
    { const float send = b2 ? q2[0] : q2[1], keep = b2 ? q2[1] : q2[0]; q1 = keep + __shfl_xor(send, 4); }
    q1 += __shfl_xor(q1, 2); q1 += __shfl_xor(q1, 1);
    if ((F.lane & 3) == 0) rgrow[F.lane >> 2] = q1;
}
__device__ __forceinline__ void p0_prologue(Frame& F) {
    LAS float* scr = (LAS float*)(F.lds + RING_OFF + F.wave * 16384);
    const int gw = F.vcu * NWAVES + F.wave, NGW = F.G * NWAVES;
    if (blockIdx.x == 0) for (int c = F.tid; c < D; c += NWAVES * 64) F.C8[c] = 8.f * 1.4426950408889634f * logsigf_(F.lam[c]);
    constexpr int I_IN = (D / 64) * (DINP / 32), I_OUT = (DMIX / 64) * (D / 32);
    for (int it = gw; it < I_IN + I_OUT; it += NGW) {
        if (it < I_IN) p0_transpose_item(F.w_in, DIN, D, DINP / 32, F.WinT, scr, it, F.lane);
        else p0_transpose_item(F.w_out, D, DMIX, D / 32, F.WoutT, scr, it - I_IN, F.lane);
    }
    __syncthreads();
    LAS float* wrt = (LAS float*)(F.lds + RING_OFF);
    for (int idx = F.tid; idx < 16 * 1024; idx += NWAVES * 64) { const int k = idx >> 4, j = idx & 15; wrt[j * 1024 + k] = F.w_in[(size_t)k * DIN + DINP + j]; }
    __syncthreads();
    LAS float* rgl = (LAS float*)(F.lds + RING_OFF + 65536);
    float w2[16];
#pragma unroll
    for (int j = 0; j < 16; ++j) w2[j] = F.w_gk2[j * 512 + F.tid];
    const float bg = F.b_gk[F.tid];
    for (int it = F.vcu; it < NP * (TP / 64) + NS; it += F.G) {
        const int nrow = it < NP * (TP / 64) ? 64 : TS; const int r0 = it < NP * (TP / 64) ? it * 64 : NROWP + (it - NP * (TP / 64)) * TS;
        for (int r = F.wave; r < nrow; r += NWAVES) p0_row(F, r0 + r, wrt, rgl + r * 16);
        __syncthreads();
        float cum = 0.f;
        for (int t = 0; t < nrow; ++t) { float z = bg;
#pragma unroll
            for (int j4 = 0; j4 < 4; ++j4) { const f32x4 rg = *(const LAS f32x4*)(rgl + t * 16 + 4 * j4); z += (rg.x * w2[4 * j4] + rg.y * w2[4 * j4 + 1]) + (rg.z * w2[4 * j4 + 2] + rg.w * w2[4 * j4 + 3]); }
            cum += logsigf_(z) * (1.f / 16.f);
            F.BCUM[(size_t)(r0 + t) * 512 + F.tid] = cum; }
        F.DEC[(size_t)it * 512 + F.tid] = __expf(cum);
        __syncthreads();
    }
}

__device__ __forceinline__ float rdlane(float v, int l) { return __builtin_bit_cast(float, __builtin_amdgcn_readlane(__builtin_bit_cast(int, v), l)); }
__device__ __forceinline__ void lru_simple_item(const Frame& F, int kind, int seq, int nb) {
    const int lane = F.lane, c = nb * 64 + lane;
    const int T = kind ? TS : TP; const size_t row0 = kind ? (size_t)NROWP + (size_t)seq * TS : (size_t)seq * TP;
    float wrg[64], wig[64];
#pragma unroll
    for (int d = 0; d < 64; ++d) { wrg[d] = F.w_rg[(size_t)(nb * 64 + d) * 64 + lane]; wig[d] = F.w_ig[(size_t)(nb * 64 + d) * 64 + lane]; }
    const float brg = F.b_rg[c], big = F.b_ig[c], cb = F.conv_b[c], cw0 = F.conv_w[c], cw1 = F.conv_w[1024 + c], cw2 = F.conv_w[2048 + c], cw3 = F.conv_w[3072 + c];
    const float c8 = 8.f * logsigf_(F.lam[c]);
    float h = kind ? F.st_h[(size_t)seq * 1024 + c] : 0.f;
    float xm3 = kind ? F.st_conv[((size_t)seq * 3 + 0) * 1024 + c] : 0.f, xm2 = kind ? F.st_conv[((size_t)seq * 3 + 1) * 1024 + c] : 0.f, xm1 = kind ? F.st_conv[((size_t)seq * 3 + 2) * 1024 + c] : 0.f;
    for (int t0 = 0; t0 < T; t0 += 8) {
        float xv[8], zv[8];
#pragma unroll
        for (int i = 0; i < 8; ++i) { const bf16* pr = F.PROJ + (row0 + t0 + i) * DINP; xv[i] = bf2f(pr[C_XL + c]); zv[i] = bf2f(pr[C_ZL + c]); }
#pragma unroll 1
        for (int i = 0; i < 8; ++i) {
            const float x = xv[i]; const float xc = cb + cw0 * xm3 + cw1 * xm2 + cw2 * xm1 + cw3 * x; xm3 = xm2; xm2 = xm1; xm1 = x;
            float ar = brg, ai = big;
#pragma unroll
            for (int d = 0; d < 64; ++d) { const float xd = rdlane(xc, d); ar += xd * wrg[d]; ai += xd * wig[d]; }
            const float r = sigmoidf_(ar), ig = sigmoidf_(ai);
            const float la = c8 * r, a = __expf(la), u = sqrtf(-expm1f(2.f * la)) * (ig * xc);
            h = a * h + u;
            const float z = zv[i], y = h * z * sigmoidf_(z);
            F.YMIX[(row0 + t0 + i) * DMIX + c] = (bf16)f2bf(y);
        }
    }
    float* ho = F.out + (kind ? O_HS : O_HP) + (size_t)seq * 1024 + c; *ho = h;
    float* co = F.out + (kind ? O_CS : O_CP) + (size_t)seq * 3 * 1024 + c; co[0] = xm3; co[1024] = xm2; co[2048] = xm1;
}
__device__ __forceinline__ void gla_simple_item(const Frame& F, int kind, int seq, int h, int hsel) {
    int t2 = F.tid & 255; asm volatile("" : "+v"(t2)); const int w4 = t2 >> 6;
    const int T = kind ? TS : TP; const size_t row0 = kind ? (size_t)NROWP + (size_t)seq * TS : (size_t)seq * TP;
    LAS float* L = (LAS float*)(F.lds + RING_OFF + hsel * 4096);
    LAS float* al = L, *qs = L + 128, *ks = L + 256, *red = L + 384;
    float S[128];
    const float* s0 = F.st_gla + (((size_t)seq * NH + h) * HK) * HV + t2;
#pragma unroll
    for (int d = 0; d < 128; ++d) S[d] = kind ? s0[(size_t)d * HV] : 0.f;
    const float gh = F.g_head[t2];
    for (int t = 0; t < T; ++t) {
        const size_t row = row0 + t; const bf16* pr = F.PROJ + row * DINP;
        if (t2 < 128) { const bool cbeg = kind ? false : ((t & 63) == 0 && t > 0); const size_t ci = (size_t)(seq * (TP / 64) + (t >> 6) - 1);
            al[t2] = cbeg ? F.DEC[ci * 512 + h * 128 + t2] : 1.f; qs[t2] = bf2f(pr[C_Q + h * 128 + t2]); ks[t2] = bf2f(pr[C_K + h * 128 + t2]); }
        const float vv = bf2f(pr[C_V + h * 256 + t2]), zz = bf2f(pr[C_ZG + h * 256 + t2]);
        __syncthreads();
        float o = 0.f;
#pragma unroll
        for (int d4 = 0; d4 < 32; ++d4) { const f32x4 a4 = *(const LAS f32x4*)(al + 4 * d4), k4 = *(const LAS f32x4*)(ks + 4 * d4), q4 = *(const LAS f32x4*)(qs + 4 * d4);
            S[4 * d4 + 0] = a4.x * S[4 * d4 + 0] + k4.x * vv; o += q4.x * S[4 * d4 + 0];
            S[4 * d4 + 1] = a4.y * S[4 * d4 + 1] + k4.y * vv; o += q4.y * S[4 * d4 + 1];
            S[4 * d4 + 2] = a4.z * S[4 * d4 + 2] + k4.z * vv; o += q4.z * S[4 * d4 + 2];
            S[4 * d4 + 3] = a4.w * S[4 * d4 + 3] + k4.w * vv; o += q4.w * S[4 * d4 + 3]; }
        const float ss = wave_sum(o * o);
        if (F.lane == 0) red[w4] = ss;
        __syncthreads();
        const float tot = (red[0] + red[1]) + (red[2] + red[3]);
        const float rs = rsqrtf(tot * (1.f / 256.f) + EPS);
        const float y = o * rs * gh * (zz * sigmoidf_(zz));
        F.YMIX[row * DMIX + 1024 + h * 256 + t2] = (bf16)f2bf(y);
        __syncthreads();
    }
    if (t2 < 128) al[t2] = F.DEC[(kind ? (size_t)(NP * (TP / 64) + seq) : (size_t)(seq * (TP / 64) + TP / 64 - 1)) * 512 + h * 128 + t2];
    __syncthreads();
    float* so = F.out + (kind ? O_GS : O_GP) + (((size_t)seq * NH + h) * HK) * HV + t2;
#pragma unroll
    for (int d = 0; d < 128; ++d) so[(size_t)d * HV] = S[d] * al[d];
    __syncthreads();
}
#ifndef DUP_PHASE
#define DUP_PHASE -1
#endif


typedef short bf16x8_t __attribute__((ext_vector_type(8)));
typedef float f32x16 __attribute__((ext_vector_type(16)));
constexpr int LRU_XL_ROWS = 44;
constexpr int LRU_XL_OFF = 0, LRU_XL_WB = LRU_XL_ROWS * 128;
constexpr int LRU_ZL_OFF = LRU_XL_OFF + 8 * LRU_XL_WB, LRU_ZL_WB = 32 * 128;
constexpr int LRU_XC_OFF = LRU_ZL_OFF + 8 * LRU_ZL_WB, LRU_XC_WB = 32 * 144;
constexpr int LRU_SL_OFF = LRU_XC_OFF + 8 * LRU_XC_WB;
constexpr int LRU_HC_OFF = LRU_SL_OFF + 2 * 8 * 2 * 64 * 4;
constexpr int LRU_WG_OFF = LRU_HC_OFF + 2 * 64 * 4;
constexpr int LRU_END = LRU_WG_OFF + 128 * 144;
static_assert(LRU_END <= RING_BYTES, "LRU LDS map");
#define L2E 1.4426950408889634f
template <int KIND>
__device__ __forceinline__ void lru_item(const Frame& F, int sg, int nb) {
    int lane = F.lane; asm volatile("" : "+v"(lane));
    const int wave = F.wave, cl = lane & 31, hh = lane >> 5;
    LAS unsigned char* XLw = F.lds + RING_OFF + LRU_XL_OFF + wave * LRU_XL_WB;
    LAS unsigned char* ZLw = F.lds + RING_OFF + LRU_ZL_OFF + wave * LRU_ZL_WB;
    LAS unsigned char* XCw = F.lds + RING_OFF + LRU_XC_OFF + wave * LRU_XC_WB;
    LAS float* SL = (LAS float*)(F.lds + RING_OFF + LRU_SL_OFF);
    LAS float* HC = (LAS float*)(F.lds + RING_OFF + LRU_HC_OFF);
    LAS unsigned char* WGl = F.lds + RING_OFF + LRU_WG_OFF;
    __syncthreads();
    { const int col = F.tid & 127, kq = F.tid >> 7; const float* W = ((col >> 6) ? F.w_ig : F.w_rg) + (size_t)nb * 4096 + (size_t)(16 * kq) * 64 + (col & 63);
      v4u p0, p1;
      p0.x = pk2(-L2E * W[0 * 64], -L2E * W[1 * 64]); p0.y = pk2(-L2E * W[2 * 64], -L2E * W[3 * 64]); p0.z = pk2(-L2E * W[4 * 64], -L2E * W[5 * 64]); p0.w = pk2(-L2E * W[6 * 64], -L2E * W[7 * 64]);
      p1.x = pk2(-L2E * W[8 * 64], -L2E * W[9 * 64]); p1.y = pk2(-L2E * W[10 * 64], -L2E * W[11 * 64]); p1.z = pk2(-L2E * W[12 * 64], -L2E * W[13 * 64]); p1.w = pk2(-L2E * W[14 * 64], -L2E * W[15 * 64]);
      *(LAS v4u*)(WGl + col * 144 + (16 * kq) * 2) = p0; *(LAS v4u*)(WGl + col * 144 + (16 * kq + 8) * 2) = p1; }
    constexpr int NR = KIND ? 1 : 8;
    const size_t rowbase = KIND ? (size_t)NROWP + (size_t)sg * 256 : (size_t)sg * TP;
    if (KIND == 0) { if (F.tid < 64) HC[F.tid] = 0.f; }
    if (KIND == 0) {
#pragma unroll
        for (int q = 0; q < 5; ++q) { const int p = lane + 64 * q; const int row = p >> 3, pc = p & 7;
            if (row < 35) { const long tok = (long)wave * 32 + row - 3; v4u v = (v4u){0u, 0u, 0u, 0u};
                if (tok >= 0) v = *(const GAS v4u*)(F.PROJ + (rowbase + tok) * DINP + C_XL + nb * 64 + pc * 8);
                *(LAS v4u*)(XLw + row * 128 + pc * 16) = v; } }
    } else {
#pragma unroll
        for (int q = 0; q < 6; ++q) { const int p = lane + 64 * q; const int row = p >> 3, pc = p & 7;
            if (row < 44) { const int sq = row / 11, rr = row - sq * 11; const int seq = sg * 32 + wave * 4 + sq; v4u v;
                if (rr < 3) { const float* sp = F.st_conv + ((size_t)seq * 3 + rr) * 1024 + nb * 64 + pc * 8; const f32x4 a = *(const GAS f32x4*)sp, b = *(const GAS f32x4*)(sp + 4);
                    v.x = pk2(a.x, a.y); v.y = pk2(a.z, a.w); v.z = pk2(b.x, b.y); v.w = pk2(b.z, b.w); }
                else v = *(const GAS v4u*)(F.PROJ + ((size_t)NROWP + (size_t)seq * 8 + rr - 3) * DINP + C_XL + nb * 64 + pc * 8);
                *(LAS v4u*)(XLw + row * 128 + pc * 16) = v; } }
    }
#pragma unroll
    for (int q = 0; q < 4; ++q) { const int p = lane + 64 * q; const int row = p >> 3, pc = p & 7;
        *(LAS v4u*)(ZLw + row * 128 + pc * 16) = *(const GAS v4u*)(F.PROJ + (rowbase + wave * 32 + row) * DINP + C_ZL + nb * 64 + pc * 8); }
    for (int r = 0; r < NR; ++r) {
        const int par = r & 1;
        const size_t srow = rowbase + (size_t)r * 256 + wave * 32;
        const bool more = (KIND == 0) && (r + 1 < NR);
        __syncthreads();
        v4u xn[5];
        if (more) {
#pragma unroll
            for (int q = 0; q < 5; ++q) { const int p = lane + 64 * q; const int row = p >> 3, pc = p & 7;
                if (row < 35) xn[q] = *(const GAS v4u*)(F.PROJ + (srow + 256 + row - 3) * DINP + C_XL + nb * 64 + pc * 8); }
        }
        float xc[2][16];
#pragma unroll
        for (int ct = 0; ct < 2; ++ct) {
            const int cg = nb * 64 + 32 * ct + cl; float cw[4]; const float cb = F.conv_b[cg];
#pragma unroll
            for (int j = 0; j < 4; ++j) cw[j] = F.conv_w[j * 1024 + cg];
            const LAS unsigned short* xl = (const LAS unsigned short*)XLw + 32 * ct + cl;
            unsigned short xr[4][7];
#pragma unroll
            for (int g = 0; g < 4; ++g) { const int rb = KIND ? g * 11 + 4 * hh : 8 * g + 4 * hh;
#pragma unroll
                for (int e = 0; e < 7; ++e) xr[g][e] = xl[(rb + e) * 64]; }
#pragma unroll
            for (int g = 0; g < 4; ++g)
#pragma unroll
                for (int e = 0; e < 4; ++e) xc[ct][4 * g + e] = cb + cw[0] * bf2f(xr[g][e]) + cw[1] * bf2f(xr[g][e + 1]) + cw[2] * bf2f(xr[g][e + 2]) + cw[3] * bf2f(xr[g][e + 3]);
        }
#pragma unroll
        for (int ct = 0; ct < 2; ++ct)
#pragma unroll
            for (int i = 0; i < 16; i += 2) { const unsigned w = pg8::cvt_pk_bf16(xc[ct][i], xc[ct][i + 1]);
                *(LAS unsigned short*)(XCw + ((i & 3) + 8 * (i >> 2) + 4 * hh) * 144 + (32 * ct + cl) * 2) = (unsigned short)w;
                *(LAS unsigned short*)(XCw + (((i + 1) & 3) + 8 * (i >> 2) + 4 * hh) * 144 + (32 * ct + cl) * 2) = (unsigned short)(w >> 16); }
        if (more) {
#pragma unroll
            for (int q = 0; q < 5; ++q) { const int p = lane + 64 * q; const int row = p >> 3, pc = p & 7;
                if (row < 35) *(LAS v4u*)(XLw + row * 128 + pc * 16) = xn[q]; }
        }
        bf16x8_t Af[4];
#pragma unroll
        for (int s = 0; s < 4; ++s) Af[s] = *(const LAS bf16x8_t*)(XCw + cl * 144 + (16 * s + 8 * hh) * 2);
        float At_[2], Ut_[2];
        float Aloc[2][16], Hloc[2][16], AGk[2][4], UGk[2][4];
#pragma unroll
        for (int ct = 0; ct < 2; ++ct) {
            f32x16 ar, ai; const int cg = nb * 64 + 32 * ct + cl;
            const float brg = -L2E * F.b_rg[cg], big = -L2E * F.b_ig[cg], c8 = F.C8[cg];
#pragma unroll
            for (int i = 0; i < 16; ++i) { ar[i] = brg; ai[i] = big; }
            bf16x8_t b0[4], b1[4];
#pragma unroll
            for (int s = 0; s < 4; ++s) { b0[s] = *(const LAS bf16x8_t*)(WGl + (32 * ct + cl) * 144 + (16 * s + 8 * hh) * 2); b1[s] = *(const LAS bf16x8_t*)(WGl + (64 + 32 * ct + cl) * 144 + (16 * s + 8 * hh) * 2); }
#pragma unroll
            for (int s = 0; s < 4; ++s) { ar = __builtin_amdgcn_mfma_f32_32x32x16_bf16(Af[s], b0[s], ar, 0, 0, 0); ai = __builtin_amdgcn_mfma_f32_32x32x16_bf16(Af[s], b1[s], ai, 0, 0, 0); }
            float AG[4], UG[4];
#pragma unroll
            for (int g = 0; g < 4; ++g) { float Ap = 1.f, Hp = 0.f;
#pragma unroll
                for (int e = 0; e < 4; ++e) { const int i = 4 * g + e;
                    const float rr = __builtin_amdgcn_rcpf(1.f + __builtin_amdgcn_exp2f(ar[i])), ig = __builtin_amdgcn_rcpf(1.f + __builtin_amdgcn_exp2f(ai[i]));
                    const float a = __builtin_amdgcn_exp2f(c8 * rr);
                    const float u = __builtin_amdgcn_sqrtf(fmaxf(1.f - a * a, 0.f)) * (ig * xc[ct][i]);
                    Hp = a * Hp + u; Ap = a * Ap; Aloc[ct][i] = Ap; Hloc[ct][i] = Hp; }
                AG[g] = Ap; UG[g] = Hp; }
            float At = 1.f, Ut = 0.f;
#pragma unroll
            for (int g = 0; g < 4; ++g) { const float pA = __shfl_xor(AG[g], 32), pU = __shfl_xor(UG[g], 32);
                const float a0 = hh ? pA : AG[g], u0 = hh ? pU : UG[g], a1 = hh ? AG[g] : pA, u1 = hh ? UG[g] : pU;
                Ut = a0 * Ut + u0; At = a0 * At; Ut = a1 * Ut + u1; At = a1 * At; AGk[ct][g] = AG[g]; UGk[ct][g] = UG[g]; }
            At_[ct] = At; Ut_[ct] = Ut;
        }
        v4u zn[4];
        if (more) {
#pragma unroll
            for (int q = 0; q < 4; ++q) { const int p = lane + 64 * q; const int row = p >> 3, pc = p & 7;
                zn[q] = *(const GAS v4u*)(F.PROJ + (srow + 256 + row) * DINP + C_ZL + nb * 64 + pc * 8); }
        }
        float hin[2] = {0.f, 0.f};
        if (KIND == 0) {
            if (hh == 0) {
#pragma unroll
                for (int ct = 0; ct < 2; ++ct) { SL[((par * 8 + wave) * 2 + 0) * 64 + 32 * ct + cl] = At_[ct]; SL[((par * 8 + wave) * 2 + 1) * 64 + 32 * ct + cl] = Ut_[ct]; } }
            __syncthreads();
#pragma unroll
            for (int ct = 0; ct < 2; ++ct) { float sa[7], su[7]; float hs = HC[par * 64 + 32 * ct + cl];
#pragma unroll
                for (int w2 = 0; w2 < 7; ++w2) { sa[w2] = SL[((par * 8 + w2) * 2 + 0) * 64 + 32 * ct + cl]; su[w2] = SL[((par * 8 + w2) * 2 + 1) * 64 + 32 * ct + cl]; }
#pragma unroll
                for (int w2 = 0; w2 < 7; ++w2) { const float hn = sa[w2] * hs + su[w2]; hs = w2 < wave ? hn : hs; }
                hin[ct] = hs;
                if (wave == 7 && hh == 0) HC[(par ^ 1) * 64 + 32 * ct + cl] = At_[ct] * hs + Ut_[ct]; }
        }
#pragma unroll
        for (int ct = 0; ct < 2; ++ct) {
            float hst[4]; float hs = hin[ct];
#pragma unroll
            for (int g = 0; g < 4; ++g) { const float pA = __shfl_xor(AGk[ct][g], 32), pU = __shfl_xor(UGk[ct][g], 32);
                const float a0 = hh ? pA : AGk[ct][g], u0 = hh ? pU : UGk[ct][g], a1 = hh ? AGk[ct][g] : pA, u1 = hh ? UGk[ct][g] : pU;
                if (KIND == 1) hs = F.st_h[(size_t)(sg * 32 + wave * 4 + g) * 1024 + nb * 64 + 32 * ct + cl];
                const float hs0 = hs; hs = a0 * hs + u0;
                hst[g] = hh ? hs : hs0; hs = a1 * hs + u1;
                if (KIND == 1 && hh == 0) F.out[O_HS + (size_t)(sg * 32 + wave * 4 + g) * 1024 + nb * 64 + 32 * ct + cl] = hs;
            }
            if (KIND == 0 && r == NR - 1 && wave == 7 && hh == 0) F.out[O_HP + (size_t)sg * 1024 + nb * 64 + 32 * ct + cl] = hs;
            LAS unsigned short* zl = (LAS unsigned short*)ZLw + 32 * ct + cl;
            unsigned short zr[16];
#pragma unroll
            for (int i = 0; i < 16; ++i) zr[i] = zl[((i & 3) + 8 * (i >> 2) + 4 * hh) * 64];
            unsigned short yr[16];
#pragma unroll
            for (int i = 0; i < 16; i += 2) { const float y0 = (Aloc[ct][i] * hst[i >> 2] + Hloc[ct][i]) * bf2f(zr[i]), y1 = (Aloc[ct][i + 1] * hst[i >> 2] + Hloc[ct][i + 1]) * bf2f(zr[i + 1]);
                const unsigned w = pg8::cvt_pk_bf16(y0, y1); yr[i] = (unsigned short)w; yr[i + 1] = (unsigned short)(w >> 16); }
#pragma unroll
            for (int i = 0; i < 16; ++i) zl[((i & 3) + 8 * (i >> 2) + 4 * hh) * 64] = yr[i];
        }
        v4u yo[4];
#pragma unroll
        for (int q = 0; q < 4; ++q) { const int p = lane + 64 * q; yo[q] = *(const LAS v4u*)(ZLw + (p >> 3) * 128 + (p & 7) * 16); }
#pragma unroll
        for (int q = 0; q < 4; ++q) { const int p = lane + 64 * q; *(GAS v4u*)(F.YMIX + (srow + (p >> 3)) * DMIX + nb * 64 + (p & 7) * 8) = yo[q]; }
        if (KIND == 0) {
            if (r == NR - 1 && wave == 7) { for (int e = lane; e < 192; e += 64) { const int j = e >> 6, c = e & 63;
                F.out[O_CP + ((size_t)sg * 3 + j) * 1024 + nb * 64 + c] = bf2f(((const LAS unsigned short*)XLw)[(32 + j) * 64 + c]); } }
        } else {
            for (int e = lane; e < 4 * 192; e += 64) { const int sq = e / 192, j = (e % 192) >> 6, c = e & 63;
                F.out[O_CS + ((size_t)(sg * 32 + wave * 4 + sq) * 3 + j) * 1024 + nb * 64 + c] = bf2f(((const LAS unsigned short*)XLw)[(sq * 11 + 8 + j) * 64 + c]); }
        }
        if (more) {
#pragma unroll
            for (int q = 0; q < 4; ++q) { const int p = lane + 64 * q; *(LAS v4u*)(ZLw + (p >> 3) * 128 + (p & 7) * 16) = zn[q]; }
        }
    }
    __syncthreads();
}


constexpr int GL_BUF = 49152;
constexpr int GL_QT = 0, GL_KT = 16384, GL_VZ = 32768, GL_AT = 2 * GL_BUF, GL_SBT = GL_AT + 9216, GL_YL = GL_SBT + 17408, GL_DEC = GL_YL + 9216, GL_END = GL_DEC + 16384;
static_assert(GL_END <= RING_BYTES, "GLA LDS map");
__device__ __forceinline__ unsigned off_b(unsigned row, unsigned ch) { return 256u * row + 16u * (ch ^ (((row & 3u) << 2) | ((row >> 2) & 3u))); }
__device__ __forceinline__ void tr_addr(unsigned lane, unsigned c, unsigned ks, unsigned& a0, unsigned& a1) {
    const unsigned h = lane >> 5, blk = (lane >> 4) & 1u, q = (lane & 15u) >> 2, p = lane & 3u;
    a0 = off_b(16u * ks + 8u * h + q, 4u * c + 2u * blk + (p >> 1)) + 8u * (p & 1u);
    a1 = off_b(16u * ks + 8u * h + 4u + q, 4u * c + 2u * blk + (p >> 1)) + 8u * (p & 1u);
}
__device__ __forceinline__ void tr_frag4(unsigned base, const unsigned (&a)[8], bf16x8_t (&f)[4]) {
    v2u r0, r1, r2, r3, r4, r5, r6, r7;
    asm volatile("ds_read_b64_tr_b16 %0, %8\n\tds_read_b64_tr_b16 %1, %9\n\tds_read_b64_tr_b16 %2, %10\n\tds_read_b64_tr_b16 %3, %11\n\t"
                 "ds_read_b64_tr_b16 %4, %12\n\tds_read_b64_tr_b16 %5, %13\n\tds_read_b64_tr_b16 %6, %14\n\tds_read_b64_tr_b16 %7, %15\n\ts_waitcnt lgkmcnt(0)"
                 : "=&v"(r0), "=&v"(r1), "=&v"(r2), "=&v"(r3), "=&v"(r4), "=&v"(r5), "=&v"(r6), "=&v"(r7)
                 : "v"(base + a[0]), "v"(base + a[1]), "v"(base + a[2]), "v"(base + a[3]), "v"(base + a[4]), "v"(base + a[5]), "v"(base + a[6]), "v"(base + a[7]) : "memory");
    f[0] = __builtin_bit_cast(bf16x8_t, (v4u){r0.x, r0.y, r1.x, r1.y}); f[1] = __builtin_bit_cast(bf16x8_t, (v4u){r2.x, r2.y, r3.x, r3.y});
    f[2] = __builtin_bit_cast(bf16x8_t, (v4u){r4.x, r4.y, r5.x, r5.y}); f[3] = __builtin_bit_cast(bf16x8_t, (v4u){r6.x, r6.y, r7.x, r7.y});
}
__device__ __forceinline__ void gla_item(const Frame& F, int b, int h, int vs) {
    int tid = F.tid; asm volatile("" : "+v"(tid));
    const int lane = tid & 63, wave = F.wave, cl = lane & 31, hh = lane >> 5;
    LAS unsigned char* L = F.lds + RING_OFF;
    const unsigned Lb = (unsigned)(size_t)L;
    const int dt = wave >> 1, vt = wave & 1;
    const size_t row0 = (size_t)b * TP;
    f32x16 Sacc;
#pragma unroll
    for (int i = 0; i < 16; ++i) Sacc[i] = 0.f;
    v4u pq[2], pk[2], pv, pz;
    float gh[16];
#pragma unroll
    for (int i = 0; i < 16; ++i) gh[i] = F.g_head[vs * 64 + 32 * vt + (i & 3) + 8 * (i >> 2) + 4 * hh];
    const int qrow = tid >> 4, qch = tid & 15, vrow = tid >> 3, vch = tid & 7;
    const unsigned sq0 = off_b(qrow, qch), sq1 = off_b(qrow + 32, qch), sv0 = off_b(vrow, vch), sv1 = off_b(vrow, 8 + vch);
    unsigned tk[8], tv[8];
#pragma unroll
    for (unsigned ks = 0; ks < 4; ++ks) { tr_addr(lane, dt, ks, tk[2 * ks], tk[2 * ks + 1]); tr_addr(lane, vt, ks, tv[2 * ks], tv[2 * ks + 1]); }
#define GL_LOAD(n) do { const bf16* pr = F.PROJ + (row0 + (size_t)(n) * 64) * DINP; \
        pq[0] = *(const GAS v4u*)(pr + (size_t)qrow * DINP + C_Q + h * 128 + qch * 8); pq[1] = *(const GAS v4u*)(pr + (size_t)(qrow + 32) * DINP + C_Q + h * 128 + qch * 8); \
        pk[0] = *(const GAS v4u*)(pr + (size_t)qrow * DINP + C_K + h * 128 + qch * 8); pk[1] = *(const GAS v4u*)(pr + (size_t)(qrow + 32) * DINP + C_K + h * 128 + qch * 8); \
        pv = *(const GAS v4u*)(pr + (size_t)vrow * DINP + C_V + h * 256 + vs * 64 + vch * 8); pz = *(const GAS v4u*)(pr + (size_t)vrow * DINP + C_ZG + h * 256 + vs * 64 + vch * 8); \
        } while (0)
#define GL_STAGE(bo) do { LAS unsigned char* B_ = L + (bo); \
        *(LAS v4u*)(B_ + GL_QT + sq0) = pq[0]; *(LAS v4u*)(B_ + GL_QT + sq1) = pq[1]; *(LAS v4u*)(B_ + GL_KT + sq0) = pk[0]; *(LAS v4u*)(B_ + GL_KT + sq1) = pk[1]; \
        *(LAS v4u*)(B_ + GL_VZ + sv0) = pv; *(LAS v4u*)(B_ + GL_VZ + sv1) = pz; } while (0)
#define GL_ROWF(img, row, ks) (*(const LAS bf16x8_t*)(L + (img) + off_b((row), 2 * (ks) + hh)))
#define GL_PADF(base, stride, row, ks) (*(const LAS bf16x8_t*)(L + (base) + (row) * (stride) + (16 * (ks) + 8 * hh) * 2))
#define GL_UPD(bo) do { bf16x8_t fa[4], fb[4]; f32x4 dc[4]; \
        _Pragma("unroll") for (int g = 0; g < 4; ++g) dc[g] = *(const LAS f32x4*)(L + GL_DEC + (n * 128 + 32 * dt + 8 * g + 4 * hh) * 4); \
        tr_frag4(Lb + (bo) + GL_KT, tk, fa); tr_frag4(Lb + (bo) + GL_VZ, tv, fb); \
        _Pragma("unroll") for (int ks = 0; ks < 4; ++ks) Sacc = __builtin_amdgcn_mfma_f32_32x32x16_bf16(fa[ks], fb[ks], Sacc, 0, 0, 0); \
        _Pragma("unroll") for (int i = 0; i < 16; ++i) Sacc[i] *= dc[i >> 2][i & 3]; } while (0)
    __syncthreads();
    for (int i = tid; i < (TP / 64) * 32; i += NWAVES * 64) *(LAS f32x4*)(L + GL_DEC + i * 16) = *(const GAS f32x4*)(F.DEC + ((size_t)(b * (TP / 64) + (i >> 5))) * 512 + h * 128 + (i & 31) * 4);
    GL_LOAD(0); GL_STAGE(0);
    GL_LOAD(1);
    for (int n = 0; n < TP / 64; ++n) {
        const int bo = (n & 1) * GL_BUF;
        __syncthreads();
        if (n > 0) {
            *(GAS v4u*)(F.YMIX + (row0 + (size_t)(n - 1) * 64 + vrow) * DMIX + 1024 + h * 256 + vs * 64 + vch * 8) = *(const LAS v4u*)(L + GL_YL + vrow * 144 + vch * 16); }
        if (n + 1 < TP / 64) GL_STAGE(GL_BUF - bo);
        if (n + 2 < TP / 64) GL_LOAD(n + 2);
#pragma unroll
        for (int g = 0; g < 4; ++g) { v2u w; w.x = pg8::cvt_pk_bf16(Sacc[4 * g], Sacc[4 * g + 1]); w.y = pg8::cvt_pk_bf16(Sacc[4 * g + 2], Sacc[4 * g + 3]);
            *(LAS v2u*)(L + GL_SBT + (32 * vt + cl) * 272 + (32 * dt + 8 * g + 4 * hh) * 2) = w; }
        const bool attw = (wave >= 4 && wave < 7);
        if (attw) {
            const int st = (wave - 4) >> 1, ct = (wave - 3) >> 1;
            f32x16 a;
#pragma unroll
            for (int i = 0; i < 16; ++i) a[i] = 0.f;
            bf16x8_t ka[8], qb[8];
#pragma unroll
            for (int ks = 0; ks < 8; ++ks) { ka[ks] = GL_ROWF(bo + GL_KT, 32 * st + cl, ks); qb[ks] = GL_ROWF(bo + GL_QT, 32 * ct + cl, ks); }
            asm volatile("s_waitcnt lgkmcnt(0)" ::: "memory");
#pragma unroll
            for (int ks = 0; ks < 8; ++ks) a = __builtin_amdgcn_mfma_f32_32x32x16_bf16(ka[ks], qb[ks], a, 0, 0, 0);
            if (st == ct) {
#pragma unroll
                for (int i = 0; i < 16; ++i) { const int sl = (i & 3) + 8 * (i >> 2) + 4 * hh; a[i] = sl <= cl ? a[i] : 0.f; } }
#pragma unroll
            for (int g = 0; g < 4; ++g) { v2u w; w.x = pg8::cvt_pk_bf16(a[4 * g], a[4 * g + 1]); w.y = pg8::cvt_pk_bf16(a[4 * g + 2], a[4 * g + 3]);
                *(LAS v2u*)(L + GL_AT + (32 * ct + cl) * 144 + (32 * st + 8 * g + 4 * hh) * 2) = w; }
        } else GL_UPD(bo);
        __syncthreads();
        if (attw) GL_UPD(bo);
        if (wave < 4) {
            f32x16 o;
#pragma unroll
            for (int i = 0; i < 16; ++i) o[i] = 0.f;
            bf16x8_t fv[4], fa[4], fs[4], fq[4]; tr_frag4(Lb + bo + GL_VZ, tv, fv);
            v2u zc[4];
#pragma unroll
            for (int ks = 0; ks < 4; ++ks) { fa[ks] = GL_PADF(GL_AT, 144, 32 * dt + cl, ks); fs[ks] = GL_PADF(GL_SBT, 272, 32 * vt + cl, ks); fq[ks] = GL_ROWF(bo + GL_QT, 32 * dt + cl, ks); }
            asm volatile("s_waitcnt lgkmcnt(0)" ::: "memory");
            o = __builtin_amdgcn_mfma_f32_32x32x16_bf16(fv[0], fa[0], o, 0, 0, 0);
            o = __builtin_amdgcn_mfma_f32_32x32x16_bf16(fv[1], fa[1], o, 0, 0, 0);
            if (dt) { o = __builtin_amdgcn_mfma_f32_32x32x16_bf16(fv[2], fa[2], o, 0, 0, 0); o = __builtin_amdgcn_mfma_f32_32x32x16_bf16(fv[3], fa[3], o, 0, 0, 0); }
#pragma unroll
            for (int ks = 0; ks < 4; ++ks) o = __builtin_amdgcn_mfma_f32_32x32x16_bf16(fs[ks], fq[ks], o, 0, 0, 0);
#pragma unroll
            for (int ks = 0; ks < 4; ++ks) { fs[ks] = GL_PADF(GL_SBT, 272, 32 * vt + cl, 4 + ks); fq[ks] = GL_ROWF(bo + GL_QT, 32 * dt + cl, 4 + ks); }
#pragma unroll
            for (int g = 0; g < 4; ++g) zc[g] = *(const LAS v2u*)(L + bo + GL_VZ + off_b(32 * dt + cl, 8 + 4 * vt + g) + 8 * hh);
            asm volatile("s_waitcnt lgkmcnt(0)" ::: "memory");
#pragma unroll
            for (int ks = 0; ks < 4; ++ks) o = __builtin_amdgcn_mfma_f32_32x32x16_bf16(fs[ks], fq[ks], o, 0, 0, 0);
            float ss = 0.f;
#pragma unroll
            for (int i = 0; i < 16; ++i) ss += o[i] * o[i];
            ss += __shfl_xor(ss, 32);
            const size_t row = row0 + (size_t)n * 64 + 32 * dt + cl;
            if (hh == 0) F.PSS[(size_t)(h * 8 + vs * 2 + vt) * NROWP + row] = ss;
#pragma unroll
            for (int g = 0; g < 4; ++g) {
                const float y0 = o[4 * g] * gh[4 * g] * bflo(zc[g].x), y1 = o[4 * g + 1] * gh[4 * g + 1] * bfhi(zc[g].x), y2 = o[4 * g + 2] * gh[4 * g + 2] * bflo(zc[g].y), y3 = o[4 * g + 3] * gh[4 * g + 3] * bfhi(zc[g].y);
                v2u w; w.x = pg8::cvt_pk_bf16(y0, y1); w.y = pg8::cvt_pk_bf16(y2, y3); *(LAS v2u*)(L + GL_YL + (32 * dt + cl) * 144 + (32 * vt + 8 * g + 4 * hh) * 2) = w; }
        }
    }
    __syncthreads();
    *(GAS v4u*)(F.YMIX + (row0 + (size_t)(TP / 64 - 1) * 64 + vrow) * DMIX + 1024 + h * 256 + vs * 64 + vch * 8) = *(const LAS v4u*)(L + GL_YL + vrow * 144 + vch * 16);
    float* so = F.out + O_GP + (((size_t)b * NH + h) * HK + 32 * dt) * HV + vs * 64 + 32 * vt + cl;
#pragma unroll
    for (int i = 0; i < 16; ++i) so[(size_t)((i & 3) + 8 * (i >> 2) + 4 * hh) * HV] = Sacc[i];
    __syncthreads();
#undef GL_LOAD
#undef GL_STAGE
#undef GL_ROWF
#undef GL_PADF
#undef GL_UPD
}
__device__ __forceinline__ void p2b_norm(Frame& F) {
    const int gw = F.vcu * NWAVES + F.wave, NGW = F.G * NWAVES;
    for (int r = gw; r < NROWP; r += NGW) {
        const int hd = F.lane >> 4;
        float tot = 0.f;
#pragma unroll
        for (int k = 0; k < 8; ++k) tot += F.PSS[(size_t)(hd * 8 + k) * NROWP + r];
        const float rs = rsqrtf(tot * (1.f / 256.f) + EPS);
        GAS v4u* yp = (GAS v4u*)(F.YMIX + (size_t)r * DMIX + 1024 + F.lane * 16);
#pragma unroll
        for (int q = 0; q < 2; ++q) { v4u w = yp[q];
            w.x = pk2(bflo(w.x) * rs, bfhi(w.x) * rs); w.y = pk2(bflo(w.y) * rs, bfhi(w.y) * rs); w.z = pk2(bflo(w.z) * rs, bfhi(w.z) * rs); w.w = pk2(bflo(w.w) * rs, bfhi(w.w) * rs); yp[q] = w; }
    }
}

constexpr int GS_Q = 0, GS_K = 4096, GS_V = 8192, GS_DEC = 16384, GS_ATT = 16896, GS_OP = 17408, GS_END = GS_OP + 8 * 8 * 256 * 4;
static_assert(GS_END <= RING_BYTES, "GLA sample LDS map");
__device__ __forceinline__ void gla_sample_item(const Frame& F, int seq, int h) {
    int tid = F.tid; asm volatile("" : "+v"(tid));
    const int lane = tid & 63, wave = F.wave, v4 = tid & 63, dg = wave;
    LAS float* Lq = (LAS float*)(F.lds + RING_OFF + GS_Q);
    LAS float* Lk = (LAS float*)(F.lds + RING_OFF + GS_K);
    LAS float* Lv = (LAS float*)(F.lds + RING_OFF + GS_V);
    LAS float* Ld = (LAS float*)(F.lds + RING_OFF + GS_DEC);
    LAS float* La = (LAS float*)(F.lds + RING_OFF + GS_ATT);
    LAS float* Lo = (LAS float*)(F.lds + RING_OFF + GS_OP);
    const size_t row0 = (size_t)NROWP + (size_t)seq * TS;
    const float* s0 = F.st_gla + (((size_t)seq * NH + h) * HK + 16 * dg) * HV + 4 * v4;
    f32x4 S[16];
#pragma unroll
    for (int i = 0; i < 16; ++i) S[i] = *(const GAS f32x4*)(s0 + (size_t)i * HV);
    __syncthreads();
    { const int t = tid >> 6, c = tid & 63; const bf16* pr = F.PROJ + (row0 + t) * DINP;
      const unsigned q2 = *(const GAS unsigned*)(pr + C_Q + h * 128 + 2 * c), k2 = *(const GAS unsigned*)(pr + C_K + h * 128 + 2 * c);
      Lq[t * 128 + 2 * c] = bflo(q2); Lq[t * 128 + 2 * c + 1] = bfhi(q2); Lk[t * 128 + 2 * c] = bflo(k2); Lk[t * 128 + 2 * c + 1] = bfhi(k2);
      const v2u vv = *(const GAS v2u*)(pr + C_V + h * 256 + 4 * c);
      *(LAS f32x4*)(Lv + t * 256 + 4 * c) = (f32x4){bflo(vv.x), bfhi(vv.x), bflo(vv.y), bfhi(vv.y)};
      if (tid < 128) Ld[tid] = F.DEC[(size_t)(NP * (TP / 64) + seq) * 512 + h * 128 + tid]; }
    __syncthreads();
    if (wave == 0) { const int t = lane >> 3, s = lane & 7; float a = 0.f;
        for (int d = 0; d < 128; d += 4) { const f32x4 q = *(const LAS f32x4*)(Lq + t * 128 + d), k = *(const LAS f32x4*)(Lk + s * 128 + d); a += (q.x * k.x + q.y * k.y) + (q.z * k.z + q.w * k.w); }
        La[lane] = s <= t ? a : 0.f; }
    f32x4 o[8];
#pragma unroll
    for (int t = 0; t < 8; ++t) o[t] = (f32x4){0.f, 0.f, 0.f, 0.f};
    f32x4 vr[8];
#pragma unroll
    for (int t = 0; t < 8; ++t) vr[t] = *(const LAS f32x4*)(Lv + t * 256 + 4 * v4);
    float* so = F.out + O_GS + (((size_t)seq * NH + h) * HK + 16 * dg) * HV + 4 * v4;
#pragma unroll
    for (int i = 0; i < 16; ++i) { const int d = 16 * dg + i; f32x4 sn = S[i];
#pragma unroll
        for (int t = 0; t < 8; ++t) { const float q = Lq[t * 128 + d], k = Lk[t * 128 + d]; o[t] += q * S[i]; sn += k * vr[t]; }
        *(GAS f32x4*)(so + (size_t)i * HV) = sn * Ld[d]; }
#pragma unroll
    for (int t = 0; t < 8; ++t) *(LAS f32x4*)(Lo + (dg * 8 + t) * 256 + 4 * v4) = o[t];
    __syncthreads();
    { const int t = wave; f32x4 a = (f32x4){0.f, 0.f, 0.f, 0.f};
#pragma unroll
      for (int g = 0; g < 8; ++g) a += *(const LAS f32x4*)(Lo + (g * 8 + t) * 256 + 4 * v4);
#pragma unroll
      for (int s = 0; s < 8; ++s) a += La[t * 8 + s] * vr[s];
      const float ss = wave_sum((a.x * a.x + a.y * a.y) + (a.z * a.z + a.w * a.w));
      const float rs = rsqrtf(ss * (1.f / 256.f) + EPS);
      const f32x4 gh = *(const GAS f32x4*)(F.g_head + 4 * v4);
      const v2u zz = *(const GAS v2u*)(F.PROJ + (row0 + t) * DINP + C_ZG + h * 256 + 4 * v4);
      const float z0 = bflo(zz.x), z1 = bfhi(zz.x), z2 = bflo(zz.y), z3 = bfhi(zz.y);
      v2u w; w.x = pk2(a.x * rs * gh.x * z0, a.y * rs * gh.y * z1); w.y = pk2(a.z * rs * gh.z * z2, a.w * rs * gh.w * z3);
      *(GAS v2u*)(F.YMIX + (row0 + t) * DMIX + 1024 + h * 256 + 4 * v4) = w; }
}

__device__ __forceinline__ void p2_mix_simple(Frame& F) {
    for (int it = F.vcu; it < 2 * NP * 16; it += F.G) {
        if (it < NP * 16) { for (int rep = 0; rep < (DUP_PHASE == 6 ? 2 : 1); ++rep) lru_item<0>(F, it >> 4, it & 15); }
        else { const int g = it - NP * 16; for (int rep = 0; rep < (DUP_PHASE == 7 ? 2 : 1); ++rep) gla_item(F, g >> 4, (g >> 2) & 3, g & 3); }
    }
    for (int rep = 0; rep < (DUP_PHASE == 8 ? 2 : 1); ++rep) for (int it = F.vcu; it < 4 * 16; it += F.G) lru_item<1>(F, it >> 4, it & 15);
    for (int rep = 0; rep < (DUP_PHASE == 9 ? 2 : 1); ++rep) for (int it = F.vcu; it < NS * NH; it += F.G) gla_sample_item(F, it >> 2, it & 3);
    __syncthreads();
}

__device__ __forceinline__ void p4_final(Frame& F) {
    const int gw = F.vcu * NWAVES + F.wave, NGW = F.G * NWAVES;
    const GAS f32x4* gp = (const GAS f32x4*)F.g_post + F.lane;
    f32x4 g[4];
#pragma unroll
    for (int j = 0; j < 4; ++j) g[j] = gp[64 * j];
    for (int r = gw; r < NTOK; r += NGW) {
        const float* xrow = r < NROWP ? F.xp + (size_t)r * D : F.xs + (size_t)(r - NROWP) * D;
        const GAS f32x4* xr = (const GAS f32x4*)xrow + F.lane;
        const GAS v2u* yr = (const GAS v2u*)(F.YBF + (size_t)r * D) + F.lane;
        float ps = F.lane < 16 ? F.PART[(size_t)F.lane * NTOK + r] : 0.f;
        const float rs = rsqrtf(wave_sum(ps) * (1.f / D) + EPS);
        GAS f32x4* orow = (GAS f32x4*)(F.out + (size_t)r * D) + F.lane;
#pragma unroll
        for (int j = 0; j < 4; ++j) { const f32x4 x = xr[64 * j]; const v2u y = yr[64 * j];
            f32x4 o; o.x = x.x + bflo(y.x) * rs * g[j].x; o.y = x.y + bfhi(y.x) * rs * g[j].y; o.z = x.z + bflo(y.y) * rs * g[j].z; o.w = x.w + bfhi(y.y) * rs * g[j].w;
            orow[64 * j] = o; }
    }
}


struct Args { const float* in[19]; float* out; unsigned char* ws; int ph_lo, ph_hi, li, pad; };
__global__ void __launch_bounds__(NWAVES * 64, 2) mk_fwd(Args args) {
    extern __shared__ __attribute__((aligned(16))) unsigned char lds[];
    Frame F;
    F.lds = (LAS unsigned char*)lds;
    F.MISC = (volatile LAS unsigned*)(F.lds + MISC_OFF);
    F.tid = threadIdx.x; F.lane = F.tid & 63; F.wave = __builtin_amdgcn_readfirstlane(F.tid >> 6);
    F.G = gridDim.x; { const int bx = blockIdx.x; F.vcu = (F.G % 8 == 0) ? (bx % 8) * (F.G / 8) + bx / 8 : bx; }
    unsigned char* ws = args.ws;
    F.ctl = (gu32*)(ws + WS_CTL);
    F.xp = args.in[0]; F.xs = args.in[1]; F.st_h = args.in[2]; F.st_conv = args.in[3]; F.st_gla = args.in[4]; F.g_pre = args.in[5]; F.w_in = args.in[6];
    F.conv_w = args.in[7]; F.conv_b = args.in[8]; F.w_rg = args.in[9]; F.b_rg = args.in[10]; F.w_ig = args.in[11]; F.b_ig = args.in[12]; F.lam = args.in[13];
    F.w_gk2 = args.in[14]; F.b_gk = args.in[15]; F.g_head = args.in[16]; F.w_out = args.in[17]; F.g_post = args.in[18];
    F.out = args.out;
    F.WinT = (bf16*)(ws + WS_WINT); F.WoutT = (bf16*)(ws + WS_WOUT); F.XN = (bf16*)(ws + WS_XN); F.PROJ = (bf16*)(ws + WS_PROJ);
    F.YMIX = (bf16*)args.out;
    F.YBF = (bf16*)(ws + WS_XN);
    F.RGK = (float*)(ws + WS_RGK); F.PART = (float*)(ws + WS_PART); F.DEC = (float*)(ws + WS_DEC); F.PSS = (float*)(ws + WS_RGK); F.C8 = (float*)(ws + WS_PART);
    F.BCUM = args.out + O_GS;
    for (int u = F.tid; u < (LDS_BYTES - LDSCTL_OFF) / 4; u += NWAVES * 64) ((LAS unsigned*)(F.lds + LDSCTL_OFF))[u] = 0u;
    __syncthreads();
    XcdBarrier bar; bar.bar = (unsigned*)(F.ctl + CW_BAR); bar.x = 0; bar.st = nullptr;
    if (N_LAUNCHES == 1) bar = xcd_barrier_post((unsigned*)(F.ctl + CW_BAR), F.MISC + 8);
#define GRID_BAR() do { if (N_LAUNCHES == 1) xcd_barrier(bar); } while (0)
    const int lo = args.ph_lo, hi = args.ph_hi;
#ifndef PH_MASK
#define PH_MASK 31
#endif
#define IN(k) (lo <= (k) && (k) < hi && ((PH_MASK >> (k)) & 1))
#define BOTH(k) (IN(k) && IN((k) + 1))
#ifndef DUP_PHASE
#define DUP_PHASE -1
#endif
#define REPS(k) for (int rep_ = 0; rep_ < ((DUP_PHASE == (k)) ? 2 : 1); ++rep_)
    if (IN(0)) { REPS(0) { p0_prologue(F); if (BOTH(0)) GRID_BAR(); } }
    if (IN(1)) { REPS(1) {
        pg8::Gemm g{F.XN, F.WinT, NTOK, DINP, D}; pg8::StaticOrder S; S.init(NTOK, DINP, F.G, (int)blockIdx.x);
        pg8::EpiProj E{F.PROJ, DINP, F.BCUM};
        pg8::gemm_phase<pg8::EpiProj, pg8::StaticOrder, true, true>(F.lds + RING_OFF, g, S, E);
        if (BOTH(1)) GRID_BAR(); }
    }
    if (IN(2)) { REPS(2) { p2_mix_simple(F); GRID_BAR(); } REPS(5) { p2b_norm(F); if (BOTH(2)) GRID_BAR(); } }
    if (IN(3)) { REPS(3) {
        pg8::Gemm g{F.YMIX, F.WoutT, NTOK, D, DMIX}; pg8::StaticOrder S; S.init(NTOK, D, F.G, (int)blockIdx.x);
        pg8::EpiY E{F.YBF, D, F.PART, NTOK};
        pg8::gemm_phase<pg8::EpiY, pg8::StaticOrder, true, true>(F.lds + RING_OFF, g, S, E);
        if (BOTH(3)) GRID_BAR(); }
    }
    if (IN(4)) { REPS(4) { p4_final(F); if (DUP_PHASE == 4) GRID_BAR(); } }
#undef IN
#undef BOTH
}

extern "C" void kernel_launch(void* const* d_in, const int* in_sizes, int n_in, void* d_out, int out_size, void* d_ws, size_t ws_size, hipStream_t stream) {
    static int grid = 0;
    if (grid == 0) {
        if (n_in != 19 || in_sizes[0] != NROWP * D || in_sizes[6] != D * DIN || (size_t)out_size != O_END || ws_size < WS_END) {
            fprintf(stderr, "kernel_launch: unexpected shapes: n_in %d in0 %d in6 %d out %d ws %zu; nothing launched\n", n_in, n_in > 0 ? in_sizes[0] : -1, n_in > 6 ? in_sizes[6] : -1, out_size, ws_size); grid = -1; return; }
        int dev = 0, cus = 0, per_cu = 0;
        if (hipGetDevice(&dev) != hipSuccess || hipDeviceGetAttribute(&cus, hipDeviceAttributeMultiprocessorCount, dev) != hipSuccess) { grid = -1; return; }
        if (hipFuncSetAttribute((const void*)mk_fwd, hipFuncAttributeMaxDynamicSharedMemorySize, LDS_BYTES) != hipSuccess) { fprintf(stderr, "kernel_launch: hipFuncSetAttribute failed\n"); grid = -1; return; }
        if (hipOccupancyMaxActiveBlocksPerMultiprocessor(&per_cu, (const void*)mk_fwd, NWAVES * 64, LDS_BYTES) != hipSuccess || per_cu < 1)
            fprintf(stderr, "kernel_launch: note: occupancy query reports %d workgroups per CU\n", per_cu);
        (void)hipGetLastError();
        grid = cus;
    }
    if (grid < 0) return;
    if (hipMemsetAsync((char*)d_ws + WS_CTL, 0, CTL_ZERO_BYTES, stream) != hipSuccess) { fprintf(stderr, "kernel_launch: hipMemsetAsync failed\n"); return; }
    Args a{};
    for (int i = 0; i < 19; ++i) a.in[i] = (const float*)d_in[i];
    a.out = (float*)d_out; a.ws = (unsigned char*)d_ws;
    for (int li = 0; li < N_LAUNCHES; ++li) {
        a.ph_lo = (N_LAUNCHES == 1) ? 0 : li; a.ph_hi = (N_LAUNCHES == 1) ? N_PHASES : li + 1; a.li = li;
        hipLaunchKernelGGL(mk_fwd, dim3(grid), dim3(NWAVES * 64), LDS_BYTES, stream, a);
        const hipError_t le = hipPeekAtLastError();
        if (le != hipSuccess) { fprintf(stderr, "kernel_launch: launch %d failed: %s\n", li, hipGetErrorName(le)); break; }
    }
}
```

```cpp
#define MK_N_LAUNCHES 1
#include <hip/hip_runtime.h>
#include <cstdio>
#include <cstdint>
namespace pg8 {
#define PG8_LAS __attribute__((address_space(3)))
typedef unsigned short bf16_t;
typedef short bf16x8 __attribute__((ext_vector_type(8)));
typedef float f32x4 __attribute__((ext_vector_type(4)));
typedef unsigned u32x4 __attribute__((ext_vector_type(4)));
constexpr int BM = 256, BK = 64, HALF = 128, HTB = HALF * BK * 2  , STAGE_BYTES = 8 * HTB, NXCD = 8, WGM = 8;

__host__ __device__ __forceinline__ int lds_byte(int r, int c) { const int st = (r >> 4) * 2 + (c >> 5), rr = r & 15, cc = c & 31, ob = rr * 64 + cc * 2; return st * 1024 + (ob ^ (((ob >> 9) & 1) << 5)); }
__host__ __device__ __forceinline__ void stage_rc(int b, int& R, int& C) { const int st = b / 1024, sb = b % 1024, swz = sb ^ (((sb >> 9) & 1) << 5); R = (st >> 1) * 16 + swz / 64; C = (st & 1) * 32 + (swz % 64) / 2; }
__host__ __device__ __forceinline__ int perm32(int rho) { const int n = rho >> 4, i = rho & 15; return 8 * (i >> 2) + 4 * n + (i & 3); }

struct Unit { int pm, pn, k0, nt, slab; };
struct Gemm { const bf16_t* A; const bf16_t* Bt; int M, N, K; };

struct StaticOrder {
    int nM, nN, nwg, G, c;
    __host__ __device__ void init(int M, int N, int G_, int c_) { nM = M / BM; nN = N / BM; nwg = nM * nN; G = G_; c = c_; }
    __host__ __device__ bool next(int i, Unit& u) const {
        const long L = (long)i * G + c; if (L >= nwg) return false;
        int wgid = (int)L; { const int q = nwg / NXCD, r = nwg % NXCD, xcd = wgid % NXCD, off = wgid / NXCD; wgid = (xcd < r ? xcd * (q + 1) : r * (q + 1) + (xcd - r) * q) + off; }
        const int nig = WGM * nN, gid = wgid / nig, fm = gid * WGM, gsz = (nM - fm) < WGM ? (nM - fm) : WGM;
        u.pm = fm + ((wgid % nig) % gsz); u.pn = (wgid % nig) / gsz; u.k0 = 0; u.nt = 0; u.slab = -1; return true;
    }
    __device__ __forceinline__ void a_ready(const Unit&) const {}
    __device__ __forceinline__ void done(const Unit&) const {}
};
__device__ __forceinline__ unsigned cvt_pk_bf16(float lo, float hi) { unsigned r; asm volatile("v_cvt_pk_bf16_f32 %0, %1, %2" : "=v"(r) : "v"(lo), "v"(hi)); return r; }
typedef float f32x2 __attribute__((ext_vector_type(2)));
struct EpiProj {
    static constexpr bool PERM = true, AFTER_DRAIN = false;
    bf16_t* O; int ldc; const float* bcum;
    __device__ __forceinline__ void operator()(const f32x4 (&acc)[2][2][4][2], const Unit& u, int wr, int wc, int fr, int fq) const {
        const int row0 = u.pm * BM + wr * 64 + fr; const int col0 = u.pn * BM + wc * 32 + 8 * fq;
        const int gk = (u.pn >= 8 && u.pn < 12) ? (u.pn < 10 ? 1 : 2) : (((u.pn >= 4 && u.pn < 8) || u.pn >= 16) ? 3 : 0);
        const float sgn = gk == 1 ? 1.4426950408889634f : -1.4426950408889634f, sc = gk == 1 ? 0.08838834764831845f : 1.f;
#pragma unroll
        for (int ai = 0; ai < 2; ++ai)
#pragma unroll
            for (int m = 0; m < 4; ++m) { const int row = row0 + ai * HALF + m * 16; bf16_t* rowp = O + (size_t)row * ldc + col0;
#pragma unroll
                for (int bj = 0; bj < 2; ++bj) { f32x4 v0 = acc[ai][bj][m][0], v1 = acc[ai][bj][m][1];
                    if (gk == 3) {
#pragma unroll
                        for (int e = 0; e < 4; ++e) { v0[e] *= __builtin_amdgcn_rcpf(1.f + __builtin_amdgcn_exp2f(-1.4426950408889634f * v0[e])); v1[e] *= __builtin_amdgcn_rcpf(1.f + __builtin_amdgcn_exp2f(-1.4426950408889634f * v1[e])); } }
                    else if (gk) { const float* bp = bcum + (size_t)row * 512 + (col0 + bj * HALF - (gk == 1 ? 2048 : 2560)); const f32x4 b0 = *(const f32x4*)bp, b1 = *(const f32x4*)(bp + 4);
                        v0[0] *= sc * __builtin_amdgcn_exp2f(sgn * b0[0]); v0[1] *= sc * __builtin_amdgcn_exp2f(sgn * b0[1]); v0[2] *= sc * __builtin_amdgcn_exp2f(sgn * b0[2]); v0[3] *= sc * __builtin_amdgcn_exp2f(sgn * b0[3]);
                        v1[0] *= sc * __builtin_amdgcn_exp2f(sgn * b1[0]); v1[1] *= sc * __builtin_amdgcn_exp2f(sgn * b1[1]); v1[2] *= sc * __builtin_amdgcn_exp2f(sgn * b1[2]); v1[3] *= sc * __builtin_amdgcn_exp2f(sgn * b1[3]); }
                    u32x4 w; w.x = cvt_pk_bf16(v0[0], v0[1]); w.y = cvt_pk_bf16(v0[2], v0[3]); w.z = cvt_pk_bf16(v1[0], v1[1]); w.w = cvt_pk_bf16(v1[2], v1[3]);
                    *(u32x4*)(rowp + bj * HALF) = w; } }
    }
};
struct EpiY {
    static constexpr bool PERM = true, AFTER_DRAIN = false;
    bf16_t* O; int ldc; bf16_t* slabs; int row_s; size_t slab_elems;
    __device__ __forceinline__ void operator()(const f32x4 (&acc)[2][2][4][2], const Unit& u, int wr, int wc, int fr, int fq) const {
        const int row0 = u.pm * BM + wr * 64 + fr; const int col0 = u.pn * BM + wc * 32 + 8 * fq;
        bf16_t* base = u.slab >= 0 ? slabs + (size_t)u.slab * slab_elems - (size_t)row_s * ldc : O;
#pragma unroll
        for (int ai = 0; ai < 2; ++ai)
#pragma unroll
            for (int m = 0; m < 4; ++m) { const int row = row0 + ai * HALF + m * 16; bf16_t* rowp = base + (size_t)row * ldc + col0;
#pragma unroll
                for (int bj = 0; bj < 2; ++bj) { const f32x4 v0 = acc[ai][bj][m][0], v1 = acc[ai][bj][m][1];
                    u32x4 w; w.x = cvt_pk_bf16(v0[0], v0[1]); w.y = cvt_pk_bf16(v0[2], v0[3]); w.z = cvt_pk_bf16(v1[0], v1[1]); w.w = cvt_pk_bf16(v1[2], v1[3]);
                    *(u32x4*)(rowp + bj * HALF) = w; } }
    }
};
struct Gemm2Order {
    StaticOrder so; int nfull, nN, pm0, KS, ntS, nsl, G, c;
    __host__ __device__ void init(int MP, int M, int N, int K, int KS_, int G_, int c_) { so.init(MP, N, G_, c_); nfull = so.nwg; nN = N / BM; pm0 = MP / BM; KS = KS_; ntS = K / BK / KS_; nsl = ((M - MP) / BM) * nN * KS_; G = G_; c = c_; }
    __host__ __device__ bool next(int i, Unit& u) const {
        const long L = (long)i * G + c;
        if (L < nfull) return so.next(i, u);
        const long Ls = L - nfull; if (Ls >= nsl) return false;
        const int lu = (int)Ls / KS, ks = (int)Ls % KS; u.pm = pm0 + lu / nN; u.pn = lu % nN; u.k0 = ks * ntS; u.nt = ntS; u.slab = ks; return true;
    }
    __device__ __forceinline__ void a_ready(const Unit&) const {}
    __device__ __forceinline__ void done(const Unit&) const {}
};
struct NoKScale { static constexpr bool ON = false; };
struct HeadScale {
    static constexpr bool ON = true; static constexpr int MAXU = 2;
    const float* pss; int nrowp; float eps;
    static constexpr int OFF = 131072;
    __device__ __forceinline__ void prep(PG8_LAS unsigned char* lds, const Unit& u, int par) const {
        const int r = threadIdx.x & 255; const int row = u.pm * BM + r;
        PG8_LAS float* T = (PG8_LAS float*)(lds + OFF) + par * 5 * 256;
        const __amdgpu_buffer_rsrc_t rsrc = __builtin_amdgcn_make_buffer_rsrc((void*)pss, 0, 32 * nrowp * 4, 0x00020000);
        float prev = 1.f;
#pragma unroll
        for (int h = 0; h < 4; ++h) { float rs = 1.f;
            if (row < nrowp) { float v[8];
#pragma unroll
                for (int k = 0; k < 8; ++k) v[k] = __builtin_bit_cast(float, __builtin_amdgcn_raw_buffer_load_b32(rsrc, row * 4, (h * 8 + k) * nrowp * 4, 0));
                const float tot = ((v[0] + v[1]) + (v[2] + v[3])) + ((v[4] + v[5]) + (v[6] + v[7]));
                rs = __builtin_amdgcn_rsqf(tot * (1.f / 256.f) + eps); }
            T[h * 256 + r] = prev * __builtin_amdgcn_rcpf(rs); prev = rs;
            asm volatile("" ::: "memory"); }
        T[4 * 256 + r] = prev;
    }
    __device__ __forceinline__ void scale(f32x4 (&acc)[2][2][4][2], PG8_LAS unsigned char* lds, int par, int idx, int wr, int fr) const {
        const unsigned a = (unsigned)(size_t)(lds + OFF) + (unsigned)(((par * 5 + idx) * 256 + wr * 64 + fr) * 4);
        float f0, f1, f2, f3, f4, f5, f6, f7;
        asm volatile("ds_read_b32 %0, %8\n\tds_read_b32 %1, %8 offset:64\n\tds_read_b32 %2, %8 offset:128\n\tds_read_b32 %3, %8 offset:192\n\t"
                     "ds_read_b32 %4, %8 offset:512\n\tds_read_b32 %5, %8 offset:576\n\tds_read_b32 %6, %8 offset:640\n\tds_read_b32 %7, %8 offset:704\n\ts_waitcnt lgkmcnt(0)"
                     : "=&v"(f0), "=&v"(f1), "=&v"(f2), "=&v"(f3), "=&v"(f4), "=&v"(f5), "=&v"(f6), "=&v"(f7) : "v"(a) : "memory");
        const float f[2][4] = {{f0, f1, f2, f3}, {f4, f5, f6, f7}};
#pragma unroll
        for (int ai = 0; ai < 2; ++ai)
#pragma unroll
            for (int m = 0; m < 4; ++m)
#pragma unroll
                for (int bj = 0; bj < 2; ++bj)
#pragma unroll
                    for (int n = 0; n < 2; ++n) acc[ai][bj][m][n] = acc[ai][bj][m][n] * f[ai][m];
    }
};
template <class Epi, class Sched, bool ALIGN_EPI = false, bool SP2 = false, class KS = NoKScale>
__device__ __forceinline__ void gemm_phase(PG8_LAS unsigned char* lds, const Gemm g, const Sched& S, const Epi& E, const KS ksc = KS()) {
    const int tid = threadIdx.x, wid = __builtin_amdgcn_readfirstlane(tid >> 6), lane = tid & 63, wr = wid >> 2, wc = wid & 3, fr = lane & 15, fq = lane >> 4;
    const int K = g.K, ntK = K / BK;
    unsigned voffA[2], voffB[2];
#pragma unroll
    for (int i = 0; i < 2; ++i) { int R, C; stage_rc(tid * 16 + i * 8192, R, C); const int Rb = Epi::PERM ? ((R & ~31) + perm32(R & 31)) : R;
        voffA[i] = (unsigned)(R * K + C) * 2u; voffB[i] = (unsigned)(Rb * K + C) * 2u; }
    const size_t kstep = (size_t)(BK * 2);
    const size_t hstep = (size_t)HALF * K * 2;
    const size_t tstep = 2 * hstep;
    const unsigned ldsw = (unsigned)wid * 1024u;
    const int aoff = lds_byte(wr * 64 + fr, fq * 8), boff = lds_byte(wc * 32 + fr, fq * 8);
#define PG8_SA(b, h) (((b) * 2 + (h)) * HTB)
#define PG8_SB(b, h) ((4 + (b) * 2 + (h)) * HTB)
#define PG8_STAGE(bufoff, gbase, voff) do { _Pragma("unroll") for (int _i = 0; _i < 2; ++_i) \
        __builtin_amdgcn_global_load_lds((const unsigned*)((const char*)(gbase) + (voff)[_i]), (PG8_LAS unsigned*)(lds + (bufoff) + ldsw + _i * 8192), 16, 0, 0); } while (0)
#define PG8_LDA(dst, b, h) do { _Pragma("unroll") for (int m = 0; m < 4; ++m) _Pragma("unroll") for (int k = 0; k < 2; ++k) dst[m][k] = *(const PG8_LAS bf16x8*)(lds + PG8_SA(b, h) + aoff + m * 2048 + k * 1024); } while (0)
#define PG8_LDB(dst, b, h) do { _Pragma("unroll") for (int n = 0; n < 2; ++n) _Pragma("unroll") for (int k = 0; k < 2; ++k) dst[n][k] = *(const PG8_LAS bf16x8*)(lds + PG8_SB(b, h) + boff + n * 2048 + k * 1024); } while (0)
#define PG8_MMA(ai, bj, At, Bt) do { __builtin_amdgcn_s_setprio(1); _Pragma("unroll") for (int m = 0; m < 4; ++m) _Pragma("unroll") for (int n = 0; n < 2; ++n) _Pragma("unroll") for (int k = 0; k < 2; ++k) \
        acc[ai][bj][m][n] = __builtin_amdgcn_mfma_f32_16x16x32_bf16(Bt[n][k], At[m][k], acc[ai][bj][m][n], 0, 0, 0); __builtin_amdgcn_s_setprio(0); } while (0)
#define PG8_WAIT_V(n) asm volatile("s_waitcnt vmcnt(" #n ")" ::: "memory")
#define PG8_WAIT_L(n) asm volatile("s_waitcnt lgkmcnt(" #n ")" ::: "memory")
#define PG8_BAR __builtin_amdgcn_s_barrier()
#define PG8_SCHED __builtin_amdgcn_sched_barrier(0)
    Unit cur, nxt; int ui = 0;
    if (!S.next(0, cur)) return;
    f32x4 acc[2][2][4][2];
#pragma unroll
    for (int a = 0; a < 2; ++a)
#pragma unroll
        for (int b = 0; b < 2; ++b)
#pragma unroll
            for (int m = 0; m < 4; ++m)
#pragma unroll
                for (int n = 0; n < 2; ++n) acc[a][b][m][n] = (f32x4){0.f, 0.f, 0.f, 0.f};
    bf16x8 At[4][2], B0[2][2], B1[2][2];
    const char* cA = (const char*)g.A + (size_t)cur.pm * tstep + (size_t)cur.k0 * (BK * 2); const char* cB = (const char*)g.Bt + (size_t)cur.pn * tstep + (size_t)cur.k0 * (BK * 2);
    S.a_ready(cur);
    if constexpr (KS::ON) { Unit pu; for (int i = 0; i < KS::MAXU && S.next(i, pu); ++i) ksc.prep(lds, pu, i); }
    if constexpr (SP2) {
        PG8_STAGE(PG8_SB(0, 0), cB, voffB); PG8_STAGE(PG8_SB(0, 1), cB + hstep, voffB); PG8_STAGE(PG8_SA(0, 0), cA, voffA); PG8_STAGE(PG8_SA(0, 1), cA + hstep, voffA);
        if (wr == 1) PG8_BAR;
        PG8_WAIT_V(2); PG8_BAR;
        PG8_STAGE(PG8_SB(1, 0), cB + kstep, voffB); PG8_STAGE(PG8_SA(1, 0), cA + kstep, voffA); PG8_STAGE(PG8_SB(1, 1), cB + hstep + kstep, voffB);
        PG8_WAIT_V(6); PG8_BAR;
    } else {
        PG8_STAGE(PG8_SB(0, 0), cB, voffB); PG8_STAGE(PG8_SA(0, 0), cA, voffA); PG8_STAGE(PG8_SB(0, 1), cB + hstep, voffB); PG8_STAGE(PG8_SA(0, 1), cA + hstep, voffA);
        if (wr == 1) PG8_BAR;
        PG8_WAIT_V(4); PG8_BAR;
        PG8_STAGE(PG8_SB(1, 0), cB + kstep, voffB); PG8_STAGE(PG8_SA(1, 0), cA + kstep, voffA); PG8_STAGE(PG8_SB(1, 1), cB + hstep + kstep, voffB);
        PG8_WAIT_V(6); PG8_BAR;
    }
    for (;;) {
        const bool has_next = S.next(ui + 1, nxt);
        const char* nA = has_next ? (const char*)g.A + (size_t)nxt.pm * tstep + (size_t)nxt.k0 * (BK * 2) : cA; const char* nB = has_next ? (const char*)g.Bt + (size_t)nxt.pn * tstep + (size_t)nxt.k0 * (BK * 2) : cB;
        const int nt = cur.nt ? cur.nt : ntK;
        for (int t = 0; t < nt; t += 2) {
            const bool last = (t == nt - 2);
            const char* a1 = cA + (size_t)(t + 1) * kstep;
            const char* a2 = last ? nA : cA + (size_t)(t + 2) * kstep; const char* b2 = last ? nB : cB + (size_t)(t + 2) * kstep;
            const char* a3 = a2 + kstep; const char* b3 = b2 + kstep;
            if (last && has_next) S.a_ready(nxt);
            if constexpr (KS::ON) { if (t >= 16 && (t & 3) == 0) ksc.scale(acc, lds, ui & 1, (t - 16) >> 2, wr, fr); }
            if constexpr (SP2) {
            PG8_LDB(B0, 0, 0); PG8_LDB(B1, 0, 1); PG8_SCHED; PG8_LDA(At, 0, 0); PG8_STAGE(PG8_SA(1, 1), a1 + hstep, voffA);
            PG8_WAIT_V(8); PG8_WAIT_L(0); PG8_BAR; PG8_MMA(0, 0, At, B0); PG8_MMA(0, 1, At, B1); PG8_BAR; PG8_SCHED;
            PG8_LDA(At, 0, 1); PG8_STAGE(PG8_SB(0, 0), b2, voffB); PG8_STAGE(PG8_SB(0, 1), b2 + hstep, voffB); PG8_STAGE(PG8_SA(0, 0), a2, voffA);
            PG8_WAIT_V(8); PG8_WAIT_L(0); PG8_BAR; PG8_MMA(1, 0, At, B0); PG8_MMA(1, 1, At, B1); PG8_BAR; PG8_SCHED;
            PG8_LDB(B0, 1, 0); PG8_LDB(B1, 1, 1); PG8_SCHED; PG8_LDA(At, 1, 0); PG8_STAGE(PG8_SA(0, 1), a2 + hstep, voffA);
            PG8_WAIT_V(8); PG8_WAIT_L(0); PG8_BAR; PG8_MMA(0, 0, At, B0); PG8_MMA(0, 1, At, B1); PG8_BAR; PG8_SCHED;
            PG8_LDA(At, 1, 1); PG8_STAGE(PG8_SB(1, 0), b3, voffB); PG8_STAGE(PG8_SB(1, 1), b3 + hstep, voffB); PG8_STAGE(PG8_SA(1, 0), a3, voffA);
            PG8_WAIT_V(8); PG8_WAIT_L(0); PG8_BAR; PG8_MMA(1, 0, At, B0); PG8_MMA(1, 1, At, B1); PG8_BAR; PG8_SCHED;
            } else {
            PG8_LDB(B0, 0, 0); PG8_SCHED; PG8_LDA(At, 0, 0); PG8_STAGE(PG8_SA(1, 1), a1 + hstep, voffA);
            PG8_WAIT_L(8); PG8_BAR; PG8_WAIT_L(0); PG8_MMA(0, 0, At, B0); PG8_BAR; PG8_SCHED;
            PG8_LDB(B1, 0, 1); PG8_STAGE(PG8_SB(0, 0), b2, voffB);
            PG8_BAR; PG8_WAIT_L(0); PG8_MMA(0, 1, At, B1); PG8_BAR;
            PG8_LDA(At, 0, 1); PG8_STAGE(PG8_SA(0, 0), a2, voffA);
            PG8_BAR; PG8_WAIT_L(0); PG8_MMA(1, 0, At, B0); PG8_BAR; PG8_SCHED;
            PG8_STAGE(PG8_SB(0, 1), b2 + hstep, voffB);
            PG8_WAIT_V(6); PG8_BAR; PG8_MMA(1, 1, At, B1); PG8_BAR;
            PG8_LDB(B0, 1, 0); PG8_SCHED; PG8_LDA(At, 1, 0); PG8_STAGE(PG8_SA(0, 1), a2 + hstep, voffA);
            PG8_WAIT_L(8); PG8_BAR; PG8_WAIT_L(0); PG8_MMA(0, 0, At, B0); PG8_BAR; PG8_SCHED;
            PG8_LDB(B1, 1, 1); PG8_STAGE(PG8_SB(1, 0), b3, voffB);
            PG8_BAR; PG8_WAIT_L(0); PG8_MMA(0, 1, At, B1); PG8_BAR;
            PG8_LDA(At, 1, 1); PG8_STAGE(PG8_SA(1, 0), a3, voffA);
            PG8_BAR; PG8_WAIT_L(0); PG8_MMA(1, 0, At, B0); PG8_BAR; PG8_SCHED;
            PG8_STAGE(PG8_SB(1, 1), b3 + hstep, voffB);
            PG8_WAIT_V(6); PG8_BAR; PG8_MMA(1, 1, At, B1); PG8_BAR;
            }
        }
        if constexpr (KS::ON) ksc.scale(acc, lds, ui & 1, 4, wr, fr);
        if constexpr (ALIGN_EPI) { if (wr == 0) PG8_BAR; }
        if constexpr (!Epi::AFTER_DRAIN) { E(acc, cur, wr, wc, fr, fq); S.done(cur); }
        if (!has_next) break;
#pragma unroll
        for (int a = 0; a < 2; ++a)
#pragma unroll
            for (int b = 0; b < 2; ++b)
#pragma unroll
                for (int m = 0; m < 4; ++m)
#pragma unroll
                    for (int n = 0; n < 2; ++n) acc[a][b][m][n] = (f32x4){0.f, 0.f, 0.f, 0.f};
        cur = nxt; cA = nA; cB = nB; ++ui;
        if constexpr (ALIGN_EPI) { if (wr == 1) PG8_BAR; }
    }
    PG8_WAIT_V(0);
    if constexpr (!ALIGN_EPI) { if (wr == 0) PG8_BAR; }
    PG8_BAR;
    if constexpr (Epi::AFTER_DRAIN) { E.fused(acc, cur, wr, wc, fr, fq, lds, wid, lane); S.done(cur); }
#undef PG8_SA
#undef PG8_SB
#undef PG8_STAGE
#undef PG8_LDA
#undef PG8_LDB
#undef PG8_MMA
#undef PG8_WAIT_V
#undef PG8_WAIT_L
#undef PG8_BAR
#undef PG8_SCHED
}
}

#ifndef MK_N_LAUNCHES
#define MK_N_LAUNCHES 1
#endif
constexpr int N_PHASES = 5, N_LAUNCHES = MK_N_LAUNCHES;
constexpr int NWAVES = 8;
constexpr int D = 1024, NP = 8, TP = 2048, NS = 128, TS = 8, NROWP = NP * TP, NROWS = NS * TS, NTOK = NROWP + NROWS;
constexpr int DIN = 5136, DINP = 5120, DMIX = 2048, HK = 128, HV = 256, NH = 4;
constexpr int C_XL = 0, C_ZL = 1024, C_Q = 2048, C_K = 2560, C_V = 3072, C_ZG = 4096;
constexpr float EPS = 1e-6f;
constexpr size_t O_YP = 0, O_YS = 16777216, O_HP = 17825792, O_CP = 17833984, O_GP = 17858560, O_HS = 18907136, O_CS = 19038208, O_GS = 19431424, O_END = 36208640;
constexpr size_t MiB = 1u << 20;
constexpr size_t WS_CTL = 0, CTL_ZERO_BYTES = 1 * MiB;
constexpr size_t WS_WINT = 2 * MiB, WS_WOUT = 12 * MiB, WS_RGK = 16 * MiB, WS_PART = 18 * MiB, WS_DEC = 19 * MiB + 256 * 1024, WS_XN = 20 * MiB, WS_PROJ = 54 * MiB, WS_YS = 224 * MiB, WS_END = 240 * MiB;
static_assert(WS_DEC + (size_t)(NP * (TP / 64) + NS) * 512 * 4 <= WS_XN && WS_PART + (size_t)16 * NTOK * 4 <= WS_DEC, "d_ws map (DEC)");
static_assert(WS_WINT + (size_t)DINP * D * 2 <= WS_WOUT && WS_WOUT + (size_t)D * DMIX * 2 <= WS_RGK && WS_RGK + (size_t)NTOK * 16 * 4 <= WS_PART && WS_PART + (size_t)16 * NTOK * 4 <= WS_XN &&
              WS_XN + (size_t)NTOK * D * 2 <= WS_PROJ && WS_PROJ + (size_t)NTOK * DINP * 2 <= WS_YS && WS_YS + (size_t)8 * NROWS * D * 2 <= WS_END, "d_ws map");
constexpr int CW_BAR = 4096;
constexpr int RING_OFF = 0, RING_BYTES = 162816, LDSCTL_OFF = RING_BYTES, MISC_OFF = LDSCTL_OFF + 320, LDS_BYTES = 163840;

#define GAS __attribute__((address_space(1)))
#define LAS __attribute__((address_space(3)))
typedef unsigned short bf16;
typedef unsigned v4u __attribute__((ext_vector_type(4)));
typedef unsigned v2u __attribute__((ext_vector_type(2)));
typedef float f32x4 __attribute__((ext_vector_type(4)));
typedef GAS unsigned gu32;
#define RLX_AGENT __ATOMIC_RELAXED, __HIP_MEMORY_SCOPE_AGENT
#define LDS_WAIT() asm volatile("s_waitcnt lgkmcnt(0)" ::: "memory")
#define VM_WAIT() asm volatile("s_waitcnt vmcnt(0)" ::: "memory")
__device__ __forceinline__ unsigned f2bf(float f) { unsigned u = __builtin_bit_cast(unsigned, f); return (u + 0x7fffu + ((u >> 16) & 1u)) >> 16; }
__device__ __forceinline__ unsigned pk2(float lo, float hi) { return f2bf(lo) | (f2bf(hi) << 16); }
__device__ __forceinline__ float bf2f(unsigned b) { return __builtin_bit_cast(float, b << 16); }
__device__ __forceinline__ float bflo(unsigned w) { return __builtin_bit_cast(float, w << 16); }
__device__ __forceinline__ float bfhi(unsigned w) { return __builtin_bit_cast(float, w & 0xffff0000u); }
__device__ __forceinline__ float sigmoidf_(float x) { return 1.f / (1.f + __expf(-x)); }
__device__ __forceinline__ float logsigf_(float x) { return fminf(x, 0.f) - log1pf(__expf(-fabsf(x))); }
#define XB_TMO      128
#define XB_XCNT(j)  (256  + 64 * (j))
#define XB_XSUB(j)  (1280 + 64 * (j))
#define XB_XGEN(j)  (2304 + 64 * (j))
#define XB_TOP      3328
#define XB_TOPGEN   3392
#define XCD_BAR_WORDS 3456
#define XB_SPIN_CAP (1u << 18)

__device__ __forceinline__ unsigned xb_ld(unsigned* p)              { return __hip_atomic_load(p, __ATOMIC_RELAXED, __HIP_MEMORY_SCOPE_AGENT); }
__device__ __forceinline__ unsigned xb_add(unsigned* p, unsigned v) { return __hip_atomic_fetch_add(p, v, __ATOMIC_RELAXED, __HIP_MEMORY_SCOPE_AGENT); }
__device__ __forceinline__ unsigned xb_xcc_id() { return (unsigned)__builtin_amdgcn_s_getreg((3 << 11) | 20) & 0xFu; }
#define XB_SPIN(cond, bar) do { unsigned _sp = 0; while (cond) { __builtin_amdgcn_s_sleep(1); \
    if ((++_sp & 255u) == 0u) { if (xb_ld(&(bar)[XB_TMO])) break; if (_sp > XB_SPIN_CAP) { atomicAdd(&(bar)[XB_TMO], 1u); break; } } } } while (0)

struct XcdBarrier {
    unsigned* bar; unsigned x;
    volatile LAS unsigned* st;
};

__device__ __forceinline__ XcdBarrier xcd_barrier_post(unsigned* bar, volatile LAS unsigned* st) {
    XcdBarrier b; b.bar = bar; b.x = xb_xcc_id(); b.st = st;
    if (threadIdx.x == 0) (void)xb_add(&bar[XB_XCNT(b.x)], 1u);
    return b;
}
__device__ __forceinline__ void xcd_barrier_complete(unsigned* bar, unsigned x, unsigned& nloc, unsigned& nx) {
    const unsigned G = gridDim.x * gridDim.y * gridDim.z;
    unsigned sum, cnt, mine, sp = 0u;
    for (;;) {
        sum = 0u; cnt = 0u; mine = 0u;
#pragma unroll
        for (unsigned j = 0; j < 16; ++j) { const unsigned c = xb_ld(&bar[XB_XCNT(j)]); sum += c; cnt += (c > 0u) ? 1u : 0u; mine = (j == x) ? c : mine; }
        if (sum == G) break;
        __builtin_amdgcn_s_sleep(1);
        if ((++sp & 255u) == 0u) { if (xb_ld(&bar[XB_TMO])) break; if (sp > XB_SPIN_CAP) { atomicAdd(&bar[XB_TMO], 1u); break; } }
    }
    nloc = mine > 0u ? mine : 1u; nx = cnt > 0u ? cnt : 1u;
}

__device__ __forceinline__ void xcd_barrier(const XcdBarrier& b) {
    asm volatile("s_waitcnt vmcnt(0)" ::: "memory");
    __syncthreads();
    if (threadIdx.x == 0) {
        unsigned* bar = b.bar;
        __builtin_amdgcn_s_waitcnt(0);
        unsigned nloc = b.st[0], nx = b.st[1];
        if (nloc == 0u) { xcd_barrier_complete(bar, b.x, nloc, nx); b.st[0] = nloc; b.st[1] = nx; }
        const unsigned old = xb_add(&bar[XB_XSUB(b.x)], 1u);
        const unsigned gen = old / nloc;
        if (old + 1u == (gen + 1u) * nloc) {
            __builtin_amdgcn_fence(__ATOMIC_RELEASE, "agent");
            asm volatile("s_waitcnt vmcnt(0)" ::: "memory");
            const unsigned og = xb_add(&bar[XB_TOP], 1u);
            const unsigned tg = og / nx;
            if (og + 1u == (tg + 1u) * nx) xb_add(&bar[XB_TOPGEN], 1u);
            else XB_SPIN(xb_ld(&bar[XB_TOPGEN]) == tg, bar);
            __builtin_amdgcn_fence(__ATOMIC_ACQUIRE, "agent");
            xb_add(&bar[XB_XGEN(b.x)], 1u);
            asm volatile("s_waitcnt vmcnt(0)" ::: "memory");
        } else {
            XB_SPIN(xb_ld(&bar[XB_XGEN(b.x)]) == gen, bar);
            __builtin_amdgcn_fence(__ATOMIC_ACQUIRE, "agent");
            asm volatile("s_waitcnt vmcnt(0)" ::: "memory");
        }
    }
    __syncthreads();
}
#ifndef DUP_PHASE
#define DUP_PHASE -1
#endif

struct Frame {
    LAS unsigned char* lds;
    volatile LAS unsigned* MISC;
    gu32* ctl;
    int tid, lane, wave, vcu, G;
    const float *xp, *xs, *st_h, *st_conv, *st_gla, *g_pre, *w_in, *conv_w, *conv_b, *w_rg, *b_rg, *w_ig, *b_ig, *lam, *w_gk2, *b_gk, *g_head, *w_out, *g_post;
    float* out;
    bf16 *WinT, *WoutT, *XN, *PROJ, *YMIX, *YBF, *YS;
    float *RGK, *PART, *BCUM, *DEC, *PSS, *C8;
};
__device__ __forceinline__ float wave_sum(float v) {
#pragma unroll
    for (int o = 1; o < 64; o <<= 1) v += __shfl_xor(v, o);
    return v;
}

__device__ __forceinline__ void p0_transpose_item(const float* W, int ldw, int K, int nblk, bf16* WT, LAS float* scr, int item, int lane) {
    const int kb = item / nblk, nb = item % nblk, k0 = 64 * kb, n0 = 32 * nb;
#pragma unroll 8
    for (int i = 0; i < 32; ++i) { const int kk = 2 * i + (lane >> 5); scr[kk * 33 + (lane & 31)] = W[(size_t)(k0 + kk) * ldw + n0 + (lane & 31)]; }
    LDS_WAIT(); asm volatile("" ::: "memory");
    const int c = lane & 7;
#pragma unroll
    for (int j = 0; j < 4; ++j) { const int n = (lane >> 3) + 8 * j; const LAS float* s = scr + (8 * c) * 33 + n;
        v4u o; o.x = pk2(s[0 * 33], s[1 * 33]); o.y = pk2(s[2 * 33], s[3 * 33]); o.z = pk2(s[4 * 33], s[5 * 33]); o.w = pk2(s[6 * 33], s[7 * 33]);
        *(GAS v4u*)(WT + (size_t)(n0 + n) * K + k0 + 8 * c) = o; }
    LDS_WAIT(); asm volatile("" ::: "memory");
}
struct RowX { f32x4 v[4]; };
__device__ __forceinline__ RowX p0_load_row(const Frame& F, int r) {
    const float* xrow = r < NROWP ? F.xp + (size_t)r * D : F.xs + (size_t)(r - NROWP) * D;
    const GAS f32x4* xr = (const GAS f32x4*)xrow + F.lane; RowX x;
#pragma unroll
    for (int j = 0; j < 4; ++j) x.v[j] = xr[64 * j];
    return x;
}
__device__ __forceinline__ float p0_treduce16(const float (&p)[16], int lane) {
    const bool b5 = lane & 32, b4 = lane & 16, b3 = lane & 8, b2 = lane & 4;
    float q8[8], q4[4], q2[2], q1;
#pragma unroll
    for (int i = 0; i < 8; ++i) { const float send = b5 ? p[i] : p[i + 8], keep = b5 ? p[i + 8] : p[i]; q8[i] = keep + __shfl_xor(send, 32); }
#pragma unroll
    for (int i = 0; i < 4; ++i) { const float send = b4 ? q8[i] : q8[i + 4], keep = b4 ? q8[i + 4] : q8[i]; q4[i] = keep + __shfl_xor(send, 16); }
#pragma unroll
    for (int i = 0; i < 2; ++i) { const float send = b3 ? q4[i] : q4[i + 2], keep = b3 ? q4[i + 2] : q4[i]; q2[i] = keep + __shfl_xor(send, 8); }
    { const float send = b2 ? q2[0] : q2[1], keep = b2 ? q2[1] : q2[0]; q1 = keep + __shfl_xor(send, 4); }
    q1 += __shfl_xor(q1, 2); q1 += __shfl_xor(q1, 1);
    return q1;
}
__device__ __forceinline__ void p0_rows2(const Frame& F, int rA, int rB, RowX xa, RowX xb, const LAS float* wrt, LAS float* rgA, LAS float* rgB) {
    const GAS f32x4* gp = (const GAS f32x4*)F.g_pre + F.lane;
    float sa = 0.f, sb = 0.f;
#pragma unroll
    for (int j = 0; j < 4; ++j) { sa += (xa.v[j].x * xa.v[j].x + xa.v[j].y * xa.v[j].y) + (xa.v[j].z * xa.v[j].z + xa.v[j].w * xa.v[j].w); sb += (xb.v[j].x * xb.v[j].x + xb.v[j].y * xb.v[j].y) + (xb.v[j].z * xb.v[j].z + xb.v[j].w * xb.v[j].w); }
#pragma unroll
    for (int o = 1; o < 64; o <<= 1) { sa += __shfl_xor(sa, o); sb += __shfl_xor(sb, o); }
    const float ra = rsqrtf(sa * (1.f / D) + EPS), rb = rsqrtf(sb * (1.f / D) + EPS);
    GAS v2u* oa = (GAS v2u*)(F.XN + (size_t)rA * D) + F.lane; GAS v2u* ob = (GAS v2u*)(F.XN + (size_t)rB * D) + F.lane;
#pragma unroll
    for (int j = 0; j < 4; ++j) { const f32x4 g = gp[64 * j]; xa.v[j] = xa.v[j] * ra * g; xb.v[j] = xb.v[j] * rb * g;
        v2u wa, wb; wa.x = pg8::cvt_pk_bf16(xa.v[j].x, xa.v[j].y); wa.y = pg8::cvt_pk_bf16(xa.v[j].z, xa.v[j].w); wb.x = pg8::cvt_pk_bf16(xb.v[j].x, xb.v[j].y); wb.y = pg8::cvt_pk_bf16(xb.v[j].z, xb.v[j].w);
        oa[64 * j] = wa; ob[64 * j] = wb; }
    float pa[16], pb[16];
#pragma unroll
    for (int jj = 0; jj < 16; ++jj) { float a = 0.f, b2 = 0.f;
#pragma unroll
        for (int j = 0; j < 4; ++j) { const f32x4 w = *(const LAS f32x4*)(wrt + jj * 1024 + 256 * j + 4 * F.lane);
            a += (xa.v[j].x * w.x + xa.v[j].y * w.y) + (xa.v[j].z * w.z + xa.v[j].w * w.w); b2 += (xb.v[j].x * w.x + xb.v[j].y * w.y) + (xb.v[j].z * w.z + xb.v[j].w * w.w); }
        pa[jj] = a; pb[jj] = b2; if ((jj & 3) == 3) asm volatile("" ::: "memory"); }
    const float qa = p0_treduce16(pa, F.lane), qb = p0_treduce16(pb, F.lane);
    if ((F.lane & 3) == 0) { rgA[F.lane >> 2] = qa; rgB[F.lane >> 2] = qb; }
}
__device__ __forceinline__ void p0_prologue(Frame& F) {
    LAS float* scr = (LAS float*)(F.lds + RING_OFF + F.wave * 16384);
    const int gw = F.vcu * NWAVES + F.wave, NGW = F.G * NWAVES;
    if (blockIdx.x == 0) for (int c = F.tid; c < D; c += NWAVES * 64) F.C8[c] = 8.f * 1.4426950408889634f * logsigf_(F.lam[c]);
    constexpr int I_IN = (D / 64) * (DINP / 32), I_OUT = (DMIX / 64) * (D / 32);
    for (int rep = 0; rep < (DUP_PHASE == 10 ? 2 : 1); ++rep)
    for (int it = gw; it < I_IN + I_OUT; it += NGW) {
        if (it < I_IN) p0_transpose_item(F.w_in, DIN, D, DINP / 32, F.WinT, scr, it, F.lane);
        else p0_transpose_item(F.w_out, D, DMIX, D / 32, F.WoutT, scr, it - I_IN, F.lane);
    }
    __syncthreads();
    LAS float* wrt = (LAS float*)(F.lds + RING_OFF);
    for (int idx = F.tid; idx < 4 * 1024; idx += NWAVES * 64) { const int k = idx >> 2, jq = idx & 3; const f32x4 w = *(const GAS f32x4*)(F.w_in + (size_t)k * DIN + DINP + 4 * jq);
        wrt[(4 * jq + 0) * 1024 + k] = w.x; wrt[(4 * jq + 1) * 1024 + k] = w.y; wrt[(4 * jq + 2) * 1024 + k] = w.z; wrt[(4 * jq + 3) * 1024 + k] = w.w; }
    __syncthreads();
    LAS float* rgl = (LAS float*)(F.lds + RING_OFF + 65536);
    float w2[16];
#pragma unroll
    for (int j = 0; j < 16; ++j) w2[j] = F.w_gk2[j * 512 + F.tid];
    const float bg = F.b_gk[F.tid];
    for (int rep = 0; rep < (DUP_PHASE == 11 ? 2 : 1); ++rep)
    for (int it = F.vcu; it < NP * (TP / 64) + NS; it += F.G) {
        const int nrow = it < NP * (TP / 64) ? 64 : TS; const int r0 = it < NP * (TP / 64) ? it * 64 : NROWP + (it - NP * (TP / 64)) * TS;
        if (nrow == 64) {
            RowX xa = p0_load_row(F, r0 + F.wave), xb = p0_load_row(F, r0 + F.wave + 8);
#pragma unroll 1
            for (int i = 0; i < 4; ++i) { const int ra = F.wave + 16 * i, rb = ra + 8; RowX na = xa, nb = xb;
                if (i < 3) { na = p0_load_row(F, r0 + ra + 16); nb = p0_load_row(F, r0 + rb + 16); }
                p0_rows2(F, r0 + ra, r0 + rb, xa, xb, wrt, rgl + ra * 16, rgl + rb * 16); xa = na; xb = nb; }
        } else { const RowX xa = p0_load_row(F, r0 + F.wave); p0_rows2(F, r0 + F.wave, r0 + F.wave, xa, xa, wrt, rgl + F.wave * 16, rgl + F.wave * 16); }
        __syncthreads();
        float cum = 0.f;
        for (int t = 0; t < nrow; t += 4) { float z[4];
#pragma unroll
            for (int u = 0; u < 4; ++u) { z[u] = bg;
#pragma unroll
                for (int j4 = 0; j4 < 4; ++j4) { const f32x4 rg = *(const LAS f32x4*)(rgl + (t + u) * 16 + 4 * j4); z[u] += (rg.x * w2[4 * j4] + rg.y * w2[4 * j4 + 1]) + (rg.z * w2[4 * j4 + 2] + rg.w * w2[4 * j4 + 3]); } }
#pragma unroll
            for (int u = 0; u < 4; ++u) {
                cum -= 0.04332169878499658f * __builtin_amdgcn_logf(1.f + __builtin_amdgcn_exp2f(-1.4426950408889634f * z[u]));
                F.BCUM[(size_t)(r0 + t + u) * 512 + F.tid] = cum; } }
        F.DEC[(size_t)it * 512 + F.tid] = __builtin_amdgcn_exp2f(1.4426950408889634f * cum);
        __syncthreads();
    }
}

__device__ __forceinline__ float rdlane(float v, int l) { return __builtin_bit_cast(float, __builtin_amdgcn_readlane(__builtin_bit_cast(int, v), l)); }
__device__ __forceinline__ void lru_simple_item(const Frame& F, int kind, int seq, int nb) {
    const int lane = F.lane, c = nb * 64 + lane;
    const int T = kind ? TS : TP; const size_t row0 = kind ? (size_t)NROWP + (size_t)seq * TS : (size_t)seq * TP;
    float wrg[64], wig[64];
#pragma unroll
    for (int d = 0; d < 64; ++d) { wrg[d] = F.w_rg[(size_t)(nb * 64 + d) * 64 + lane]; wig[d] = F.w_ig[(size_t)(nb * 64 + d) * 64 + lane]; }
    const float brg = F.b_rg[c], big = F.b_ig[c], cb = F.conv_b[c], cw0 = F.conv_w[c], cw1 = F.conv_w[1024 + c], cw2 = F.conv_w[2048 + c], cw3 = F.conv_w[3072 + c];
    const float c8 = 8.f * logsigf_(F.lam[c]);
    float h = kind ? F.st_h[(size_t)seq * 1024 + c] : 0.f;
    float xm3 = kind ? F.st_conv[((size_t)seq * 3 + 0) * 1024 + c] : 0.f, xm2 = kind ? F.st_conv[((size_t)seq * 3 + 1) * 1024 + c] : 0.f, xm1 = kind ? F.st_conv[((size_t)seq * 3 + 2) * 1024 + c] : 0.f;
    for (int t0 = 0; t0 < T; t0 += 8) {
        float xv[8], zv[8];
#pragma unroll
        for (int i = 0; i < 8; ++i) { const bf16* pr = F.PROJ + (row0 + t0 + i) * DINP; xv[i] = bf2f(pr[C_XL + c]); zv[i] = bf2f(pr[C_ZL + c]); }
#pragma unroll 1
        for (int i = 0; i < 8; ++i) {
            const float x = xv[i]; const float xc = cb + cw0 * xm3 + cw1 * xm2 + cw2 * xm1 + cw3 * x; xm3 = xm2; xm2 = xm1; xm1 = x;
            float ar = brg, ai = big;
#pragma unroll
            for (int d = 0; d < 64; ++d) { const float xd = rdlane(xc, d); ar += xd * wrg[d]; ai += xd * wig[d]; }
            const float r = sigmoidf_(ar), ig = sigmoidf_(ai);
            const float la = c8 * r, a = __expf(la), u = sqrtf(-expm1f(2.f * la)) * (ig * xc);
            h = a * h + u;
            const float z = zv[i], y = h * z * sigmoidf_(z);
            F.YMIX[(row0 + t0 + i) * DMIX + c] = (bf16)f2bf(y);
        }
    }
    float* ho = F.out + (kind ? O_HS : O_HP) + (size_t)seq * 1024 + c; *ho = h;
    float* co = F.out + (kind ? O_CS : O_CP) + (size_t)seq * 3 * 1024 + c; co[0] = xm3; co[1024] = xm2; co[2048] = xm1;
}
__device__ __forceinline__ void gla_simple_item(const Frame& F, int kind, int seq, int h, int hsel) {
    int t2 = F.tid & 255; asm volatile("" : "+v"(t2)); const int w4 = t2 >> 6;
    const int T = kind ? TS : TP; const size_t row0 = kind ? (size_t)NROWP + (size_t)seq * TS : (size_t)seq * TP;
    LAS float* L = (LAS float*)(F.lds + RING_OFF + hsel * 4096);
    LAS float* al = L, *qs = L + 128, *ks = L + 256, *red = L + 384;
    float S[128];
    const float* s0 = F.st_gla + (((size_t)seq * NH + h) * HK) * HV + t2;
#pragma unroll
    for (int d = 0; d < 128; ++d) S[d] = kind ? s0[(size_t)d * HV] : 0.f;
    const float gh = F.g_head[t2];
    for (int t = 0; t < T; ++t) {
        const size_t row = row0 + t; const bf16* pr = F.PROJ + row * DINP;
        if (t2 < 128) { const bool cbeg = kind ? false : ((t & 63) == 0 && t > 0); const size_t ci = (size_t)(seq * (TP / 64) + (t >> 6) - 1);
            al[t2] = cbeg ? F.DEC[ci * 512 + h * 128 + t2] : 1.f; qs[t2] = bf2f(pr[C_Q + h * 128 + t2]); ks[t2] = bf2f(pr[C_K + h * 128 + t2]); }
        const float vv = bf2f(pr[C_V + h * 256 + t2]), zz = bf2f(pr[C_ZG + h * 256 + t2]);
        __syncthreads();
        float o = 0.f;
#pragma unroll
        for (int d4 = 0; d4 < 32; ++d4) { const f32x4 a4 = *(const LAS f32x4*)(al + 4 * d4), k4 = *(const LAS f32x4*)(ks + 4 * d4), q4 = *(const LAS f32x4*)(qs + 4 * d4);
            S[4 * d4 + 0] = a4.x * S[4 * d4 + 0] + k4.x * vv; o += q4.x * S[4 * d4 + 0];
            S[4 * d4 + 1] = a4.y * S[4 * d4 + 1] + k4.y * vv; o += q4.y * S[4 * d4 + 1];
            S[4 * d4 + 2] = a4.z * S[4 * d4 + 2] + k4.z * vv; o += q4.z * S[4 * d4 + 2];
            S[4 * d4 + 3] = a4.w * S[4 * d4 + 3] + k4.w * vv; o += q4.w * S[4 * d4 + 3]; }
        const float ss = wave_sum(o * o);
        if (F.lane == 0) red[w4] = ss;
        __syncthreads();
        const float tot = (red[0] + red[1]) + (red[2] + red[3]);
        const float rs = rsqrtf(tot * (1.f / 256.f) + EPS);
        const float y = o * rs * gh * (zz * sigmoidf_(zz));
        F.YMIX[row * DMIX + 1024 + h * 256 + t2] = (bf16)f2bf(y);
        __syncthreads();
    }
    if (t2 < 128) al[t2] = F.DEC[(kind ? (size_t)(NP * (TP / 64) + seq) : (size_t)(seq * (TP / 64) + TP / 64 - 1)) * 512 + h * 128 + t2];
    __syncthreads();
    float* so = F.out + (kind ? O_GS : O_GP) + (((size_t)seq * NH + h) * HK) * HV + t2;
#pragma unroll
    for (int d = 0; d < 128; ++d) so[(size_t)d * HV] = S[d] * al[d];
    __syncthreads();
}


typedef short bf16x8_t __attribute__((ext_vector_type(8)));
typedef float f32x16 __attribute__((ext_vector_type(16)));
constexpr int LRU_XL_ROWS = 44;
constexpr int LRU_XL_OFF = 0, LRU_XL_WB = LRU_XL_ROWS * 128;
constexpr int LRU_ZL_OFF = LRU_XL_OFF + 8 * LRU_XL_WB, LRU_ZL_WB = 32 * 128;
constexpr int LRU_XC_OFF = LRU_ZL_OFF + 8 * LRU_ZL_WB, LRU_XC_WB = 32 * 144;
constexpr int LRU_SL_OFF = LRU_XC_OFF + 8 * LRU_XC_WB;
constexpr int LRU_HC_OFF = LRU_SL_OFF + 2 * 8 * 2 * 64 * 4;
constexpr int LRU_WG_OFF = LRU_HC_OFF + 2 * 64 * 4;
constexpr int LRU_END = LRU_WG_OFF + 128 * 144;
static_assert(LRU_END <= RING_BYTES, "LRU LDS map");
#define L2E 1.4426950408889634f
template <int KIND>
__device__ __forceinline__ void lru_item(const Frame& F, int sg, int nb) {
    int lane = F.lane; asm volatile("" : "+v"(lane));
    const int wave = F.wave, cl = lane & 31, hh = lane >> 5;
    LAS unsigned char* XLw = F.lds + RING_OFF + LRU_XL_OFF + wave * LRU_XL_WB;
    LAS unsigned char* ZLw = F.lds + RING_OFF + LRU_ZL_OFF + wave * LRU_ZL_WB;
    LAS unsigned char* XCw = F.lds + RING_OFF + LRU_XC_OFF + wave * LRU_XC_WB;
    LAS float* SL = (LAS float*)(F.lds + RING_OFF + LRU_SL_OFF);
    LAS float* HC = (LAS float*)(F.lds + RING_OFF + LRU_HC_OFF);
    LAS unsigned char* WGl = F.lds + RING_OFF + LRU_WG_OFF;
    __syncthreads();
    { const int col = F.tid & 127, kq = F.tid >> 7; const float* W = ((col >> 6) ? F.w_ig : F.w_rg) + (size_t)nb * 4096 + (size_t)(16 * kq) * 64 + (col & 63);
      v4u p0, p1;
      p0.x = pk2(-L2E * W[0 * 64], -L2E * W[1 * 64]); p0.y = pk2(-L2E * W[2 * 64], -L2E * W[3 * 64]); p0.z = pk2(-L2E * W[4 * 64], -L2E * W[5 * 64]); p0.w = pk2(-L2E * W[6 * 64], -L2E * W[7 * 64]);
      p1.x = pk2(-L2E * W[8 * 64], -L2E * W[9 * 64]); p1.y = pk2(-L2E * W[10 * 64], -L2E * W[11 * 64]); p1.z = pk2(-L2E * W[12 * 64], -L2E * W[13 * 64]); p1.w = pk2(-L2E * W[14 * 64], -L2E * W[15 * 64]);
      *(LAS v4u*)(WGl + col * 144 + (16 * kq) * 2) = p0; *(LAS v4u*)(WGl + col * 144 + (16 * kq + 8) * 2) = p1; }
    constexpr int NR = KIND ? 1 : 8;
    const size_t rowbase = KIND ? (size_t)NROWP + (size_t)sg * 256 : (size_t)sg * TP;
    if (KIND == 0) { if (F.tid < 64) HC[F.tid] = 0.f; }
    if (KIND == 0) {
#pragma unroll
        for (int q = 0; q < 5; ++q) { const int p = lane + 64 * q; const int row = p >> 3, pc = p & 7;
            if (row < 35) { const long tok = (long)wave * 32 + row - 3; v4u v = (v4u){0u, 0u, 0u, 0u};
                if (tok >= 0) v = *(const GAS v4u*)(F.PROJ + (rowbase + tok) * DINP + C_XL + nb * 64 + pc * 8);
                *(LAS v4u*)(XLw + row * 128 + pc * 16) = v; } }
    } else {
#pragma unroll
        for (int q = 0; q < 6; ++q) { const int p = lane + 64 * q; const int row = p >> 3, pc = p & 7;
            if (row < 44) { const int sq = row / 11, rr = row - sq * 11; const int seq = sg * 32 + wave * 4 + sq; v4u v;
                if (rr < 3) { const float* sp = F.st_conv + ((size_t)seq * 3 + rr) * 1024 + nb * 64 + pc * 8; const f32x4 a = *(const GAS f32x4*)sp, b = *(const GAS f32x4*)(sp + 4);
                    v.x = pk2(a.x, a.y); v.y = pk2(a.z, a.w); v.z = pk2(b.x, b.y); v.w = pk2(b.z, b.w); }
                else v = *(const GAS v4u*)(F.PROJ + ((size_t)NROWP + (size_t)seq * 8 + rr - 3) * DINP + C_XL + nb * 64 + pc * 8);
                *(LAS v4u*)(XLw + row * 128 + pc * 16) = v; } }
    }
#pragma unroll
    for (int q = 0; q < 4; ++q) { const int p = lane + 64 * q; const int row = p >> 3, pc = p & 7;
        *(LAS v4u*)(ZLw + row * 128 + pc * 16) = *(const GAS v4u*)(F.PROJ + (rowbase + wave * 32 + row) * DINP + C_ZL + nb * 64 + pc * 8); }
    for (int r = 0; r < NR; ++r) {
        const int par = r & 1;
        const size_t srow = rowbase + (size_t)r * 256 + wave * 32;
        const bool more = (KIND == 0) && (r + 1 < NR);
        __syncthreads();
        v4u xn[5];
        if (more) {
#pragma unroll
            for (int q = 0; q < 5; ++q) { const int p = lane + 64 * q; const int row = p >> 3, pc = p & 7;
                if (row < 35) xn[q] = *(const GAS v4u*)(F.PROJ + (srow + 256 + row - 3) * DINP + C_XL + nb * 64 + pc * 8); }
        }
        float xc[2][16];
#pragma unroll
        for (int ct = 0; ct < 2; ++ct) {
            const int cg = nb * 64 + 32 * ct + cl; float cw[4]; const float cb = F.conv_b[cg];
#pragma unroll
            for (int j = 0; j < 4; ++j) cw[j] = F.conv_w[j * 1024 + cg];
            const LAS unsigned short* xl = (const LAS unsigned short*)XLw + 32 * ct + cl;
            unsigned short xr[4][7];
#pragma unroll
            for (int g = 0; g < 4; ++g) { const int rb = KIND ? g * 11 + 4 * hh : 8 * g + 4 * hh;
#pragma unroll
                for (int e = 0; e < 7; ++e) xr[g][e] = xl[(rb + e) * 64]; }
#pragma unroll
            for (int g = 0; g < 4; ++g)
#pragma unroll
                for (int e = 0; e < 4; ++e) xc[ct][4 * g + e] = cb + cw[0] * bf2f(xr[g][e]) + cw[1] * bf2f(xr[g][e + 1]) + cw[2] * bf2f(xr[g][e + 2]) + cw[3] * bf2f(xr[g][e + 3]);
        }
#pragma unroll
        for (int ct = 0; ct < 2; ++ct)
#pragma unroll
            for (int i = 0; i < 16; i += 2) { const unsigned w = pg8::cvt_pk_bf16(xc[ct][i], xc[ct][i + 1]);
                *(LAS unsigned short*)(XCw + ((i & 3) + 8 * (i >> 2) + 4 * hh) * 144 + (32 * ct + cl) * 2) = (unsigned short)w;
                *(LAS unsigned short*)(XCw + (((i + 1) & 3) + 8 * (i >> 2) + 4 * hh) * 144 + (32 * ct + cl) * 2) = (unsigned short)(w >> 16); }
        if (more) {
#pragma unroll
            for (int q = 0; q < 5; ++q) { const int p = lane + 64 * q; const int row = p >> 3, pc = p & 7;
                if (row < 35) *(LAS v4u*)(XLw + row * 128 + pc * 16) = xn[q]; }
        }
        bf16x8_t Af[4];
#pragma unroll
        for (int s = 0; s < 4; ++s) Af[s] = *(const LAS bf16x8_t*)(XCw + cl * 144 + (16 * s + 8 * hh) * 2);
        float At_[2], Ut_[2];
        float Aloc[2][16], Hloc[2][16], AGk[2][4], UGk[2][4];
#pragma unroll
        for (int ct = 0; ct < 2; ++ct) {
            f32x16 ar, ai; const int cg = nb * 64 + 32 * ct + cl;
            const float brg = -L2E * F.b_rg[cg], big = -L2E * F.b_ig[cg], c8 = F.C8[cg];
#pragma unroll
            for (int i = 0; i < 16; ++i) { ar[i] = brg; ai[i] = big; }
            bf16x8_t b0[4], b1[4];
#pragma unroll
            for (int s = 0; s < 4; ++s) { b0[s] = *(const LAS bf16x8_t*)(WGl + (32 * ct + cl) * 144 + (16 * s + 8 * hh) * 2); b1[s] = *(const LAS bf16x8_t*)(WGl + (64 + 32 * ct + cl) * 144 + (16 * s + 8 * hh) * 2); }
#pragma unroll
            for (int s = 0; s < 4; ++s) { ar = __builtin_amdgcn_mfma_f32_32x32x16_bf16(Af[s], b0[s], ar, 0, 0, 0); ai = __builtin_amdgcn_mfma_f32_32x32x16_bf16(Af[s], b1[s], ai, 0, 0, 0); }
            float AG[4], UG[4];
#pragma unroll
            for (int g = 0; g < 4; ++g) { float Ap = 1.f, Hp = 0.f;
#pragma unroll
                for (int e = 0; e < 4; ++e) { const int i = 4 * g + e;
                    const float rr = __builtin_amdgcn_rcpf(1.f + __builtin_amdgcn_exp2f(ar[i])), ig = __builtin_amdgcn_rcpf(1.f + __builtin_amdgcn_exp2f(ai[i]));
                    const float a = __builtin_amdgcn_exp2f(c8 * rr);
                    const float u = __builtin_amdgcn_sqrtf(fmaxf(1.f - a * a, 0.f)) * (ig * xc[ct][i]);
                    Hp = a * Hp + u; Ap = a * Ap; Aloc[ct][i] = Ap; Hloc[ct][i] = Hp; }
                AG[g] = Ap; UG[g] = Hp; }
            float At = 1.f, Ut = 0.f;
#pragma unroll
            for (int g = 0; g < 4; ++g) { const float pA = __shfl_xor(AG[g], 32), pU = __shfl_xor(UG[g], 32);
                const float a0 = hh ? pA : AG[g], u0 = hh ? pU : UG[g], a1 = hh ? AG[g] : pA, u1 = hh ? UG[g] : pU;
                Ut = a0 * Ut + u0; At = a0 * At; Ut = a1 * Ut + u1; At = a1 * At; AGk[ct][g] = AG[g]; UGk[ct][g] = UG[g]; }
            At_[ct] = At; Ut_[ct] = Ut;
        }
        v4u zn[4];
        if (more) {
#pragma unroll
            for (int q = 0; q < 4; ++q) { const int p = lane + 64 * q; const int row = p >> 3, pc = p & 7;
                zn[q] = *(const GAS v4u*)(F.PROJ + (srow + 256 + row) * DINP + C_ZL + nb * 64 + pc * 8); }
        }
        float hin[2] = {0.f, 0.f};
        if (KIND == 0) {
            if (hh == 0) {
#pragma unroll
                for (int ct = 0; ct < 2; ++ct) { SL[((par * 8 + wave) * 2 + 0) * 64 + 32 * ct + cl] = At_[ct]; SL[((par * 8 + wave) * 2 + 1) * 64 + 32 * ct + cl] = Ut_[ct]; } }
            __syncthreads();
#pragma unroll
            for (int ct = 0; ct < 2; ++ct) { float sa[7], su[7]; float hs = HC[par * 64 + 32 * ct + cl];
#pragma unroll
                for (int w2 = 0; w2 < 7; ++w2) { sa[w2] = SL[((par * 8 + w2) * 2 + 0) * 64 + 32 * ct + cl]; su[w2] = SL[((par * 8 + w2) * 2 + 1) * 64 + 32 * ct + cl]; }
#pragma unroll
                for (int w2 = 0; w2 < 7; ++w2) { const float hn = sa[w2] * hs + su[w2]; hs = w2 < wave ? hn : hs; }
                hin[ct] = hs;
                if (wave == 7 && hh == 0) HC[(par ^ 1) * 64 + 32 * ct + cl] = At_[ct] * hs + Ut_[ct]; }
        }
#pragma unroll
        for (int ct = 0; ct < 2; ++ct) {
            float hst[4]; float hs = hin[ct];
#pragma unroll
            for (int g = 0; g < 4; ++g) { const float pA = __shfl_xor(AGk[ct][g], 32), pU = __shfl_xor(UGk[ct][g], 32);
                const float a0 = hh ? pA : AGk[ct][g], u0 = hh ? pU : UGk[ct][g], a1 = hh ? AGk[ct][g] : pA, u1 = hh ? UGk[ct][g] : pU;
                if (KIND == 1) hs = F.st_h[(size_t)(sg * 32 + wave * 4 + g) * 1024 + nb * 64 + 32 * ct + cl];
                const float hs0 = hs; hs = a0 * hs + u0;
                hst[g] = hh ? hs : hs0; hs = a1 * hs + u1;
                if (KIND == 1 && hh == 0) F.out[O_HS + (size_t)(sg * 32 + wave * 4 + g) * 1024 + nb * 64 + 32 * ct + cl] = hs;
            }
            if (KIND == 0 && r == NR - 1 && wave == 7 && hh == 0) F.out[O_HP + (size_t)sg * 1024 + nb * 64 + 32 * ct + cl] = hs;
            LAS unsigned short* zl = (LAS unsigned short*)ZLw + 32 * ct + cl;
            unsigned short zr[16];
#pragma unroll
            for (int i = 0; i < 16; ++i) zr[i] = zl[((i & 3) + 8 * (i >> 2) + 4 * hh) * 64];
            unsigned short yr[16];
#pragma unroll
            for (int i = 0; i < 16; i += 2) { const float y0 = (Aloc[ct][i] * hst[i >> 2] + Hloc[ct][i]) * bf2f(zr[i]), y1 = (Aloc[ct][i + 1] * hst[i >> 2] + Hloc[ct][i + 1]) * bf2f(zr[i + 1]);
                const unsigned w = pg8::cvt_pk_bf16(y0, y1); yr[i] = (unsigned short)w; yr[i + 1] = (unsigned short)(w >> 16); }
#pragma unroll
            for (int i = 0; i < 16; ++i) zl[((i & 3) + 8 * (i >> 2) + 4 * hh) * 64] = yr[i];
        }
        v4u yo[4];
#pragma unroll
        for (int q = 0; q < 4; ++q) { const int p = lane + 64 * q; yo[q] = *(const LAS v4u*)(ZLw + (p >> 3) * 128 + (p & 7) * 16); }
#pragma unroll
        for (int q = 0; q < 4; ++q) { const int p = lane + 64 * q; *(GAS v4u*)(F.YMIX + (srow + (p >> 3)) * DMIX + nb * 64 + (p & 7) * 8) = yo[q]; }
        if (KIND == 0) {
            if (r == NR - 1 && wave == 7) { for (int e = lane; e < 192; e += 64) { const int j = e >> 6, c = e & 63;
                F.out[O_CP + ((size_t)sg * 3 + j) * 1024 + nb * 64 + c] = bf2f(((const LAS unsigned short*)XLw)[(32 + j) * 64 + c]); } }
        } else {
            for (int e = lane; e < 4 * 192; e += 64) { const int sq = e / 192, j = (e % 192) >> 6, c = e & 63;
                F.out[O_CS + ((size_t)(sg * 32 + wave * 4 + sq) * 3 + j) * 1024 + nb * 64 + c] = bf2f(((const LAS unsigned short*)XLw)[(sq * 11 + 8 + j) * 64 + c]); }
        }
        if (more) {
#pragma unroll
            for (int q = 0; q < 4; ++q) { const int p = lane + 64 * q; *(LAS v4u*)(ZLw + (p >> 3) * 128 + (p & 7) * 16) = zn[q]; }
        }
    }
    __syncthreads();
}


constexpr int GL_BUF = 49152;
constexpr int GL_QT = 0, GL_KT = 16384, GL_VZ = 32768, GL_AT = 2 * GL_BUF, GL_SBT = GL_AT + 9216, GL_YL = GL_SBT + 17408, GL_DEC = GL_YL + 9216, GL_END = GL_DEC + 16384;
static_assert(GL_END <= RING_BYTES, "GLA LDS map");
__device__ __forceinline__ unsigned off_b(unsigned row, unsigned ch) { return 256u * row + 16u * (ch ^ (((row & 3u) << 2) | ((row >> 2) & 3u))); }
__device__ __forceinline__ void tr_addr(unsigned lane, unsigned c, unsigned ks, unsigned& a0, unsigned& a1) {
    const unsigned h = lane >> 5, blk = (lane >> 4) & 1u, q = (lane & 15u) >> 2, p = lane & 3u;
    a0 = off_b(16u * ks + 8u * h + q, 4u * c + 2u * blk + (p >> 1)) + 8u * (p & 1u);
    a1 = off_b(16u * ks + 8u * h + 4u + q, 4u * c + 2u * blk + (p >> 1)) + 8u * (p & 1u);
}
__device__ __forceinline__ void tr_frag4(unsigned base, const unsigned (&a)[8], bf16x8_t (&f)[4]) {
    v2u r0, r1, r2, r3, r4, r5, r6, r7;
    asm volatile("ds_read_b64_tr_b16 %0, %8\n\tds_read_b64_tr_b16 %1, %9\n\tds_read_b64_tr_b16 %2, %10\n\tds_read_b64_tr_b16 %3, %11\n\t"
                 "ds_read_b64_tr_b16 %4, %12\n\tds_read_b64_tr_b16 %5, %13\n\tds_read_b64_tr_b16 %6, %14\n\tds_read_b64_tr_b16 %7, %15\n\ts_waitcnt lgkmcnt(0)"
                 : "=&v"(r0), "=&v"(r1), "=&v"(r2), "=&v"(r3), "=&v"(r4), "=&v"(r5), "=&v"(r6), "=&v"(r7)
                 : "v"(base + a[0]), "v"(base + a[1]), "v"(base + a[2]), "v"(base + a[3]), "v"(base + a[4]), "v"(base + a[5]), "v"(base + a[6]), "v"(base + a[7]) : "memory");
    f[0] = __builtin_bit_cast(bf16x8_t, (v4u){r0.x, r0.y, r1.x, r1.y}); f[1] = __builtin_bit_cast(bf16x8_t, (v4u){r2.x, r2.y, r3.x, r3.y});
    f[2] = __builtin_bit_cast(bf16x8_t, (v4u){r4.x, r4.y, r5.x, r5.y}); f[3] = __builtin_bit_cast(bf16x8_t, (v4u){r6.x, r6.y, r7.x, r7.y});
}
__device__ __forceinline__ void gla_item(const Frame& F, int b, int h, int vs) {
    int tid = F.tid; asm volatile("" : "+v"(tid));
    const int lane = tid & 63, wave = F.wave, cl = lane & 31, hh = lane >> 5;
    LAS unsigned char* L = F.lds + RING_OFF;
    const unsigned Lb = (unsigned)(size_t)L;
    const int dt = wave >> 1, vt = wave & 1;
    const size_t row0 = (size_t)b * TP;
    f32x16 Sacc;
#pragma unroll
    for (int i = 0; i < 16; ++i) Sacc[i] = 0.f;
    v4u pq[2], pk[2], pv, pz;
    float gh[16];
#pragma unroll
    for (int i = 0; i < 16; ++i) gh[i] = F.g_head[vs * 64 + 32 * vt + (i & 3) + 8 * (i >> 2) + 4 * hh];
    const int qrow = tid >> 4, qch = tid & 15, vrow = tid >> 3, vch = tid & 7;
    const unsigned sq0 = off_b(qrow, qch), sq1 = off_b(qrow + 32, qch), sv0 = off_b(vrow, vch), sv1 = off_b(vrow, 8 + vch);
    unsigned tk[8], tv[8];
#pragma unroll
    for (unsigned ks = 0; ks < 4; ++ks) { tr_addr(lane, dt, ks, tk[2 * ks], tk[2 * ks + 1]); tr_addr(lane, vt, ks, tv[2 * ks], tv[2 * ks + 1]); }
#define GL_LOAD(n) do { const bf16* pr = F.PROJ + (row0 + (size_t)(n) * 64) * DINP; \
        pq[0] = *(const GAS v4u*)(pr + (size_t)qrow * DINP + C_Q + h * 128 + qch * 8); pq[1] = *(const GAS v4u*)(pr + (size_t)(qrow + 32) * DINP + C_Q + h * 128 + qch * 8); \
        pk[0] = *(const GAS v4u*)(pr + (size_t)qrow * DINP + C_K + h * 128 + qch * 8); pk[1] = *(const GAS v4u*)(pr + (size_t)(qrow + 32) * DINP + C_K + h * 128 + qch * 8); \
        pv = *(const GAS v4u*)(pr + (size_t)vrow * DINP + C_V + h * 256 + vs * 64 + vch * 8); pz = *(const GAS v4u*)(pr + (size_t)vrow * DINP + C_ZG + h * 256 + vs * 64 + vch * 8); \
        } while (0)
#define GL_STAGE(bo) do { LAS unsigned char* B_ = L + (bo); \
        *(LAS v4u*)(B_ + GL_QT + sq0) = pq[0]; *(LAS v4u*)(B_ + GL_QT + sq1) = pq[1]; *(LAS v4u*)(B_ + GL_KT + sq0) = pk[0]; *(LAS v4u*)(B_ + GL_KT + sq1) = pk[1]; \
        *(LAS v4u*)(B_ + GL_VZ + sv0) = pv; *(LAS v4u*)(B_ + GL_VZ + sv1) = pz; } while (0)
#define GL_ROWF(img, row, ks) (*(const LAS bf16x8_t*)(L + (img) + off_b((row), 2 * (ks) + hh)))
#define GL_PADF(base, stride, row, ks) (*(const LAS bf16x8_t*)(L + (base) + (row) * (stride) + (16 * (ks) + 8 * hh) * 2))
#define GL_UPD(bo) do { bf16x8_t fa[4], fb[4]; f32x4 dc[4]; \
        _Pragma("unroll") for (int g = 0; g < 4; ++g) dc[g] = *(const LAS f32x4*)(L + GL_DEC + (n * 128 + 32 * dt + 8 * g + 4 * hh) * 4); \
        tr_frag4(Lb + (bo) + GL_KT, tk, fa); tr_frag4(Lb + (bo) + GL_VZ, tv, fb); \
        _Pragma("unroll") for (int ks = 0; ks < 4; ++ks) Sacc = __builtin_amdgcn_mfma_f32_32x32x16_bf16(fa[ks], fb[ks], Sacc, 0, 0, 0); \
        _Pragma("unroll") for (int i = 0; i < 16; ++i) Sacc[i] *= dc[i >> 2][i & 3]; } while (0)
    __syncthreads();
    for (int i = tid; i < (TP / 64) * 32; i += NWAVES * 64) *(LAS f32x4*)(L + GL_DEC + i * 16) = *(const GAS f32x4*)(F.DEC + ((size_t)(b * (TP / 64) + (i >> 5))) * 512 + h * 128 + (i & 31) * 4);
    GL_LOAD(0); GL_STAGE(0);
    GL_LOAD(1);
    for (int n = 0; n < TP / 64; ++n) {
        const int bo = (n & 1) * GL_BUF;
        __syncthreads();
        if (n > 0) {
            *(GAS v4u*)(F.YMIX + (row0 + (size_t)(n - 1) * 64 + vrow) * DMIX + 1024 + h * 256 + vs * 64 + vch * 8) = *(const LAS v4u*)(L + GL_YL + vrow * 144 + vch * 16); }
        if (n + 1 < TP / 64) GL_STAGE(GL_BUF - bo);
        if (n + 2 < TP / 64) GL_LOAD(n + 2);
#pragma unroll
        for (int g = 0; g < 4; ++g) { v2u w; w.x = pg8::cvt_pk_bf16(Sacc[4 * g], Sacc[4 * g + 1]); w.y = pg8::cvt_pk_bf16(Sacc[4 * g + 2], Sacc[4 * g + 3]);
            *(LAS v2u*)(L + GL_SBT + (32 * vt + cl) * 272 + (32 * dt + 8 * g + 4 * hh) * 2) = w; }
        const bool attw = (wave >= 4 && wave < 7);
        if (attw) {
            const int st = (wave - 4) >> 1, ct = (wave - 3) >> 1;
            f32x16 a;
#pragma unroll
            for (int i = 0; i < 16; ++i) a[i] = 0.f;
            bf16x8_t ka[8], qb[8];
#pragma unroll
            for (int ks = 0; ks < 8; ++ks) { ka[ks] = GL_ROWF(bo + GL_KT, 32 * st + cl, ks); qb[ks] = GL_ROWF(bo + GL_QT, 32 * ct + cl, ks); }
            asm volatile("s_waitcnt lgkmcnt(0)" ::: "memory");
#pragma unroll
            for (int ks = 0; ks < 8; ++ks) a = __builtin_amdgcn_mfma_f32_32x32x16_bf16(ka[ks], qb[ks], a, 0, 0, 0);
            if (st == ct) {
#pragma unroll
                for (int i = 0; i < 16; ++i) { const int sl = (i & 3) + 8 * (i >> 2) + 4 * hh; a[i] = sl <= cl ? a[i] : 0.f; } }
#pragma unroll
            for (int g = 0; g < 4; ++g) { v2u w; w.x = pg8::cvt_pk_bf16(a[4 * g], a[4 * g + 1]); w.y = pg8::cvt_pk_bf16(a[4 * g + 2], a[4 * g + 3]);
                *(LAS v2u*)(L + GL_AT + (32 * ct + cl) * 144 + (32 * st + 8 * g + 4 * hh) * 2) = w; }
        } else GL_UPD(bo);
        __syncthreads();
        if (attw) GL_UPD(bo);
        if (wave < 4) {
            f32x16 o;
#pragma unroll
            for (int i = 0; i < 16; ++i) o[i] = 0.f;
            bf16x8_t fv[4], fa[4], fs[4], fq[4]; tr_frag4(Lb + bo + GL_VZ, tv, fv);
            v2u zc[4];
#pragma unroll
            for (int ks = 0; ks < 4; ++ks) { fa[ks] = GL_PADF(GL_AT, 144, 32 * dt + cl, ks); fs[ks] = GL_PADF(GL_SBT, 272, 32 * vt + cl, ks); fq[ks] = GL_ROWF(bo + GL_QT, 32 * dt + cl, ks); }
            asm volatile("s_waitcnt lgkmcnt(0)" ::: "memory");
            o = __builtin_amdgcn_mfma_f32_32x32x16_bf16(fv[0], fa[0], o, 0, 0, 0);
            o = __builtin_amdgcn_mfma_f32_32x32x16_bf16(fv[1], fa[1], o, 0, 0, 0);
            if (dt) { o = __builtin_amdgcn_mfma_f32_32x32x16_bf16(fv[2], fa[2], o, 0, 0, 0); o = __builtin_amdgcn_mfma_f32_32x32x16_bf16(fv[3], fa[3], o, 0, 0, 0); }
#pragma unroll
            for (int ks = 0; ks < 4; ++ks) o = __builtin_amdgcn_mfma_f32_32x32x16_bf16(fs[ks], fq[ks], o, 0, 0, 0);
#pragma unroll
            for (int ks = 0; ks < 4; ++ks) { fs[ks] = GL_PADF(GL_SBT, 272, 32 * vt + cl, 4 + ks); fq[ks] = GL_ROWF(bo + GL_QT, 32 * dt + cl, 4 + ks); }
#pragma unroll
            for (int g = 0; g < 4; ++g) zc[g] = *(const LAS v2u*)(L + bo + GL_VZ + off_b(32 * dt + cl, 8 + 4 * vt + g) + 8 * hh);
            asm volatile("s_waitcnt lgkmcnt(0)" ::: "memory");
#pragma unroll
            for (int ks = 0; ks < 4; ++ks) o = __builtin_amdgcn_mfma_f32_32x32x16_bf16(fs[ks], fq[ks], o, 0, 0, 0);
            float ss = 0.f;
#pragma unroll
            for (int i = 0; i < 16; ++i) ss += o[i] * o[i];
            ss += __shfl_xor(ss, 32);
            const size_t row = row0 + (size_t)n * 64 + 32 * dt + cl;
            if (hh == 0) F.PSS[(size_t)(h * 8 + vs * 2 + vt) * NROWP + row] = ss;
#pragma unroll
            for (int g = 0; g < 4; ++g) {
                const float y0 = o[4 * g] * gh[4 * g] * bflo(zc[g].x), y1 = o[4 * g + 1] * gh[4 * g + 1] * bfhi(zc[g].x), y2 = o[4 * g + 2] * gh[4 * g + 2] * bflo(zc[g].y), y3 = o[4 * g + 3] * gh[4 * g + 3] * bfhi(zc[g].y);
                v2u w; w.x = pg8::cvt_pk_bf16(y0, y1); w.y = pg8::cvt_pk_bf16(y2, y3); *(LAS v2u*)(L + GL_YL + (32 * dt + cl) * 144 + (32 * vt + 8 * g + 4 * hh) * 2) = w; }
        }
    }
    __syncthreads();
    *(GAS v4u*)(F.YMIX + (row0 + (size_t)(TP / 64 - 1) * 64 + vrow) * DMIX + 1024 + h * 256 + vs * 64 + vch * 8) = *(const LAS v4u*)(L + GL_YL + vrow * 144 + vch * 16);
    float* so = F.out + O_GP + (((size_t)b * NH + h) * HK + 32 * dt) * HV + vs * 64 + 32 * vt + cl;
#pragma unroll
    for (int i = 0; i < 16; ++i) so[(size_t)((i & 3) + 8 * (i >> 2) + 4 * hh) * HV] = Sacc[i];
    __syncthreads();
#undef GL_LOAD
#undef GL_STAGE
#undef GL_ROWF
#undef GL_PADF
#undef GL_UPD
}
__device__ __forceinline__ void p2b_norm(Frame& F) {
    const int gw = F.vcu * NWAVES + F.wave, NGW = F.G * NWAVES;
    for (int r = gw; r < NROWP; r += NGW) {
        const int hd = F.lane >> 4;
        float tot = 0.f;
#pragma unroll
        for (int k = 0; k < 8; ++k) tot += F.PSS[(size_t)(hd * 8 + k) * NROWP + r];
        const float rs = rsqrtf(tot * (1.f / 256.f) + EPS);
        GAS v4u* yp = (GAS v4u*)(F.YMIX + (size_t)r * DMIX + 1024 + F.lane * 16);
#pragma unroll
        for (int q = 0; q < 2; ++q) { v4u w = yp[q];
            w.x = pk2(bflo(w.x) * rs, bfhi(w.x) * rs); w.y = pk2(bflo(w.y) * rs, bfhi(w.y) * rs); w.z = pk2(bflo(w.z) * rs, bfhi(w.z) * rs); w.w = pk2(bflo(w.w) * rs, bfhi(w.w) * rs); yp[q] = w; }
    }
}

constexpr int GS_Q = 0, GS_K = 4096, GS_V = 8192, GS_DEC = 16384, GS_ATT = 16896, GS_OP = 17408, GS_END = GS_OP + 8 * 8 * 256 * 4;
static_assert(GS_END <= RING_BYTES, "GLA sample LDS map");
__device__ __forceinline__ void gla_sample_item(const Frame& F, int seq, int h) {
    int tid = F.tid; asm volatile("" : "+v"(tid));
    const int lane = tid & 63, wave = F.wave, v4 = tid & 63, dg = wave;
    LAS float* Lq = (LAS float*)(F.lds + RING_OFF + GS_Q);
    LAS float* Lk = (LAS float*)(F.lds + RING_OFF + GS_K);
    LAS float* Lv = (LAS float*)(F.lds + RING_OFF + GS_V);
    LAS float* Ld = (LAS float*)(F.lds + RING_OFF + GS_DEC);
    LAS float* La = (LAS float*)(F.lds + RING_OFF + GS_ATT);
    LAS float* Lo = (LAS float*)(F.lds + RING_OFF + GS_OP);
    const size_t row0 = (size_t)NROWP + (size_t)seq * TS;
    const float* s0 = F.st_gla + (((size_t)seq * NH + h) * HK + 16 * dg) * HV + 4 * v4;
    f32x4 S[16];
#pragma unroll
    for (int i = 0; i < 16; ++i) S[i] = *(const GAS f32x4*)(s0 + (size_t)i * HV);
    __syncthreads();
    { const int t = tid >> 6, c = tid & 63; const bf16* pr = F.PROJ + (row0 + t) * DINP;
      const unsigned q2 = *(const GAS unsigned*)(pr + C_Q + h * 128 + 2 * c), k2 = *(const GAS unsigned*)(pr + C_K + h * 128 + 2 * c);
      Lq[t * 128 + 2 * c] = bflo(q2); Lq[t * 128 + 2 * c + 1] = bfhi(q2); Lk[t * 128 + 2 * c] = bflo(k2); Lk[t * 128 + 2 * c + 1] = bfhi(k2);
      const v2u vv = *(const GAS v2u*)(pr + C_V + h * 256 + 4 * c);
      *(LAS f32x4*)(Lv + t * 256 + 4 * c) = (f32x4){bflo(vv.x), bfhi(vv.x), bflo(vv.y), bfhi(vv.y)};
      if (tid < 128) Ld[tid] = F.DEC[(size_t)(NP * (TP / 64) + seq) * 512 + h * 128 + tid]; }
    __syncthreads();
    if (wave == 0) { const int t = lane >> 3, s = lane & 7; float a = 0.f;
        for (int d = 0; d < 128; d += 4) { const f32x4 q = *(const LAS f32x4*)(Lq + t * 128 + d), k = *(const LAS f32x4*)(Lk + s * 128 + d); a += (q.x * k.x + q.y * k.y) + (q.z * k.z + q.w * k.w); }
        La[lane] = s <= t ? a : 0.f; }
    f32x4 o[8];
#pragma unroll
    for (int t = 0; t < 8; ++t) o[t] = (f32x4){0.f, 0.f, 0.f, 0.f};
    f32x4 vr[8];
#pragma unroll
    for (int t = 0; t < 8; ++t) vr[t] = *(const LAS f32x4*)(Lv + t * 256 + 4 * v4);
    float* so = F.out + O_GS + (((size_t)seq * NH + h) * HK + 16 * dg) * HV + 4 * v4;
#pragma unroll
    for (int i = 0; i < 16; ++i) { const int d = 16 * dg + i; f32x4 sn = S[i];
#pragma unroll
        for (int t = 0; t < 8; ++t) { const float q = Lq[t * 128 + d], k = Lk[t * 128 + d]; o[t] += q * S[i]; sn += k * vr[t]; }
        *(GAS f32x4*)(so + (size_t)i * HV) = sn * Ld[d]; }
#pragma unroll
    for (int t = 0; t < 8; ++t) *(LAS f32x4*)(Lo + (dg * 8 + t) * 256 + 4 * v4) = o[t];
    __syncthreads();
    { const int t = wave; f32x4 a = (f32x4){0.f, 0.f, 0.f, 0.f};
#pragma unroll
      for (int g = 0; g < 8; ++g) a += *(const LAS f32x4*)(Lo + (g * 8 + t) * 256 + 4 * v4);
#pragma unroll
      for (int s = 0; s < 8; ++s) a += La[t * 8 + s] * vr[s];
      const float ss = wave_sum((a.x * a.x + a.y * a.y) + (a.z * a.z + a.w * a.w));
      const float rs = rsqrtf(ss * (1.f / 256.f) + EPS);
      const f32x4 gh = *(const GAS f32x4*)(F.g_head + 4 * v4);
      const v2u zz = *(const GAS v2u*)(F.PROJ + (row0 + t) * DINP + C_ZG + h * 256 + 4 * v4);
      const float z0 = bflo(zz.x), z1 = bfhi(zz.x), z2 = bflo(zz.y), z3 = bfhi(zz.y);
      v2u w; w.x = pk2(a.x * rs * gh.x * z0, a.y * rs * gh.y * z1); w.y = pk2(a.z * rs * gh.z * z2, a.w * rs * gh.w * z3);
      *(GAS v2u*)(F.YMIX + (row0 + t) * DMIX + 1024 + h * 256 + 4 * v4) = w; }
}

__device__ __forceinline__ void p2_mix_simple(Frame& F) {
    if (F.G == 256 && DUP_PHASE < 6) {
        const int v = F.vcu;
        if (v < 128) { lru_item<0>(F, v >> 4, v & 15); gla_sample_item(F, v >> 2, v & 3); }
        else { const int g = v - 128; gla_item(F, g >> 4, (g >> 2) & 3, g & 3);
            if (g < 64) { lru_item<1>(F, g >> 4, g & 15); for (int i = 0; i < 2; ++i) { const int it = 128 + 2 * g + i; gla_sample_item(F, it >> 2, it & 3); } }
            else { for (int i = 0; i < 4; ++i) { const int it = 256 + 4 * (g - 64) + i; gla_sample_item(F, it >> 2, it & 3); } } }
        __syncthreads();
        return;
    }
    for (int it = F.vcu; it < 2 * NP * 16; it += F.G) {
        if (it < NP * 16) { for (int rep = 0; rep < (DUP_PHASE == 6 ? 2 : 1); ++rep) lru_item<0>(F, it >> 4, it & 15); }
        else { const int g = it - NP * 16; for (int rep = 0; rep < (DUP_PHASE == 7 ? 2 : 1); ++rep) gla_item(F, g >> 4, (g >> 2) & 3, g & 3); }
    }
    for (int rep = 0; rep < (DUP_PHASE == 8 ? 2 : 1); ++rep) for (int it = F.vcu; it < 4 * 16; it += F.G) lru_item<1>(F, it >> 4, it & 15);
    for (int rep = 0; rep < (DUP_PHASE == 9 ? 2 : 1); ++rep) for (int it = F.vcu; it < NS * NH; it += F.G) gla_sample_item(F, it >> 2, it & 3);
    __syncthreads();
}

__device__ __forceinline__ void p4_final(Frame& F) {
    const int gw = F.vcu * NWAVES + F.wave, NGW = F.G * NWAVES;
    const GAS f32x4* gp = (const GAS f32x4*)F.g_post + F.lane;
    f32x4 g[4];
#pragma unroll
    for (int j = 0; j < 4; ++j) g[j] = gp[64 * j];
    for (int r = gw; r < NTOK; r += NGW) {
        const float* xrow = r < NROWP ? F.xp + (size_t)r * D : F.xs + (size_t)(r - NROWP) * D;
        const GAS f32x4* xr = (const GAS f32x4*)xrow + F.lane;
        f32x4 y[4], x[4];
#pragma unroll
        for (int j = 0; j < 4; ++j) x[j] = xr[64 * j];
        if (r < NROWP) { const GAS v2u* yr = (const GAS v2u*)(F.YBF + (size_t)r * D) + F.lane;
#pragma unroll
            for (int j = 0; j < 4; ++j) { const v2u w = yr[64 * j]; y[j] = (f32x4){bflo(w.x), bfhi(w.x), bflo(w.y), bfhi(w.y)}; }
        } else {
#pragma unroll
            for (int j = 0; j < 4; ++j) y[j] = (f32x4){0.f, 0.f, 0.f, 0.f};
#pragma unroll
            for (int s = 0; s < 8; ++s) { const GAS v2u* yr = (const GAS v2u*)(F.YS + ((size_t)s * NROWS + (r - NROWP)) * D) + F.lane;
#pragma unroll
                for (int j = 0; j < 4; ++j) { const v2u w = yr[64 * j]; y[j] += (f32x4){bflo(w.x), bfhi(w.x), bflo(w.y), bfhi(w.y)}; } }
        }
        float ss = 0.f;
#pragma unroll
        for (int j = 0; j < 4; ++j) ss += (y[j].x * y[j].x + y[j].y * y[j].y) + (y[j].z * y[j].z + y[j].w * y[j].w);
        const float rs = rsqrtf(wave_sum(ss) * (1.f / D) + EPS);
        GAS f32x4* orow = (GAS f32x4*)(F.out + (size_t)r * D) + F.lane;
#pragma unroll
        for (int j = 0; j < 4; ++j) orow[64 * j] = x[j] + y[j] * rs * g[j];
    }
}


struct Args { const float* in[19]; float* out; unsigned char* ws; int ph_lo, ph_hi, li, pad; };
__global__ void __launch_bounds__(NWAVES * 64, 2) mk_fwd(Args args) {
    extern __shared__ __attribute__((aligned(16))) unsigned char lds[];
    Frame F;
    F.lds = (LAS unsigned char*)lds;
    F.MISC = (volatile LAS unsigned*)(F.lds + MISC_OFF);
    F.tid = threadIdx.x; F.lane = F.tid & 63; F.wave = __builtin_amdgcn_readfirstlane(F.tid >> 6);
    F.G = gridDim.x; { const int bx = blockIdx.x; F.vcu = (F.G % 8 == 0) ? (bx % 8) * (F.G / 8) + bx / 8 : bx; }
    unsigned char* ws = args.ws;
    F.ctl = (gu32*)(ws + WS_CTL);
    F.xp = args.in[0]; F.xs = args.in[1]; F.st_h = args.in[2]; F.st_conv = args.in[3]; F.st_gla = args.in[4]; F.g_pre = args.in[5]; F.w_in = args.in[6];
    F.conv_w = args.in[7]; F.conv_b = args.in[8]; F.w_rg = args.in[9]; F.b_rg = args.in[10]; F.w_ig = args.in[11]; F.b_ig = args.in[12]; F.lam = args.in[13];
    F.w_gk2 = args.in[14]; F.b_gk = args.in[15]; F.g_head = args.in[16]; F.w_out = args.in[17]; F.g_post = args.in[18];
    F.out = args.out;
    F.WinT = (bf16*)(ws + WS_WINT); F.WoutT = (bf16*)(ws + WS_WOUT); F.XN = (bf16*)(ws + WS_XN); F.PROJ = (bf16*)(ws + WS_PROJ);
    F.YMIX = (bf16*)args.out;
    F.YBF = (bf16*)(ws + WS_XN);
    F.RGK = (float*)(ws + WS_RGK); F.PART = (float*)(ws + WS_PART); F.DEC = (float*)(ws + WS_DEC); F.PSS = (float*)(ws + WS_RGK); F.C8 = (float*)(ws + WS_PART); F.YS = (bf16*)(ws + WS_YS);
    F.BCUM = args.out + O_GS;
    for (int u = F.tid; u < (LDS_BYTES - LDSCTL_OFF) / 4; u += NWAVES * 64) ((LAS unsigned*)(F.lds + LDSCTL_OFF))[u] = 0u;
    __syncthreads();
    XcdBarrier bar; bar.bar = (unsigned*)(F.ctl + CW_BAR); bar.x = 0; bar.st = nullptr;
    if (N_LAUNCHES == 1) bar = xcd_barrier_post((unsigned*)(F.ctl + CW_BAR), F.MISC + 8);
#define GRID_BAR() do { if (N_LAUNCHES == 1) xcd_barrier(bar); } while (0)
    const int lo = args.ph_lo, hi = args.ph_hi;
#ifndef PH_MASK
#define PH_MASK 31
#endif
#define IN(k) (lo <= (k) && (k) < hi && ((PH_MASK >> (k)) & 1))
#define BOTH(k) (IN(k) && IN((k) + 1))
#ifndef DUP_PHASE
#define DUP_PHASE -1
#endif
#define REPS(k) for (int rep_ = 0; rep_ < ((DUP_PHASE == (k)) ? 2 : 1); ++rep_)
    if (IN(0)) { REPS(0) { p0_prologue(F); if (BOTH(0)) GRID_BAR(); } }
    if (IN(1)) { REPS(1) {
        pg8::Gemm g{F.XN, F.WinT, NTOK, DINP, D}; pg8::StaticOrder S; S.init(NTOK, DINP, F.G, (int)blockIdx.x);
        pg8::EpiProj E{F.PROJ, DINP, F.BCUM};
        pg8::gemm_phase<pg8::EpiProj, pg8::StaticOrder, true, true>(F.lds + RING_OFF, g, S, E);
        if (BOTH(1)) GRID_BAR(); }
    }
    if (IN(2)) { REPS(2) { p2_mix_simple(F); if (BOTH(2)) GRID_BAR(); } }
    if (IN(3)) { REPS(3) {
        pg8::Gemm g{F.YMIX, F.WoutT, NTOK, D, DMIX}; pg8::Gemm2Order S; S.init(NROWP, NTOK, D, DMIX, 8, F.G, (int)blockIdx.x);
        pg8::EpiY E{F.YBF, D, F.YS, NROWP, (size_t)NROWS * D};
        pg8::HeadScale KSc{F.PSS, NROWP, EPS};
        pg8::gemm_phase<pg8::EpiY, pg8::Gemm2Order, true, true, pg8::HeadScale>(F.lds + RING_OFF, g, S, E, KSc);
        if (BOTH(3)) GRID_BAR(); }
    }
    if (IN(4)) { REPS(4) { p4_final(F); if (DUP_PHASE == 4) GRID_BAR(); } }
#undef IN
#undef BOTH
}

extern "C" void kernel_launch(void* const* d_in, const int* in_sizes, int n_in, void* d_out, int out_size, void* d_ws, size_t ws_size, hipStream_t stream) {
    static int grid = 0;
    if (grid == 0) {
        if (n_in != 19 || in_sizes[0] != NROWP * D || in_sizes[6] != D * DIN || (size_t)out_size != O_END || ws_size < WS_END) {
            fprintf(stderr, "kernel_launch: unexpected shapes: n_in %d in0 %d in6 %d out %d ws %zu; nothing launched\n", n_in, n_in > 0 ? in_sizes[0] : -1, n_in > 6 ? in_sizes[6] : -1, out_size, ws_size); grid = -1; return; }
        int dev = 0, cus = 0, per_cu = 0;
        if (hipGetDevice(&dev) != hipSuccess || hipDeviceGetAttribute(&cus, hipDeviceAttributeMultiprocessorCount, dev) != hipSuccess) { grid = -1; return; }
        if (hipFuncSetAttribute((const void*)mk_fwd, hipFuncAttributeMaxDynamicSharedMemorySize, LDS_BYTES) != hipSuccess) { fprintf(stderr, "kernel_launch: hipFuncSetAttribute failed\n"); grid = -1; return; }
        if (hipOccupancyMaxActiveBlocksPerMultiprocessor(&per_cu, (const void*)mk_fwd, NWAVES * 64, LDS_BYTES) != hipSuccess || per_cu < 1)
            fprintf(stderr, "kernel_launch: note: occupancy query reports %d workgroups per CU\n", per_cu);
        (void)hipGetLastError();
        grid = cus;
    }
    if (grid < 0) return;
    if (hipMemsetAsync((char*)d_ws + WS_CTL, 0, CTL_ZERO_BYTES, stream) != hipSuccess) { fprintf(stderr, "kernel_launch: hipMemsetAsync failed\n"); return; }
    Args a{};
    for (int i = 0; i < 19; ++i) a.in[i] = (const float*)d_in[i];
    a.out = (float*)d_out; a.ws = (unsigned char*)d_ws;
    for (int li = 0; li < N_LAUNCHES; ++li) {
        a.ph_lo = (N_LAUNCHES == 1) ? 0 : li; a.ph_hi = (N_LAUNCHES == 1) ? N_PHASES : li + 1; a.li = li;
        hipLaunchKernelGGL(mk_fwd, dim3(grid), dim3(NWAVES * 64), LDS_BYTES, stream, a);
        const hipError_t le = hipPeekAtLastError();
        if (le != hipSuccess) { fprintf(stderr, "kernel_launch: launch %d failed: %s\n", li, hipGetErrorName(le)); break; }
    }
}
```

```cpp
#define MK_N_LAUNCHES 1
#include <hip/hip_runtime.h>
#include <cstdio>
#include <cstdint>
namespace pg8 {
#define PG8_LAS __attribute__((address_space(3)))
typedef unsigned short bf16_t;
typedef short bf16x8 __attribute__((ext_vector_type(8)));
typedef float f32x4 __attribute__((ext_vector_type(4)));
typedef unsigned u32x4 __attribute__((ext_vector_type(4)));
constexpr int BM = 256, BK = 64, HALF = 128, HTB = HALF * BK * 2  , STAGE_BYTES = 8 * HTB, NXCD = 8, WGM = 8;

__host__ __device__ __forceinline__ int lds_byte(int r, int c) { const int st = (r >> 4) * 2 + (c >> 5), rr = r & 15, cc = c & 31, ob = rr * 64 + cc * 2; return st * 1024 + (ob ^ (((ob >> 9) & 1) << 5)); }
__host__ __device__ __forceinline__ void stage_rc(int b, int& R, int& C) { const int st = b / 1024, sb = b % 1024, swz = sb ^ (((sb >> 9) & 1) << 5); R = (st >> 1) * 16 + swz / 64; C = (st & 1) * 32 + (swz % 64) / 2; }
__host__ __device__ __forceinline__ int perm32(int rho) { const int n = rho >> 4, i = rho & 15; return 8 * (i >> 2) + 4 * n + (i & 3); }

struct Unit { int pm, pn, k0, nt, slab; };
struct Gemm { const bf16_t* A; const bf16_t* Bt; int M, N, K; };

struct StaticOrder {
    int nM, nN, nwg, G, c;
    __host__ __device__ void init(int M, int N, int G_, int c_) { nM = M / BM; nN = N / BM; nwg = nM * nN; G = G_; c = c_; }
    __host__ __device__ bool next(int i, Unit& u) const {
        const long L = (long)i * G + c; if (L >= nwg) return false;
        int wgid = (int)L; { const int q = nwg / NXCD, r = nwg % NXCD, xcd = wgid % NXCD, off = wgid / NXCD; wgid = (xcd < r ? xcd * (q + 1) : r * (q + 1) + (xcd - r) * q) + off; }
        const int nig = WGM * nN, gid = wgid / nig, fm = gid * WGM, gsz = (nM - fm) < WGM ? (nM - fm) : WGM;
        u.pm = fm + ((wgid % nig) % gsz); u.pn = (wgid % nig) / gsz; u.k0 = 0; u.nt = 0; u.slab = -1; return true;
    }
    __device__ __forceinline__ void a_ready(const Unit&) const {}
    __device__ __forceinline__ void done(const Unit&, int) const {}
};
__device__ __forceinline__ unsigned cvt_pk_bf16(float lo, float hi) { unsigned r; asm volatile("v_cvt_pk_bf16_f32 %0, %1, %2" : "=v"(r) : "v"(lo), "v"(hi)); return r; }
typedef float f32x2 __attribute__((ext_vector_type(2)));
struct EpiProj {
    static constexpr bool PERM = true, AFTER_DRAIN = false;
    bf16_t* O; int ldc; const float* bcum; const float* ghead;
    int pm_wt;
    __device__ __forceinline__ void operator()(const f32x4 (&acc)[2][2][4][2], const Unit& u, int wr, int wc, int fr, int fq) const {
        const int row0 = u.pm * BM + wr * 64 + fr; const int col0 = u.pn * BM + wc * 32 + 8 * fq;
        const int gk = (u.pn >= 8 && u.pn < 12) ? (u.pn < 10 ? 1 : 2) : (((u.pn >= 4 && u.pn < 8) || u.pn >= 16) ? 3 : 0);
        const float sgn = gk == 1 ? 1.f : -1.f, sc = gk == 1 ? 0.08838834764831845f : 1.f;
#pragma unroll
        for (int ai = 0; ai < 2; ++ai)
#pragma unroll
            for (int m = 0; m < 4; ++m) { const int row = row0 + ai * HALF + m * 16; bf16_t* rowp = O + (size_t)row * ldc + col0;
#pragma unroll
                for (int bj = 0; bj < 2; ++bj) { f32x4 v0 = acc[ai][bj][m][0], v1 = acc[ai][bj][m][1];
                    if (gk == 3) {
#pragma unroll
                        for (int e = 0; e < 4; ++e) { v0[e] *= __builtin_amdgcn_rcpf(1.f + __builtin_amdgcn_exp2f(-1.4426950408889634f * v0[e])); v1[e] *= __builtin_amdgcn_rcpf(1.f + __builtin_amdgcn_exp2f(-1.4426950408889634f * v1[e])); }
                        if (u.pn >= 16) { const float* gp = ghead + ((col0 + bj * HALF) & 255); v0 = v0 * *(const f32x4*)gp; v1 = v1 * *(const f32x4*)(gp + 4); } }
                    else if (gk) { typedef _Float16 h8 __attribute__((ext_vector_type(8)));
                        const h8 hb = *(const h8*)((const _Float16*)bcum + (size_t)row * 512 + (col0 + bj * HALF - (gk == 1 ? 2048 : 2560)));
                        v0[0] *= sc * __builtin_amdgcn_exp2f(sgn * (float)hb[0]); v0[1] *= sc * __builtin_amdgcn_exp2f(sgn * (float)hb[1]); v0[2] *= sc * __builtin_amdgcn_exp2f(sgn * (float)hb[2]); v0[3] *= sc * __builtin_amdgcn_exp2f(sgn * (float)hb[3]);
                        v1[0] *= sc * __builtin_amdgcn_exp2f(sgn * (float)hb[4]); v1[1] *= sc * __builtin_amdgcn_exp2f(sgn * (float)hb[5]); v1[2] *= sc * __builtin_amdgcn_exp2f(sgn * (float)hb[6]); v1[3] *= sc * __builtin_amdgcn_exp2f(sgn * (float)hb[7]); }
                    u32x4 w; w.x = cvt_pk_bf16(v0[0], v0[1]); w.y = cvt_pk_bf16(v0[2], v0[3]); w.z = cvt_pk_bf16(v1[0], v1[1]); w.w = cvt_pk_bf16(v1[2], v1[3]);
                    if (u.pm >= pm_wt) __builtin_amdgcn_raw_buffer_store_b128(w, __builtin_amdgcn_make_buffer_rsrc((void*)O, 0, 0x7fffffff, 0x00020000), (int)(((size_t)row * ldc + col0 + bj * HALF) * 2), 0, 16);
                    else *(u32x4*)(rowp + bj * HALF) = w; } }
    }
};
struct EpiY {
    static constexpr bool PERM = true, AFTER_DRAIN = false;
    bf16_t* O; int ldc; bf16_t* slabs; int row_s; size_t slab_elems;
    __device__ __forceinline__ void operator()(const f32x4 (&acc)[2][2][4][2], const Unit& u, int wr, int wc, int fr, int fq) const {
        const int row0 = u.pm * BM + wr * 64 + fr; const int col0 = u.pn * BM + wc * 32 + 8 * fq;
        bf16_t* base = u.slab >= 0 ? slabs + (size_t)u.slab * slab_elems - (size_t)row_s * ldc : O;
#pragma unroll
        for (int ai = 0; ai < 2; ++ai)
#pragma unroll
            for (int m = 0; m < 4; ++m) { const int row = row0 + ai * HALF + m * 16; bf16_t* rowp = base + (size_t)row * ldc + col0;
#pragma unroll
                for (int bj = 0; bj < 2; ++bj) { const f32x4 v0 = acc[ai][bj][m][0], v1 = acc[ai][bj][m][1];
                    u32x4 w; w.x = cvt_pk_bf16(v0[0], v0[1]); w.y = cvt_pk_bf16(v0[2], v0[3]); w.z = cvt_pk_bf16(v1[0], v1[1]); w.w = cvt_pk_bf16(v1[2], v1[3]);
                    *(u32x4*)(rowp + bj * HALF) = w; } }
    }
};
struct EpiYF {
    static constexpr bool PERM = true, AFTER_DRAIN = true;
    bf16_t* slabs; int row_s; size_t slab_elems; int ldc;
    const float* base; float* out; const float* g; float* xbuf; unsigned* cnt; float eps;
    __device__ __forceinline__ void operator()(const f32x4 (&acc)[2][2][4][2], const Unit& u, int wr, int wc, int fr, int fq) const {
        const int row0 = u.pm * BM + wr * 64 + fr; const int col0 = u.pn * BM + wc * 32 + 8 * fq;
        const __amdgpu_buffer_rsrc_t rs = __builtin_amdgcn_make_buffer_rsrc((void*)slabs, 0, 0x7fffffff, 0x00020000);
        const size_t e0 = (size_t)u.slab * slab_elems - (size_t)row_s * ldc;
#pragma unroll
        for (int ai = 0; ai < 2; ++ai)
#pragma unroll
            for (int m = 0; m < 4; ++m) { const int row = row0 + ai * HALF + m * 16;
#pragma unroll
                for (int bj = 0; bj < 2; ++bj) { const f32x4 v0 = acc[ai][bj][m][0], v1 = acc[ai][bj][m][1];
                    u32x4 w; w.x = cvt_pk_bf16(v0[0], v0[1]); w.y = cvt_pk_bf16(v0[2], v0[3]); w.z = cvt_pk_bf16(v1[0], v1[1]); w.w = cvt_pk_bf16(v1[2], v1[3]);
                    __builtin_amdgcn_raw_buffer_store_b128(w, rs, (int)((e0 + (size_t)row * ldc + col0 + bj * HALF) * 2), 0, 16); } }
    }
    __device__ __forceinline__ void fused(f32x4 (&acc)[2][2][4][2], const Unit& u, int wr, int wc, int fr, int fq, PG8_LAS unsigned char* lds, int wid, int lane) const {
        PG8_LAS float* P = (PG8_LAS float*)lds;
        PG8_LAS float* Sr = (PG8_LAS float*)(lds + 4096);
        const int col0 = u.pn * BM + wc * 32 + 8 * fq;
        const float* bp = base + (size_t)(u.pm * BM + wr * 64 + fr) * ldc + col0;
        f32x4 xv[3][2][2];
#define EYF_LOAD(slot, gi) do { _Pragma("unroll") for (int bj = 0; bj < 2; ++bj) _Pragma("unroll") for (int n = 0; n < 2; ++n) xv[slot][bj][n] = *(const f32x4*)(bp + (size_t)((((gi) >> 2) * HALF) + ((gi) & 3) * 16) * ldc + bj * HALF + 4 * n); } while (0)
        EYF_LOAD(0, 0); EYF_LOAD(1, 1); EYF_LOAD(2, 2);
#pragma unroll
        for (int ai = 0; ai < 2; ++ai)
#pragma unroll
            for (int m = 0; m < 4; ++m) { float s = 0.f;
#pragma unroll
                for (int bj = 0; bj < 2; ++bj)
#pragma unroll
                    for (int n = 0; n < 2; ++n) { const f32x4 x = acc[ai][bj][m][n]; s += (x[0] * x[0] + x[1] * x[1]) + (x[2] * x[2] + x[3] * x[3]); }
                s += __shfl_xor(s, 16); s += __shfl_xor(s, 32);
                if (fq == 0) P[(ai * HALF + wr * 64 + m * 16 + fr) * 4 + wc] = s; }
        asm volatile("s_waitcnt lgkmcnt(0)" ::: "memory"); __builtin_amdgcn_s_barrier(); asm volatile("" ::: "memory");
        const int row = wid * 32 + (lane & 31);
        if (lane < 32) { const f32x4 p = *(const PG8_LAS f32x4*)(P + row * 4);
            __hip_atomic_store(xbuf + (size_t)(u.pm * BM + row) * 4 + u.pn, (p[0] + p[1]) + (p[2] + p[3]), __ATOMIC_RELAXED, __HIP_MEMORY_SCOPE_AGENT); }
        asm volatile("s_waitcnt vmcnt(0)" ::: "memory");
        if (lane == 0) __hip_atomic_fetch_add(cnt + 64 * u.pm, 1u, __ATOMIC_RELAXED, __HIP_MEMORY_SCOPE_AGENT);
        if (wid == 0) { unsigned sp = 0;
            while ((unsigned)__builtin_amdgcn_readfirstlane(__hip_atomic_load(cnt + 64 * u.pm, __ATOMIC_RELAXED, __HIP_MEMORY_SCOPE_AGENT)) < 32u) { __builtin_amdgcn_s_sleep(2); if (++sp > (1u << 22)) break; }
            __builtin_amdgcn_fence(__ATOMIC_ACQUIRE, "agent"); }
        asm volatile("s_waitcnt vmcnt(0) lgkmcnt(0)" ::: "memory"); __builtin_amdgcn_s_barrier(); asm volatile("" ::: "memory");
        if (lane < 32) { const float* sl = xbuf + (size_t)(u.pm * BM + row) * 4; float t = 0.f;
#pragma unroll
            for (int k = 0; k < 4; ++k) t += __hip_atomic_load(sl + k, __ATOMIC_RELAXED, __HIP_MEMORY_SCOPE_AGENT);
            Sr[row] = __builtin_amdgcn_rsqf(t * (1.f / 1024.f) + eps); }
        asm volatile("s_waitcnt vmcnt(0) lgkmcnt(0)" ::: "memory"); __builtin_amdgcn_s_barrier(); asm volatile("" ::: "memory");
        f32x4 gv[2][2];
#pragma unroll
        for (int bj = 0; bj < 2; ++bj)
#pragma unroll
            for (int n = 0; n < 2; ++n) gv[bj][n] = *(const f32x4*)(g + col0 + bj * HALF + 4 * n);
        float* op = out + (size_t)(u.pm * BM + wr * 64 + fr) * ldc + col0;
#pragma unroll
        for (int gi = 0; gi < 8; ++gi) { const int ai = gi >> 2, m = gi & 3; const float rs = Sr[ai * HALF + wr * 64 + m * 16 + fr];
            float* orow = op + (size_t)(ai * HALF + m * 16) * ldc;
#pragma unroll
            for (int bj = 0; bj < 2; ++bj)
#pragma unroll
                for (int n = 0; n < 2; ++n) *(f32x4*)(orow + bj * HALF + 4 * n) = xv[gi % 3][bj][n] + acc[ai][bj][m][n] * rs * gv[bj][n];
            asm volatile("" ::: "memory");
            if (gi + 3 < 8) EYF_LOAD(gi % 3, gi + 3);
            asm volatile("" ::: "memory"); }
#undef EYF_LOAD
    }
};
struct Gemm2FOrder {
    StaticOrder so; int c, nN, pm0, KS, ntS; unsigned* cnt;
    __host__ __device__ void init(int MP, int N, int K, int KS_, int c_, unsigned* cnt_) { so.init(MP, N, 256, c_); c = c_; nN = N / BM; pm0 = MP / BM; KS = KS_; ntS = K / BK / KS_; cnt = cnt_; }
    __host__ __device__ bool next(int i, Unit& u) const {
        const bool hs = (c & 63) < 32;
        if (hs && i == 0) { const int L = (c >> 6) * 32 + (c & 63), lu = L / KS, ks = L % KS; u.pm = pm0 + lu / nN; u.pn = lu % nN; u.k0 = ks * ntS; u.nt = ntS; u.slab = ks; return true; }
        if (i == (hs ? 1 : 0)) return so.next(0, u);
        return false;
    }
    __device__ __forceinline__ void a_ready(const Unit&) const {}
    __device__ __forceinline__ void done(const Unit& u, int) const {
        if (u.slab >= 0) { asm volatile("s_waitcnt vmcnt(0)" ::: "memory");
            if ((threadIdx.x & 63) == 0) __hip_atomic_fetch_add(cnt + 64 * (c & 7), 1u, __ATOMIC_RELAXED, __HIP_MEMORY_SCOPE_AGENT); }
    }
};
struct Gemm2Order {
    StaticOrder so; int nfull, nN, pm0, KS, ntS, nsl, G, c;
    __host__ __device__ void init(int MP, int M, int N, int K, int KS_, int G_, int c_) { so.init(MP, N, G_, c_); nfull = so.nwg; nN = N / BM; pm0 = MP / BM; KS = KS_; ntS = K / BK / KS_; nsl = ((M - MP) / BM) * nN * KS_; G = G_; c = c_; }
    __host__ __device__ bool next(int i, Unit& u) const {
        const long L = (long)i * G + c;
        if (L < nfull) return so.next(i, u);
        const long Ls = L - nfull; if (Ls >= nsl) return false;
        const int lu = (int)Ls / KS, ks = (int)Ls % KS; u.pm = pm0 + lu / nN; u.pn = lu % nN; u.k0 = ks * ntS; u.nt = ntS; u.slab = ks; return true;
    }
    __device__ __forceinline__ void a_ready(const Unit&) const {}
    __device__ __forceinline__ void done(const Unit&, int) const {}
};
struct NoKScale { static constexpr bool ON = false; };
struct HeadScale {
    static constexpr bool ON = true; static constexpr int MAXU = 2;
    const float* pss; int nrowp; float eps;
    static constexpr int OFF = 131072;
    __device__ __forceinline__ void prep(PG8_LAS unsigned char* lds, const Unit& u, int par) const {
        const int r = threadIdx.x & 255; const int row = u.pm * BM + r;
        PG8_LAS float* T = (PG8_LAS float*)(lds + OFF) + par * 5 * 256;
        const __amdgpu_buffer_rsrc_t rsrc = __builtin_amdgcn_make_buffer_rsrc((void*)pss, 0, 32 * nrowp * 4, 0x00020000);
        float v[32];
        if (row < nrowp) {
#pragma unroll
            for (int i = 0; i < 32; ++i) v[i] = __builtin_bit_cast(float, __builtin_amdgcn_raw_buffer_load_b32(rsrc, row * 4, i * nrowp * 4, 0));
        }
        float prev = 1.f;
#pragma unroll
        for (int h = 0; h < 4; ++h) { float rs = 1.f;
            if (row < nrowp) { const float tot = ((v[8 * h] + v[8 * h + 1]) + (v[8 * h + 2] + v[8 * h + 3])) + ((v[8 * h + 4] + v[8 * h + 5]) + (v[8 * h + 6] + v[8 * h + 7]));
                rs = __builtin_amdgcn_rsqf(tot * (1.f / 256.f) + eps); }
            T[h * 256 + r] = prev * __builtin_amdgcn_rcpf(rs); prev = rs; }
        T[4 * 256 + r] = prev;
    }
    __device__ __forceinline__ void scale(f32x4 (&acc)[2][2][4][2], PG8_LAS unsigned char* lds, int par, int idx, int wr, int fr) const {
        const unsigned a = (unsigned)(size_t)(lds + OFF) + (unsigned)(((par * 5 + idx) * 256 + wr * 64 + fr) * 4);
        float f0, f1, f2, f3, f4, f5, f6, f7;
        asm volatile("ds_read_b32 %0, %8\n\tds_read_b32 %1, %8 offset:64\n\tds_read_b32 %2, %8 offset:128\n\tds_read_b32 %3, %8 offset:192\n\t"
                     "ds_read_b32 %4, %8 offset:512\n\tds_read_b32 %5, %8 offset:576\n\tds_read_b32 %6, %8 offset:640\n\tds_read_b32 %7, %8 offset:704\n\ts_waitcnt lgkmcnt(0)"
                     : "=&v"(f0), "=&v"(f1), "=&v"(f2), "=&v"(f3), "=&v"(f4), "=&v"(f5), "=&v"(f6), "=&v"(f7) : "v"(a) : "memory");
        const float f[2][4] = {{f0, f1, f2, f3}, {f4, f5, f6, f7}};
#pragma unroll
        for (int ai = 0; ai < 2; ++ai)
#pragma unroll
            for (int m = 0; m < 4; ++m)
#pragma unroll
                for (int bj = 0; bj < 2; ++bj)
#pragma unroll
                    for (int n = 0; n < 2; ++n) acc[ai][bj][m][n] = acc[ai][bj][m][n] * f[ai][m];
    }
};

struct Gemm1Order {
    StaticOrder so; int nS, nN, pmS, G, c; unsigned* cnt;
    __host__ __device__ void init(int MP, int M, int N, int G_, int c_, unsigned* cnt_) { so.init(MP, N, G_, 0); nN = N / BM; pmS = MP / BM; nS = ((M - MP) / BM) * nN; G = G_; c = c_; cnt = cnt_; }
    __host__ __device__ bool next(int i, Unit& u) const {
        const long L = (long)i * G + c;
        if (L < nS) { u.pm = pmS + (int)L / nN; u.pn = (int)L % nN; u.k0 = 0; u.nt = 0; u.slab = -1; return true; }
        const long Lp = L - nS; if (Lp >= so.nwg) return false;
        StaticOrder t = so; t.G = 1; t.c = 0; return t.next((int)Lp, u);
    }
    __device__ __forceinline__ void a_ready(const Unit&) const {}
    __device__ __forceinline__ void done(const Unit& u, int) const {
        if (u.pm >= pmS) {
            asm volatile("s_waitcnt vmcnt(0)" ::: "memory");
            if ((threadIdx.x & 63) == 0) __hip_atomic_fetch_add(cnt, 1u, __ATOMIC_RELAXED, __HIP_MEMORY_SCOPE_AGENT);
        }
    }
};

struct OneUnitOrder {
    int pm, pn, have; unsigned* cnt;
    __host__ __device__ bool next(int i, Unit& u) const { if (i > 0 || !have) return false; u.pm = pm; u.pn = pn; u.k0 = 0; u.nt = 0; u.slab = -1; return true; }
    __device__ __forceinline__ void a_ready(const Unit&) const {}
    __device__ __forceinline__ void done(const Unit&, int) const {
        asm volatile("s_waitcnt vmcnt(0)" ::: "memory");
        if ((threadIdx.x & 63) == 0) __hip_atomic_fetch_add(cnt, 1u, __ATOMIC_RELAXED, __HIP_MEMORY_SCOPE_AGENT);
    }
};

template <class Epi, class Sched, bool ALIGN_EPI = false, bool SP2 = false, class KS = NoKScale>
__device__ __forceinline__ void gemm_phase(PG8_LAS unsigned char* lds, const Gemm g, const Sched& S, const Epi& E, const KS ksc = KS()) {
    int tid_ = threadIdx.x; asm volatile("" : "+v"(tid_));
    const int tid = tid_, wid = __builtin_amdgcn_readfirstlane(tid >> 6), lane = tid & 63, wr = wid >> 2, wc = wid & 3, fr = lane & 15, fq = lane >> 4;
    const int K = g.K, ntK = K / BK;
    unsigned voffA[2], voffB[2];
#pragma unroll
    for (int i = 0; i < 2; ++i) { int R, C; stage_rc(tid * 16 + i * 8192, R, C); const int Rb = Epi::PERM ? ((R & ~31) + perm32(R & 31)) : R;
        voffA[i] = (unsigned)(R * K + C) * 2u; voffB[i] = (unsigned)(Rb * K + C) * 2u; }
    const size_t kstep = (size_t)(BK * 2);
    const size_t hstep = (size_t)HALF * K * 2;
    const size_t tstep = 2 * hstep;
    const unsigned ldsw = (unsigned)wid * 1024u;
    const int aoff = lds_byte(wr * 64 + fr, fq * 8), boff = lds_byte(wc * 32 + fr, fq * 8);
#define PG8_SA(b, h) (((b) * 2 + (h)) * HTB)
#define PG8_SB(b, h) ((4 + (b) * 2 + (h)) * HTB)
#define PG8_STAGE(bufoff, gbase, voff) do { _Pragma("unroll") for (int _i = 0; _i < 2; ++_i) \
        __builtin_amdgcn_global_load_lds((const unsigned*)((const char*)(gbase) + (voff)[_i]), (PG8_LAS unsigned*)(lds + (bufoff) + ldsw + _i * 8192), 16, 0, 0); } while (0)
#define PG8_LDA(dst, b, h) do { _Pragma("unroll") for (int m = 0; m < 4; ++m) _Pragma("unroll") for (int k = 0; k < 2; ++k) dst[m][k] = *(const PG8_LAS bf16x8*)(lds + PG8_SA(b, h) + aoff + m * 2048 + k * 1024); } while (0)
#define PG8_LDB(dst, b, h) do { _Pragma("unroll") for (int n = 0; n < 2; ++n) _Pragma("unroll") for (int k = 0; k < 2; ++k) dst[n][k] = *(const PG8_LAS bf16x8*)(lds + PG8_SB(b, h) + boff + n * 2048 + k * 1024); } while (0)
#define PG8_MMA(ai, bj, At, Bt) do { __builtin_amdgcn_s_setprio(1); _Pragma("unroll") for (int m = 0; m < 4; ++m) _Pragma("unroll") for (int n = 0; n < 2; ++n) _Pragma("unroll") for (int k = 0; k < 2; ++k) \
        acc[ai][bj][m][n] = __builtin_amdgcn_mfma_f32_16x16x32_bf16(Bt[n][k], At[m][k], acc[ai][bj][m][n], 0, 0, 0); __builtin_amdgcn_s_setprio(0); } while (0)
#define PG8_WAIT_V(n) asm volatile("s_waitcnt vmcnt(" #n ")" ::: "memory")
#define PG8_WAIT_L(n) asm volatile("s_waitcnt lgkmcnt(" #n ")" ::: "memory")
#define PG8_BAR __builtin_amdgcn_s_barrier()
#define PG8_SCHED __builtin_amdgcn_sched_barrier(0)
    Unit cur, nxt; int ui = 0;
    if (!S.next(0, cur)) return;
    f32x4 acc[2][2][4][2];
#pragma unroll
    for (int a = 0; a < 2; ++a)
#pragma unroll
        for (int b = 0; b < 2; ++b)
#pragma unroll
            for (int m = 0; m < 4; ++m)
#pragma unroll
                for (int n = 0; n < 2; ++n) acc[a][b][m][n] = (f32x4){0.f, 0.f, 0.f, 0.f};
    bf16x8 At[4][2], B0[2][2], B1[2][2];
    const char* cA = (const char*)g.A + (size_t)cur.pm * tstep + (size_t)cur.k0 * (BK * 2); const char* cB = (const char*)g.Bt + (size_t)cur.pn * tstep + (size_t)cur.k0 * (BK * 2);
    S.a_ready(cur);
    if constexpr (KS::ON) { Unit pu; for (int i = 0; i < KS::MAXU && S.next(i, pu); ++i) ksc.prep(lds, pu, i); }
    if constexpr (SP2) {
        PG8_STAGE(PG8_SB(0, 0), cB, voffB); PG8_STAGE(PG8_SB(0, 1), cB + hstep, voffB); PG8_STAGE(PG8_SA(0, 0), cA, voffA); PG8_STAGE(PG8_SA(0, 1), cA + hstep, voffA);
        if (wr == 1) PG8_BAR;
        PG8_WAIT_V(2); PG8_BAR;
        PG8_STAGE(PG8_SB(1, 0), cB + kstep, voffB); PG8_STAGE(PG8_SA(1, 0), cA + kstep, voffA); PG8_STAGE(PG8_SB(1, 1), cB + hstep + kstep, voffB);
        PG8_WAIT_V(6); PG8_BAR;
    } else {
        PG8_STAGE(PG8_SB(0, 0), cB, voffB); PG8_STAGE(PG8_SA(0, 0), cA, voffA); PG8_STAGE(PG8_SB(0, 1), cB + hstep, voffB); PG8_STAGE(PG8_SA(0, 1), cA + hstep, voffA);
        if (wr == 1) PG8_BAR;
        PG8_WAIT_V(4); PG8_BAR;
        PG8_STAGE(PG8_SB(1, 0), cB + kstep, voffB); PG8_STAGE(PG8_SA(1, 0), cA + kstep, voffA); PG8_STAGE(PG8_SB(1, 1), cB + hstep + kstep, voffB);
        PG8_WAIT_V(6); PG8_BAR;
    }
    for (;;) {
        const bool has_next = S.next(ui + 1, nxt);
        const char* nA = has_next ? (const char*)g.A + (size_t)nxt.pm * tstep + (size_t)nxt.k0 * (BK * 2) : cA; const char* nB = has_next ? (const char*)g.Bt + (size_t)nxt.pn * tstep + (size_t)nxt.k0 * (BK * 2) : cB;
        const int nt = cur.nt ? cur.nt : ntK;
        for (int t = 0; t < nt; t += 2) {
            const bool last = (t == nt - 2);
            const char* a1 = cA + (size_t)(t + 1) * kstep;
            const char* a2 = last ? nA : cA + (size_t)(t + 2) * kstep; const char* b2 = last ? nB : cB + (size_t)(t + 2) * kstep;
            const char* a3 = a2 + kstep; const char* b3 = b2 + kstep;
            if (last && has_next) S.a_ready(nxt);
            if constexpr (KS::ON) { if (t >= 16 && (t & 3) == 0) ksc.scale(acc, lds, ui & 1, (t - 16) >> 2, wr, fr); }
            if constexpr (SP2) {
            PG8_LDB(B0, 0, 0); PG8_LDB(B1, 0, 1); PG8_SCHED; PG8_LDA(At, 0, 0); PG8_STAGE(PG8_SA(1, 1), a1 + hstep, voffA);
            PG8_WAIT_V(8); PG8_WAIT_L(0); PG8_BAR; PG8_MMA(0, 0, At, B0); PG8_MMA(0, 1, At, B1); PG8_BAR; PG8_SCHED;
            PG8_LDA(At, 0, 1); PG8_STAGE(PG8_SB(0, 0), b2, voffB); PG8_STAGE(PG8_SB(0, 1), b2 + hstep, voffB); PG8_STAGE(PG8_SA(0, 0), a2, voffA);
            PG8_WAIT_V(8); PG8_WAIT_L(0); PG8_BAR; PG8_MMA(1, 0, At, B0); PG8_MMA(1, 1, At, B1); PG8_BAR; PG8_SCHED;
            PG8_LDB(B0, 1, 0); PG8_LDB(B1, 1, 1); PG8_SCHED; PG8_LDA(At, 1, 0); PG8_STAGE(PG8_SA(0, 1), a2 + hstep, voffA);
            PG8_WAIT_V(8); PG8_WAIT_L(0); PG8_BAR; PG8_MMA(0, 0, At, B0); PG8_MMA(0, 1, At, B1); PG8_BAR; PG8_SCHED;
            PG8_LDA(At, 1, 1); PG8_STAGE(PG8_SB(1, 0), b3, voffB); PG8_STAGE(PG8_SB(1, 1), b3 + hstep, voffB); PG8_STAGE(PG8_SA(1, 0), a3, voffA);
            PG8_WAIT_V(8); PG8_WAIT_L(0); PG8_BAR; PG8_MMA(1, 0, At, B0); PG8_MMA(1, 1, At, B1); PG8_BAR; PG8_SCHED;
            } else {
            PG8_LDB(B0, 0, 0); PG8_SCHED; PG8_LDA(At, 0, 0); PG8_STAGE(PG8_SA(1, 1), a1 + hstep, voffA);
            PG8_WAIT_L(8); PG8_BAR; PG8_WAIT_L(0); PG8_MMA(0, 0, At, B0); PG8_BAR; PG8_SCHED;
            PG8_LDB(B1, 0, 1); PG8_STAGE(PG8_SB(0, 0), b2, voffB);
            PG8_BAR; PG8_WAIT_L(0); PG8_MMA(0, 1, At, B1); PG8_BAR;
            PG8_LDA(At, 0, 1); PG8_STAGE(PG8_SA(0, 0), a2, voffA);
            PG8_BAR; PG8_WAIT_L(0); PG8_MMA(1, 0, At, B0); PG8_BAR; PG8_SCHED;
            PG8_STAGE(PG8_SB(0, 1), b2 + hstep, voffB);
            PG8_WAIT_V(6); PG8_BAR; PG8_MMA(1, 1, At, B1); PG8_BAR;
            PG8_LDB(B0, 1, 0); PG8_SCHED; PG8_LDA(At, 1, 0); PG8_STAGE(PG8_SA(0, 1), a2 + hstep, voffA);
            PG8_WAIT_L(8); PG8_BAR; PG8_WAIT_L(0); PG8_MMA(0, 0, At, B0); PG8_BAR; PG8_SCHED;
            PG8_LDB(B1, 1, 1); PG8_STAGE(PG8_SB(1, 0), b3, voffB);
            PG8_BAR; PG8_WAIT_L(0); PG8_MMA(0, 1, At, B1); PG8_BAR;
            PG8_LDA(At, 1, 1); PG8_STAGE(PG8_SA(1, 0), a3, voffA);
            PG8_BAR; PG8_WAIT_L(0); PG8_MMA(1, 0, At, B0); PG8_BAR; PG8_SCHED;
            PG8_STAGE(PG8_SB(1, 1), b3 + hstep, voffB);
            PG8_WAIT_V(6); PG8_BAR; PG8_MMA(1, 1, At, B1); PG8_BAR;
            }
        }
        if constexpr (KS::ON) ksc.scale(acc, lds, ui & 1, 4, wr, fr);
        if constexpr (ALIGN_EPI) { if (wr == 0) PG8_BAR; }
        if constexpr (!Epi::AFTER_DRAIN) { E(acc, cur, wr, wc, fr, fq); S.done(cur, ui); }
        else { if (has_next) { E(acc, cur, wr, wc, fr, fq); S.done(cur, ui); } }
        if (!has_next) break;
#pragma unroll
        for (int a = 0; a < 2; ++a)
#pragma unroll
            for (int b = 0; b < 2; ++b)
#pragma unroll
                for (int m = 0; m < 4; ++m)
#pragma unroll
                    for (int n = 0; n < 2; ++n) acc[a][b][m][n] = (f32x4){0.f, 0.f, 0.f, 0.f};
        cur = nxt; cA = nA; cB = nB; ++ui;
        if constexpr (ALIGN_EPI) { if (wr == 1) PG8_BAR; }
    }
    PG8_WAIT_V(0);
    if constexpr (!ALIGN_EPI) { if (wr == 0) PG8_BAR; }
    PG8_BAR;
    if constexpr (Epi::AFTER_DRAIN) { E.fused(acc, cur, wr, wc, fr, fq, lds, wid, lane); S.done(cur, ui); }
#undef PG8_SA
#undef PG8_SB
#undef PG8_STAGE
#undef PG8_LDA
#undef PG8_LDB
#undef PG8_MMA
#undef PG8_WAIT_V
#undef PG8_WAIT_L
#undef PG8_BAR
#undef PG8_SCHED
}
}

#ifndef MK_N_LAUNCHES
#define MK_N_LAUNCHES 1
#endif
constexpr int N_PHASES = 5, N_LAUNCHES = MK_N_LAUNCHES;
constexpr int NWAVES = 8;
constexpr int D = 1024, NP = 8, TP = 2048, NS = 128, TS = 8, NROWP = NP * TP, NROWS = NS * TS, NTOK = NROWP + NROWS;
constexpr int DIN = 5136, DINP = 5120, DMIX = 2048, HK = 128, HV = 256, NH = 4;
constexpr int C_XL = 0, C_ZL = 1024, C_Q = 2048, C_K = 2560, C_V = 3072, C_ZG = 4096;
constexpr float EPS = 1e-6f;
constexpr size_t O_YP = 0, O_YS = 16777216, O_HP = 17825792, O_CP = 17833984, O_GP = 17858560, O_HS = 18907136, O_CS = 19038208, O_GS = 19431424, O_END = 36208640;
constexpr size_t MiB = 1u << 20;
constexpr size_t WS_CTL = 0, CTL_ZERO_BYTES = 64 * 1024;
constexpr size_t WS_WINT = 2 * MiB, WS_WOUT = 12 * MiB, WS_RGK = 16 * MiB, WS_PART = 18 * MiB, WS_DEC = 19 * MiB + 256 * 1024, WS_XN = 20 * MiB, WS_PROJ = 54 * MiB, WS_YS = 224 * MiB, WS_END = 240 * MiB;
static_assert(WS_DEC + (size_t)(NP * (TP / 64) + NS) * 512 * 4 <= WS_XN && WS_PART + (size_t)16 * NTOK * 4 <= WS_DEC, "d_ws map (DEC)");
static_assert(WS_WINT + (size_t)DINP * D * 2 <= WS_WOUT && WS_WOUT + (size_t)D * DMIX * 2 <= WS_RGK && WS_RGK + (size_t)NTOK * 16 * 4 <= WS_PART && WS_PART + (size_t)16 * NTOK * 4 <= WS_XN &&
              WS_XN + (size_t)NTOK * D * 2 <= WS_PROJ && WS_PROJ + (size_t)NTOK * DINP * 2 <= WS_YS && WS_YS + (size_t)8 * NROWS * D * 2 <= WS_END, "d_ws map");
constexpr int CW_BAR = 4096, CW_SAMPLE = 8192, CW_DIAG = 12288;
#ifndef LATE_SAMPLE
#define LATE_SAMPLE 0
#endif
constexpr int CHAIN_NS = LATE_SAMPLE ? 0 : 80;
#ifndef FUSE_P4
#define FUSE_P4 1
#endif
constexpr int CW_ROWS = 0;
constexpr size_t WS_XBUF = WS_PART + 65536;
static_assert(WS_XBUF + (size_t)NROWP * 4 * 4 <= WS_DEC, "d_ws map (XBUF)");
static_assert((CW_DIAG + 64) * 4 <= (int)CTL_ZERO_BYTES, "control words inside the zeroed region");
constexpr int RING_OFF = 0, RING_BYTES = 162816, LDSCTL_OFF = RING_BYTES, MISC_OFF = LDSCTL_OFF + 320, LDS_BYTES = 163840;

#define GAS __attribute__((address_space(1)))
#define LAS __attribute__((address_space(3)))
typedef unsigned short bf16;
typedef unsigned v4u __attribute__((ext_vector_type(4)));
typedef unsigned v2u __attribute__((ext_vector_type(2)));
typedef float f32x4 __attribute__((ext_vector_type(4)));
typedef GAS unsigned gu32;
#define RLX_AGENT __ATOMIC_RELAXED, __HIP_MEMORY_SCOPE_AGENT
#define LDS_WAIT() asm volatile("s_waitcnt lgkmcnt(0)" ::: "memory")
#define VM_WAIT() asm volatile("s_waitcnt vmcnt(0)" ::: "memory")
__device__ __forceinline__ unsigned f2bf(float f) { unsigned u = __builtin_bit_cast(unsigned, f); return (u + 0x7fffu + ((u >> 16) & 1u)) >> 16; }
__device__ __forceinline__ unsigned pk2(float lo, float hi) { return f2bf(lo) | (f2bf(hi) << 16); }
__device__ __forceinline__ float bf2f(unsigned b) { return __builtin_bit_cast(float, b << 16); }
__device__ __forceinline__ float bflo(unsigned w) { return __builtin_bit_cast(float, w << 16); }
__device__ __forceinline__ float bfhi(unsigned w) { return __builtin_bit_cast(float, w & 0xffff0000u); }
__device__ __forceinline__ float sigmoidf_(float x) { return 1.f / (1.f + __expf(-x)); }
__device__ __forceinline__ float logsigf_(float x) { return fminf(x, 0.f) - log1pf(__expf(-fabsf(x))); }
#define XB_TMO      128
#define XB_XCNT(j)  (256  + 64 * (j))
#define XB_XSUB(j)  (1280 + 64 * (j))
#define XB_XGEN(j)  (2304 + 64 * (j))
#define XB_TOP      3328
#define XB_TOPGEN   3392
#define XCD_BAR_WORDS 3456
#define XB_SPIN_CAP (1u << 18)

__device__ __forceinline__ unsigned xb_ld(unsigned* p)              { return __hip_atomic_load(p, __ATOMIC_RELAXED, __HIP_MEMORY_SCOPE_AGENT); }
__device__ __forceinline__ unsigned xb_add(unsigned* p, unsigned v) { return __hip_atomic_fetch_add(p, v, __ATOMIC_RELAXED, __HIP_MEMORY_SCOPE_AGENT); }
__device__ __forceinline__ unsigned xb_xcc_id() { return (unsigned)__builtin_amdgcn_s_getreg((3 << 11) | 20) & 0xFu; }
#define XB_SPIN(cond, bar) do { unsigned _sp = 0; while (cond) { __builtin_amdgcn_s_sleep(1); \
    if ((++_sp & 255u) == 0u) { if (xb_ld(&(bar)[XB_TMO])) break; if (_sp > XB_SPIN_CAP) { atomicAdd(&(bar)[XB_TMO], 1u); break; } } } } while (0)

struct XcdBarrier {
    unsigned* bar; unsigned x;
    volatile LAS unsigned* st;
};

__device__ __forceinline__ XcdBarrier xcd_barrier_post(unsigned* bar, volatile LAS unsigned* st) {
    XcdBarrier b; b.bar = bar; b.x = xb_xcc_id(); b.st = st;
    if (threadIdx.x == 0) (void)xb_add(&bar[XB_XCNT(b.x)], 1u);
    return b;
}
__device__ __forceinline__ void xcd_barrier_complete(unsigned* bar, unsigned x, unsigned& nloc, unsigned& nx) {
    const unsigned G = gridDim.x * gridDim.y * gridDim.z;
    unsigned sum, cnt, mine, sp = 0u;
    for (;;) {
        sum = 0u; cnt = 0u; mine = 0u;
#pragma unroll
        for (unsigned j = 0; j < 16; ++j) { const unsigned c = xb_ld(&bar[XB_XCNT(j)]); sum += c; cnt += (c > 0u) ? 1u : 0u; mine = (j == x) ? c : mine; }
        if (sum == G) break;
        __builtin_amdgcn_s_sleep(1);
        if ((++sp & 255u) == 0u) { if (xb_ld(&bar[XB_TMO])) break; if (sp > XB_SPIN_CAP) { atomicAdd(&bar[XB_TMO], 1u); break; } }
    }
    nloc = mine > 0u ? mine : 1u; nx = cnt > 0u ? cnt : 1u;
}

__device__ __forceinline__ void xcd_barrier(const XcdBarrier& b) {
    asm volatile("s_waitcnt vmcnt(0)" ::: "memory");
    __syncthreads();
    if (threadIdx.x == 0) {
        unsigned* bar = b.bar;
        __builtin_amdgcn_s_waitcnt(0);
        unsigned nloc = b.st[0], nx = b.st[1];
        if (nloc == 0u) { xcd_barrier_complete(bar, b.x, nloc, nx); b.st[0] = nloc; b.st[1] = nx; }
        const unsigned old = xb_add(&bar[XB_XSUB(b.x)], 1u);
        const unsigned gen = old / nloc;
        if (old + 1u == (gen + 1u) * nloc) {
            __builtin_amdgcn_fence(__ATOMIC_RELEASE, "agent");
            asm volatile("s_waitcnt vmcnt(0)" ::: "memory");
            const unsigned og = xb_add(&bar[XB_TOP], 1u);
            const unsigned tg = og / nx;
            if (og + 1u == (tg + 1u) * nx) xb_add(&bar[XB_TOPGEN], 1u);
            else XB_SPIN(xb_ld(&bar[XB_TOPGEN]) == tg, bar);
            __builtin_amdgcn_fence(__ATOMIC_ACQUIRE, "agent");
            xb_add(&bar[XB_XGEN(b.x)], 1u);
            asm volatile("s_waitcnt vmcnt(0)" ::: "memory");
        } else {
            XB_SPIN(xb_ld(&bar[XB_XGEN(b.x)]) == gen, bar);
            __builtin_amdgcn_fence(__ATOMIC_ACQUIRE, "agent");
            asm volatile("s_waitcnt vmcnt(0)" ::: "memory");
        }
    }
    __syncthreads();
}

#define CB_A(j)      (16 * (j))
#define CB_N(j)      (256 + 16 * (j))
#define CB_GEN(j)    (512 + 16 * (j))
#define CB_TOP       768
#define CB_TOPGEN    784
#define CB_CENSUS(j) (800 + 16 * (j))
constexpr int CW_CHAINBAR = CW_SAMPLE + 2688;
static_assert(CW_CHAINBAR + 1056 <= CW_DIAG, "control words (chain barrier)");
__device__ __forceinline__ bool cb_role(const XcdBarrier& b, unsigned* w, bool sixth, unsigned& nA, unsigned& nN) {
    const unsigned nloc = b.st[0]; unsigned a = xb_ld(&w[CB_CENSUS(b.x)]); if (a >= nloc) a = 0u;
    nA = a; nN = nloc - a; return sixth && a > 0u;
}
__device__ __forceinline__ void cb_npath(const XcdBarrier& b, unsigned* w, unsigned nA, unsigned nN) {
    const unsigned old = xb_add(&w[CB_N(b.x)], 1u);
    if (old + 1u == nN) {
        XB_SPIN(xb_ld(&w[CB_A(b.x)]) < nA, b.bar);
        __builtin_amdgcn_fence(__ATOMIC_RELEASE, "agent");
        asm volatile("s_waitcnt vmcnt(0)" ::: "memory");
        const unsigned og = xb_add(&w[CB_TOP], 1u);
        if (og + 1u == b.st[1]) xb_add(&w[CB_TOPGEN], 1u);
        else XB_SPIN(xb_ld(&w[CB_TOPGEN]) == 0u, b.bar);
        __builtin_amdgcn_fence(__ATOMIC_ACQUIRE, "agent");
        xb_add(&w[CB_GEN(b.x)], 1u);
        asm volatile("s_waitcnt vmcnt(0)" ::: "memory");
    } else {
        XB_SPIN(xb_ld(&w[CB_GEN(b.x)]) == 0u, b.bar);
        __builtin_amdgcn_fence(__ATOMIC_ACQUIRE, "agent");
        asm volatile("s_waitcnt vmcnt(0)" ::: "memory");
    }
}
__device__ __forceinline__ void cb_arrive(const XcdBarrier& b, unsigned* w) {
    asm volatile("s_waitcnt vmcnt(0)" ::: "memory");
    __syncthreads();
    if (threadIdx.x == 0) { unsigned nA, nN; if (cb_role(b, w, true, nA, nN)) xb_add(&w[CB_A(b.x)], 1u); else cb_npath(b, w, nA, nN); }
}
__device__ __forceinline__ void cb_wait(const XcdBarrier& b, unsigned* w) {
    if (threadIdx.x == 0) { unsigned nA, nN; if (cb_role(b, w, true, nA, nN)) { XB_SPIN(xb_ld(&w[CB_GEN(b.x)]) == 0u, b.bar); __builtin_amdgcn_fence(__ATOMIC_ACQUIRE, "agent"); asm volatile("s_waitcnt vmcnt(0)" ::: "memory"); } }
    __syncthreads();
}
__device__ __forceinline__ void cb_full(const XcdBarrier& b, unsigned* w) {
    asm volatile("s_waitcnt vmcnt(0)" ::: "memory");
    __syncthreads();
    if (threadIdx.x == 0) { unsigned nA, nN; (void)cb_role(b, w, false, nA, nN); cb_npath(b, w, nA, nN); }
    __syncthreads();
}
namespace pg8 {
struct Gemm1Chain {
    StaticOrder so; int c; unsigned* cntS; const XcdBarrier* bar; unsigned* cb;
    __host__ __device__ void init(int MP, int N, int c_, unsigned* s, const XcdBarrier* b, unsigned* cb_) { so.init(MP, N, 256, c_); c = c_; cntS = s; bar = b; cb = cb_; }
    __host__ __device__ bool next(int i, Unit& u) const {
        if (i < 5) return so.next(i, u);
        if (i == 5 && c < CHAIN_NS) { u.pm = so.nM + c / so.nN; u.pn = c % so.nN; u.k0 = 0; u.nt = 0; u.slab = -1; return true; }
        return false;
    }
    __device__ __forceinline__ void a_ready(const Unit&) const {}
    __device__ __forceinline__ void done(const Unit&, int ui) const { if (ui == 4 && c < CHAIN_NS) cb_arrive(*bar, cb); }
    __device__ __forceinline__ void chain_end() const {
        if (c < CHAIN_NS) { if (threadIdx.x == 0) __hip_atomic_fetch_add(cntS + 64 * (c & 7), 8u, __ATOMIC_RELAXED, __HIP_MEMORY_SCOPE_AGENT); cb_wait(*bar, cb); }
        else cb_full(*bar, cb);
    }
};
struct OneUnit {
    int pm, pn, k0, nt, slab;
    __host__ __device__ bool next(int i, Unit& u) const { if (i > 0) return false; u.pm = pm; u.pn = pn; u.k0 = k0; u.nt = nt; u.slab = slab; return true; }
    __device__ __forceinline__ void a_ready(const Unit&) const {}
    __device__ __forceinline__ void done(const Unit&, int) const {}
};
}
#ifndef DUP_PHASE
#define DUP_PHASE -1
#endif
#ifdef DIAG_ID
#ifndef DIAG_ID0
#define DIAG_ID0 -1
#endif
#define PSTAMP(id) do { if (DIAG_ID == (id) || DIAG_ID0 == (id)) { __syncthreads(); if (F.tid == 0) { unsigned long long q_ = (unsigned long long)(size_t)F.ctl; asm volatile("" : "+s"(q_)); \
    __hip_atomic_fetch_max((unsigned long long*)(q_ + CW_DIAG * 4) + (DIAG_ID == (id) ? 1 : 2), (unsigned long long)__builtin_amdgcn_s_memrealtime(), __ATOMIC_RELAXED, __HIP_MEMORY_SCOPE_AGENT); } } } while (0)
#else
#define PSTAMP(id) do {} while (0)
#endif

struct Frame {
    LAS unsigned char* lds;
    volatile LAS unsigned* MISC;
    gu32* ctl;
    int tid, lane, wave, vcu, G;
    const float *xp, *xs, *st_h, *st_conv, *st_gla, *g_pre, *w_in, *conv_w, *conv_b, *w_rg, *b_rg, *w_ig, *b_ig, *lam, *w_gk2, *b_gk, *g_head, *w_out, *g_post;
    float* out;
    bf16 *WinT, *WoutT, *XN, *PROJ, *YMIX, *YBF, *YS;
    float *RGK, *PART, *BCUM, *DEC, *PSS, *C8;
};
__device__ __forceinline__ float wave_sum(float v) {
#pragma unroll
    for (int o = 1; o < 64; o <<= 1) v += __shfl_xor(v, o);
    return v;
}

struct TxItem { const float* W; bf16* WT; int ldw, K, k0, n0; };
__device__ __forceinline__ TxItem p0_tx_item(const Frame& F, int it) {
    constexpr int I_IN = (D / 64) * (DINP / 32);
    TxItem t; const bool in = it < I_IN; const int item = in ? it : it - I_IN, nblk = in ? DINP / 32 : D / 32;
    t.W = in ? F.w_in : F.w_out; t.WT = in ? F.WinT : F.WoutT; t.ldw = in ? DIN : D; t.K = in ? D : DMIX; t.k0 = 64 * (item / nblk); t.n0 = 32 * (item % nblk); return t;
}
__device__ __forceinline__ void p0_tx_load(const TxItem& t, int lane, f32x4 (&wv)[8]) {
#pragma unroll
    for (int i = 0; i < 8; ++i) wv[i] = *(const GAS f32x4*)(t.W + (size_t)(t.k0 + 8 * i + (lane >> 3)) * t.ldw + t.n0 + 4 * (lane & 7));
}
__device__ __forceinline__ void p0_tx_finish(const TxItem& t, LAS float* scr, int lane, const f32x4 (&wv)[8]) {
#pragma unroll
    for (int i = 0; i < 8; ++i) { LAS float* d = scr + (8 * i + (lane >> 3)) * 33 + 4 * (lane & 7); d[0] = wv[i].x; d[1] = wv[i].y; d[2] = wv[i].z; d[3] = wv[i].w; }
    LDS_WAIT(); asm volatile("" ::: "memory");
    const int c = lane & 7;
#pragma unroll
    for (int j = 0; j < 4; ++j) { const int n = (lane >> 3) + 8 * j; const LAS float* s = scr + (8 * c) * 33 + n;
        v4u o; o.x = pk2(s[0 * 33], s[1 * 33]); o.y = pk2(s[2 * 33], s[3 * 33]); o.z = pk2(s[4 * 33], s[5 * 33]); o.w = pk2(s[6 * 33], s[7 * 33]);
        *(GAS v4u*)(t.WT + (size_t)(t.n0 + n) * t.K + t.k0 + 8 * c) = o; }
    LDS_WAIT(); asm volatile("" ::: "memory");
}
struct RowX { f32x4 v[4]; };
__device__ __forceinline__ RowX p0_load_row(const Frame& F, int r) {
    const float* xrow = r < NROWP ? F.xp + (size_t)r * D : F.xs + (size_t)(r - NROWP) * D;
    const GAS f32x4* xr = (const GAS f32x4*)xrow + F.lane; RowX x;
#pragma unroll
    for (int j = 0; j < 4; ++j) x.v[j] = xr[64 * j];
    return x;
}
__device__ __forceinline__ float p0_treduce16(const float (&p)[16], int lane) {
    const bool b5 = lane & 32, b4 = lane & 16, b3 = lane & 8, b2 = lane & 4;
    float q8[8], q4[4], q2[2], q1;
#pragma unroll
    for (int i = 0; i < 8; ++i) { const float send = b5 ? p[i] : p[i + 8], keep = b5 ? p[i + 8] : p[i]; q8[i] = keep + __shfl_xor(send, 32); }
#pragma unroll
    for (int i = 0; i < 4; ++i) { const float send = b4 ? q8[i] : q8[i + 4], keep = b4 ? q8[i + 4] : q8[i]; q4[i] = keep + __shfl_xor(send, 16); }
#pragma unroll
    for (int i = 0; i < 2; ++i) { const float send = b3 ? q4[i] : q4[i + 2], keep = b3 ? q4[i + 2] : q4[i]; q2[i] = keep + __shfl_xor(send, 8); }
    { const float send = b2 ? q2[0] : q2[1], keep = b2 ? q2[1] : q2[0]; q1 = keep + __shfl_xor(send, 4); }
    q1 += __shfl_xor(q1, 2); q1 += __shfl_xor(q1, 1);
    return q1;
}
constexpr int P0_WRB = 0, P0_XT = 33280, P0_PART = 66560, P0_RGL = 74752, P0_ROWB = 2064;
__device__ __forceinline__ void p0_rows2(const Frame& F, int rA, int rB, RowX xa, RowX xb, LAS unsigned char* xt, int sA, int sB) {
    const GAS f32x4* gp = (const GAS f32x4*)F.g_pre + F.lane;
    float sa = 0.f, sb = 0.f;
#pragma unroll
    for (int j = 0; j < 4; ++j) { sa += (xa.v[j].x * xa.v[j].x + xa.v[j].y * xa.v[j].y) + (xa.v[j].z * xa.v[j].z + xa.v[j].w * xa.v[j].w); sb += (xb.v[j].x * xb.v[j].x + xb.v[j].y * xb.v[j].y) + (xb.v[j].z * xb.v[j].z + xb.v[j].w * xb.v[j].w); }
#pragma unroll
    for (int o = 1; o < 64; o <<= 1) { sa += __shfl_xor(sa, o); sb += __shfl_xor(sb, o); }
    const float ra = rsqrtf(sa * (1.f / D) + EPS), rb = rsqrtf(sb * (1.f / D) + EPS);
    GAS v2u* oa = (GAS v2u*)(F.XN + (size_t)rA * D) + F.lane; GAS v2u* ob = (GAS v2u*)(F.XN + (size_t)rB * D) + F.lane;
#pragma unroll
    for (int j = 0; j < 4; ++j) { const f32x4 g = gp[64 * j]; const f32x4 va = xa.v[j] * ra * g, vb = xb.v[j] * rb * g;
        v2u wa, wb; wa.x = pg8::cvt_pk_bf16(va.x, va.y); wa.y = pg8::cvt_pk_bf16(va.z, va.w); wb.x = pg8::cvt_pk_bf16(vb.x, vb.y); wb.y = pg8::cvt_pk_bf16(vb.z, vb.w);
        oa[64 * j] = wa; ob[64 * j] = wb;
        *(LAS v2u*)(xt + sA * P0_ROWB + (256 * j + 4 * F.lane) * 2) = wa; *(LAS v2u*)(xt + sB * P0_ROWB + (256 * j + 4 * F.lane) * 2) = wb; }
}
__device__ __forceinline__ void p0_rgk(const Frame& F, LAS unsigned char* L0, int step, int nvalid) {
    typedef short bf16x8v __attribute__((ext_vector_type(8)));
    const int l15 = F.lane & 15, kq = F.lane >> 4;
    f32x4 acc = (f32x4){0.f, 0.f, 0.f, 0.f};
    bf16x8v a[4], b[4];
#pragma unroll
    for (int s = 0; s < 4; ++s) { a[s] = *(const LAS bf16x8v*)(L0 + P0_XT + l15 * P0_ROWB + (128 * F.wave + 32 * s + 8 * kq) * 2); b[s] = *(const LAS bf16x8v*)(L0 + P0_WRB + l15 * P0_ROWB + (128 * F.wave + 32 * s + 8 * kq) * 2); }
#pragma unroll
    for (int s = 0; s < 4; ++s) acc = __builtin_amdgcn_mfma_f32_16x16x32_bf16(a[s], b[s], acc, 0, 0, 0);
    LAS float* part = (LAS float*)(L0 + P0_PART) + F.wave * 256;
#pragma unroll
    for (int i = 0; i < 4; ++i) part[(4 * kq + i) * 16 + l15] = acc[i];
    __syncthreads();
    if (F.tid < 256) { const LAS float* pp = (const LAS float*)(L0 + P0_PART) + F.tid; float s = 0.f;
#pragma unroll
        for (int w = 0; w < 8; ++w) s += pp[w * 256];
        const int slot = F.tid >> 4;
        if (slot < nvalid) ((LAS float*)(L0 + P0_RGL))[((slot >> 1) + 16 * step + 8 * (slot & 1)) * 16 + (F.tid & 15)] = s; }
}
__device__ __forceinline__ void p0_prologue(Frame& F) {
    LAS float* scr = (LAS float*)(F.lds + RING_OFF + F.wave * 16384);
    LAS unsigned char* L0 = F.lds + RING_OFF;
    const int gw = F.vcu * NWAVES + F.wave, NGW = F.G * NWAVES;
    if (blockIdx.x == 0) for (int c = F.tid; c < D; c += NWAVES * 64) F.C8[c] = 8.f * 1.4426950408889634f * logsigf_(F.lam[c]);
    f32x4 wrb[8];
#pragma unroll
    for (int q = 0; q < 8; ++q) { const int idx = F.tid + 512 * q; wrb[q] = *(const GAS f32x4*)(F.w_in + (size_t)(idx >> 2) * DIN + DINP + 4 * (idx & 3)); }
    constexpr int I_IN = (D / 64) * (DINP / 32), I_OUT = (DMIX / 64) * (D / 32);
    { f32x4 wa[8], wb[8];
      for (int it = gw; it < I_IN + I_OUT; it += 2 * NGW) {
          const TxItem ta = p0_tx_item(F, it); const bool two = it + NGW < I_IN + I_OUT; const TxItem tb = p0_tx_item(F, two ? it + NGW : it);
          p0_tx_load(ta, F.lane, wa); if (two) p0_tx_load(tb, F.lane, wb);
          p0_tx_finish(ta, scr, F.lane, wa); if (two) p0_tx_finish(tb, scr, F.lane, wb); } }
    PSTAMP(20);
    __syncthreads();
#pragma unroll
    for (int q = 0; q < 8; ++q) { const int idx = F.tid + 512 * q; const int k = idx >> 2, jq = idx & 3; const f32x4 w = wrb[q];
        LAS unsigned short* wp = (LAS unsigned short*)(L0 + P0_WRB) + (4 * jq) * (P0_ROWB / 2) + k;
        wp[0] = (unsigned short)f2bf(w.x); wp[P0_ROWB / 2] = (unsigned short)f2bf(w.y); wp[2 * (P0_ROWB / 2)] = (unsigned short)f2bf(w.z); wp[3 * (P0_ROWB / 2)] = (unsigned short)f2bf(w.w); }
    __syncthreads();
    PSTAMP(21);
    LAS float* rgl = (LAS float*)(L0 + P0_RGL);
    float w2[16];
#pragma unroll
    for (int j = 0; j < 16; ++j) w2[j] = F.w_gk2[j * 512 + F.tid];
    const float bg = F.b_gk[F.tid];
    const bool hasS = F.vcu < NS;
    float cum = 0.f;
    int r0 = F.vcu * 64;
#define P0_BCUM(t0, nt) do { for (int t = (t0); t < (t0) + (nt); t += 4) { float z[4]; \
        _Pragma("unroll") for (int u = 0; u < 4; ++u) { z[u] = bg; \
            _Pragma("unroll") for (int j4 = 0; j4 < 4; ++j4) { const f32x4 rg = *(const LAS f32x4*)(rgl + (t + u) * 16 + 4 * j4); z[u] += (rg.x * w2[4 * j4] + rg.y * w2[4 * j4 + 1]) + (rg.z * w2[4 * j4 + 2] + rg.w * w2[4 * j4 + 3]); } } \
        _Pragma("unroll") for (int u = 0; u < 4; ++u) {          \
            cum -= 0.04332169878499658f * __builtin_amdgcn_logf(1.f + __builtin_amdgcn_exp2f(-1.4426950408889634f * z[u])); \
            ((_Float16*)F.BCUM)[(size_t)(r0 + t + u) * 512 + F.tid] = (_Float16)(1.4426950408889634f * cum); } } } while (0)
    RowX xa = p0_load_row(F, r0 + F.wave), xb = p0_load_row(F, r0 + F.wave + 8);
#pragma unroll 1
    for (int i = 0; i < 4; ++i) { const int ra = F.wave + 16 * i, rb = ra + 8; RowX na = xa, nb = xb;
        if (i < 3) { na = p0_load_row(F, r0 + ra + 16); nb = p0_load_row(F, r0 + rb + 16); }
        else if (hasS) na = p0_load_row(F, NROWP + F.vcu * TS + F.wave);
        p0_rows2(F, r0 + ra, r0 + rb, xa, xb, L0 + P0_XT, 2 * F.wave, 2 * F.wave + 1);
        __syncthreads();
        p0_rgk(F, L0, i, 16);
        __syncthreads();
        P0_BCUM(16 * i, 16);
        xa = na; xb = nb; }
    F.DEC[(size_t)F.vcu * 512 + F.tid] = __builtin_amdgcn_exp2f(1.4426950408889634f * cum);
    __syncthreads();
    if (hasS) {
        cum = 0.f; r0 = NROWP + F.vcu * TS;
        p0_rows2(F, r0 + F.wave, r0 + F.wave, xa, xa, L0 + P0_XT, 2 * F.wave, 2 * F.wave + 1);
        __syncthreads();
        p0_rgk(F, L0, 0, 16);
        __syncthreads();
        P0_BCUM(0, TS);
        F.DEC[(size_t)(NP * (TP / 64) + F.vcu) * 512 + F.tid] = __builtin_amdgcn_exp2f(1.4426950408889634f * cum);
        __syncthreads();
    }
#undef P0_BCUM
}

__device__ __forceinline__ float rdlane(float v, int l) { return __builtin_bit_cast(float, __builtin_amdgcn_readlane(__builtin_bit_cast(int, v), l)); }
__device__ __forceinline__ void lru_simple_item(const Frame& F, int kind, int seq, int nb) {
    const int lane = F.lane, c = nb * 64 + lane;
    const int T = kind ? TS : TP; const size_t row0 = kind ? (size_t)NROWP + (size_t)seq * TS : (size_t)seq * TP;
    float wrg[64], wig[64];
#pragma unroll
    for (int d = 0; d < 64; ++d) { wrg[d] = F.w_rg[(size_t)(nb * 64 + d) * 64 + lane]; wig[d] = F.w_ig[(size_t)(nb * 64 + d) * 64 + lane]; }
    const float brg = F.b_rg[c], big = F.b_ig[c], cb = F.conv_b[c], cw0 = F.conv_w[c], cw1 = F.conv_w[1024 + c], cw2 = F.conv_w[2048 + c], cw3 = F.conv_w[3072 + c];
    const float c8 = 8.f * logsigf_(F.lam[c]);
    float h = kind ? F.st_h[(size_t)seq * 1024 + c] : 0.f;
    float xm3 = kind ? F.st_conv[((size_t)seq * 3 + 0) * 1024 + c] : 0.f, xm2 = kind ? F.st_conv[((size_t)seq * 3 + 1) * 1024 + c] : 0.f, xm1 = kind ? F.st_conv[((size_t)seq * 3 + 2) * 1024 + c] : 0.f;
    for (int t0 = 0; t0 < T; t0 += 8) {
        float xv[8], zv[8];
#pragma unroll
        for (int i = 0; i < 8; ++i) { const bf16* pr = F.PROJ + (row0 + t0 + i) * DINP; xv[i] = bf2f(pr[C_XL + c]); zv[i] = bf2f(pr[C_ZL + c]); }
#pragma unroll 1
        for (int i = 0; i < 8; ++i) {
            const float x = xv[i]; const float xc = cb + cw0 * xm3 + cw1 * xm2 + cw2 * xm1 + cw3 * x; xm3 = xm2; xm2 = xm1; xm1 = x;
            float ar = brg, ai = big;
#pragma unroll
            for (int d = 0; d < 64; ++d) { const float xd = rdlane(xc, d); ar += xd * wrg[d]; ai += xd * wig[d]; }
            const float r = sigmoidf_(ar), ig = sigmoidf_(ai);
            const float la = c8 * r, a = __expf(la), u = sqrtf(-expm1f(2.f * la)) * (ig * xc);
            h = a * h + u;
            const float z = zv[i], y = h * z * sigmoidf_(z);
            F.YMIX[(row0 + t0 + i) * DMIX + c] = (bf16)f2bf(y);
        }
    }
    float* ho = F.out + (kind ? O_HS : O_HP) + (size_t)seq * 1024 + c; *ho = h;
    float* co = F.out + (kind ? O_CS : O_CP) + (size_t)seq * 3 * 1024 + c; co[0] = xm3; co[1024] = xm2; co[2048] = xm1;
}
__device__ __forceinline__ void gla_simple_item(const Frame& F, int kind, int seq, int h, int hsel) {
    int t2 = F.tid & 255; asm volatile("" : "+v"(t2)); const int w4 = t2 >> 6;
    const int T = kind ? TS : TP; const size_t row0 = kind ? (size_t)NROWP + (size_t)seq * TS : (size_t)seq * TP;
    LAS float* L = (LAS float*)(F.lds + RING_OFF + hsel * 4096);
    LAS float* al = L, *qs = L + 128, *ks = L + 256, *red = L + 384;
    float S[128];
    const float* s0 = F.st_gla + (((size_t)seq * NH + h) * HK) * HV + t2;
#pragma unroll
    for (int d = 0; d < 128; ++d) S[d] = kind ? s0[(size_t)d * HV] : 0.f;
    const float gh = F.g_head[t2];
    for (int t = 0; t < T; ++t) {
        const size_t row = row0 + t; const bf16* pr = F.PROJ + row * DINP;
        if (t2 < 128) { const bool cbeg = kind ? false : ((t & 63) == 0 && t > 0); const size_t ci = (size_t)(seq * (TP / 64) + (t >> 6) - 1);
            al[t2] = cbeg ? F.DEC[ci * 512 + h * 128 + t2] : 1.f; qs[t2] = bf2f(pr[C_Q + h * 128 + t2]); ks[t2] = bf2f(pr[C_K + h * 128 + t2]); }
        const float vv = bf2f(pr[C_V + h * 256 + t2]), zz = bf2f(pr[C_ZG + h * 256 + t2]);
        __syncthreads();
        float o = 0.f;
#pragma unroll
        for (int d4 = 0; d4 < 32; ++d4) { const f32x4 a4 = *(const LAS f32x4*)(al + 4 * d4), k4 = *(const LAS f32x4*)(ks + 4 * d4), q4 = *(const LAS f32x4*)(qs + 4 * d4);
            S[4 * d4 + 0] = a4.x * S[4 * d4 + 0] + k4.x * vv; o += q4.x * S[4 * d4 + 0];
            S[4 * d4 + 1] = a4.y * S[4 * d4 + 1] + k4.y * vv; o += q4.y * S[4 * d4 + 1];
            S[4 * d4 + 2] = a4.z * S[4 * d4 + 2] + k4.z * vv; o += q4.z * S[4 * d4 + 2];
            S[4 * d4 + 3] = a4.w * S[4 * d4 + 3] + k4.w * vv; o += q4.w * S[4 * d4 + 3]; }
        const float ss = wave_sum(o * o);
        if (F.lane == 0) red[w4] = ss;
        __syncthreads();
        const float tot = (red[0] + red[1]) + (red[2] + red[3]);
        const float rs = rsqrtf(tot * (1.f / 256.f) + EPS);
        const float y = o * rs * gh * (zz * sigmoidf_(zz));
        F.YMIX[row * DMIX + 1024 + h * 256 + t2] = (bf16)f2bf(y);
        __syncthreads();
    }
    if (t2 < 128) al[t2] = F.DEC[(kind ? (size_t)(NP * (TP / 64) + seq) : (size_t)(seq * (TP / 64) + TP / 64 - 1)) * 512 + h * 128 + t2];
    __syncthreads();
    float* so = F.out + (kind ? O_GS : O_GP) + (((size_t)seq * NH + h) * HK) * HV + t2;
#pragma unroll
    for (int d = 0; d < 128; ++d) so[(size_t)d * HV] = S[d] * al[d];
    __syncthreads();
}
#ifndef TAIL_SAMPLE
#define TAIL_SAMPLE 0
#endif


typedef short bf16x8_t __attribute__((ext_vector_type(8)));
typedef float f32x16 __attribute__((ext_vector_type(16)));
constexpr int LRU_XL_ROWS = 44;
constexpr int LRU_XL_OFF = 0, LRU_XL_WB = LRU_XL_ROWS * 128;
constexpr int LRU_ZL_OFF = LRU_XL_OFF + 8 * LRU_XL_WB, LRU_ZL_WB = 32 * 128;
constexpr int LRU_XC_OFF = LRU_ZL_OFF + 8 * LRU_ZL_WB, LRU_XC_WB = 32 * 144;
constexpr int LRU_SL_OFF = LRU_XC_OFF + 8 * LRU_XC_WB;
constexpr int LRU_HC_OFF = LRU_SL_OFF + 2 * 8 * 2 * 64 * 4;
constexpr int LRU_WG_OFF = LRU_HC_OFF + 2 * 64 * 4;
constexpr int LRU_END = LRU_WG_OFF + 128 * 144;
static_assert(LRU_END <= RING_BYTES, "LRU LDS map");
#define L2E 1.4426950408889634f
template <int KIND>
__device__ __forceinline__ void lru_item(const Frame& F, int sg, int nb) {
    int lane = F.lane; asm volatile("" : "+v"(lane));
    const int wave = F.wave, cl = lane & 31, hh = lane >> 5;
    LAS unsigned char* XLw = F.lds + RING_OFF + LRU_XL_OFF + wave * LRU_XL_WB;
    LAS unsigned char* ZLw = F.lds + RING_OFF + LRU_ZL_OFF + wave * LRU_ZL_WB;
    LAS unsigned char* XCw = F.lds + RING_OFF + LRU_XC_OFF + wave * LRU_XC_WB;
    LAS float* SL = (LAS float*)(F.lds + RING_OFF + LRU_SL_OFF);
    LAS float* HC = (LAS float*)(F.lds + RING_OFF + LRU_HC_OFF);
    LAS unsigned char* WGl = F.lds + RING_OFF + LRU_WG_OFF;
    __syncthreads();
    { const int col = F.tid & 127, kq = F.tid >> 7; const float* W = ((col >> 6) ? F.w_ig : F.w_rg) + (size_t)nb * 4096 + (size_t)(16 * kq) * 64 + (col & 63);
      v4u p0, p1;
      p0.x = pk2(-L2E * W[0 * 64], -L2E * W[1 * 64]); p0.y = pk2(-L2E * W[2 * 64], -L2E * W[3 * 64]); p0.z = pk2(-L2E * W[4 * 64], -L2E * W[5 * 64]); p0.w = pk2(-L2E * W[6 * 64], -L2E * W[7 * 64]);
      p1.x = pk2(-L2E * W[8 * 64], -L2E * W[9 * 64]); p1.y = pk2(-L2E * W[10 * 64], -L2E * W[11 * 64]); p1.z = pk2(-L2E * W[12 * 64], -L2E * W[13 * 64]); p1.w = pk2(-L2E * W[14 * 64], -L2E * W[15 * 64]);
      *(LAS v4u*)(WGl + col * 144 + (16 * kq) * 2) = p0; *(LAS v4u*)(WGl + col * 144 + (16 * kq + 8) * 2) = p1; }
    constexpr int NR = KIND ? 1 : 8;
    const size_t rowbase = KIND ? (size_t)NROWP + (size_t)sg * 256 : (size_t)sg * TP;
    if (KIND == 0) { if (F.tid < 64) HC[F.tid] = 0.f; }
    if (KIND == 0) {
#pragma unroll
        for (int q = 0; q < 5; ++q) { const int p = lane + 64 * q; const int row = p >> 3, pc = p & 7;
            if (row < 35) { const long tok = (long)wave * 32 + row - 3; v4u v = (v4u){0u, 0u, 0u, 0u};
                if (tok >= 0) v = *(const GAS v4u*)(F.PROJ + (rowbase + tok) * DINP + C_XL + nb * 64 + pc * 8);
                *(LAS v4u*)(XLw + row * 128 + pc * 16) = v; } }
    } else {
#pragma unroll
        for (int q = 0; q < 6; ++q) { const int p = lane + 64 * q; const int row = p >> 3, pc = p & 7;
            if (row < 44) { const int sq = row / 11, rr = row - sq * 11; const int seq = sg * 32 + wave * 4 + sq; v4u v;
                if (rr < 3) { const float* sp = F.st_conv + ((size_t)seq * 3 + rr) * 1024 + nb * 64 + pc * 8; const f32x4 a = *(const GAS f32x4*)sp, b = *(const GAS f32x4*)(sp + 4);
                    v.x = pk2(a.x, a.y); v.y = pk2(a.z, a.w); v.z = pk2(b.x, b.y); v.w = pk2(b.z, b.w); }
                else v = *(const GAS v4u*)(F.PROJ + ((size_t)NROWP + (size_t)seq * 8 + rr - 3) * DINP + C_XL + nb * 64 + pc * 8);
                *(LAS v4u*)(XLw + row * 128 + pc * 16) = v; } }
    }
#pragma unroll
    for (int q = 0; q < 4; ++q) { const int p = lane + 64 * q; const int row = p >> 3, pc = p & 7;
        *(LAS v4u*)(ZLw + row * 128 + pc * 16) = *(const GAS v4u*)(F.PROJ + (rowbase + wave * 32 + row) * DINP + C_ZL + nb * 64 + pc * 8); }
    for (int r = 0; r < NR; ++r) {
        const int par = r & 1;
        const size_t srow = rowbase + (size_t)r * 256 + wave * 32;
        const bool more = (KIND == 0) && (r + 1 < NR);
        __syncthreads();
        float gbr[2], gbi[2], gc8[2], cwv[2][4], cbv[2];
#pragma unroll
        for (int ct = 0; ct < 2; ++ct) { const int cg = nb * 64 + 32 * ct + cl; gbr[ct] = F.b_rg[cg]; gbi[ct] = F.b_ig[cg]; gc8[ct] = F.C8[cg]; cbv[ct] = F.conv_b[cg];
#pragma unroll
            for (int j = 0; j < 4; ++j) cwv[ct][j] = F.conv_w[j * 1024 + cg]; }
        float xc[2][16];
#pragma unroll
        for (int ct = 0; ct < 2; ++ct) {
            float cw[4]; const float cb = cbv[ct];
#pragma unroll
            for (int j = 0; j < 4; ++j) cw[j] = cwv[ct][j];
            v2u xa0, xb0, xa1, xb1, xa2, xb2, xa3, xb3;
            { const unsigned xad = (unsigned)(size_t)XLw + (unsigned)((4 * hh + ((lane & 15) >> 2)) * 128 + (32 * ct + 16 * ((lane >> 4) & 1) + 4 * (lane & 3)) * 2);
              if (KIND) asm volatile("ds_read_b64_tr_b16 %0, %8\n\tds_read_b64_tr_b16 %1, %8 offset:512\n\tds_read_b64_tr_b16 %2, %8 offset:1408\n\tds_read_b64_tr_b16 %3, %8 offset:1920\n\t"
                                     "ds_read_b64_tr_b16 %4, %8 offset:2816\n\tds_read_b64_tr_b16 %5, %8 offset:3328\n\tds_read_b64_tr_b16 %6, %8 offset:4224\n\tds_read_b64_tr_b16 %7, %8 offset:4736\n\ts_waitcnt lgkmcnt(0)"
                                     : "=&v"(xa0), "=&v"(xb0), "=&v"(xa1), "=&v"(xb1), "=&v"(xa2), "=&v"(xb2), "=&v"(xa3), "=&v"(xb3) : "v"(xad) : "memory");
              else asm volatile("ds_read_b64_tr_b16 %0, %8\n\tds_read_b64_tr_b16 %1, %8 offset:512\n\tds_read_b64_tr_b16 %2, %8 offset:1024\n\tds_read_b64_tr_b16 %3, %8 offset:1536\n\t"
                                "ds_read_b64_tr_b16 %4, %8 offset:2048\n\tds_read_b64_tr_b16 %5, %8 offset:2560\n\tds_read_b64_tr_b16 %6, %8 offset:3072\n\tds_read_b64_tr_b16 %7, %8 offset:3584\n\ts_waitcnt lgkmcnt(0)"
                                : "=&v"(xa0), "=&v"(xb0), "=&v"(xa1), "=&v"(xb1), "=&v"(xa2), "=&v"(xb2), "=&v"(xa3), "=&v"(xb3) : "v"(xad) : "memory"); }
            const unsigned xw[4][4] = {{xa0.x, xa0.y, xb0.x, xb0.y}, {xa1.x, xa1.y, xb1.x, xb1.y}, {xa2.x, xa2.y, xb2.x, xb2.y}, {xa3.x, xa3.y, xb3.x, xb3.y}};
#pragma unroll
            for (int g = 0; g < 4; ++g) { const float x0 = bflo(xw[g][0]), x1 = bfhi(xw[g][0]), x2 = bflo(xw[g][1]), x3 = bfhi(xw[g][1]), x4 = bflo(xw[g][2]), x5 = bfhi(xw[g][2]), x6 = bflo(xw[g][3]);
                xc[ct][4 * g + 0] = cb + cw[0] * x0 + cw[1] * x1 + cw[2] * x2 + cw[3] * x3; xc[ct][4 * g + 1] = cb + cw[0] * x1 + cw[1] * x2 + cw[2] * x3 + cw[3] * x4;
                xc[ct][4 * g + 2] = cb + cw[0] * x2 + cw[1] * x3 + cw[2] * x4 + cw[3] * x5; xc[ct][4 * g + 3] = cb + cw[0] * x3 + cw[1] * x4 + cw[2] * x5 + cw[3] * x6; }
        }
#pragma unroll
        for (int ct = 0; ct < 2; ++ct)
#pragma unroll
            for (int i = 0; i < 16; i += 2) { const unsigned w = pg8::cvt_pk_bf16(xc[ct][i], xc[ct][i + 1]);
                *(LAS unsigned short*)(XCw + ((i & 3) + 8 * (i >> 2) + 4 * hh) * 144 + (32 * ct + cl) * 2) = (unsigned short)w;
                *(LAS unsigned short*)(XCw + (((i + 1) & 3) + 8 * (i >> 2) + 4 * hh) * 144 + (32 * ct + cl) * 2) = (unsigned short)(w >> 16); }
        bf16x8_t Af[4];
#pragma unroll
        for (int s = 0; s < 4; ++s) Af[s] = *(const LAS bf16x8_t*)(XCw + cl * 144 + (16 * s + 8 * hh) * 2);
        float At_[2], Ut_[2];
        float Aloc[2][16], Hloc[2][16], AGk[2][4], UGk[2][4];
#pragma unroll
        for (int ct = 0; ct < 2; ++ct) {
            f32x16 ar, ai;
            const float brg = -L2E * gbr[ct], big = -L2E * gbi[ct], c8 = gc8[ct];
#pragma unroll
            for (int i = 0; i < 16; ++i) { ar[i] = brg; ai[i] = big; }
            bf16x8_t b0[4], b1[4];
#pragma unroll
            for (int s = 0; s < 4; ++s) { b0[s] = *(const LAS bf16x8_t*)(WGl + (32 * ct + cl) * 144 + (16 * s + 8 * hh) * 2); b1[s] = *(const LAS bf16x8_t*)(WGl + (64 + 32 * ct + cl) * 144 + (16 * s + 8 * hh) * 2); }
#pragma unroll
            for (int s = 0; s < 4; ++s) { ar = __builtin_amdgcn_mfma_f32_32x32x16_bf16(Af[s], b0[s], ar, 0, 0, 0); ai = __builtin_amdgcn_mfma_f32_32x32x16_bf16(Af[s], b1[s], ai, 0, 0, 0); }
            float AG[4], UG[4];
#pragma unroll
            for (int g = 0; g < 4; ++g) { float Ap = 1.f, Hp = 0.f;
#pragma unroll
                for (int e = 0; e < 4; ++e) { const int i = 4 * g + e;
                    const float rr = __builtin_amdgcn_rcpf(1.f + __builtin_amdgcn_exp2f(ar[i])), di = 1.f + __builtin_amdgcn_exp2f(ai[i]);
                    const float a = __builtin_amdgcn_exp2f(c8 * rr);
                    const float w = fmaxf(1.f - a * a, 0.f);
                    const float u = w * __builtin_amdgcn_rsqf(fmaxf(w * di * di, 1e-30f)) * xc[ct][i];
                    Hp = a * Hp + u; Ap = a * Ap; Aloc[ct][i] = Ap; Hloc[ct][i] = Hp; }
                AG[g] = Ap; UG[g] = Hp; }
            float At = 1.f, Ut = 0.f;
#pragma unroll
            for (int g = 0; g < 4; ++g) { const float pA = __shfl_xor(AG[g], 32), pU = __shfl_xor(UG[g], 32);
                const float a0 = hh ? pA : AG[g], u0 = hh ? pU : UG[g], a1 = hh ? AG[g] : pA, u1 = hh ? UG[g] : pU;
                Ut = a0 * Ut + u0; At = a0 * At; Ut = a1 * Ut + u1; At = a1 * At; AGk[ct][g] = AG[g]; UGk[ct][g] = UG[g]; }
            At_[ct] = At; Ut_[ct] = Ut;
        }
        v4u xn[5];
        if (more) {
#pragma unroll
            for (int q = 0; q < 5; ++q) { const int p = lane + 64 * q; const int row = p >> 3, pc = p & 7;
                if (row < 35) xn[q] = *(const GAS v4u*)(F.PROJ + (srow + 256 + row - 3) * DINP + C_XL + nb * 64 + pc * 8); }
        }
        v4u zn[4];
        if (more) {
#pragma unroll
            for (int q = 0; q < 4; ++q) { const int p = lane + 64 * q; const int row = p >> 3, pc = p & 7;
                zn[q] = *(const GAS v4u*)(F.PROJ + (srow + 256 + row) * DINP + C_ZL + nb * 64 + pc * 8); }
        }
        float hin[2] = {0.f, 0.f};
        if (KIND == 0) {
            if (hh == 0) {
#pragma unroll
                for (int ct = 0; ct < 2; ++ct) { SL[((par * 8 + wave) * 2 + 0) * 64 + 32 * ct + cl] = At_[ct]; SL[((par * 8 + wave) * 2 + 1) * 64 + 32 * ct + cl] = Ut_[ct]; } }
            __syncthreads();
#pragma unroll
            for (int ct = 0; ct < 2; ++ct) { float sa[7], su[7]; float hs = HC[par * 64 + 32 * ct + cl];
#pragma unroll
                for (int w2 = 0; w2 < 7; ++w2) { sa[w2] = SL[((par * 8 + w2) * 2 + 0) * 64 + 32 * ct + cl]; su[w2] = SL[((par * 8 + w2) * 2 + 1) * 64 + 32 * ct + cl]; }
#pragma unroll
                for (int w2 = 0; w2 < 7; ++w2) { const float hn = sa[w2] * hs + su[w2]; hs = w2 < wave ? hn : hs; }
                hin[ct] = hs;
                if (wave == 7 && hh == 0) HC[(par ^ 1) * 64 + 32 * ct + cl] = At_[ct] * hs + Ut_[ct]; }
        }
#pragma unroll
        for (int ct = 0; ct < 2; ++ct) {
            float hst[4]; float hs = hin[ct];
#pragma unroll
            for (int g = 0; g < 4; ++g) { const float pA = __shfl_xor(AGk[ct][g], 32), pU = __shfl_xor(UGk[ct][g], 32);
                const float a0 = hh ? pA : AGk[ct][g], u0 = hh ? pU : UGk[ct][g], a1 = hh ? AGk[ct][g] : pA, u1 = hh ? UGk[ct][g] : pU;
                if (KIND == 1) hs = F.st_h[(size_t)(sg * 32 + wave * 4 + g) * 1024 + nb * 64 + 32 * ct + cl];
                const float hs0 = hs; hs = a0 * hs + u0;
                hst[g] = hh ? hs : hs0; hs = a1 * hs + u1;
                if (KIND == 1 && hh == 0) F.out[O_HS + (size_t)(sg * 32 + wave * 4 + g) * 1024 + nb * 64 + 32 * ct + cl] = hs;
            }
            if (KIND == 0 && r == NR - 1 && wave == 7 && hh == 0) F.out[O_HP + (size_t)sg * 1024 + nb * 64 + 32 * ct + cl] = hs;
            LAS unsigned short* zl = (LAS unsigned short*)ZLw + 32 * ct + cl;
            v2u zt0, zt1, zt2, zt3;
            { const unsigned za = (unsigned)(size_t)ZLw + (unsigned)((4 * hh + ((lane & 15) >> 2)) * 128 + (32 * ct + 16 * ((lane >> 4) & 1) + 4 * (lane & 3)) * 2);
              asm volatile("ds_read_b64_tr_b16 %0, %4\n\tds_read_b64_tr_b16 %1, %4 offset:1024\n\tds_read_b64_tr_b16 %2, %4 offset:2048\n\tds_read_b64_tr_b16 %3, %4 offset:3072\n\ts_waitcnt lgkmcnt(0)"
                           : "=&v"(zt0), "=&v"(zt1), "=&v"(zt2), "=&v"(zt3) : "v"(za) : "memory"); }
            const unsigned zw[8] = {zt0.x, zt0.y, zt1.x, zt1.y, zt2.x, zt2.y, zt3.x, zt3.y};
            unsigned short yr[16];
#pragma unroll
            for (int i = 0; i < 16; i += 2) { const float y0 = (Aloc[ct][i] * hst[i >> 2] + Hloc[ct][i]) * bflo(zw[i >> 1]), y1 = (Aloc[ct][i + 1] * hst[i >> 2] + Hloc[ct][i + 1]) * bfhi(zw[i >> 1]);
                const unsigned w = pg8::cvt_pk_bf16(y0, y1); yr[i] = (unsigned short)w; yr[i + 1] = (unsigned short)(w >> 16); }
#pragma unroll
            for (int i = 0; i < 16; ++i) zl[((i & 3) + 8 * (i >> 2) + 4 * hh) * 64] = yr[i];
        }
        v4u yo[4];
#pragma unroll
        for (int q = 0; q < 4; ++q) { const int p = lane + 64 * q; yo[q] = *(const LAS v4u*)(ZLw + (p >> 3) * 128 + (p & 7) * 16); }
#pragma unroll
        for (int q = 0; q < 4; ++q) { const int p = lane + 64 * q;
            if (KIND == 1 && LATE_SAMPLE) __builtin_amdgcn_raw_buffer_store_b128(yo[q], __builtin_amdgcn_make_buffer_rsrc((void*)F.YMIX, 0, 0x7fffffff, 0x00020000), (int)(((srow + (p >> 3)) * DMIX + nb * 64 + (p & 7) * 8) * 2), 0, 16);
            else *(GAS v4u*)(F.YMIX + (srow + (p >> 3)) * DMIX + nb * 64 + (p & 7) * 8) = yo[q]; }
        if (KIND == 0) {
            if (r == NR - 1 && wave == 7) { for (int e = lane; e < 192; e += 64) { const int j = e >> 6, c = e & 63;
                F.out[O_CP + ((size_t)sg * 3 + j) * 1024 + nb * 64 + c] = bf2f(((const LAS unsigned short*)XLw)[(32 + j) * 64 + c]); } }
        } else {
            for (int e = lane; e < 4 * 192; e += 64) { const int sq = e / 192, j = (e % 192) >> 6, c = e & 63;
                F.out[O_CS + ((size_t)(sg * 32 + wave * 4 + sq) * 3 + j) * 1024 + nb * 64 + c] = bf2f(((const LAS unsigned short*)XLw)[(sq * 11 + 8 + j) * 64 + c]); }
        }
        if (more) {
#pragma unroll
            for (int q = 0; q < 5; ++q) { const int p = lane + 64 * q; const int row = p >> 3, pc = p & 7;
                if (row < 35) *(LAS v4u*)(XLw + row * 128 + pc * 16) = xn[q]; }
        }
        if (more) {
#pragma unroll
            for (int q = 0; q < 4; ++q) { const int p = lane + 64 * q; *(LAS v4u*)(ZLw + (p >> 3) * 128 + (p & 7) * 16) = zn[q]; }
        }
    }
    __syncthreads();
}


constexpr int GL_BUF = 49152;
constexpr int GL_QT = 0, GL_KT = 16384, GL_VZ = 32768, GL_AT = 2 * GL_BUF, GL_SBT = GL_AT + 9216, GL_YL = GL_SBT + 17408, GL_DEC = GL_YL + 9216, GL_END = GL_DEC + 16384;
static_assert(GL_END <= RING_BYTES, "GLA LDS map");
__device__ __forceinline__ unsigned off_b(unsigned row, unsigned ch) { return 256u * row + 16u * (ch ^ (((row & 3u) << 2) | ((row >> 2) & 3u))); }
__device__ __forceinline__ void tr_addr(unsigned lane, unsigned c, unsigned ks, unsigned& a0, unsigned& a1) {
    const unsigned h = lane >> 5, blk = (lane >> 4) & 1u, q = (lane & 15u) >> 2, p = lane & 3u;
    a0 = off_b(16u * ks + 8u * h + q, 4u * c + 2u * blk + (p >> 1)) + 8u * (p & 1u);
    a1 = off_b(16u * ks + 8u * h + 4u + q, 4u * c + 2u * blk + (p >> 1)) + 8u * (p & 1u);
}
__device__ __forceinline__ void tr_frag4(unsigned base, const unsigned (&a)[8], bf16x8_t (&f)[4]) {
    v2u r0, r1, r2, r3, r4, r5, r6, r7;
    asm volatile("ds_read_b64_tr_b16 %0, %8\n\tds_read_b64_tr_b16 %1, %9\n\tds_read_b64_tr_b16 %2, %10\n\tds_read_b64_tr_b16 %3, %11\n\t"
                 "ds_read_b64_tr_b16 %4, %12\n\tds_read_b64_tr_b16 %5, %13\n\tds_read_b64_tr_b16 %6, %14\n\tds_read_b64_tr_b16 %7, %15\n\ts_waitcnt lgkmcnt(0)"
                 : "=&v"(r0), "=&v"(r1), "=&v"(r2), "=&v"(r3), "=&v"(r4), "=&v"(r5), "=&v"(r6), "=&v"(r7)
                 : "v"(base + a[0]), "v"(base + a[1]), "v"(base + a[2]), "v"(base + a[3]), "v"(base + a[4]), "v"(base + a[5]), "v"(base + a[6]), "v"(base + a[7]) : "memory");
    f[0] = __builtin_bit_cast(bf16x8_t, (v4u){r0.x, r0.y, r1.x, r1.y}); f[1] = __builtin_bit_cast(bf16x8_t, (v4u){r2.x, r2.y, r3.x, r3.y});
    f[2] = __builtin_bit_cast(bf16x8_t, (v4u){r4.x, r4.y, r5.x, r5.y}); f[3] = __builtin_bit_cast(bf16x8_t, (v4u){r6.x, r6.y, r7.x, r7.y});
}
__device__ __forceinline__ void gla_item(const Frame& F, int b, int h, int vs) {
    int tid = F.tid; asm volatile("" : "+v"(tid));
    const int lane = tid & 63, wave = F.wave, cl = lane & 31, hh = lane >> 5;
    LAS unsigned char* L = F.lds + RING_OFF;
    const unsigned Lb = (unsigned)(size_t)L;
    const int dt = wave >> 1, vt = wave & 1;
    const size_t row0 = (size_t)b * TP;
    f32x16 Sacc;
#pragma unroll
    for (int i = 0; i < 16; ++i) Sacc[i] = 0.f;
    v4u pq[2][2], pk[2][2], pv[2], pz[2];
    const int qrow = tid >> 4, qch = tid & 15, vrow = tid >> 3, vch = tid & 7;
    const unsigned sq0 = off_b(qrow, qch), sq1 = off_b(qrow + 32, qch), sv0 = off_b(vrow, vch), sv1 = off_b(vrow, 8 + vch);
    unsigned tk[8], tv[8];
#pragma unroll
    for (unsigned ks = 0; ks < 4; ++ks) { tr_addr(lane, dt, ks, tk[2 * ks], tk[2 * ks + 1]); tr_addr(lane, vt, ks, tv[2 * ks], tv[2 * ks + 1]); }
#define GL_LOAD(n, s) do { const bf16* pr = F.PROJ + (row0 + (size_t)(n) * 64) * DINP; \
        pq[s][0] = *(const GAS v4u*)(pr + (size_t)qrow * DINP + C_Q + h * 128 + qch * 8); pq[s][1] = *(const GAS v4u*)(pr + (size_t)(qrow + 32) * DINP + C_Q + h * 128 + qch * 8); \
        pk[s][0] = *(const GAS v4u*)(pr + (size_t)qrow * DINP + C_K + h * 128 + qch * 8); pk[s][1] = *(const GAS v4u*)(pr + (size_t)(qrow + 32) * DINP + C_K + h * 128 + qch * 8); \
        pv[s] = *(const GAS v4u*)(pr + (size_t)vrow * DINP + C_V + h * 256 + vs * 64 + vch * 8); pz[s] = *(const GAS v4u*)(pr + (size_t)vrow * DINP + C_ZG + h * 256 + vs * 64 + vch * 8); \
        } while (0)
#define GL_STAGE(bo, s) do { LAS unsigned char* B_ = L + (bo); \
        *(LAS v4u*)(B_ + GL_QT + sq0) = pq[s][0]; *(LAS v4u*)(B_ + GL_QT + sq1) = pq[s][1]; *(LAS v4u*)(B_ + GL_KT + sq0) = pk[s][0]; *(LAS v4u*)(B_ + GL_KT + sq1) = pk[s][1]; \
        *(LAS v4u*)(B_ + GL_VZ + sv0) = pv[s]; *(LAS v4u*)(B_ + GL_VZ + sv1) = pz[s]; } while (0)
#define GL_ROWF(img, row, ks) (*(const LAS bf16x8_t*)(L + (img) + off_b((row), 2 * (ks) + hh)))
#define GL_PADF(base, stride, row, ks) (*(const LAS bf16x8_t*)(L + (base) + (row) * (stride) + (16 * (ks) + 8 * hh) * 2))
#define GL_UPD(bo) do { bf16x8_t fa[4], fb[4]; f32x4 dc[4]; \
        _Pragma("unroll") for (int g = 0; g < 4; ++g) dc[g] = *(const LAS f32x4*)(L + GL_DEC + (n * 128 + 32 * dt + 8 * g + 4 * hh) * 4); \
        tr_frag4(Lb + (bo) + GL_KT, tk, fa); tr_frag4(Lb + (bo) + GL_VZ, tv, fb); \
        _Pragma("unroll") for (int ks = 0; ks < 4; ++ks) Sacc = __builtin_amdgcn_mfma_f32_32x32x16_bf16(fa[ks], fb[ks], Sacc, 0, 0, 0); \
        _Pragma("unroll") for (int i = 0; i < 16; ++i) Sacc[i] *= dc[i >> 2][i & 3]; } while (0)
    __syncthreads();
    for (int i = tid; i < (TP / 64) * 32; i += NWAVES * 64) *(LAS f32x4*)(L + GL_DEC + i * 16) = *(const GAS f32x4*)(F.DEC + ((size_t)(b * (TP / 64) + (i >> 5))) * 512 + h * 128 + (i & 31) * 4);
    GL_LOAD(0, 0); GL_STAGE(0, 0);
    GL_LOAD(1, 1); GL_LOAD(2, 0);
#ifdef DIAG_DUR
    unsigned long long acc_ = 0ull, tA_ = 0ull;
#define DT0() do { tA_ = __builtin_amdgcn_s_memrealtime(); } while (0)
#define DT1(id) do { if (DIAG_ID == (id)) acc_ += __builtin_amdgcn_s_memrealtime() - tA_; } while (0)
#else
#define DT0() do {} while (0)
#define DT1(id) do {} while (0)
#endif
    for (int n2 = 0; n2 < TP / 64; n2 += 2) {
#define SET_ 1
      { const int n = n2;
        const int bo = (n & 1) * GL_BUF;
        __syncthreads();
        DT0(); if (wave >= 4) __builtin_amdgcn_s_setprio(1);
        if (n > 0) {
            *(GAS v4u*)(F.YMIX + (row0 + (size_t)(n - 1) * 64 + vrow) * DMIX + 1024 + h * 256 + vs * 64 + vch * 8) = *(const LAS v4u*)(L + GL_YL + vrow * 144 + vch * 16); }
        if (n + 1 < TP / 64) GL_STAGE(GL_BUF - bo, SET_);
        if (n + 3 < TP / 64) GL_LOAD(n + 3, SET_);
        DT1(34); DT0();
#pragma unroll
        for (int g = 0; g < 4; ++g) { v2u w; w.x = pg8::cvt_pk_bf16(Sacc[4 * g], Sacc[4 * g + 1]); w.y = pg8::cvt_pk_bf16(Sacc[4 * g + 2], Sacc[4 * g + 3]);
            *(LAS v2u*)(L + GL_SBT + (32 * vt + cl) * 272 + (32 * dt + 8 * g + 4 * hh) * 2) = w; }
        const bool attw = (wave >= 4 && wave < 7);
        if (attw) {
            const int st = (wave - 4) >> 1, ct = (wave - 3) >> 1;
            f32x16 a;
#pragma unroll
            for (int i = 0; i < 16; ++i) a[i] = 0.f;
            bf16x8_t ka[8], qb[8];
#pragma unroll
            for (int ks = 0; ks < 8; ++ks) { ka[ks] = GL_ROWF(bo + GL_KT, 32 * st + cl, ks); qb[ks] = GL_ROWF(bo + GL_QT, 32 * ct + cl, ks); }
            asm volatile("s_waitcnt lgkmcnt(0)" ::: "memory");
#pragma unroll
            for (int ks = 0; ks < 8; ++ks) a = __builtin_amdgcn_mfma_f32_32x32x16_bf16(ka[ks], qb[ks], a, 0, 0, 0);
            if (st == ct) {
#pragma unroll
                for (int i = 0; i < 16; ++i) { const int sl = (i & 3) + 8 * (i >> 2) + 4 * hh; a[i] = sl <= cl ? a[i] : 0.f; } }
#pragma unroll
            for (int g = 0; g < 4; ++g) { v2u w; w.x = pg8::cvt_pk_bf16(a[4 * g], a[4 * g + 1]); w.y = pg8::cvt_pk_bf16(a[4 * g + 2], a[4 * g + 3]);
                *(LAS v2u*)(L + GL_AT + (32 * ct + cl) * 144 + (32 * st + 8 * g + 4 * hh) * 2) = w; }
        } else GL_UPD(bo);
        DT1(35); if (wave >= 4) __builtin_amdgcn_s_setprio(0);
        __syncthreads();
        if (attw) GL_UPD(bo);
        if (wave < 4) {
            f32x16 o;
#pragma unroll
            for (int i = 0; i < 16; ++i) o[i] = 0.f;
            bf16x8_t fv[4], fa[4], fs[4], fq[4]; tr_frag4(Lb + bo + GL_VZ, tv, fv);
            v2u zc[4];
#pragma unroll
            for (int ks = 0; ks < 4; ++ks) { fa[ks] = GL_PADF(GL_AT, 144, 32 * dt + cl, ks); fs[ks] = GL_PADF(GL_SBT, 272, 32 * vt + cl, ks); fq[ks] = GL_ROWF(bo + GL_QT, 32 * dt + cl, ks); }
            asm volatile("s_waitcnt lgkmcnt(0)" ::: "memory");
            o = __builtin_amdgcn_mfma_f32_32x32x16_bf16(fv[0], fa[0], o, 0, 0, 0);
            o = __builtin_amdgcn_mfma_f32_32x32x16_bf16(fv[1], fa[1], o, 0, 0, 0);
            if (dt) { o = __builtin_amdgcn_mfma_f32_32x32x16_bf16(fv[2], fa[2], o, 0, 0, 0); o = __builtin_amdgcn_mfma_f32_32x32x16_bf16(fv[3], fa[3], o, 0, 0, 0); }
#pragma unroll
            for (int ks = 0; ks < 4; ++ks) o = __builtin_amdgcn_mfma_f32_32x32x16_bf16(fs[ks], fq[ks], o, 0, 0, 0);
#pragma unroll
            for (int ks = 0; ks < 4; ++ks) { fs[ks] = GL_PADF(GL_SBT, 272, 32 * vt + cl, 4 + ks); fq[ks] = GL_ROWF(bo + GL_QT, 32 * dt + cl, 4 + ks); }
#pragma unroll
            for (int g = 0; g < 4; ++g) zc[g] = *(const LAS v2u*)(L + bo + GL_VZ + off_b(32 * dt + cl, 8 + 4 * vt + g) + 8 * hh);
            asm volatile("s_waitcnt lgkmcnt(0)" ::: "memory");
#pragma unroll
            for (int ks = 0; ks < 4; ++ks) o = __builtin_amdgcn_mfma_f32_32x32x16_bf16(fs[ks], fq[ks], o, 0, 0, 0);
            float ss = 0.f;
#pragma unroll
            for (int i = 0; i < 16; ++i) ss += o[i] * o[i];
            ss += __shfl_xor(ss, 32);
            const size_t row = row0 + (size_t)n * 64 + 32 * dt + cl;
            if (hh == 0) F.PSS[(size_t)(h * 8 + vs * 2 + vt) * NROWP + row] = ss;
#pragma unroll
            for (int g = 0; g < 4; ++g) {
                const float y0 = o[4 * g] * bflo(zc[g].x), y1 = o[4 * g + 1] * bfhi(zc[g].x), y2 = o[4 * g + 2] * bflo(zc[g].y), y3 = o[4 * g + 3] * bfhi(zc[g].y);
                v2u w; w.x = pg8::cvt_pk_bf16(y0, y1); w.y = pg8::cvt_pk_bf16(y2, y3); *(LAS v2u*)(L + GL_YL + (32 * dt + cl) * 144 + (32 * vt + 8 * g + 4 * hh) * 2) = w; }
        }
          }
#undef SET_
#define SET_ 0
      { const int n = n2 + 1;
        const int bo = (n & 1) * GL_BUF;
        __syncthreads();
        DT0(); if (wave >= 4) __builtin_amdgcn_s_setprio(1);
        if (n > 0) {
            *(GAS v4u*)(F.YMIX + (row0 + (size_t)(n - 1) * 64 + vrow) * DMIX + 1024 + h * 256 + vs * 64 + vch * 8) = *(const LAS v4u*)(L + GL_YL + vrow * 144 + vch * 16); }
        if (n + 1 < TP / 64) GL_STAGE(GL_BUF - bo, SET_);
        if (n + 3 < TP / 64) GL_LOAD(n + 3, SET_);
        DT1(34); DT0();
#pragma unroll
        for (int g = 0; g < 4; ++g) { v2u w; w.x = pg8::cvt_pk_bf16(Sacc[4 * g], Sacc[4 * g + 1]); w.y = pg8::cvt_pk_bf16(Sacc[4 * g + 2], Sacc[4 * g + 3]);
            *(LAS v2u*)(L + GL_SBT + (32 * vt + cl) * 272 + (32 * dt + 8 * g + 4 * hh) * 2) = w; }
        const bool attw = (wave >= 4 && wave < 7);
        if (attw) {
            const int st = (wave - 4) >> 1, ct = (wave - 3) >> 1;
            f32x16 a;
#pragma unroll
            for (int i = 0; i < 16; ++i) a[i] = 0.f;
            bf16x8_t ka[8], qb[8];
#pragma unroll
            for (int ks = 0; ks < 8; ++ks) { ka[ks] = GL_ROWF(bo + GL_KT, 32 * st + cl, ks); qb[ks] = GL_ROWF(bo + GL_QT, 32 * ct + cl, ks); }
            asm volatile("s_waitcnt lgkmcnt(0)" ::: "memory");
#pragma unroll
            for (int ks = 0; ks < 8; ++ks) a = __builtin_amdgcn_mfma_f32_32x32x16_bf16(ka[ks], qb[ks], a, 0, 0, 0);
            if (st == ct) {
#pragma unroll
                for (int i = 0; i < 16; ++i) { const int sl = (i & 3) + 8 * (i >> 2) + 4 * hh; a[i] = sl <= cl ? a[i] : 0.f; } }
#pragma unroll
            for (int g = 0; g < 4; ++g) { v2u w; w.x = pg8::cvt_pk_bf16(a[4 * g], a[4 * g + 1]); w.y = pg8::cvt_pk_bf16(a[4 * g + 2], a[4 * g + 3]);
                *(LAS v2u*)(L + GL_AT + (32 * ct + cl) * 144 + (32 * st + 8 * g + 4 * hh) * 2) = w; }
        } else GL_UPD(bo);
        DT1(35); if (wave >= 4) __builtin_amdgcn_s_setprio(0);
        __syncthreads();
        if (attw) GL_UPD(bo);
        if (wave < 4) {
            f32x16 o;
#pragma unroll
            for (int i = 0; i < 16; ++i) o[i] = 0.f;
            bf16x8_t fv[4], fa[4], fs[4], fq[4]; tr_frag4(Lb + bo + GL_VZ, tv, fv);
            v2u zc[4];
#pragma unroll
            for (int ks = 0; ks < 4; ++ks) { fa[ks] = GL_PADF(GL_AT, 144, 32 * dt + cl, ks); fs[ks] = GL_PADF(GL_SBT, 272, 32 * vt + cl, ks); fq[ks] = GL_ROWF(bo + GL_QT, 32 * dt + cl, ks); }
            asm volatile("s_waitcnt lgkmcnt(0)" ::: "memory");
            o = __builtin_amdgcn_mfma_f32_32x32x16_bf16(fv[0], fa[0], o, 0, 0, 0);
            o = __builtin_amdgcn_mfma_f32_32x32x16_bf16(fv[1], fa[1], o, 0, 0, 0);
            if (dt) { o = __builtin_amdgcn_mfma_f32_32x32x16_bf16(fv[2], fa[2], o, 0, 0, 0); o = __builtin_amdgcn_mfma_f32_32x32x16_bf16(fv[3], fa[3], o, 0, 0, 0); }
#pragma unroll
            for (int ks = 0; ks < 4; ++ks) o = __builtin_amdgcn_mfma_f32_32x32x16_bf16(fs[ks], fq[ks], o, 0, 0, 0);
#pragma unroll
            for (int ks = 0; ks < 4; ++ks) { fs[ks] = GL_PADF(GL_SBT, 272, 32 * vt + cl, 4 + ks); fq[ks] = GL_ROWF(bo + GL_QT, 32 * dt + cl, 4 + ks); }
#pragma unroll
            for (int g = 0; g < 4; ++g) zc[g] = *(const LAS v2u*)(L + bo + GL_VZ + off_b(32 * dt + cl, 8 + 4 * vt + g) + 8 * hh);
            asm volatile("s_waitcnt lgkmcnt(0)" ::: "memory");
#pragma unroll
            for (int ks = 0; ks < 4; ++ks) o = __builtin_amdgcn_mfma_f32_32x32x16_bf16(fs[ks], fq[ks], o, 0, 0, 0);
            float ss = 0.f;
#pragma unroll
            for (int i = 0; i < 16; ++i) ss += o[i] * o[i];
            ss += __shfl_xor(ss, 32);
            const size_t row = row0 + (size_t)n * 64 + 32 * dt + cl;
            if (hh == 0) F.PSS[(size_t)(h * 8 + vs * 2 + vt) * NROWP + row] = ss;
#pragma unroll
            for (int g = 0; g < 4; ++g) {
                const float y0 = o[4 * g] * bflo(zc[g].x), y1 = o[4 * g + 1] * bfhi(zc[g].x), y2 = o[4 * g + 2] * bflo(zc[g].y), y3 = o[4 * g + 3] * bfhi(zc[g].y);
                v2u w; w.x = pg8::cvt_pk_bf16(y0, y1); w.y = pg8::cvt_pk_bf16(y2, y3); *(LAS v2u*)(L + GL_YL + (32 * dt + cl) * 144 + (32 * vt + 8 * g + 4 * hh) * 2) = w; }
        }
          }
#undef SET_
    }
    __syncthreads();
    *(GAS v4u*)(F.YMIX + (row0 + (size_t)(TP / 64 - 1) * 64 + vrow) * DMIX + 1024 + h * 256 + vs * 64 + vch * 8) = *(const LAS v4u*)(L + GL_YL + vrow * 144 + vch * 16);
    float* so = F.out + O_GP + (((size_t)b * NH + h) * HK + 32 * dt) * HV + vs * 64 + 32 * vt + cl;
#pragma unroll
    for (int i = 0; i < 16; ++i) so[(size_t)((i & 3) + 8 * (i >> 2) + 4 * hh) * HV] = Sacc[i];
    __syncthreads();
#ifdef DIAG_DUR
    if (blockIdx.x == DIAG_WG && tid == DIAG_WAVE * 64) __hip_atomic_fetch_max((unsigned long long*)((unsigned char*)F.ctl + CW_DIAG * 4) + 1, acc_, __ATOMIC_RELAXED, __HIP_MEMORY_SCOPE_AGENT);
#endif
#if defined(DIAG_ID) && DIAG_ID == 6
    if (tid == 0) __hip_atomic_fetch_max((unsigned long long*)((unsigned char*)F.ctl + CW_DIAG * 4) + 1, (unsigned long long)__builtin_amdgcn_s_memrealtime(), __ATOMIC_RELAXED, __HIP_MEMORY_SCOPE_AGENT);
#endif
#undef GL_LOAD
#undef GL_STAGE
#undef GL_ROWF
#undef GL_PADF
#undef GL_UPD
}
__device__ __forceinline__ void p2b_norm(Frame& F) {
    const int gw = F.vcu * NWAVES + F.wave, NGW = F.G * NWAVES;
    for (int r = gw; r < NROWP; r += NGW) {
        const int hd = F.lane >> 4;
        float tot = 0.f;
#pragma unroll
        for (int k = 0; k < 8; ++k) tot += F.PSS[(size_t)(hd * 8 + k) * NROWP + r];
        const float rs = rsqrtf(tot * (1.f / 256.f) + EPS);
        GAS v4u* yp = (GAS v4u*)(F.YMIX + (size_t)r * DMIX + 1024 + F.lane * 16);
#pragma unroll
        for (int q = 0; q < 2; ++q) { v4u w = yp[q];
            w.x = pk2(bflo(w.x) * rs, bfhi(w.x) * rs); w.y = pk2(bflo(w.y) * rs, bfhi(w.y) * rs); w.z = pk2(bflo(w.z) * rs, bfhi(w.z) * rs); w.w = pk2(bflo(w.w) * rs, bfhi(w.w) * rs); yp[q] = w; }
    }
}

constexpr int GS_Q = 0, GS_K = 4096, GS_V = 8192, GS_DEC = 16384, GS_ATT = 16896, GS_OP = 17408, GS_END = GS_OP + 8 * 8 * 256 * 4;
static_assert(GS_END <= RING_BYTES, "GLA sample LDS map");
struct GlsSmall { unsigned q2, k2; v2u vv, zz; float dec; };
__device__ __forceinline__ const float* gls_state_ptr(const Frame& F, int it, int tid) { return F.st_gla + (((size_t)(it >> 2) * NH + (it & 3)) * HK + 16 * (tid >> 6)) * HV + 4 * (tid & 63); }
__device__ __forceinline__ void gls_small(const Frame& F, int it, int tid, GlsSmall& P) {
    const int seq = it >> 2, h = it & 3, t = tid >> 6, c = tid & 63; const bf16* pr = F.PROJ + ((size_t)NROWP + (size_t)seq * TS + t) * DINP;
    P.q2 = *(const GAS unsigned*)(pr + C_Q + h * 128 + 2 * c); P.k2 = *(const GAS unsigned*)(pr + C_K + h * 128 + 2 * c);
    P.vv = *(const GAS v2u*)(pr + C_V + h * 256 + 4 * c);
    P.zz = *(const GAS v2u*)(pr + C_ZG + h * 256 + 4 * c);
    P.dec = F.DEC[(size_t)(NP * (TP / 64) + seq) * 512 + h * 128 + (tid & 127)];
}
__device__ __forceinline__ void gla_sample_chain(const Frame& F, int first, int count) {
    int tid = F.tid; asm volatile("" : "+v"(tid));
    const int lane = tid & 63, wave = F.wave, v4 = tid & 63, dg = wave;
    LAS float* Lq = (LAS float*)(F.lds + RING_OFF + GS_Q);
    LAS float* Lk = (LAS float*)(F.lds + RING_OFF + GS_K);
    LAS float* Lv = (LAS float*)(F.lds + RING_OFF + GS_V);
    LAS float* Ld = (LAS float*)(F.lds + RING_OFF + GS_DEC);
    LAS float* La = (LAS float*)(F.lds + RING_OFF + GS_ATT);
    LAS float* Lo = (LAS float*)(F.lds + RING_OFF + GS_OP);
    f32x4 S[16]; GlsSmall P, Pn;
    int a = first; const int last = first + count - 1;
    const int voff = ((16 * (tid >> 6)) * HV + 4 * (tid & 63)) * 4;
#define GLS_RSRC(base, it) __builtin_amdgcn_make_buffer_rsrc((void*)((base) + (size_t)(it) * (HK * HV)), 0, HK * HV * 4, 0x00020000)
#ifdef CHAIN_GLOBAL
#define GLS_LD(r, base, it, i) (*(const GAS f32x4*)((base) + (size_t)(it) * (HK * HV) + (size_t)(16 * (tid >> 6) + (i)) * HV + 4 * (tid & 63)))
#define GLS_ST(val, r, base, it, i) (*(GAS f32x4*)((base) + (size_t)(it) * (HK * HV) + (size_t)(16 * (tid >> 6) + (i)) * HV + 4 * (tid & 63)) = (val))
#else
#define GLS_LD(r, base, it, i) __builtin_bit_cast(f32x4, __builtin_amdgcn_raw_buffer_load_b128(r, voff, (i) * HV * 4, 0))
#define GLS_ST(val, r, base, it, i) __builtin_amdgcn_raw_buffer_store_b128(__builtin_bit_cast(v4u, (val)), r, voff, (i) * HV * 4, 0)
#endif
    { const __amdgpu_buffer_rsrc_t r0 = GLS_RSRC(F.st_gla, a);
      gls_small(F, a, tid, P);
#pragma unroll
      for (int i = 0; i < 16; ++i) S[i] = GLS_LD(r0, F.st_gla, a, i); }
    for (;;) {
        __syncthreads();
#ifdef CHAIN_VMWAIT
        VM_WAIT();
#endif
        const int b = a + 1; const bool nb = a < last;
        const __amdgpu_buffer_rsrc_t r1 = __builtin_amdgcn_make_buffer_rsrc((void*)(F.st_gla + (size_t)(nb ? b : a) * (HK * HV)), 0, nb ? HK * HV * 4 : 0, 0x00020000), rO = GLS_RSRC(F.out + O_GS, a);
        if (nb) gls_small(F, b, tid, Pn);
        const int seq = a >> 2, h = a & 3; const size_t row0 = (size_t)NROWP + (size_t)seq * TS;
        { const int t = tid >> 6, c = tid & 63;
          Lq[t * 128 + 2 * c] = bflo(P.q2); Lq[t * 128 + 2 * c + 1] = bfhi(P.q2); Lk[t * 128 + 2 * c] = bflo(P.k2); Lk[t * 128 + 2 * c + 1] = bfhi(P.k2);
          *(LAS f32x4*)(Lv + t * 256 + 4 * c) = (f32x4){bflo(P.vv.x), bfhi(P.vv.x), bflo(P.vv.y), bfhi(P.vv.y)};
          if (tid < 128) Ld[tid] = P.dec; }
        __syncthreads();
        if (wave == 0) { const int t = lane >> 3, s = lane & 7; float av = 0.f;
            for (int d = 0; d < 128; d += 4) { const f32x4 q = *(const LAS f32x4*)(Lq + t * 128 + d), k = *(const LAS f32x4*)(Lk + s * 128 + d); av += (q.x * k.x + q.y * k.y) + (q.z * k.z + q.w * k.w); }
            La[lane] = s <= t ? av : 0.f; }
        f32x4 o[8];
#pragma unroll
        for (int t = 0; t < 8; ++t) o[t] = (f32x4){0.f, 0.f, 0.f, 0.f};
        f32x4 vr[8];
#pragma unroll
        for (int t = 0; t < 8; ++t) vr[t] = *(const LAS f32x4*)(Lv + t * 256 + 4 * v4);
#pragma unroll
        for (int hf = 0; hf < 2; ++hf) {
#pragma unroll
            for (int i2 = 0; i2 < 8; i2 += 2) { const int i = 8 * hf + i2, d = 16 * dg + i;
                typedef float f32x2 __attribute__((ext_vector_type(2)));
                f32x2 qv[8], kv[8];
#pragma unroll
                for (int t = 0; t < 8; ++t) { qv[t] = *(const LAS f32x2*)(Lq + t * 128 + d); kv[t] = *(const LAS f32x2*)(Lk + t * 128 + d); }
                const f32x2 dv = *(const LAS f32x2*)(Ld + d);
                f32x4 sn0 = S[i], sn1 = S[i + 1];
#pragma unroll
                for (int t = 0; t < 8; ++t) { o[t] += qv[t].x * S[i]; sn0 += kv[t].x * vr[t]; o[t] += qv[t].y * S[i + 1]; sn1 += kv[t].y * vr[t]; }
                GLS_ST(sn0 * dv.x, rO, F.out + O_GS, a, i); GLS_ST(sn1 * dv.y, rO, F.out + O_GS, a, i + 1);
                asm volatile("" ::: "memory"); }
#pragma unroll
            for (int i8 = 0; i8 < 8; ++i8) S[8 * hf + i8] = GLS_LD(r1, F.st_gla, nb ? b : a, 8 * hf + i8);
            asm volatile("" ::: "memory");
        }
#pragma unroll
        for (int t = 0; t < 8; ++t) *(LAS f32x4*)(Lo + (dg * 8 + t) * 256 + 4 * v4) = o[t];
        __syncthreads();
        { const int t = wave; f32x4 acc = (f32x4){0.f, 0.f, 0.f, 0.f};
#pragma unroll
          for (int g = 0; g < 8; ++g) acc += *(const LAS f32x4*)(Lo + (g * 8 + t) * 256 + 4 * v4);
#pragma unroll
          for (int s = 0; s < 8; ++s) acc += La[t * 8 + s] * vr[s];
          const float ss = wave_sum((acc.x * acc.x + acc.y * acc.y) + (acc.z * acc.z + acc.w * acc.w));
          const float rs = rsqrtf(ss * (1.f / 256.f) + EPS);
          const float z0 = bflo(P.zz.x), z1 = bfhi(P.zz.x), z2 = bflo(P.zz.y), z3 = bfhi(P.zz.y);
          v2u w; w.x = pk2(acc.x * rs * z0, acc.y * rs * z1); w.y = pk2(acc.z * rs * z2, acc.w * rs * z3);
          __builtin_amdgcn_raw_buffer_store_b64(w, __builtin_amdgcn_make_buffer_rsrc((void*)F.YMIX, 0, 0x7fffffff, 0x00020000), (int)(((row0 + t) * DMIX + 1024 + h * 256 + 4 * v4) * 2), 0, 16); }
        if (!nb) break;
        a = b; P = Pn;
    }
#undef GLS_RSRC
#undef GLS_LD
#undef GLS_ST
}

struct GlsPre { f32x4 S[16]; unsigned q2, k2; v2u vv, zz; float dec; };
__device__ __forceinline__ void gls_load(const Frame& F, int seq, int h, GlsPre& P) {
    int tid = F.tid; asm volatile("" : "+v"(tid));
    const int v4 = tid & 63, dg = tid >> 6;
    const size_t row0 = (size_t)NROWP + (size_t)seq * TS;
    const float* s0 = F.st_gla + (((size_t)seq * NH + h) * HK + 16 * dg) * HV + 4 * v4;
#pragma unroll
    for (int i = 0; i < 16; ++i) P.S[i] = *(const GAS f32x4*)(s0 + (size_t)i * HV);
    const int t = tid >> 6, c = tid & 63; const bf16* pr = F.PROJ + (row0 + t) * DINP;
    P.q2 = *(const GAS unsigned*)(pr + C_Q + h * 128 + 2 * c); P.k2 = *(const GAS unsigned*)(pr + C_K + h * 128 + 2 * c);
    P.vv = *(const GAS v2u*)(pr + C_V + h * 256 + 4 * c);
    P.zz = *(const GAS v2u*)(pr + C_ZG + h * 256 + 4 * c);
    P.dec = F.DEC[(size_t)(NP * (TP / 64) + seq) * 512 + h * 128 + (tid & 127)];
}
__device__ __forceinline__ void gls_compute(const Frame& F, int seq, int h, const GlsPre& P) {
    int tid = F.tid; asm volatile("" : "+v"(tid));
    const int lane = tid & 63, wave = F.wave, v4 = tid & 63, dg = wave;
    LAS float* Lq = (LAS float*)(F.lds + RING_OFF + GS_Q);
    LAS float* Lk = (LAS float*)(F.lds + RING_OFF + GS_K);
    LAS float* Lv = (LAS float*)(F.lds + RING_OFF + GS_V);
    LAS float* Ld = (LAS float*)(F.lds + RING_OFF + GS_DEC);
    LAS float* La = (LAS float*)(F.lds + RING_OFF + GS_ATT);
    LAS float* Lo = (LAS float*)(F.lds + RING_OFF + GS_OP);
    const size_t row0 = (size_t)NROWP + (size_t)seq * TS;
    __syncthreads();
    { const int t = tid >> 6, c = tid & 63;
      Lq[t * 128 + 2 * c] = bflo(P.q2); Lq[t * 128 + 2 * c + 1] = bfhi(P.q2); Lk[t * 128 + 2 * c] = bflo(P.k2); Lk[t * 128 + 2 * c + 1] = bfhi(P.k2);
      *(LAS f32x4*)(Lv + t * 256 + 4 * c) = (f32x4){bflo(P.vv.x), bfhi(P.vv.x), bflo(P.vv.y), bfhi(P.vv.y)};
      if (tid < 128) Ld[tid] = P.dec; }
    __syncthreads();
    if (wave == 0) { const int t = lane >> 3, s = lane & 7; float a = 0.f;
        for (int d = 0; d < 128; d += 4) { const f32x4 q = *(const LAS f32x4*)(Lq + t * 128 + d), k = *(const LAS f32x4*)(Lk + s * 128 + d); a += (q.x * k.x + q.y * k.y) + (q.z * k.z + q.w * k.w); }
        La[lane] = s <= t ? a : 0.f; }
    f32x4 o[8];
#pragma unroll
    for (int t = 0; t < 8; ++t) o[t] = (f32x4){0.f, 0.f, 0.f, 0.f};
    f32x4 vr[8];
#pragma unroll
    for (int t = 0; t < 8; ++t) vr[t] = *(const LAS f32x4*)(Lv + t * 256 + 4 * v4);
    float* so = F.out + O_GS + (((size_t)seq * NH + h) * HK + 16 * dg) * HV + 4 * v4;
#pragma unroll
    for (int i = 0; i < 16; ++i) { const int d = 16 * dg + i; f32x4 sn = P.S[i];
#pragma unroll
        for (int t = 0; t < 8; ++t) { const float q = Lq[t * 128 + d], k = Lk[t * 128 + d]; o[t] += q * P.S[i]; sn += k * vr[t]; }
        *(GAS f32x4*)(so + (size_t)i * HV) = sn * Ld[d]; }
#pragma unroll
    for (int t = 0; t < 8; ++t) *(LAS f32x4*)(Lo + (dg * 8 + t) * 256 + 4 * v4) = o[t];
    __syncthreads();
    { const int t = wave; f32x4 a = (f32x4){0.f, 0.f, 0.f, 0.f};
#pragma unroll
      for (int g = 0; g < 8; ++g) a += *(const LAS f32x4*)(Lo + (g * 8 + t) * 256 + 4 * v4);
#pragma unroll
      for (int s = 0; s < 8; ++s) a += La[t * 8 + s] * vr[s];
      const float ss = wave_sum((a.x * a.x + a.y * a.y) + (a.z * a.z + a.w * a.w));
      const float rs = rsqrtf(ss * (1.f / 256.f) + EPS);
      const float z0 = bflo(P.zz.x), z1 = bfhi(P.zz.x), z2 = bflo(P.zz.y), z3 = bfhi(P.zz.y);
      v2u w; w.x = pk2(a.x * rs * z0, a.y * rs * z1); w.y = pk2(a.z * rs * z2, a.w * rs * z3);
      if (LATE_SAMPLE) __builtin_amdgcn_raw_buffer_store_b64(w, __builtin_amdgcn_make_buffer_rsrc((void*)F.YMIX, 0, 0x7fffffff, 0x00020000), (int)(((row0 + t) * DMIX + 1024 + h * 256 + 4 * v4) * 2), 0, 16);
      else *(GAS v2u*)(F.YMIX + (row0 + t) * DMIX + 1024 + h * 256 + 4 * v4) = w; }
}
__device__ __forceinline__ void gla_sample_item(const Frame& F, int seq, int h) { GlsPre P; gls_load(F, seq, h, P); gls_compute(F, seq, h, P); }

__device__ __forceinline__ bool tail_ws(const Frame& F) { return TAIL_SAMPLE && F.G == 256 && DUP_PHASE < 0; }
constexpr int GEMM1_WGS = 232;
__device__ __forceinline__ void p1_tail_sample(Frame& F, unsigned* cnt) {
    const int j = (int)blockIdx.x - GEMM1_WGS, nj = 256 - GEMM1_WGS;
    if (F.tid < 64) { unsigned sp = 0;
        while ((unsigned)__builtin_amdgcn_readfirstlane(__hip_atomic_load(cnt, __ATOMIC_RELAXED, __HIP_MEMORY_SCOPE_AGENT)) < 80u * 8u) { __builtin_amdgcn_s_sleep(8); if (++sp > (1u << 22)) break; }
        __builtin_amdgcn_fence(__ATOMIC_ACQUIRE, "agent");
        asm volatile("s_waitcnt vmcnt(0)" ::: "memory"); }
    __syncthreads();
    for (int it = j; it < NS * NH; it += nj) gla_sample_item(F, it >> 2, it & 3);
    __syncthreads();
}
#ifndef SPLIT_P1
#define SPLIT_P1 1
#endif
__device__ __forceinline__ bool split_p1(const Frame& F) { return SPLIT_P1 && F.G == 256 && DUP_PHASE < 0; }
__device__ __forceinline__ void wait_count(Frame& F, unsigned* cnt, unsigned target) {
    if (F.tid < 64) { unsigned sp = 0;
        for (;;) { unsigned v = F.lane < 8 ? __hip_atomic_load(cnt + 64 * F.lane, __ATOMIC_RELAXED, __HIP_MEMORY_SCOPE_AGENT) : 0u;
            v += __shfl_xor(v, 1); v += __shfl_xor(v, 2); v += __shfl_xor(v, 4);
            if ((unsigned)__builtin_amdgcn_readfirstlane(v) >= target) break;
            __builtin_amdgcn_s_sleep(8); if (++sp > (1u << 22)) break; }
        __builtin_amdgcn_fence(__ATOMIC_ACQUIRE, "agent");
        asm volatile("s_waitcnt vmcnt(0)" ::: "memory"); }
    __syncthreads();
}
__device__ __forceinline__ void wait_sample_units(Frame& F, unsigned* cnt) { wait_count(F, cnt, 80u * 8u); }
__device__ __forceinline__ void p12_mix(Frame& F, unsigned* cnt) {
    const int c = (int)blockIdx.x;
    if (c < 128) gla_item(F, c >> 4, (c >> 2) & 3, c & 3); else lru_item<0>(F, (c - 128) >> 4, (c - 128) & 15);
    if (c < 80) PSTAMP(10); else if (c < 128) PSTAMP(11); else PSTAMP(12);
    if (LATE_SAMPLE) return;
    wait_sample_units(F, cnt);
    PSTAMP(13);
    unsigned* head = cnt + 512;
    volatile LAS unsigned* slot = F.MISC + 16;
    for (;;) {
        if (F.tid == 0) slot[0] = __hip_atomic_fetch_add(head, 1u, __ATOMIC_RELAXED, __HIP_MEMORY_SCOPE_AGENT);
        __syncthreads();
        const int it = (int)slot[0];
        __syncthreads();
        if (it >= 64 + NS * NH) break;
        if (it < 64) lru_item<1>(F, it >> 4, it & 15); else gla_sample_item(F, (it - 64) >> 2, (it - 64) & 3);
    }
}
__device__ __forceinline__ void p3_late(Frame& F, unsigned* cntS) {
    const int c = (int)blockIdx.x;
    unsigned* cntQ = cntS + 1024;
    if (c < 80) {
        pg8::Gemm g{F.XN, F.WinT, NTOK, DINP, D}; pg8::OneUnit S{NROWP / 256 + c / 20, c % 20, 0, 0, -1};
        pg8::EpiProj E{F.PROJ, DINP, F.BCUM, F.g_head, NROWP / 256};
        pg8::gemm_phase<pg8::EpiProj, pg8::OneUnit, true, true>(F.lds + RING_OFF, g, S, E);
        if (F.tid == 0) __hip_atomic_fetch_add(cntS + 64 * (c & 7), 8u, __ATOMIC_RELAXED, __HIP_MEMORY_SCOPE_AGENT);
    }
    PSTAMP(14);
    { pg8::Gemm g{F.YMIX, F.WoutT, NTOK, D, DMIX}; pg8::Gemm2Order S; S.init(NROWP, NROWP, D, DMIX, 8, F.G, c);
      pg8::EpiY E{F.YBF, D, F.YS, NROWP, (size_t)NROWS * D};
      pg8::HeadScale KSc{F.PSS, NROWP, EPS};
      pg8::gemm_phase<pg8::EpiY, pg8::Gemm2Order, true, true, pg8::HeadScale>(F.lds + RING_OFF, g, S, E, KSc); }
    if (c < 80) PSTAMP(17); else PSTAMP(15);
    if (c < 80) return;
    wait_count(F, cntS, 80u * 8u);
    const int j = c - 80;
    if (j < 64) lru_item<1>(F, j >> 4, j & 15);
    const int gfirst = j < 64 ? 2 * j : (j < 112 ? 128 + 4 * (j - 64) : 320 + 3 * (j - 112)), gcount = j < 64 ? 2 : (j < 112 ? 4 : 3);
#ifdef NO_CHAIN
    for (int k = 0; k < gcount; ++k) gla_sample_item(F, (gfirst + k) >> 2, (gfirst + k) & 3);
#elif defined(CHAIN_ONE)
    for (int k = 0; k < gcount; ++k) gla_sample_chain(F, gfirst + k, 1);
#else
    gla_sample_chain(F, gfirst, gcount);
#endif
    const unsigned ndone = (unsigned)gcount + (j < 64 ? 1u : 0u);
    VM_WAIT();
    __syncthreads();
    if (F.tid == 0 && ndone) __hip_atomic_fetch_add(cntQ + 64 * (c & 7), ndone, __ATOMIC_RELAXED, __HIP_MEMORY_SCOPE_AGENT);
    PSTAMP(16);
    const int L = c - 80;
    if (L < 128) {
        wait_count(F, cntQ, 64u + NS * NH);
        pg8::Gemm g{F.YMIX, F.WoutT, NTOK, D, DMIX}; pg8::OneUnit S{NROWP / 256 + (L >> 3) / 4, (L >> 3) % 4, (L & 7) * 4, 4, L & 7};
        pg8::EpiY E{F.YBF, D, F.YS, NROWP, (size_t)NROWS * D};
        pg8::gemm_phase<pg8::EpiY, pg8::OneUnit, true, true>(F.lds + RING_OFF, g, S, E);
    }
}
__device__ __forceinline__ void p2_mix_simple(Frame& F) {
    if (tail_ws(F)) {
        const int v = F.vcu;
        if (v < 128) lru_item<0>(F, v >> 4, v & 15); else { const int g = v - 128; gla_item(F, g >> 4, (g >> 2) & 3, g & 3); if (g < 64) lru_item<1>(F, g >> 4, g & 15); }
        __syncthreads();
        return;
    }
    for (int it = F.vcu; it < 2 * NP * 16; it += F.G) {
        if (it < NP * 16) { for (int rep = 0; rep < (DUP_PHASE == 6 ? 2 : 1); ++rep) lru_item<0>(F, it >> 4, it & 15); }
        else { const int g = it - NP * 16; for (int rep = 0; rep < (DUP_PHASE == 7 ? 2 : 1); ++rep) gla_item(F, g >> 4, (g >> 2) & 3, g & 3); }
    }
    for (int rep = 0; rep < (DUP_PHASE == 8 ? 2 : 1); ++rep) for (int it = F.vcu; it < 4 * 16; it += F.G) lru_item<1>(F, it >> 4, it & 15);
    for (int rep = 0; rep < (DUP_PHASE == 9 ? 2 : 1); ++rep) for (int it = F.vcu; it < NS * NH; it += F.G) gla_sample_item(F, it >> 2, it & 3);
    __syncthreads();
}

__device__ __forceinline__ void p4_final(Frame& F) {
    int gw = F.vcu * NWAVES + F.wave, NGW = F.G * NWAVES;
    if (FUSE_P4 && !LATE_SAMPLE) {
        const int c = (int)blockIdx.x; if ((c & 63) < 32) return;
        gw = NROWP + ((c >> 6) * 32 + (c & 63) - 32) * NWAVES + F.wave; NGW = NTOK; }
    const GAS f32x4* gp = (const GAS f32x4*)F.g_post + F.lane;
    f32x4 g[4];
#pragma unroll
    for (int j = 0; j < 4; ++j) g[j] = gp[64 * j];
    for (int r = gw; r < NTOK; r += NGW) {
        const float* xrow = r < NROWP ? F.xp + (size_t)r * D : F.xs + (size_t)(r - NROWP) * D;
        const GAS f32x4* xr = (const GAS f32x4*)xrow + F.lane;
        f32x4 y[4], x[4];
#pragma unroll
        for (int j = 0; j < 4; ++j) x[j] = xr[64 * j];
        if (r < NROWP) { const GAS v2u* yr = (const GAS v2u*)(F.YBF + (size_t)r * D) + F.lane;
#pragma unroll
            for (int j = 0; j < 4; ++j) { const v2u w = yr[64 * j]; y[j] = (f32x4){bflo(w.x), bfhi(w.x), bflo(w.y), bfhi(w.y)}; }
        } else {
#pragma unroll
            for (int j = 0; j < 4; ++j) y[j] = (f32x4){0.f, 0.f, 0.f, 0.f};
#pragma unroll
            for (int s = 0; s < 8; ++s) { const GAS v2u* yr = (const GAS v2u*)(F.YS + ((size_t)s * NROWS + (r - NROWP)) * D) + F.lane;
#pragma unroll
                for (int j = 0; j < 4; ++j) { const v2u w = yr[64 * j]; y[j] += (f32x4){bflo(w.x), bfhi(w.x), bflo(w.y), bfhi(w.y)}; } }
        }
        float ss = 0.f;
#pragma unroll
        for (int j = 0; j < 4; ++j) ss += (y[j].x * y[j].x + y[j].y * y[j].y) + (y[j].z * y[j].z + y[j].w * y[j].w);
        const float rs = rsqrtf(wave_sum(ss) * (1.f / D) + EPS);
        GAS f32x4* orow = (GAS f32x4*)(F.out + (size_t)r * D) + F.lane;
#pragma unroll
        for (int j = 0; j < 4; ++j) orow[64 * j] = x[j] + y[j] * rs * g[j];
    }
}


struct Args { const float* in[19]; float* out; unsigned char* ws; int ph_lo, ph_hi, li, pad; };
__global__ void __launch_bounds__(NWAVES * 64, 2) mk_fwd(Args args) {
    extern __shared__ __attribute__((aligned(16))) unsigned char lds[];
    Frame F;
    F.lds = (LAS unsigned char*)lds;
    F.MISC = (volatile LAS unsigned*)(F.lds + MISC_OFF);
    F.tid = threadIdx.x; F.lane = F.tid & 63; F.wave = __builtin_amdgcn_readfirstlane(F.tid >> 6);
    F.G = gridDim.x; { const int bx = blockIdx.x; F.vcu = (F.G % 8 == 0) ? (bx % 8) * (F.G / 8) + bx / 8 : bx; }
    unsigned char* ws = args.ws;
    F.ctl = (gu32*)(ws + WS_CTL);
    F.xp = args.in[0]; F.xs = args.in[1]; F.st_h = args.in[2]; F.st_conv = args.in[3]; F.st_gla = args.in[4]; F.g_pre = args.in[5]; F.w_in = args.in[6];
    F.conv_w = args.in[7]; F.conv_b = args.in[8]; F.w_rg = args.in[9]; F.b_rg = args.in[10]; F.w_ig = args.in[11]; F.b_ig = args.in[12]; F.lam = args.in[13];
    F.w_gk2 = args.in[14]; F.b_gk = args.in[15]; F.g_head = args.in[16]; F.w_out = args.in[17]; F.g_post = args.in[18];
    F.out = args.out;
    F.WinT = (bf16*)(ws + WS_WINT); F.WoutT = (bf16*)(ws + WS_WOUT); F.XN = (bf16*)(ws + WS_XN); F.PROJ = (bf16*)(ws + WS_PROJ);
    F.YMIX = (bf16*)args.out;
    F.YBF = (bf16*)(ws + WS_XN);
    F.RGK = (float*)(ws + WS_RGK); F.PART = (float*)(ws + WS_PART); F.DEC = (float*)(ws + WS_DEC); F.PSS = (float*)(ws + WS_RGK); F.C8 = (float*)(ws + WS_PART); F.YS = (bf16*)(ws + WS_YS);
    F.BCUM = TAIL_SAMPLE ? args.out : args.out + O_GS;
    for (int u = F.tid; u < (LDS_BYTES - LDSCTL_OFF) / 4; u += NWAVES * 64) ((LAS unsigned*)(F.lds + LDSCTL_OFF))[u] = 0u;
    __syncthreads();
    XcdBarrier bar; bar.bar = (unsigned*)(F.ctl + CW_BAR); bar.x = 0; bar.st = nullptr;
    if (N_LAUNCHES == 1) bar = xcd_barrier_post((unsigned*)(F.ctl + CW_BAR), F.MISC + 8);
    if (N_LAUNCHES == 1 && (int)blockIdx.x < CHAIN_NS && F.tid == 0) (void)xb_add((unsigned*)(F.ctl + CW_CHAINBAR) + CB_CENSUS(bar.x), 1u);
#define GRID_BAR() do { if (N_LAUNCHES == 1) xcd_barrier(bar); } while (0)
    const int lo = args.ph_lo, hi = args.ph_hi;
#ifdef DIAG_ID
#define dg ((unsigned long long*)(args.ws + WS_CTL + CW_DIAG * 4))
    if (F.tid == 0) { __hip_atomic_fetch_max(dg, ~(unsigned long long)__builtin_amdgcn_s_memrealtime(), __ATOMIC_RELAXED, __HIP_MEMORY_SCOPE_AGENT); }
#ifndef DIAG_ID0
#define DIAG_ID0 -1
#endif
#define STAMP(id) do { if ((DIAG_ID == (id) || DIAG_ID0 == (id)) && F.tid == 0) __hip_atomic_fetch_max(dg + (DIAG_ID == (id) ? 1 : 2), (unsigned long long)__builtin_amdgcn_s_memrealtime(), __ATOMIC_RELAXED, __HIP_MEMORY_SCOPE_AGENT); } while (0)
#else
#define STAMP(id) do {} while (0)
#endif
#ifndef PH_MASK
#define PH_MASK 31
#endif
#define IN(k) (lo <= (k) && (k) < hi && ((PH_MASK >> (k)) & 1))
#define BOTH(k) (IN(k) && IN((k) + 1))
#ifndef MK_FALLBACK
#define MK_FALLBACK 0
#endif
#ifndef DUP_PHASE
#define DUP_PHASE -1
#endif
#define REPS(k) for (int rep_ = 0; rep_ < ((DUP_PHASE == (k)) ? 2 : 1); ++rep_)
    if (IN(0)) { REPS(0) { p0_prologue(F); STAMP(0); if (BOTH(0)) GRID_BAR(); } }
    if (split_p1(F)) {
        if (IN(1)) {
            unsigned* cntS = (unsigned*)(F.ctl + CW_SAMPLE);
            pg8::Gemm g{F.XN, F.WinT, NTOK, DINP, D}; pg8::Gemm1Chain S; S.init(NROWP, DINP, (int)blockIdx.x, cntS, &bar, (unsigned*)(F.ctl + CW_CHAINBAR));
            pg8::EpiProj E{F.PROJ, DINP, F.BCUM, F.g_head, NROWP / 256};
            pg8::gemm_phase<pg8::EpiProj, pg8::Gemm1Chain, true, true>(F.lds + RING_OFF, g, S, E);
            S.chain_end();
            STAMP(1);
            p12_mix(F, cntS);
            STAMP(2);
            GRID_BAR();
#if LATE_SAMPLE
            p3_late(F, cntS);
            STAMP(3);
            GRID_BAR();
#endif
        }
#if MK_FALLBACK
    } else {
    if (IN(1)) { REPS(1) {
        pg8::Gemm g{F.XN, F.WinT, NTOK, DINP, D}; pg8::EpiProj E{F.PROJ, DINP, F.BCUM, F.g_head, tail_ws(F) ? NROWP / 256 : (1 << 30)};
        if (tail_ws(F)) {
            unsigned* cntS = (unsigned*)(F.ctl + CW_SAMPLE);
            if (blockIdx.x < GEMM1_WGS) { pg8::Gemm1Order S; S.init(NROWP, NTOK, DINP, GEMM1_WGS, (int)blockIdx.x, cntS);
                pg8::gemm_phase<pg8::EpiProj, pg8::Gemm1Order, true, true>(F.lds + RING_OFF, g, S, E); }
            else p1_tail_sample(F, cntS);
        } else {
            pg8::StaticOrder S; S.init(NTOK, DINP, F.G, (int)blockIdx.x);
            pg8::gemm_phase<pg8::EpiProj, pg8::StaticOrder, true, true>(F.lds + RING_OFF, g, S, E);
        }
        STAMP(1); if (BOTH(1)) GRID_BAR(); }
    }
    if (IN(2)) { REPS(2) { p2_mix_simple(F); STAMP(2); if (BOTH(2)) GRID_BAR(); } }
    }
#else
    }
#endif
#if FUSE_P4
    if (IN(3) && !LATE_SAMPLE) {
        unsigned* cntL = (unsigned*)(F.ctl + CW_SAMPLE + 2048);
        pg8::Gemm g{F.YMIX, F.WoutT, NTOK, D, DMIX}; pg8::Gemm2FOrder S; S.init(NROWP, D, DMIX, 8, (int)blockIdx.x, cntL);
        pg8::EpiYF E{F.YS, NROWP, (size_t)NROWS * D, D, F.xp, F.out, F.g_post, (float*)(ws + WS_XBUF), (unsigned*)(F.ctl + CW_ROWS), EPS};
        pg8::HeadScale KSc{F.PSS, NROWP, EPS};
        pg8::gemm_phase<pg8::EpiYF, pg8::Gemm2FOrder, true, true, pg8::HeadScale>(F.lds + RING_OFF, g, S, E, KSc);
        STAMP(3);
        if (((int)blockIdx.x & 63) >= 32) wait_count(F, cntL, 128u * 8u);
    }
#else
    if (IN(3) && !LATE_SAMPLE) { REPS(3) {
        pg8::Gemm g{F.YMIX, F.WoutT, NTOK, D, DMIX}; pg8::Gemm2Order S; S.init(NROWP, NTOK, D, DMIX, 8, F.G, (int)blockIdx.x);
        pg8::EpiY E{F.YBF, D, F.YS, NROWP, (size_t)NROWS * D};
        pg8::HeadScale KSc{F.PSS, NROWP, EPS};
        pg8::gemm_phase<pg8::EpiY, pg8::Gemm2Order, true, true, pg8::HeadScale>(F.lds + RING_OFF, g, S, E, KSc);
        STAMP(3);
        if (BOTH(3)) GRID_BAR(); }
    }
#endif
    if (IN(4)) { REPS(4) { p4_final(F); if (DUP_PHASE == 4) GRID_BAR(); } }
#ifdef DIAG_ID
    STAMP(4);
    GRID_BAR();
    if (blockIdx.x == 0) {
#ifdef DIAG_DUR
        const unsigned long long t0 = 0ull, t1 = __hip_atomic_load(dg + 1, __ATOMIC_RELAXED, __HIP_MEMORY_SCOPE_AGENT);
#else
        const unsigned long long t0 = DIAG_ID0 >= 0 ? __hip_atomic_load(dg + 2, __ATOMIC_RELAXED, __HIP_MEMORY_SCOPE_AGENT) : ~__hip_atomic_load(dg, __ATOMIC_RELAXED, __HIP_MEMORY_SCOPE_AGENT), t1 = __hip_atomic_load(dg + 1, __ATOMIC_RELAXED, __HIP_MEMORY_SCOPE_AGENT);
#endif
#ifndef DIAG_BASE
#define DIAG_BASE 0.f
#define DIAG_SPAN 1000.f
#endif
        const float f = 1.f + ((float)(t1 - t0) * 0.01f - DIAG_BASE) * (1.f / DIAG_SPAN);
        for (int i = F.tid; i < NP * 1024; i += NWAVES * 64) F.out[O_HP + i] *= f; }
#endif
#undef IN
#undef BOTH
}

extern "C" void kernel_launch(void* const* d_in, const int* in_sizes, int n_in, void* d_out, int out_size, void* d_ws, size_t ws_size, hipStream_t stream) {
    static int grid = 0;
    if (grid == 0) {
        if (n_in != 19 || in_sizes[0] != NROWP * D || in_sizes[6] != D * DIN || (size_t)out_size != O_END || ws_size < WS_END) {
            fprintf(stderr, "kernel_launch: unexpected shapes: n_in %d in0 %d in6 %d out %d ws %zu; nothing launched\n", n_in, n_in > 0 ? in_sizes[0] : -1, n_in > 6 ? in_sizes[6] : -1, out_size, ws_size); grid = -1; return; }
        int dev = 0, cus = 0, per_cu = 0;
        if (hipGetDevice(&dev) != hipSuccess || hipDeviceGetAttribute(&cus, hipDeviceAttributeMultiprocessorCount, dev) != hipSuccess) { grid = -1; return; }
        if (hipFuncSetAttribute((const void*)mk_fwd, hipFuncAttributeMaxDynamicSharedMemorySize, LDS_BYTES) != hipSuccess) { fprintf(stderr, "kernel_launch: hipFuncSetAttribute failed\n"); grid = -1; return; }
        if (hipOccupancyMaxActiveBlocksPerMultiprocessor(&per_cu, (const void*)mk_fwd, NWAVES * 64, LDS_BYTES) != hipSuccess || per_cu < 1)
            fprintf(stderr, "kernel_launch: note: occupancy query reports %d workgroups per CU\n", per_cu);
        (void)hipGetLastError();
        grid = cus;
        if (!MK_FALLBACK && grid != 256) { fprintf(stderr, "kernel_launch: this build's phase schedule is for 256 CUs, found %d; rebuild with -DMK_FALLBACK=1 -DSPLIT_P1=0; nothing launched\n", grid); grid = -1; return; }
    }
    if (grid < 0) return;
    if (hipMemsetAsync((char*)d_ws + WS_CTL, 0, CTL_ZERO_BYTES, stream) != hipSuccess) { fprintf(stderr, "kernel_launch: hipMemsetAsync failed\n"); return; }
    Args a{};
    for (int i = 0; i < 19; ++i) a.in[i] = (const float*)d_in[i];
    a.out = (float*)d_out; a.ws = (unsigned char*)d_ws;
    for (int li = 0; li < N_LAUNCHES; ++li) {
        a.ph_lo = (N_LAUNCHES == 1) ? 0 : li; a.ph_hi = (N_LAUNCHES == 1) ? N_PHASES : li + 1; a.li = li;
        hipLaunchKernelGGL(mk_fwd, dim3(grid), dim3(NWAVES * 64), LDS_BYTES, stream, a);
        const hipError_t le = hipPeekAtLastError();
        if (le != hipSuccess) { fprintf(stderr, "kernel_launch: launch %d failed: %s\n", li, hipGetErrorName(le)); break; }
    }
}
```

```cpp
#define MK_N_LAUNCHES 1
#include <hip/hip_runtime.h>
#include <cstdio>
#include <cstdint>
namespace pg8 {
#define PG8_LAS __attribute__((address_space(3)))
typedef unsigned short bf16_t;
typedef short bf16x8 __attribute__((ext_vector_type(8)));
typedef float f32x4 __attribute__((ext_vector_type(4)));
typedef unsigned u32x4 __attribute__((ext_vector_type(4)));
constexpr int BM = 256, BK = 64, HALF = 128, HTB = HALF * BK * 2  , STAGE_BYTES = 8 * HTB, NXCD = 8, WGM = 8;

__host__ __device__ __forceinline__ int lds_byte(int r, int c) { const int st = (r >> 4) * 2 + (c >> 5), rr = r & 15, cc = c & 31, ob = rr * 64 + cc * 2; return st * 1024 + (ob ^ (((ob >> 9) & 1) << 5)); }
__host__ __device__ __forceinline__ void stage_rc(int b, int& R, int& C) { const int st = b / 1024, sb = b % 1024, swz = sb ^ (((sb >> 9) & 1) << 5); R = (st >> 1) * 16 + swz / 64; C = (st & 1) * 32 + (swz % 64) / 2; }
__host__ __device__ __forceinline__ int perm32(int rho) { const int n = rho >> 4, i = rho & 15; return 8 * (i >> 2) + 4 * n + (i & 3); }

struct Unit { int pm, pn, k0, nt, slab; };
struct Gemm { const bf16_t* A; const bf16_t* Bt; int M, N, K; };

struct StaticOrder {
    int nM, nN, nwg, G, c;
    __host__ __device__ void init(int M, int N, int G_, int c_) { nM = M / BM; nN = N / BM; nwg = nM * nN; G = G_; c = c_; }
    __host__ __device__ bool next(int i, Unit& u) const {
        const long L = (long)i * G + c; if (L >= nwg) return false;
        int wgid = (int)L; { const int q = nwg / NXCD, r = nwg % NXCD, xcd = wgid % NXCD, off = wgid / NXCD; wgid = (xcd < r ? xcd * (q + 1) : r * (q + 1) + (xcd - r) * q) + off; }
        const int nig = WGM * nN, gid = wgid / nig, fm = gid * WGM, gsz = (nM - fm) < WGM ? (nM - fm) : WGM;
        u.pm = fm + ((wgid % nig) % gsz); u.pn = (wgid % nig) / gsz; u.k0 = 0; u.nt = 0; u.slab = -1; return true;
    }
    __device__ __forceinline__ void a_ready(const Unit&) const {}
    __device__ __forceinline__ void done(const Unit&, int) const {}
};
__device__ __forceinline__ unsigned cvt_pk_bf16(float lo, float hi) { unsigned r; asm volatile("v_cvt_pk_bf16_f32 %0, %1, %2" : "=v"(r) : "v"(lo), "v"(hi)); return r; }
typedef float f32x2 __attribute__((ext_vector_type(2)));
struct EpiProj {
    static constexpr bool PERM = true, AFTER_DRAIN = false;
    bf16_t* O; int ldc; const float* bcum; const float* ghead;
    int pm_wt;
    __device__ __forceinline__ void operator()(const f32x4 (&acc)[2][2][4][2], const Unit& u, int wr, int wc, int fr, int fq) const {
        const int row0 = u.pm * BM + wr * 64 + fr; const int col0 = u.pn * BM + wc * 32 + 8 * fq;
        const int gk = (u.pn >= 8 && u.pn < 12) ? (u.pn < 10 ? 1 : 2) : (((u.pn >= 4 && u.pn < 8) || u.pn >= 16) ? 3 : 0);
        const float sgn = gk == 1 ? 1.f : -1.f, sc = gk == 1 ? 0.08838834764831845f : 1.f;
#pragma unroll
        for (int ai = 0; ai < 2; ++ai)
#pragma unroll
            for (int m = 0; m < 4; ++m) { const int row = row0 + ai * HALF + m * 16; bf16_t* rowp = O + (size_t)row * ldc + col0;
#pragma unroll
                for (int bj = 0; bj < 2; ++bj) { f32x4 v0 = acc[ai][bj][m][0], v1 = acc[ai][bj][m][1];
                    if (gk == 3) {
#pragma unroll
                        for (int e = 0; e < 4; ++e) { v0[e] *= __builtin_amdgcn_rcpf(1.f + __builtin_amdgcn_exp2f(-1.4426950408889634f * v0[e])); v1[e] *= __builtin_amdgcn_rcpf(1.f + __builtin_amdgcn_exp2f(-1.4426950408889634f * v1[e])); }
                        if (u.pn >= 16) { const float* gp = ghead + ((col0 + bj * HALF) & 255); v0 = v0 * *(const f32x4*)gp; v1 = v1 * *(const f32x4*)(gp + 4); } }
                    else if (gk) { typedef _Float16 h8 __attribute__((ext_vector_type(8)));
                        const h8 hb = *(const h8*)((const _Float16*)bcum + (size_t)row * 512 + (col0 + bj * HALF - (gk == 1 ? 2048 : 2560)));
                        v0[0] *= sc * __builtin_amdgcn_exp2f(sgn * (float)hb[0]); v0[1] *= sc * __builtin_amdgcn_exp2f(sgn * (float)hb[1]); v0[2] *= sc * __builtin_amdgcn_exp2f(sgn * (float)hb[2]); v0[3] *= sc * __builtin_amdgcn_exp2f(sgn * (float)hb[3]);
                        v1[0] *= sc * __builtin_amdgcn_exp2f(sgn * (float)hb[4]); v1[1] *= sc * __builtin_amdgcn_exp2f(sgn * (float)hb[5]); v1[2] *= sc * __builtin_amdgcn_exp2f(sgn * (float)hb[6]); v1[3] *= sc * __builtin_amdgcn_exp2f(sgn * (float)hb[7]); }
                    u32x4 w; w.x = cvt_pk_bf16(v0[0], v0[1]); w.y = cvt_pk_bf16(v0[2], v0[3]); w.z = cvt_pk_bf16(v1[0], v1[1]); w.w = cvt_pk_bf16(v1[2], v1[3]);
                    if (u.pm >= pm_wt) __builtin_amdgcn_raw_buffer_store_b128(w, __builtin_amdgcn_make_buffer_rsrc((void*)O, 0, 0x7fffffff, 0x00020000), (int)(((size_t)row * ldc + col0 + bj * HALF) * 2), 0, 16);
                    else *(u32x4*)(rowp + bj * HALF) = w; } }
    }
};
struct EpiY {
    static constexpr bool PERM = true, AFTER_DRAIN = false;
    bf16_t* O; int ldc; bf16_t* slabs; int row_s; size_t slab_elems;
    __device__ __forceinline__ void operator()(const f32x4 (&acc)[2][2][4][2], const Unit& u, int wr, int wc, int fr, int fq) const {
        const int row0 = u.pm * BM + wr * 64 + fr; const int col0 = u.pn * BM + wc * 32 + 8 * fq;
        bf16_t* base = u.slab >= 0 ? slabs + (size_t)u.slab * slab_elems - (size_t)row_s * ldc : O;
#pragma unroll
        for (int ai = 0; ai < 2; ++ai)
#pragma unroll
            for (int m = 0; m < 4; ++m) { const int row = row0 + ai * HALF + m * 16; bf16_t* rowp = base + (size_t)row * ldc + col0;
#pragma unroll
                for (int bj = 0; bj < 2; ++bj) { const f32x4 v0 = acc[ai][bj][m][0], v1 = acc[ai][bj][m][1];
                    u32x4 w; w.x = cvt_pk_bf16(v0[0], v0[1]); w.y = cvt_pk_bf16(v0[2], v0[3]); w.z = cvt_pk_bf16(v1[0], v1[1]); w.w = cvt_pk_bf16(v1[2], v1[3]);
                    *(u32x4*)(rowp + bj * HALF) = w; } }
    }
};
struct EpiYF {
    static constexpr bool PERM = true, AFTER_DRAIN = true;
    bf16_t* slabs; int row_s; size_t slab_elems; int ldc;
    const float* base; float* out; const float* g; float* xbuf; unsigned* cnt; float eps;
    __device__ __forceinline__ void operator()(const f32x4 (&acc)[2][2][4][2], const Unit& u, int wr, int wc, int fr, int fq) const {
        const int row0 = u.pm * BM + wr * 64 + fr; const int col0 = u.pn * BM + wc * 32 + 8 * fq;
        const __amdgpu_buffer_rsrc_t rs = __builtin_amdgcn_make_buffer_rsrc((void*)slabs, 0, 0x7fffffff, 0x00020000);
        const size_t e0 = (size_t)u.slab * slab_elems - (size_t)row_s * ldc;
#pragma unroll
        for (int ai = 0; ai < 2; ++ai)
#pragma unroll
            for (int m = 0; m < 4; ++m) { const int row = row0 + ai * HALF + m * 16;
#pragma unroll
                for (int bj = 0; bj < 2; ++bj) { const f32x4 v0 = acc[ai][bj][m][0], v1 = acc[ai][bj][m][1];
                    u32x4 w; w.x = cvt_pk_bf16(v0[0], v0[1]); w.y = cvt_pk_bf16(v0[2], v0[3]); w.z = cvt_pk_bf16(v1[0], v1[1]); w.w = cvt_pk_bf16(v1[2], v1[3]);
                    __builtin_amdgcn_raw_buffer_store_b128(w, rs, (int)((e0 + (size_t)row * ldc + col0 + bj * HALF) * 2), 0, 16); } }
    }
    __device__ __forceinline__ void fused(f32x4 (&acc)[2][2][4][2], const Unit& u, int wr, int wc, int fr, int fq, PG8_LAS unsigned char* lds, int wid, int lane) const {
        PG8_LAS float* P = (PG8_LAS float*)lds;
        PG8_LAS float* Sr = (PG8_LAS float*)(lds + 4096);
        const int col0 = u.pn * BM + wc * 32 + 8 * fq;
        const float* bp = base + (size_t)(u.pm * BM + wr * 64 + fr) * ldc + col0;
        f32x4 xv[3][2][2];
#define EYF_LOAD(slot, gi) do { _Pragma("unroll") for (int bj = 0; bj < 2; ++bj) _Pragma("unroll") for (int n = 0; n < 2; ++n) xv[slot][bj][n] = *(const f32x4*)(bp + (size_t)((((gi) >> 2) * HALF) + ((gi) & 3) * 16) * ldc + bj * HALF + 4 * n); } while (0)
        EYF_LOAD(0, 0); EYF_LOAD(1, 1); EYF_LOAD(2, 2);
#pragma unroll
        for (int ai = 0; ai < 2; ++ai)
#pragma unroll
            for (int m = 0; m < 4; ++m) { float s = 0.f;
#pragma unroll
                for (int bj = 0; bj < 2; ++bj)
#pragma unroll
                    for (int n = 0; n < 2; ++n) { const f32x4 x = acc[ai][bj][m][n]; s += (x[0] * x[0] + x[1] * x[1]) + (x[2] * x[2] + x[3] * x[3]); }
                s += __shfl_xor(s, 16); s += __shfl_xor(s, 32);
                if (fq == 0) P[(ai * HALF + wr * 64 + m * 16 + fr) * 4 + wc] = s; }
        asm volatile("s_waitcnt lgkmcnt(0)" ::: "memory"); __builtin_amdgcn_s_barrier(); asm volatile("" ::: "memory");
        const int row = wid * 32 + (lane & 31);
        if (lane < 32) { const f32x4 p = *(const PG8_LAS f32x4*)(P + row * 4);
            __hip_atomic_store(xbuf + (size_t)(u.pm * BM + row) * 4 + u.pn, (p[0] + p[1]) + (p[2] + p[3]), __ATOMIC_RELAXED, __HIP_MEMORY_SCOPE_AGENT); }
        asm volatile("s_waitcnt vmcnt(0)" ::: "memory");
        if (lane == 0) __hip_atomic_fetch_add(cnt + 64 * u.pm, 1u, __ATOMIC_RELAXED, __HIP_MEMORY_SCOPE_AGENT);
        if (wid == 0) { unsigned sp = 0;
            while ((unsigned)__builtin_amdgcn_readfirstlane(__hip_atomic_load(cnt + 64 * u.pm, __ATOMIC_RELAXED, __HIP_MEMORY_SCOPE_AGENT)) < 32u) { __builtin_amdgcn_s_sleep(2); if (++sp > (1u << 22)) break; }
            __builtin_amdgcn_fence(__ATOMIC_ACQUIRE, "agent"); }
        asm volatile("s_waitcnt vmcnt(0) lgkmcnt(0)" ::: "memory"); __builtin_amdgcn_s_barrier(); asm volatile("" ::: "memory");
        if (lane < 32) { const float* sl = xbuf + (size_t)(u.pm * BM + row) * 4; float t = 0.f;
#pragma unroll
            for (int k = 0; k < 4; ++k) t += __hip_atomic_load(sl + k, __ATOMIC_RELAXED, __HIP_MEMORY_SCOPE_AGENT);
            Sr[row] = __builtin_amdgcn_rsqf(t * (1.f / 1024.f) + eps); }
        asm volatile("s_waitcnt vmcnt(0) lgkmcnt(0)" ::: "memory"); __builtin_amdgcn_s_barrier(); asm volatile("" ::: "memory");
        f32x4 gv[2][2];
#pragma unroll
        for (int bj = 0; bj < 2; ++bj)
#pragma unroll
            for (int n = 0; n < 2; ++n) gv[bj][n] = *(const f32x4*)(g + col0 + bj * HALF + 4 * n);
        float* op = out + (size_t)(u.pm * BM + wr * 64 + fr) * ldc + col0;
#pragma unroll
        for (int gi = 0; gi < 8; ++gi) { const int ai = gi >> 2, m = gi & 3; const float rs = Sr[ai * HALF + wr * 64 + m * 16 + fr];
            float* orow = op + (size_t)(ai * HALF + m * 16) * ldc;
#pragma unroll
            for (int bj = 0; bj < 2; ++bj)
#pragma unroll
                for (int n = 0; n < 2; ++n) *(f32x4*)(orow + bj * HALF + 4 * n) = xv[gi % 3][bj][n] + acc[ai][bj][m][n] * rs * gv[bj][n];
            asm volatile("" ::: "memory");
            if (gi + 3 < 8) EYF_LOAD(gi % 3, gi + 3);
            asm volatile("" ::: "memory"); }
#undef EYF_LOAD
    }
};
struct Gemm2FOrder {
    StaticOrder so; int c, nN, pm0, KS, ntS; unsigned* cnt;
    __host__ __device__ void init(int MP, int N, int K, int KS_, int c_, unsigned* cnt_) { so.init(MP, N, 256, c_); c = c_; nN = N / BM; pm0 = MP / BM; KS = KS_; ntS = K / BK / KS_; cnt = cnt_; }
    __host__ __device__ bool next(int i, Unit& u) const {
        const bool hs = (c & 63) < 32;
        if (hs && i == 0) { const int L = (c >> 6) * 32 + (c & 63), lu = L / KS, ks = L % KS; u.pm = pm0 + lu / nN; u.pn = lu % nN; u.k0 = ks * ntS; u.nt = ntS; u.slab = ks; return true; }
        if (i == (hs ? 1 : 0)) return so.next(0, u);
        return false;
    }
    __device__ __forceinline__ void a_ready(const Unit&) const {}
    __device__ __forceinline__ void done(const Unit& u, int) const {
        if (u.slab >= 0) { asm volatile("s_waitcnt vmcnt(0)" ::: "memory");
            if ((threadIdx.x & 63) == 0) __hip_atomic_fetch_add(cnt + 64 * (c & 7), 1u, __ATOMIC_RELAXED, __HIP_MEMORY_SCOPE_AGENT); }
    }
};
struct Gemm2Order {
    StaticOrder so; int nfull, nN, pm0, KS, ntS, nsl, G, c;
    __host__ __device__ void init(int MP, int M, int N, int K, int KS_, int G_, int c_) { so.init(MP, N, G_, c_); nfull = so.nwg; nN = N / BM; pm0 = MP / BM; KS = KS_; ntS = K / BK / KS_; nsl = ((M - MP) / BM) * nN * KS_; G = G_; c = c_; }
    __host__ __device__ bool next(int i, Unit& u) const {
        const long L = (long)i * G + c;
        if (L < nfull) return so.next(i, u);
        const long Ls = L - nfull; if (Ls >= nsl) return false;
        const int lu = (int)Ls / KS, ks = (int)Ls % KS; u.pm = pm0 + lu / nN; u.pn = lu % nN; u.k0 = ks * ntS; u.nt = ntS; u.slab = ks; return true;
    }
    __device__ __forceinline__ void a_ready(const Unit&) const {}
    __device__ __forceinline__ void done(const Unit&, int) const {}
};
struct NoKScale { static constexpr bool ON = false; };
struct HeadScale {
    static constexpr bool ON = true; static constexpr int MAXU = 2;
    const float* pss; int nrowp; float eps;
    static constexpr int OFF = 131072;
    __device__ __forceinline__ void prep(PG8_LAS unsigned char* lds, const Unit& u, int par) const {
        const int r = threadIdx.x & 255; const int row = u.pm * BM + r;
        PG8_LAS float* T = (PG8_LAS float*)(lds + OFF) + par * 5 * 256;
        const __amdgpu_buffer_rsrc_t rsrc = __builtin_amdgcn_make_buffer_rsrc((void*)pss, 0, 32 * nrowp * 4, 0x00020000);
        float v[32];
        if (row < nrowp) {
#pragma unroll
            for (int i = 0; i < 32; ++i) v[i] = __builtin_bit_cast(float, __builtin_amdgcn_raw_buffer_load_b32(rsrc, row * 4, i * nrowp * 4, 0));
        }
        float prev = 1.f;
#pragma unroll
        for (int h = 0; h < 4; ++h) { float rs = 1.f;
            if (row < nrowp) { const float tot = ((v[8 * h] + v[8 * h + 1]) + (v[8 * h + 2] + v[8 * h + 3])) + ((v[8 * h + 4] + v[8 * h + 5]) + (v[8 * h + 6] + v[8 * h + 7]));
                rs = __builtin_amdgcn_rsqf(tot * (1.f / 256.f) + eps); }
            T[h * 256 + r] = prev * __builtin_amdgcn_rcpf(rs); prev = rs; }
        T[4 * 256 + r] = prev;
    }
    __device__ __forceinline__ void scale(f32x4 (&acc)[2][2][4][2], PG8_LAS unsigned char* lds, int par, int idx, int wr, int fr) const {
        const unsigned a = (unsigned)(size_t)(lds + OFF) + (unsigned)(((par * 5 + idx) * 256 + wr * 64 + fr) * 4);
        float f0, f1, f2, f3, f4, f5, f6, f7;
        asm volatile("ds_read_b32 %0, %8\n\tds_read_b32 %1, %8 offset:64\n\tds_read_b32 %2, %8 offset:128\n\tds_read_b32 %3, %8 offset:192\n\t"
                     "ds_read_b32 %4, %8 offset:512\n\tds_read_b32 %5, %8 offset:576\n\tds_read_b32 %6, %8 offset:640\n\tds_read_b32 %7, %8 offset:704\n\ts_waitcnt lgkmcnt(0)"
                     : "=&v"(f0), "=&v"(f1), "=&v"(f2), "=&v"(f3), "=&v"(f4), "=&v"(f5), "=&v"(f6), "=&v"(f7) : "v"(a) : "memory");
        const float f[2][4] = {{f0, f1, f2, f3}, {f4, f5, f6, f7}};
#pragma unroll
        for (int ai = 0; ai < 2; ++ai)
#pragma unroll
            for (int m = 0; m < 4; ++m)
#pragma unroll
                for (int bj = 0; bj < 2; ++bj)
#pragma unroll
                    for (int n = 0; n < 2; ++n) acc[ai][bj][m][n] = acc[ai][bj][m][n] * f[ai][m];
    }
};

struct Gemm1Order {
    StaticOrder so; int nS, nN, pmS, G, c; unsigned* cnt;
    __host__ __device__ void init(int MP, int M, int N, int G_, int c_, unsigned* cnt_) { so.init(MP, N, G_, 0); nN = N / BM; pmS = MP / BM; nS = ((M - MP) / BM) * nN; G = G_; c = c_; cnt = cnt_; }
    __host__ __device__ bool next(int i, Unit& u) const {
        const long L = (long)i * G + c;
        if (L < nS) { u.pm = pmS + (int)L / nN; u.pn = (int)L % nN; u.k0 = 0; u.nt = 0; u.slab = -1; return true; }
        const long Lp = L - nS; if (Lp >= so.nwg) return false;
        StaticOrder t = so; t.G = 1; t.c = 0; return t.next((int)Lp, u);
    }
    __device__ __forceinline__ void a_ready(const Unit&) const {}
    __device__ __forceinline__ void done(const Unit& u, int) const {
        if (u.pm >= pmS) {
            asm volatile("s_waitcnt vmcnt(0)" ::: "memory");
            if ((threadIdx.x & 63) == 0) __hip_atomic_fetch_add(cnt, 1u, __ATOMIC_RELAXED, __HIP_MEMORY_SCOPE_AGENT);
        }
    }
};

struct OneUnitOrder {
    int pm, pn, have; unsigned* cnt;
    __host__ __device__ bool next(int i, Unit& u) const { if (i > 0 || !have) return false; u.pm = pm; u.pn = pn; u.k0 = 0; u.nt = 0; u.slab = -1; return true; }
    __device__ __forceinline__ void a_ready(const Unit&) const {}
    __device__ __forceinline__ void done(const Unit&, int) const {
        asm volatile("s_waitcnt vmcnt(0)" ::: "memory");
        if ((threadIdx.x & 63) == 0) __hip_atomic_fetch_add(cnt, 1u, __ATOMIC_RELAXED, __HIP_MEMORY_SCOPE_AGENT);
    }
};

template <class Epi, class Sched, bool ALIGN_EPI = false, bool SP2 = false, class KS = NoKScale>
__device__ __forceinline__ void gemm_phase(PG8_LAS unsigned char* lds, const Gemm g, const Sched& S, const Epi& E, const KS ksc = KS()) {
    int tid_ = threadIdx.x; asm volatile("" : "+v"(tid_));
    const int tid = tid_, wid = __builtin_amdgcn_readfirstlane(tid >> 6), lane = tid & 63, wr = wid >> 2, wc = wid & 3, fr = lane & 15, fq = lane >> 4;
    const int K = g.K, ntK = K / BK;
    unsigned voffA[2], voffB[2];
#pragma unroll
    for (int i = 0; i < 2; ++i) { int R, C; stage_rc(tid * 16 + i * 8192, R, C); const int Rb = Epi::PERM ? ((R & ~31) + perm32(R & 31)) : R;
        voffA[i] = (unsigned)(R * K + C) * 2u; voffB[i] = (unsigned)(Rb * K + C) * 2u; }
    const size_t kstep = (size_t)(BK * 2);
    const size_t hstep = (size_t)HALF * K * 2;
    const size_t tstep = 2 * hstep;
    const unsigned ldsw = (unsigned)wid * 1024u;
    const int aoff = lds_byte(wr * 64 + fr, fq * 8), boff = lds_byte(wc * 32 + fr, fq * 8);
#define PG8_SA(b, h) (((b) * 2 + (h)) * HTB)
#define PG8_SB(b, h) ((4 + (b) * 2 + (h)) * HTB)
#define PG8_STAGE(bufoff, gbase, voff) do { _Pragma("unroll") for (int _i = 0; _i < 2; ++_i) \
        __builtin_amdgcn_global_load_lds((const unsigned*)((const char*)(gbase) + (voff)[_i]), (PG8_LAS unsigned*)(lds + (bufoff) + ldsw + _i * 8192), 16, 0, 0); } while (0)
#define PG8_LDA(dst, b, h) do { _Pragma("unroll") for (int m = 0; m < 4; ++m) _Pragma("unroll") for (int k = 0; k < 2; ++k) dst[m][k] = *(const PG8_LAS bf16x8*)(lds + PG8_SA(b, h) + aoff + m * 2048 + k * 1024); } while (0)
#define PG8_LDB(dst, b, h) do { _Pragma("unroll") for (int n = 0; n < 2; ++n) _Pragma("unroll") for (int k = 0; k < 2; ++k) dst[n][k] = *(const PG8_LAS bf16x8*)(lds + PG8_SB(b, h) + boff + n * 2048 + k * 1024); } while (0)
#define PG8_MMA(ai, bj, At, Bt) do { __builtin_amdgcn_s_setprio(1); _Pragma("unroll") for (int m = 0; m < 4; ++m) _Pragma("unroll") for (int n = 0; n < 2; ++n) _Pragma("unroll") for (int k = 0; k < 2; ++k) \
        acc[ai][bj][m][n] = __builtin_amdgcn_mfma_f32_16x16x32_bf16(Bt[n][k], At[m][k], acc[ai][bj][m][n], 0, 0, 0); __builtin_amdgcn_s_setprio(0); } while (0)
#define PG8_WAIT_V(n) asm volatile("s_waitcnt vmcnt(" #n ")" ::: "memory")
#define PG8_WAIT_L(n) asm volatile("s_waitcnt lgkmcnt(" #n ")" ::: "memory")
#define PG8_BAR __builtin_amdgcn_s_barrier()
#define PG8_SCHED __builtin_amdgcn_sched_barrier(0)
    Unit cur, nxt; int ui = 0;
    if (!S.next(0, cur)) return;
    f32x4 acc[2][2][4][2];
#pragma unroll
    for (int a = 0; a < 2; ++a)
#pragma unroll
        for (int b = 0; b < 2; ++b)
#pragma unroll
            for (int m = 0; m < 4; ++m)
#pragma unroll
                for (int n = 0; n < 2; ++n) acc[a][b][m][n] = (f32x4){0.f, 0.f, 0.f, 0.f};
    bf16x8 At[4][2], B0[2][2], B1[2][2];
    const char* cA = (const char*)g.A + (size_t)cur.pm * tstep + (size_t)cur.k0 * (BK * 2); const char* cB = (const char*)g.Bt + (size_t)cur.pn * tstep + (size_t)cur.k0 * (BK * 2);
    S.a_ready(cur);
    if constexpr (KS::ON) { Unit pu; for (int i = 0; i < KS::MAXU && S.next(i, pu); ++i) ksc.prep(lds, pu, i); }
    if constexpr (SP2) {
        PG8_STAGE(PG8_SB(0, 0), cB, voffB); PG8_STAGE(PG8_SB(0, 1), cB + hstep, voffB); PG8_STAGE(PG8_SA(0, 0), cA, voffA); PG8_STAGE(PG8_SA(0, 1), cA + hstep, voffA);
        if (wr == 1) PG8_BAR;
        PG8_WAIT_V(2); PG8_BAR;
        PG8_STAGE(PG8_SB(1, 0), cB + kstep, voffB); PG8_STAGE(PG8_SA(1, 0), cA + kstep, voffA); PG8_STAGE(PG8_SB(1, 1), cB + hstep + kstep, voffB);
        PG8_WAIT_V(6); PG8_BAR;
    } else {
        PG8_STAGE(PG8_SB(0, 0), cB, voffB); PG8_STAGE(PG8_SA(0, 0), cA, voffA); PG8_STAGE(PG8_SB(0, 1), cB + hstep, voffB); PG8_STAGE(PG8_SA(0, 1), cA + hstep, voffA);
        if (wr == 1) PG8_BAR;
        PG8_WAIT_V(4); PG8_BAR;
        PG8_STAGE(PG8_SB(1, 0), cB + kstep, voffB); PG8_STAGE(PG8_SA(1, 0), cA + kstep, voffA); PG8_STAGE(PG8_SB(1, 1), cB + hstep + kstep, voffB);
        PG8_WAIT_V(6); PG8_BAR;
    }
    for (;;) {
        const bool has_next = S.next(ui + 1, nxt);
        const char* nA = has_next ? (const char*)g.A + (size_t)nxt.pm * tstep + (size_t)nxt.k0 * (BK * 2) : cA; const char* nB = has_next ? (const char*)g.Bt + (size_t)nxt.pn * tstep + (size_t)nxt.k0 * (BK * 2) : cB;
        const int nt = cur.nt ? cur.nt : ntK;
        for (int t = 0; t < nt; t += 2) {
            const bool last = (t == nt - 2);
            const char* a1 = cA + (size_t)(t + 1) * kstep;
            const char* a2 = last ? nA : cA + (size_t)(t + 2) * kstep; const char* b2 = last ? nB : cB + (size_t)(t + 2) * kstep;
            const char* a3 = a2 + kstep; const char* b3 = b2 + kstep;
            if (last && has_next) S.a_ready(nxt);
            if constexpr (KS::ON) { if (t >= 16 && (t & 3) == 0) ksc.scale(acc, lds, ui & 1, (t - 16) >> 2, wr, fr); }
            if constexpr (SP2) {
            PG8_LDB(B0, 0, 0); PG8_LDB(B1, 0, 1); PG8_SCHED; PG8_LDA(At, 0, 0); PG8_STAGE(PG8_SA(1, 1), a1 + hstep, voffA);
            PG8_WAIT_V(8); PG8_WAIT_L(0); PG8_BAR; PG8_MMA(0, 0, At, B0); PG8_MMA(0, 1, At, B1); PG8_BAR; PG8_SCHED;
            PG8_LDA(At, 0, 1); PG8_STAGE(PG8_SB(0, 0), b2, voffB); PG8_STAGE(PG8_SB(0, 1), b2 + hstep, voffB); PG8_STAGE(PG8_SA(0, 0), a2, voffA);
            PG8_WAIT_V(8); PG8_WAIT_L(0); PG8_BAR; PG8_MMA(1, 0, At, B0); PG8_MMA(1, 1, At, B1); PG8_BAR; PG8_SCHED;
            PG8_LDB(B0, 1, 0); PG8_LDB(B1, 1, 1); PG8_SCHED; PG8_LDA(At, 1, 0); PG8_STAGE(PG8_SA(0, 1), a2 + hstep, voffA);
            PG8_WAIT_V(8); PG8_WAIT_L(0); PG8_BAR; PG8_MMA(0, 0, At, B0); PG8_MMA(0, 1, At, B1); PG8_BAR; PG8_SCHED;
            PG8_LDA(At, 1, 1); PG8_STAGE(PG8_SB(1, 0), b3, voffB); PG8_STAGE(PG8_SB(1, 1), b3 + hstep, voffB); PG8_STAGE(PG8_SA(1, 0), a3, voffA);
            PG8_WAIT_V(8); PG8_WAIT_L(0); PG8_BAR; PG8_MMA(1, 0, At, B0); PG8_MMA(1, 1, At, B1); PG8_BAR; PG8_SCHED;
            } else {
            PG8_LDB(B0, 0, 0); PG8_SCHED; PG8_LDA(At, 0, 0); PG8_STAGE(PG8_SA(1, 1), a1 + hstep, voffA);
            PG8_WAIT_L(8); PG8_BAR; PG8_WAIT_L(0); PG8_MMA(0, 0, At, B0); PG8_BAR; PG8_SCHED;
            PG8_LDB(B1, 0, 1); PG8_STAGE(PG8_SB(0, 0), b2, voffB);
            PG8_BAR; PG8_WAIT_L(0); PG8_MMA(0, 1, At, B1); PG8_BAR;
            PG8_LDA(At, 0, 1); PG8_STAGE(PG8_SA(0, 0), a2, voffA);
            PG8_BAR; PG8_WAIT_L(0); PG8_MMA(1, 0, At, B0); PG8_BAR; PG8_SCHED;
            PG8_STAGE(PG8_SB(0, 1), b2 + hstep, voffB);
            PG8_WAIT_V(6); PG8_BAR; PG8_MMA(1, 1, At, B1); PG8_BAR;
            PG8_LDB(B0, 1, 0); PG8_SCHED; PG8_LDA(At, 1, 0); PG8_STAGE(PG8_SA(0, 1), a2 + hstep, voffA);
            PG8_WAIT_L(8); PG8_BAR; PG8_WAIT_L(0); PG8_MMA(0, 0, At, B0); PG8_BAR; PG8_SCHED;
            PG8_LDB(B1, 1, 1); PG8_STAGE(PG8_SB(1, 0), b3, voffB);
            PG8_BAR; PG8_WAIT_L(0); PG8_MMA(0, 1, At, B1); PG8_BAR;
            PG8_LDA(At, 1, 1); PG8_STAGE(PG8_SA(1, 0), a3, voffA);
            PG8_BAR; PG8_WAIT_L(0); PG8_MMA(1, 0, At, B0); PG8_BAR; PG8_SCHED;
            PG8_STAGE(PG8_SB(1, 1), b3 + hstep, voffB);
            PG8_WAIT_V(6); PG8_BAR; PG8_MMA(1, 1, At, B1); PG8_BAR;
            }
        }
        if constexpr (KS::ON) ksc.scale(acc, lds, ui & 1, 4, wr, fr);
        if constexpr (ALIGN_EPI) { if (wr == 0) PG8_BAR; }
        if constexpr (!Epi::AFTER_DRAIN) { E(acc, cur, wr, wc, fr, fq); S.done(cur, ui); }
        else { if (has_next) { E(acc, cur, wr, wc, fr, fq); S.done(cur, ui); } }
        if (!has_next) break;
#pragma unroll
        for (int a = 0; a < 2; ++a)
#pragma unroll
            for (int b = 0; b < 2; ++b)
#pragma unroll
                for (int m = 0; m < 4; ++m)
#pragma unroll
                    for (int n = 0; n < 2; ++n) acc[a][b][m][n] = (f32x4){0.f, 0.f, 0.f, 0.f};
        cur = nxt; cA = nA; cB = nB; ++ui;
        if constexpr (ALIGN_EPI) { if (wr == 1) PG8_BAR; }
    }
    PG8_WAIT_V(0);
    if constexpr (!ALIGN_EPI) { if (wr == 0) PG8_BAR; }
    PG8_BAR;
    if constexpr (Epi::AFTER_DRAIN) { E.fused(acc, cur, wr, wc, fr, fq, lds, wid, lane); S.done(cur, ui); }
#undef PG8_SA
#undef PG8_SB
#undef PG8_STAGE
#undef PG8_LDA
#undef PG8_LDB
#undef PG8_MMA
#undef PG8_WAIT_V
#undef PG8_WAIT_L
#undef PG8_BAR
#undef PG8_SCHED
}
}

#ifndef MK_N_LAUNCHES
#define MK_N_LAUNCHES 1
#endif
constexpr int N_PHASES = 5, N_LAUNCHES = MK_N_LAUNCHES;
constexpr int NWAVES = 8;
constexpr int D = 1024, NP = 8, TP = 2048, NS = 128, TS = 8, NROWP = NP * TP, NROWS = NS * TS, NTOK = NROWP + NROWS;
constexpr int DIN = 5136, DINP = 5120, DMIX = 2048, HK = 128, HV = 256, NH = 4;
constexpr int C_XL = 0, C_ZL = 1024, C_Q = 2048, C_K = 2560, C_V = 3072, C_ZG = 4096;
constexpr float EPS = 1e-6f;
constexpr size_t O_YP = 0, O_YS = 16777216, O_HP = 17825792, O_CP = 17833984, O_GP = 17858560, O_HS = 18907136, O_CS = 19038208, O_GS = 19431424, O_END = 36208640;
constexpr size_t MiB = 1u << 20;
constexpr size_t WS_CTL = 0, CTL_ZERO_BYTES = 64 * 1024;
constexpr size_t WS_WINT = 2 * MiB, WS_WOUT = 12 * MiB, WS_RGK = 16 * MiB, WS_PART = 18 * MiB, WS_DEC = 19 * MiB + 256 * 1024, WS_XN = 20 * MiB, WS_PROJ = 54 * MiB, WS_YS = 224 * MiB, WS_END = 240 * MiB;
static_assert(WS_DEC + (size_t)(NP * (TP / 64) + NS) * 512 * 4 <= WS_XN && WS_PART + (size_t)16 * NTOK * 4 <= WS_DEC, "d_ws map (DEC)");
static_assert(WS_WINT + (size_t)DINP * D * 2 <= WS_WOUT && WS_WOUT + (size_t)D * DMIX * 2 <= WS_RGK && WS_RGK + (size_t)NTOK * 16 * 4 <= WS_PART && WS_PART + (size_t)16 * NTOK * 4 <= WS_XN &&
              WS_XN + (size_t)NTOK * D * 2 <= WS_PROJ && WS_PROJ + (size_t)NTOK * DINP * 2 <= WS_YS && WS_YS + (size_t)8 * NROWS * D * 2 <= WS_END, "d_ws map");
constexpr int CW_BAR = 4096, CW_SAMPLE = 8192, CW_DIAG = 12288;
#ifndef LATE_SAMPLE
#define LATE_SAMPLE 0
#endif
constexpr int CHAIN_NS = LATE_SAMPLE ? 0 : 80;
#ifndef FUSE_P4
#define FUSE_P4 1
#endif
constexpr int CW_ROWS = 0;
constexpr size_t WS_XBUF = WS_PART + 65536;
static_assert(WS_XBUF + (size_t)NROWP * 4 * 4 <= WS_DEC, "d_ws map (XBUF)");
static_assert((CW_DIAG + 64) * 4 <= (int)CTL_ZERO_BYTES, "control words inside the zeroed region");
constexpr int RING_OFF = 0, RING_BYTES = 162816, LDSCTL_OFF = RING_BYTES, MISC_OFF = LDSCTL_OFF + 320, LDS_BYTES = 163840;

#define GAS __attribute__((address_space(1)))
#define LAS __attribute__((address_space(3)))
typedef unsigned short bf16;
typedef unsigned v4u __attribute__((ext_vector_type(4)));
typedef unsigned v2u __attribute__((ext_vector_type(2)));
typedef float f32x4 __attribute__((ext_vector_type(4)));
typedef GAS unsigned gu32;
#define RLX_AGENT __ATOMIC_RELAXED, __HIP_MEMORY_SCOPE_AGENT
#define LDS_WAIT() asm volatile("s_waitcnt lgkmcnt(0)" ::: "memory")
#define VM_WAIT() asm volatile("s_waitcnt vmcnt(0)" ::: "memory")
__device__ __forceinline__ unsigned f2bf(float f) { unsigned u = __builtin_bit_cast(unsigned, f); return (u + 0x7fffu + ((u >> 16) & 1u)) >> 16; }
__device__ __forceinline__ unsigned pk2(float lo, float hi) { return f2bf(lo) | (f2bf(hi) << 16); }
__device__ __forceinline__ float bf2f(unsigned b) { return __builtin_bit_cast(float, b << 16); }
__device__ __forceinline__ float bflo(unsigned w) { return __builtin_bit_cast(float, w << 16); }
__device__ __forceinline__ float bfhi(unsigned w) { return __builtin_bit_cast(float, w & 0xffff0000u); }
__device__ __forceinline__ float sigmoidf_(float x) { return 1.f / (1.f + __expf(-x)); }
__device__ __forceinline__ float logsigf_(float x) { return fminf(x, 0.f) - log1pf(__expf(-fabsf(x))); }
#define XB_TMO      128
#define XB_XCNT(j)  (256  + 64 * (j))
#define XB_XSUB(j)  (1280 + 64 * (j))
#define XB_XGEN(j)  (2304 + 64 * (j))
#define XB_TOP      3328
#define XB_TOPGEN   3392
#define XCD_BAR_WORDS 3456
#define XB_SPIN_CAP (1u << 18)

__device__ __forceinline__ unsigned xb_ld(unsigned* p)              { return __hip_atomic_load(p, __ATOMIC_RELAXED, __HIP_MEMORY_SCOPE_AGENT); }
__device__ __forceinline__ unsigned xb_add(unsigned* p, unsigned v) { return __hip_atomic_fetch_add(p, v, __ATOMIC_RELAXED, __HIP_MEMORY_SCOPE_AGENT); }
__device__ __forceinline__ unsigned xb_xcc_id() { return (unsigned)__builtin_amdgcn_s_getreg((3 << 11) | 20) & 0xFu; }
#define XB_SPIN(cond, bar) do { unsigned _sp = 0; while (cond) { __builtin_amdgcn_s_sleep(1); \
    if ((++_sp & 255u) == 0u) { if (xb_ld(&(bar)[XB_TMO])) break; if (_sp > XB_SPIN_CAP) { atomicAdd(&(bar)[XB_TMO], 1u); break; } } } } while (0)

struct XcdBarrier {
    unsigned* bar; unsigned x;
    volatile LAS unsigned* st;
};

__device__ __forceinline__ XcdBarrier xcd_barrier_post(unsigned* bar, volatile LAS unsigned* st) {
    XcdBarrier b; b.bar = bar; b.x = xb_xcc_id(); b.st = st;
    if (threadIdx.x == 0) (void)xb_add(&bar[XB_XCNT(b.x)], 1u);
    return b;
}
__device__ __forceinline__ void xcd_barrier_complete(unsigned* bar, unsigned x, unsigned& nloc, unsigned& nx) {
    const unsigned G = gridDim.x * gridDim.y * gridDim.z;
    unsigned sum, cnt, mine, sp = 0u;
    for (;;) {
        sum = 0u; cnt = 0u; mine = 0u;
#pragma unroll
        for (unsigned j = 0; j < 16; ++j) { const unsigned c = xb_ld(&bar[XB_XCNT(j)]); sum += c; cnt += (c > 0u) ? 1u : 0u; mine = (j == x) ? c : mine; }
        if (sum == G) break;
        __builtin_amdgcn_s_sleep(1);
        if ((++sp & 255u) == 0u) { if (xb_ld(&bar[XB_TMO])) break; if (sp > XB_SPIN_CAP) { atomicAdd(&bar[XB_TMO], 1u); break; } }
    }
    nloc = mine > 0u ? mine : 1u; nx = cnt > 0u ? cnt : 1u;
}

__device__ __forceinline__ void xcd_barrier(const XcdBarrier& b) {
    asm volatile("s_waitcnt vmcnt(0)" ::: "memory");
    __syncthreads();
    if (threadIdx.x == 0) {
        unsigned* bar = b.bar;
        __builtin_amdgcn_s_waitcnt(0);
        unsigned nloc = b.st[0], nx = b.st[1];
        if (nloc == 0u) { xcd_barrier_complete(bar, b.x, nloc, nx); b.st[0] = nloc; b.st[1] = nx; }
        const unsigned old = xb_add(&bar[XB_XSUB(b.x)], 1u);
        const unsigned gen = old / nloc;
        if (old + 1u == (gen + 1u) * nloc) {
            __builtin_amdgcn_fence(__ATOMIC_RELEASE, "agent");
            asm volatile("s_waitcnt vmcnt(0)" ::: "memory");
            const unsigned og = xb_add(&bar[XB_TOP], 1u);
            const unsigned tg = og / nx;
            if (og + 1u == (tg + 1u) * nx) xb_add(&bar[XB_TOPGEN], 1u);
            else XB_SPIN(xb_ld(&bar[XB_TOPGEN]) == tg, bar);
            __builtin_amdgcn_fence(__ATOMIC_ACQUIRE, "agent");
            xb_add(&bar[XB_XGEN(b.x)], 1u);
            asm volatile("s_waitcnt vmcnt(0)" ::: "memory");
        } else {
            XB_SPIN(xb_ld(&bar[XB_XGEN(b.x)]) == gen, bar);
            __builtin_amdgcn_fence(__ATOMIC_ACQUIRE, "agent");
            asm volatile("s_waitcnt vmcnt(0)" ::: "memory");
        }
    }
    __syncthreads();
}

#define CB_A(j)      (16 * (j))
#define CB_N(j)      (256 + 16 * (j))
#define CB_GEN(j)    (512 + 16 * (j))
#define CB_TOP       768
#define CB_TOPGEN    784
#define CB_CENSUS(j) (800 + 16 * (j))
constexpr int CW_CHAINBAR = CW_SAMPLE + 2688;
static_assert(CW_CHAINBAR + 1056 <= CW_DIAG, "control words (chain barrier)");
__device__ __forceinline__ bool cb_role(const XcdBarrier& b, unsigned* w, bool sixth, unsigned& nA, unsigned& nN) {
    const unsigned nloc = b.st[0]; unsigned a = xb_ld(&w[CB_CENSUS(b.x)]); if (a >= nloc) a = 0u;
    nA = a; nN = nloc - a; return sixth && a > 0u;
}
__device__ __forceinline__ void cb_npath(const XcdBarrier& b, unsigned* w, unsigned nA, unsigned nN) {
    const unsigned old = xb_add(&w[CB_N(b.x)], 1u);
    if (old + 1u == nN) {
        XB_SPIN(xb_ld(&w[CB_A(b.x)]) < nA, b.bar);
        __builtin_amdgcn_fence(__ATOMIC_RELEASE, "agent");
        asm volatile("s_waitcnt vmcnt(0)" ::: "memory");
        const unsigned og = xb_add(&w[CB_TOP], 1u);
        if (og + 1u == b.st[1]) xb_add(&w[CB_TOPGEN], 1u);
        else XB_SPIN(xb_ld(&w[CB_TOPGEN]) == 0u, b.bar);
        __builtin_amdgcn_fence(__ATOMIC_ACQUIRE, "agent");
        xb_add(&w[CB_GEN(b.x)], 1u);
        asm volatile("s_waitcnt vmcnt(0)" ::: "memory");
    } else {
        XB_SPIN(xb_ld(&w[CB_GEN(b.x)]) == 0u, b.bar);
        __builtin_amdgcn_fence(__ATOMIC_ACQUIRE, "agent");
        asm volatile("s_waitcnt vmcnt(0)" ::: "memory");
    }
}
__device__ __forceinline__ void cb_arrive(const XcdBarrier& b, unsigned* w) {
    asm volatile("s_waitcnt vmcnt(0)" ::: "memory");
    __syncthreads();
    if (threadIdx.x == 0) { unsigned nA, nN; if (cb_role(b, w, true, nA, nN)) xb_add(&w[CB_A(b.x)], 1u); else cb_npath(b, w, nA, nN); }
}
__device__ __forceinline__ void cb_wait(const XcdBarrier& b, unsigned* w) {
    if (threadIdx.x == 0) { unsigned nA, nN; if (cb_role(b, w, true, nA, nN)) { XB_SPIN(xb_ld(&w[CB_GEN(b.x)]) == 0u, b.bar); __builtin_amdgcn_fence(__ATOMIC_ACQUIRE, "agent"); asm volatile("s_waitcnt vmcnt(0)" ::: "memory"); } }
    __syncthreads();
}
__device__ __forceinline__ void cb_full(const XcdBarrier& b, unsigned* w) {
    asm volatile("s_waitcnt vmcnt(0)" ::: "memory");
    __syncthreads();
    if (threadIdx.x == 0) { unsigned nA, nN; (void)cb_role(b, w, false, nA, nN); cb_npath(b, w, nA, nN); }
    __syncthreads();
}
namespace pg8 {
struct Gemm1Chain {
    StaticOrder so; int c; unsigned* cntS; const XcdBarrier* bar; unsigned* cb;
    __host__ __device__ void init(int MP, int N, int c_, unsigned* s, const XcdBarrier* b, unsigned* cb_) { so.init(MP, N, 256, c_); c = c_; cntS = s; bar = b; cb = cb_; }
    __host__ __device__ bool next(int i, Unit& u) const {
        if (i < 5) return so.next(i, u);
        if (i == 5 && c < CHAIN_NS) { u.pm = so.nM + c / so.nN; u.pn = c % so.nN; u.k0 = 0; u.nt = 0; u.slab = -1; return true; }
        return false;
    }
    __device__ __forceinline__ void a_ready(const Unit&) const {}
    __device__ __forceinline__ void done(const Unit&, int ui) const { if (ui == 4 && c < CHAIN_NS) cb_arrive(*bar, cb); }
    __device__ __forceinline__ void chain_end() const {
        if (c < CHAIN_NS) { if (threadIdx.x == 0) __hip_atomic_fetch_add(cntS + 64 * (c & 7), 8u, __ATOMIC_RELAXED, __HIP_MEMORY_SCOPE_AGENT); cb_wait(*bar, cb); }
        else cb_full(*bar, cb);
    }
};
struct OneUnit {
    int pm, pn, k0, nt, slab;
    __host__ __device__ bool next(int i, Unit& u) const { if (i > 0) return false; u.pm = pm; u.pn = pn; u.k0 = k0; u.nt = nt; u.slab = slab; return true; }
    __device__ __forceinline__ void a_ready(const Unit&) const {}
    __device__ __forceinline__ void done(const Unit&, int) const {}
};
}
#ifndef DUP_PHASE
#define DUP_PHASE -1
#endif
#ifdef DIAG_ID
#ifndef DIAG_ID0
#define DIAG_ID0 -1
#endif
#define PSTAMP(id) do { if (DIAG_ID == (id) || DIAG_ID0 == (id)) { __syncthreads(); if (F.tid == 0) { unsigned long long q_ = (unsigned long long)(size_t)F.ctl; asm volatile("" : "+s"(q_)); \
    __hip_atomic_fetch_max((unsigned long long*)(q_ + CW_DIAG * 4) + (DIAG_ID == (id) ? 1 : 2), (unsigned long long)__builtin_amdgcn_s_memrealtime(), __ATOMIC_RELAXED, __HIP_MEMORY_SCOPE_AGENT); } } } while (0)
#else
#define PSTAMP(id) do {} while (0)
#endif

struct Frame {
    LAS unsigned char* lds;
    volatile LAS unsigned* MISC;
    gu32* ctl;
    int tid, lane, wave, vcu, G;
    const float *xp, *xs, *st_h, *st_conv, *st_gla, *g_pre, *w_in, *conv_w, *conv_b, *w_rg, *b_rg, *w_ig, *b_ig, *lam, *w_gk2, *b_gk, *g_head, *w_out, *g_post;
    float* out;
    bf16 *WinT, *WoutT, *XN, *PROJ, *YMIX, *YBF, *YS;
    float *RGK, *PART, *BCUM, *DEC, *PSS, *C8;
};
__device__ __forceinline__ float wave_sum(float v) {
#pragma unroll
    for (int o = 1; o < 64; o <<= 1) v += __shfl_xor(v, o);
    return v;
}

struct TxItem { const float* W; bf16* WT; int ldw, K, k0, n0; };
__device__ __forceinline__ TxItem p0_tx_item(const Frame& F, int it) {
    constexpr int I_IN = (D / 64) * (DINP / 32);
    TxItem t; const bool in = it < I_IN; const int item = in ? it : it - I_IN, nblk = in ? DINP / 32 : D / 32;
    t.W = in ? F.w_in : F.w_out; t.WT = in ? F.WinT : F.WoutT; t.ldw = in ? DIN : D; t.K = in ? D : DMIX; t.k0 = 64 * (item / nblk); t.n0 = 32 * (item % nblk); return t;
}
__device__ __forceinline__ void p0_tx_load(const TxItem& t, int lane, f32x4 (&wv)[8]) {
#pragma unroll
    for (int i = 0; i < 8; ++i) wv[i] = *(const GAS f32x4*)(t.W + (size_t)(t.k0 + 8 * i + (lane >> 3)) * t.ldw + t.n0 + 4 * (lane & 7));
}
__device__ __forceinline__ void p0_tx_finish(const TxItem& t, LAS float* scr, int lane, const f32x4 (&wv)[8]) {
#pragma unroll
    for (int i = 0; i < 8; ++i) { LAS float* d = scr + (8 * i + (lane >> 3)) * 33 + 4 * (lane & 7); d[0] = wv[i].x; d[1] = wv[i].y; d[2] = wv[i].z; d[3] = wv[i].w; }
    LDS_WAIT(); asm volatile("" ::: "memory");
    const int c = lane & 7;
#pragma unroll
    for (int j = 0; j < 4; ++j) { const int n = (lane >> 3) + 8 * j; const LAS float* s = scr + (8 * c) * 33 + n;
        v4u o; o.x = pk2(s[0 * 33], s[1 * 33]); o.y = pk2(s[2 * 33], s[3 * 33]); o.z = pk2(s[4 * 33], s[5 * 33]); o.w = pk2(s[6 * 33], s[7 * 33]);
        *(GAS v4u*)(t.WT + (size_t)(t.n0 + n) * t.K + t.k0 + 8 * c) = o; }
    LDS_WAIT(); asm volatile("" ::: "memory");
}
struct RowX { f32x4 v[4]; };
__device__ __forceinline__ RowX p0_load_row(const Frame& F, int r) {
    const float* xrow = r < NROWP ? F.xp + (size_t)r * D : F.xs + (size_t)(r - NROWP) * D;
    const GAS f32x4* xr = (const GAS f32x4*)xrow + F.lane; RowX x;
#pragma unroll
    for (int j = 0; j < 4; ++j) x.v[j] = xr[64 * j];
    return x;
}
__device__ __forceinline__ float p0_treduce16(const float (&p)[16], int lane) {
    const bool b5 = lane & 32, b4 = lane & 16, b3 = lane & 8, b2 = lane & 4;
    float q8[8], q4[4], q2[2], q1;
#pragma unroll
    for (int i = 0; i < 8; ++i) { const float send = b5 ? p[i] : p[i + 8], keep = b5 ? p[i + 8] : p[i]; q8[i] = keep + __shfl_xor(send, 32); }
#pragma unroll
    for (int i = 0; i < 4; ++i) { const float send = b4 ? q8[i] : q8[i + 4], keep = b4 ? q8[i + 4] : q8[i]; q4[i] = keep + __shfl_xor(send, 16); }
#pragma unroll
    for (int i = 0; i < 2; ++i) { const float send = b3 ? q4[i] : q4[i + 2], keep = b3 ? q4[i + 2] : q4[i]; q2[i] = keep + __shfl_xor(send, 8); }
    { const float send = b2 ? q2[0] : q2[1], keep = b2 ? q2[1] : q2[0]; q1 = keep + __shfl_xor(send, 4); }
    q1 += __shfl_xor(q1, 2); q1 += __shfl_xor(q1, 1);
    return q1;
}
constexpr int P0_WRB = 0, P0_XT = 33280, P0_PART = 66560, P0_RGL = 74752, P0_ROWB = 2064;
__device__ __forceinline__ void p0_rows2(const Frame& F, int rA, int rB, RowX xa, RowX xb, LAS unsigned char* xt, int sA, int sB) {
    const GAS f32x4* gp = (const GAS f32x4*)F.g_pre + F.lane;
    float sa = 0.f, sb = 0.f;
#pragma unroll
    for (int j = 0; j < 4; ++j) { sa += (xa.v[j].x * xa.v[j].x + xa.v[j].y * xa.v[j].y) + (xa.v[j].z * xa.v[j].z + xa.v[j].w * xa.v[j].w); sb += (xb.v[j].x * xb.v[j].x + xb.v[j].y * xb.v[j].y) + (xb.v[j].z * xb.v[j].z + xb.v[j].w * xb.v[j].w); }
#pragma unroll
    for (int o = 1; o < 64; o <<= 1) { sa += __shfl_xor(sa, o); sb += __shfl_xor(sb, o); }
    const float ra = rsqrtf(sa * (1.f / D) + EPS), rb = rsqrtf(sb * (1.f / D) + EPS);
    GAS v2u* oa = (GAS v2u*)(F.XN + (size_t)rA * D) + F.lane; GAS v2u* ob = (GAS v2u*)(F.XN + (size_t)rB * D) + F.lane;
#pragma unroll
    for (int j = 0; j < 4; ++j) { const f32x4 g = gp[64 * j]; const f32x4 va = xa.v[j] * ra * g, vb = xb.v[j] * rb * g;
        v2u wa, wb; wa.x = pg8::cvt_pk_bf16(va.x, va.y); wa.y = pg8::cvt_pk_bf16(va.z, va.w); wb.x = pg8::cvt_pk_bf16(vb.x, vb.y); wb.y = pg8::cvt_pk_bf16(vb.z, vb.w);
        oa[64 * j] = wa; ob[64 * j] = wb;
        *(LAS v2u*)(xt + sA * P0_ROWB + (256 * j + 4 * F.lane) * 2) = wa; *(LAS v2u*)(xt + sB * P0_ROWB + (256 * j + 4 * F.lane) * 2) = wb; }
}
__device__ __forceinline__ void p0_rgk(const Frame& F, LAS unsigned char* L0, int step, int nvalid) {
    typedef short bf16x8v __attribute__((ext_vector_type(8)));
    const int l15 = F.lane & 15, kq = F.lane >> 4;
    f32x4 acc = (f32x4){0.f, 0.f, 0.f, 0.f};
    bf16x8v a[4], b[4];
#pragma unroll
    for (int s = 0; s < 4; ++s) { a[s] = *(const LAS bf16x8v*)(L0 + P0_XT + l15 * P0_ROWB + (128 * F.wave + 32 * s + 8 * kq) * 2); b[s] = *(const LAS bf16x8v*)(L0 + P0_WRB + l15 * P0_ROWB + (128 * F.wave + 32 * s + 8 * kq) * 2); }
#pragma unroll
    for (int s = 0; s < 4; ++s) acc = __builtin_amdgcn_mfma_f32_16x16x32_bf16(a[s], b[s], acc, 0, 0, 0);
    LAS float* part = (LAS float*)(L0 + P0_PART) + F.wave * 256;
#pragma unroll
    for (int i = 0; i < 4; ++i) part[(4 * kq + i) * 16 + l15] = acc[i];
    __syncthreads();
    if (F.tid < 256) { const LAS float* pp = (const LAS float*)(L0 + P0_PART) + F.tid; float s = 0.f;
#pragma unroll
        for (int w = 0; w < 8; ++w) s += pp[w * 256];
        const int slot = F.tid >> 4;
        if (slot < nvalid) ((LAS float*)(L0 + P0_RGL))[((slot >> 1) + 16 * step + 8 * (slot & 1)) * 16 + (F.tid & 15)] = s; }
}
__device__ __forceinline__ void p0_prologue(Frame& F) {
    LAS float* scr = (LAS float*)(F.lds + RING_OFF + F.wave * 16384);
    LAS unsigned char* L0 = F.lds + RING_OFF;
    const int gw = F.vcu * NWAVES + F.wave, NGW = F.G * NWAVES;
    if (blockIdx.x == 0) for (int c = F.tid; c < D; c += NWAVES * 64) F.C8[c] = 8.f * 1.4426950408889634f * logsigf_(F.lam[c]);
    f32x4 wrb[8];
#pragma unroll
    for (int q = 0; q < 8; ++q) { const int idx = F.tid + 512 * q; wrb[q] = *(const GAS f32x4*)(F.w_in + (size_t)(idx >> 2) * DIN + DINP + 4 * (idx & 3)); }
    constexpr int I_IN = (D / 64) * (DINP / 32), I_OUT = (DMIX / 64) * (D / 32);
    { f32x4 wa[8], wb[8];
      for (int it = gw; it < I_IN + I_OUT; it += 2 * NGW) {
          const TxItem ta = p0_tx_item(F, it); const bool two = it + NGW < I_IN + I_OUT; const TxItem tb = p0_tx_item(F, two ? it + NGW : it);
          p0_tx_load(ta, F.lane, wa); if (two) p0_tx_load(tb, F.lane, wb);
          p0_tx_finish(ta, scr, F.lane, wa); if (two) p0_tx_finish(tb, scr, F.lane, wb); } }
    PSTAMP(20);
    __syncthreads();
#pragma unroll
    for (int q = 0; q < 8; ++q) { const int idx = F.tid + 512 * q; const int k = idx >> 2, jq = idx & 3; const f32x4 w = wrb[q];
        LAS unsigned short* wp = (LAS unsigned short*)(L0 + P0_WRB) + (4 * jq) * (P0_ROWB / 2) + k;
        wp[0] = (unsigned short)f2bf(w.x); wp[P0_ROWB / 2] = (unsigned short)f2bf(w.y); wp[2 * (P0_ROWB / 2)] = (unsigned short)f2bf(w.z); wp[3 * (P0_ROWB / 2)] = (unsigned short)f2bf(w.w); }
    __syncthreads();
    PSTAMP(21);
    LAS float* rgl = (LAS float*)(L0 + P0_RGL);
    float w2[16];
#pragma unroll
    for (int j = 0; j < 16; ++j) w2[j] = F.w_gk2[j * 512 + F.tid];
    const float bg = F.b_gk[F.tid];
    const bool hasS = F.vcu < NS;
    float cum = 0.f;
    int r0 = F.vcu * 64;
#define P0_BCUM(t0, nt) do { for (int t = (t0); t < (t0) + (nt); t += 4) { float z[4]; \
        _Pragma("unroll") for (int u = 0; u < 4; ++u) { z[u] = bg; \
            _Pragma("unroll") for (int j4 = 0; j4 < 4; ++j4) { const f32x4 rg = *(const LAS f32x4*)(rgl + (t + u) * 16 + 4 * j4); z[u] += (rg.x * w2[4 * j4] + rg.y * w2[4 * j4 + 1]) + (rg.z * w2[4 * j4 + 2] + rg.w * w2[4 * j4 + 3]); } } \
        _Pragma("unroll") for (int u = 0; u < 4; ++u) {          \
            cum -= 0.04332169878499658f * __builtin_amdgcn_logf(1.f + __builtin_amdgcn_exp2f(-1.4426950408889634f * z[u])); \
            ((_Float16*)F.BCUM)[(size_t)(r0 + t + u) * 512 + F.tid] = (_Float16)(1.4426950408889634f * cum); } } } while (0)
    RowX xa = p0_load_row(F, r0 + F.wave), xb = p0_load_row(F, r0 + F.wave + 8);
#pragma unroll 1
    for (int i = 0; i < 4; ++i) { const int ra = F.wave + 16 * i, rb = ra + 8; RowX na = xa, nb = xb;
        if (i < 3) { na = p0_load_row(F, r0 + ra + 16); nb = p0_load_row(F, r0 + rb + 16); }
        else if (hasS) na = p0_load_row(F, NROWP + F.vcu * TS + F.wave);
        p0_rows2(F, r0 + ra, r0 + rb, xa, xb, L0 + P0_XT, 2 * F.wave, 2 * F.wave + 1);
        __syncthreads();
        p0_rgk(F, L0, i, 16);
        __syncthreads();
        P0_BCUM(16 * i, 16);
        xa = na; xb = nb; }
    F.DEC[(size_t)F.vcu * 512 + F.tid] = __builtin_amdgcn_exp2f(1.4426950408889634f * cum);
    __syncthreads();
    if (hasS) {
        cum = 0.f; r0 = NROWP + F.vcu * TS;
        p0_rows2(F, r0 + F.wave, r0 + F.wave, xa, xa, L0 + P0_XT, 2 * F.wave, 2 * F.wave + 1);
        __syncthreads();
        p0_rgk(F, L0, 0, 16);
        __syncthreads();
        P0_BCUM(0, TS);
        F.DEC[(size_t)(NP * (TP / 64) + F.vcu) * 512 + F.tid] = __builtin_amdgcn_exp2f(1.4426950408889634f * cum);
        __syncthreads();
    }
#undef P0_BCUM
}

__device__ __forceinline__ float rdlane(float v, int l) { return __builtin_bit_cast(float, __builtin_amdgcn_readlane(__builtin_bit_cast(int, v), l)); }
__device__ __forceinline__ void lru_simple_item(const Frame& F, int kind, int seq, int nb) {
    const int lane = F.lane, c = nb * 64 + lane;
    const int T = kind ? TS : TP; const size_t row0 = kind ? (size_t)NROWP + (size_t)seq * TS : (size_t)seq * TP;
    float wrg[64], wig[64];
#pragma unroll
    for (int d = 0; d < 64; ++d) { wrg[d] = F.w_rg[(size_t)(nb * 64 + d) * 64 + lane]; wig[d] = F.w_ig[(size_t)(nb * 64 + d) * 64 + lane]; }
    const float brg = F.b_rg[c], big = F.b_ig[c], cb = F.conv_b[c], cw0 = F.conv_w[c], cw1 = F.conv_w[1024 + c], cw2 = F.conv_w[2048 + c], cw3 = F.conv_w[3072 + c];
    const float c8 = 8.f * logsigf_(F.lam[c]);
    float h = kind ? F.st_h[(size_t)seq * 1024 + c] : 0.f;
    float xm3 = kind ? F.st_conv[((size_t)seq * 3 + 0) * 1024 + c] : 0.f, xm2 = kind ? F.st_conv[((size_t)seq * 3 + 1) * 1024 + c] : 0.f, xm1 = kind ? F.st_conv[((size_t)seq * 3 + 2) * 1024 + c] : 0.f;
    for (int t0 = 0; t0 < T; t0 += 8) {
        float xv[8], zv[8];
#pragma unroll
        for (int i = 0; i < 8; ++i) { const bf16* pr = F.PROJ + (row0 + t0 + i) * DINP; xv[i] = bf2f(pr[C_XL + c]); zv[i] = bf2f(pr[C_ZL + c]); }
#pragma unroll 1
        for (int i = 0; i < 8; ++i) {
            const float x = xv[i]; const float xc = cb + cw0 * xm3 + cw1 * xm2 + cw2 * xm1 + cw3 * x; xm3 = xm2; xm2 = xm1; xm1 = x;
            float ar = brg, ai = big;
#pragma unroll
            for (int d = 0; d < 64; ++d) { const float xd = rdlane(xc, d); ar += xd * wrg[d]; ai += xd * wig[d]; }
            const float r = sigmoidf_(ar), ig = sigmoidf_(ai);
            const float la = c8 * r, a = __expf(la), u = sqrtf(-expm1f(2.f * la)) * (ig * xc);
            h = a * h + u;
            const float z = zv[i], y = h * z * sigmoidf_(z);
            F.YMIX[(row0 + t0 + i) * DMIX + c] = (bf16)f2bf(y);
        }
    }
    float* ho = F.out + (kind ? O_HS : O_HP) + (size_t)seq * 1024 + c; *ho = h;
    float* co = F.out + (kind ? O_CS : O_CP) + (size_t)seq * 3 * 1024 + c; co[0] = xm3; co[1024] = xm2; co[2048] = xm1;
}
__device__ __forceinline__ void gla_simple_item(const Frame& F, int kind, int seq, int h, int hsel) {
    int t2 = F.tid & 255; asm volatile("" : "+v"(t2)); const int w4 = t2 >> 6;
    const int T = kind ? TS : TP; const size_t row0 = kind ? (size_t)NROWP + (size_t)seq * TS : (size_t)seq * TP;
    LAS float* L = (LAS float*)(F.lds + RING_OFF + hsel * 4096);
    LAS float* al = L, *qs = L + 128, *ks = L + 256, *red = L + 384;
    float S[128];
    const float* s0 = F.st_gla + (((size_t)seq * NH + h) * HK) * HV + t2;
#pragma unroll
    for (int d = 0; d < 128; ++d) S[d] = kind ? s0[(size_t)d * HV] : 0.f;
    const float gh = F.g_head[t2];
    for (int t = 0; t < T; ++t) {
        const size_t row = row0 + t; const bf16* pr = F.PROJ + row * DINP;
        if (t2 < 128) { const bool cbeg = kind ? false : ((t & 63) == 0 && t > 0); const size_t ci = (size_t)(seq * (TP / 64) + (t >> 6) - 1);
            al[t2] = cbeg ? F.DEC[ci * 512 + h * 128 + t2] : 1.f; qs[t2] = bf2f(pr[C_Q + h * 128 + t2]); ks[t2] = bf2f(pr[C_K + h * 128 + t2]); }
        const float vv = bf2f(pr[C_V + h * 256 + t2]), zz = bf2f(pr[C_ZG + h * 256 + t2]);
        __syncthreads();
        float o = 0.f;
#pragma unroll
        for (int d4 = 0; d4 < 32; ++d4) { const f32x4 a4 = *(const LAS f32x4*)(al + 4 * d4), k4 = *(const LAS f32x4*)(ks + 4 * d4), q4 = *(const LAS f32x4*)(qs + 4 * d4);
            S[4 * d4 + 0] = a4.x * S[4 * d4 + 0] + k4.x * vv; o += q4.x * S[4 * d4 + 0];
            S[4 * d4 + 1] = a4.y * S[4 * d4 + 1] + k4.y * vv; o += q4.y * S[4 * d4 + 1];
            S[4 * d4 + 2] = a4.z * S[4 * d4 + 2] + k4.z * vv; o += q4.z * S[4 * d4 + 2];
            S[4 * d4 + 3] = a4.w * S[4 * d4 + 3] + k4.w * vv; o += q4.w * S[4 * d4 + 3]; }
        const float ss = wave_sum(o * o);
        if (F.lane == 0) red[w4] = ss;
        __syncthreads();
        const float tot = (red[0] + red[1]) + (red[2] + red[3]);
        const float rs = rsqrtf(tot * (1.f / 256.f) + EPS);
        const float y = o * rs * gh * (zz * sigmoidf_(zz));
        F.YMIX[row * DMIX + 1024 + h * 256 + t2] = (bf16)f2bf(y);
        __syncthreads();
    }
    if (t2 < 128) al[t2] = F.DEC[(kind ? (size_t)(NP * (TP / 64) + seq) : (size_t)(seq * (TP / 64) + TP / 64 - 1)) * 512 + h * 128 + t2];
    __syncthreads();
    float* so = F.out + (kind ? O_GS : O_GP) + (((size_t)seq * NH + h) * HK) * HV + t2;
#pragma unroll
    for (int d = 0; d < 128; ++d) so[(size_t)d * HV] = S[d] * al[d];
    __syncthreads();
}
#ifndef TAIL_SAMPLE
#define TAIL_SAMPLE 0
#endif


typedef short bf16x8_t __attribute__((ext_vector_type(8)));
typedef float f32x16 __attribute__((ext_vector_type(16)));
constexpr int LRU_XL_ROWS = 44;
constexpr int LRU_XL_OFF = 0, LRU_XL_WB = LRU_XL_ROWS * 128;
constexpr int LRU_ZL_OFF = LRU_XL_OFF + 8 * LRU_XL_WB, LRU_ZL_WB = 32 * 128;
constexpr int LRU_XC_OFF = LRU_ZL_OFF + 8 * LRU_ZL_WB, LRU_XC_WB = 32 * 144;
constexpr int LRU_SL_OFF = LRU_XC_OFF + 8 * LRU_XC_WB;
constexpr int LRU_HC_OFF = LRU_SL_OFF + 2 * 8 * 2 * 64 * 4;
constexpr int LRU_WG_OFF = LRU_HC_OFF + 2 * 64 * 4;
constexpr int LRU_END = LRU_WG_OFF + 128 * 144;
static_assert(LRU_END <= RING_BYTES, "LRU LDS map");
#define L2E 1.4426950408889634f
template <int KIND>
__device__ __forceinline__ void lru_item(const Frame& F, int sg, int nb) {
    int lane = F.lane; asm volatile("" : "+v"(lane));
    const int wave = F.wave, cl = lane & 31, hh = lane >> 5;
    LAS unsigned char* XLw = F.lds + RING_OFF + LRU_XL_OFF + wave * LRU_XL_WB;
    LAS unsigned char* ZLw = F.lds + RING_OFF + LRU_ZL_OFF + wave * LRU_ZL_WB;
    LAS unsigned char* XCw = F.lds + RING_OFF + LRU_XC_OFF + wave * LRU_XC_WB;
    LAS float* SL = (LAS float*)(F.lds + RING_OFF + LRU_SL_OFF);
    LAS float* HC = (LAS float*)(F.lds + RING_OFF + LRU_HC_OFF);
    LAS unsigned char* WGl = F.lds + RING_OFF + LRU_WG_OFF;
    __syncthreads();
    constexpr int NR = KIND ? 1 : 8;
    const size_t rowbase = KIND ? (size_t)NROWP + (size_t)sg * 256 : (size_t)sg * TP;
    if (KIND == 0) { if (F.tid < 64) HC[F.tid] = 0.f; }
    v4u xl0[KIND ? 6 : 5], zl0[4];
    if (KIND == 0) {
#pragma unroll
        for (int q = 0; q < 5; ++q) { const int p = lane + 64 * q; const int row = p >> 3, pc = p & 7; xl0[q] = (v4u){0u, 0u, 0u, 0u};
            if (row < 35) { const long tok = (long)wave * 32 + row - 3; if (tok >= 0) xl0[q] = *(const GAS v4u*)(F.PROJ + (rowbase + tok) * DINP + C_XL + nb * 64 + pc * 8); } }
    } else {
#pragma unroll
        for (int q = 0; q < 6; ++q) { const int p = lane + 64 * q; const int row = p >> 3, pc = p & 7; xl0[q] = (v4u){0u, 0u, 0u, 0u};
            if (row < 44) { const int sq = row / 11, rr = row - sq * 11; const int seq = sg * 32 + wave * 4 + sq;
                if (rr < 3) { const float* sp = F.st_conv + ((size_t)seq * 3 + rr) * 1024 + nb * 64 + pc * 8; const f32x4 a = *(const GAS f32x4*)sp, b = *(const GAS f32x4*)(sp + 4);
                    xl0[q].x = pk2(a.x, a.y); xl0[q].y = pk2(a.z, a.w); xl0[q].z = pk2(b.x, b.y); xl0[q].w = pk2(b.z, b.w); }
                else xl0[q] = *(const GAS v4u*)(F.PROJ + ((size_t)NROWP + (size_t)seq * 8 + rr - 3) * DINP + C_XL + nb * 64 + pc * 8); } }
    }
#pragma unroll
    for (int q = 0; q < 4; ++q) { const int p = lane + 64 * q; const int row = p >> 3, pc = p & 7; zl0[q] = *(const GAS v4u*)(F.PROJ + (rowbase + wave * 32 + row) * DINP + C_ZL + nb * 64 + pc * 8); }
    { const int col = F.tid & 127, kq = F.tid >> 7; const float* W = ((col >> 6) ? F.w_ig : F.w_rg) + (size_t)nb * 4096 + (size_t)(16 * kq) * 64 + (col & 63);
      float wv[16];
#pragma unroll
      for (int j = 0; j < 16; ++j) wv[j] = W[j * 64];
      v4u p0, p1;
      p0.x = pk2(-L2E * wv[0], -L2E * wv[1]); p0.y = pk2(-L2E * wv[2], -L2E * wv[3]); p0.z = pk2(-L2E * wv[4], -L2E * wv[5]); p0.w = pk2(-L2E * wv[6], -L2E * wv[7]);
      p1.x = pk2(-L2E * wv[8], -L2E * wv[9]); p1.y = pk2(-L2E * wv[10], -L2E * wv[11]); p1.z = pk2(-L2E * wv[12], -L2E * wv[13]); p1.w = pk2(-L2E * wv[14], -L2E * wv[15]);
      *(LAS v4u*)(WGl + col * 144 + (16 * kq) * 2) = p0; *(LAS v4u*)(WGl + col * 144 + (16 * kq + 8) * 2) = p1; }
#pragma unroll
    for (int q = 0; q < (KIND ? 6 : 5); ++q) { const int p = lane + 64 * q; const int row = p >> 3, pc = p & 7; if (row < (KIND ? 44 : 35)) *(LAS v4u*)(XLw + row * 128 + pc * 16) = xl0[q]; }
#pragma unroll
    for (int q = 0; q < 4; ++q) { const int p = lane + 64 * q; *(LAS v4u*)(ZLw + (p >> 3) * 128 + (p & 7) * 16) = zl0[q]; }
    for (int r = 0; r < NR; ++r) {
        const int par = r & 1;
        const size_t srow = rowbase + (size_t)r * 256 + wave * 32;
        const bool more = (KIND == 0) && (r + 1 < NR);
        __syncthreads();
        float gbr[2], gbi[2], gc8[2], cwv[2][4], cbv[2];
#pragma unroll
        for (int ct = 0; ct < 2; ++ct) { const int cg = nb * 64 + 32 * ct + cl; gbr[ct] = F.b_rg[cg]; gbi[ct] = F.b_ig[cg]; gc8[ct] = F.C8[cg]; cbv[ct] = F.conv_b[cg];
#pragma unroll
            for (int j = 0; j < 4; ++j) cwv[ct][j] = F.conv_w[j * 1024 + cg]; }
        float xc[2][16];
#pragma unroll
        for (int ct = 0; ct < 2; ++ct) {
            float cw[4]; const float cb = cbv[ct];
#pragma unroll
            for (int j = 0; j < 4; ++j) cw[j] = cwv[ct][j];
            v2u xa0, xb0, xa1, xb1, xa2, xb2, xa3, xb3;
            { const unsigned xad = (unsigned)(size_t)XLw + (unsigned)((4 * hh + ((lane & 15) >> 2)) * 128 + (32 * ct + 16 * ((lane >> 4) & 1) + 4 * (lane & 3)) * 2);
              if (KIND) asm volatile("ds_read_b64_tr_b16 %0, %8\n\tds_read_b64_tr_b16 %1, %8 offset:512\n\tds_read_b64_tr_b16 %2, %8 offset:1408\n\tds_read_b64_tr_b16 %3, %8 offset:1920\n\t"
                                     "ds_read_b64_tr_b16 %4, %8 offset:2816\n\tds_read_b64_tr_b16 %5, %8 offset:3328\n\tds_read_b64_tr_b16 %6, %8 offset:4224\n\tds_read_b64_tr_b16 %7, %8 offset:4736\n\ts_waitcnt lgkmcnt(0)"
                                     : "=&v"(xa0), "=&v"(xb0), "=&v"(xa1), "=&v"(xb1), "=&v"(xa2), "=&v"(xb2), "=&v"(xa3), "=&v"(xb3) : "v"(xad) : "memory");
              else asm volatile("ds_read_b64_tr_b16 %0, %8\n\tds_read_b64_tr_b16 %1, %8 offset:512\n\tds_read_b64_tr_b16 %2, %8 offset:1024\n\tds_read_b64_tr_b16 %3, %8 offset:1536\n\t"
                                "ds_read_b64_tr_b16 %4, %8 offset:2048\n\tds_read_b64_tr_b16 %5, %8 offset:2560\n\tds_read_b64_tr_b16 %6, %8 offset:3072\n\tds_read_b64_tr_b16 %7, %8 offset:3584\n\ts_waitcnt lgkmcnt(0)"
                                : "=&v"(xa0), "=&v"(xb0), "=&v"(xa1), "=&v"(xb1), "=&v"(xa2), "=&v"(xb2), "=&v"(xa3), "=&v"(xb3) : "v"(xad) : "memory"); }
            const unsigned xw[4][4] = {{xa0.x, xa0.y, xb0.x, xb0.y}, {xa1.x, xa1.y, xb1.x, xb1.y}, {xa2.x, xa2.y, xb2.x, xb2.y}, {xa3.x, xa3.y, xb3.x, xb3.y}};
#pragma unroll
            for (int g = 0; g < 4; ++g) { const float x0 = bflo(xw[g][0]), x1 = bfhi(xw[g][0]), x2 = bflo(xw[g][1]), x3 = bfhi(xw[g][1]), x4 = bflo(xw[g][2]), x5 = bfhi(xw[g][2]), x6 = bflo(xw[g][3]);
                xc[ct][4 * g + 0] = cb + cw[0] * x0 + cw[1] * x1 + cw[2] * x2 + cw[3] * x3; xc[ct][4 * g + 1] = cb + cw[0] * x1 + cw[1] * x2 + cw[2] * x3 + cw[3] * x4;
                xc[ct][4 * g + 2] = cb + cw[0] * x2 + cw[1] * x3 + cw[2] * x4 + cw[3] * x5; xc[ct][4 * g + 3] = cb + cw[0] * x3 + cw[1] * x4 + cw[2] * x5 + cw[3] * x6; }
        }
#pragma unroll
        for (int ct = 0; ct < 2; ++ct)
#pragma unroll
            for (int i = 0; i < 16; i += 2) { const unsigned w = pg8::cvt_pk_bf16(xc[ct][i], xc[ct][i + 1]);
                *(LAS unsigned short*)(XCw + ((i & 3) + 8 * (i >> 2) + 4 * hh) * 144 + (32 * ct + cl) * 2) = (unsigned short)w;
                *(LAS unsigned short*)(XCw + (((i + 1) & 3) + 8 * (i >> 2) + 4 * hh) * 144 + (32 * ct + cl) * 2) = (unsigned short)(w >> 16); }
        bf16x8_t Af[4];
#pragma unroll
        for (int s = 0; s < 4; ++s) Af[s] = *(const LAS bf16x8_t*)(XCw + cl * 144 + (16 * s + 8 * hh) * 2);
        float At_[2], Ut_[2];
        float Aloc[2][16], Hloc[2][16], AGk[2][4], UGk[2][4];
#pragma unroll
        for (int ct = 0; ct < 2; ++ct) {
            f32x16 ar, ai;
            const float brg = -L2E * gbr[ct], big = -L2E * gbi[ct], c8 = gc8[ct];
#pragma unroll
            for (int i = 0; i < 16; ++i) { ar[i] = brg; ai[i] = big; }
            bf16x8_t b0[4], b1[4];
#pragma unroll
            for (int s = 0; s < 4; ++s) { b0[s] = *(const LAS bf16x8_t*)(WGl + (32 * ct + cl) * 144 + (16 * s + 8 * hh) * 2); b1[s] = *(const LAS bf16x8_t*)(WGl + (64 + 32 * ct + cl) * 144 + (16 * s + 8 * hh) * 2); }
#pragma unroll
            for (int s = 0; s < 4; ++s) { ar = __builtin_amdgcn_mfma_f32_32x32x16_bf16(Af[s], b0[s], ar, 0, 0, 0); ai = __builtin_amdgcn_mfma_f32_32x32x16_bf16(Af[s], b1[s], ai, 0, 0, 0); }
            float AG[4], UG[4];
#pragma unroll
            for (int g = 0; g < 4; ++g) { float Ap = 1.f, Hp = 0.f;
#pragma unroll
                for (int e = 0; e < 4; ++e) { const int i = 4 * g + e;
                    const float rr = __builtin_amdgcn_rcpf(1.f + __builtin_amdgcn_exp2f(ar[i])), di = 1.f + __builtin_amdgcn_exp2f(ai[i]);
                    const float a = __builtin_amdgcn_exp2f(c8 * rr);
                    const float w = fmaxf(1.f - a * a, 0.f);
                    const float u = w * __builtin_amdgcn_rsqf(fmaxf(w * di * di, 1e-30f)) * xc[ct][i];
                    Hp = a * Hp + u; Ap = a * Ap; Aloc[ct][i] = Ap; Hloc[ct][i] = Hp; }
                AG[g] = Ap; UG[g] = Hp; }
            float At = 1.f, Ut = 0.f;
#pragma unroll
            for (int g = 0; g < 4; ++g) { const float pA = __shfl_xor(AG[g], 32), pU = __shfl_xor(UG[g], 32);
                const float a0 = hh ? pA : AG[g], u0 = hh ? pU : UG[g], a1 = hh ? AG[g] : pA, u1 = hh ? UG[g] : pU;
                Ut = a0 * Ut + u0; At = a0 * At; Ut = a1 * Ut + u1; At = a1 * At; AGk[ct][g] = AG[g]; UGk[ct][g] = UG[g]; }
            At_[ct] = At; Ut_[ct] = Ut;
        }
        v4u xn[5];
        if (more) {
#pragma unroll
            for (int q = 0; q < 5; ++q) { const int p = lane + 64 * q; const int row = p >> 3, pc = p & 7;
                if (row < 35) xn[q] = *(const GAS v4u*)(F.PROJ + (srow + 256 + row - 3) * DINP + C_XL + nb * 64 + pc * 8); }
        }
        v4u zn[4];
        if (more) {
#pragma unroll
            for (int q = 0; q < 4; ++q) { const int p = lane + 64 * q; const int row = p >> 3, pc = p & 7;
                zn[q] = *(const GAS v4u*)(F.PROJ + (srow + 256 + row) * DINP + C_ZL + nb * 64 + pc * 8); }
        }
        float hin[2] = {0.f, 0.f};
        if (KIND == 0) {
            if (hh == 0) {
#pragma unroll
                for (int ct = 0; ct < 2; ++ct) { SL[((par * 8 + wave) * 2 + 0) * 64 + 32 * ct + cl] = At_[ct]; SL[((par * 8 + wave) * 2 + 1) * 64 + 32 * ct + cl] = Ut_[ct]; } }
            __syncthreads();
#pragma unroll
            for (int ct = 0; ct < 2; ++ct) { float sa[7], su[7]; float hs = HC[par * 64 + 32 * ct + cl];
#pragma unroll
                for (int w2 = 0; w2 < 7; ++w2) { sa[w2] = SL[((par * 8 + w2) * 2 + 0) * 64 + 32 * ct + cl]; su[w2] = SL[((par * 8 + w2) * 2 + 1) * 64 + 32 * ct + cl]; }
#pragma unroll
                for (int w2 = 0; w2 < 7; ++w2) { const float hn = sa[w2] * hs + su[w2]; hs = w2 < wave ? hn : hs; }
                hin[ct] = hs;
                if (wave == 7 && hh == 0) HC[(par ^ 1) * 64 + 32 * ct + cl] = At_[ct] * hs + Ut_[ct]; }
        }
#pragma unroll
        for (int ct = 0; ct < 2; ++ct) {
            float hst[4]; float hs = hin[ct];
#pragma unroll
            for (int g = 0; g < 4; ++g) { const float pA = __shfl_xor(AGk[ct][g], 32), pU = __shfl_xor(UGk[ct][g], 32);
                const float a0 = hh ? pA : AGk[ct][g], u0 = hh ? pU : UGk[ct][g], a1 = hh ? AGk[ct][g] : pA, u1 = hh ? UGk[ct][g] : pU;
                if (KIND == 1) hs = F.st_h[(size_t)(sg * 32 + wave * 4 + g) * 1024 + nb * 64 + 32 * ct + cl];
                const float hs0 = hs; hs = a0 * hs + u0;
                hst[g] = hh ? hs : hs0; hs = a1 * hs + u1;
                if (KIND == 1 && hh == 0) F.out[O_HS + (size_t)(sg * 32 + wave * 4 + g) * 1024 + nb * 64 + 32 * ct + cl] = hs;
            }
            if (KIND == 0 && r == NR - 1 && wave == 7 && hh == 0) F.out[O_HP + (size_t)sg * 1024 + nb * 64 + 32 * ct + cl] = hs;
            LAS unsigned short* zl = (LAS unsigned short*)ZLw + 32 * ct + cl;
            v2u zt0, zt1, zt2, zt3;
            { const unsigned za = (unsigned)(size_t)ZLw + (unsigned)((4 * hh + ((lane & 15) >> 2)) * 128 + (32 * ct + 16 * ((lane >> 4) & 1) + 4 * (lane & 3)) * 2);
              asm volatile("ds_read_b64_tr_b16 %0, %4\n\tds_read_b64_tr_b16 %1, %4 offset:1024\n\tds_read_b64_tr_b16 %2, %4 offset:2048\n\tds_read_b64_tr_b16 %3, %4 offset:3072\n\ts_waitcnt lgkmcnt(0)"
                           : "=&v"(zt0), "=&v"(zt1), "=&v"(zt2), "=&v"(zt3) : "v"(za) : "memory"); }
            const unsigned zw[8] = {zt0.x, zt0.y, zt1.x, zt1.y, zt2.x, zt2.y, zt3.x, zt3.y};
            unsigned short yr[16];
#pragma unroll
            for (int i = 0; i < 16; i += 2) { const float y0 = (Aloc[ct][i] * hst[i >> 2] + Hloc[ct][i]) * bflo(zw[i >> 1]), y1 = (Aloc[ct][i + 1] * hst[i >> 2] + Hloc[ct][i + 1]) * bfhi(zw[i >> 1]);
                const unsigned w = pg8::cvt_pk_bf16(y0, y1); yr[i] = (unsigned short)w; yr[i + 1] = (unsigned short)(w >> 16); }
#pragma unroll
            for (int i = 0; i < 16; ++i) zl[((i & 3) + 8 * (i >> 2) + 4 * hh) * 64] = yr[i];
        }
        v4u yo[4];
#pragma unroll
        for (int q = 0; q < 4; ++q) { const int p = lane + 64 * q; yo[q] = *(const LAS v4u*)(ZLw + (p >> 3) * 128 + (p & 7) * 16); }
#pragma unroll
        for (int q = 0; q < 4; ++q) { const int p = lane + 64 * q;
            if (KIND == 1 && LATE_SAMPLE) __builtin_amdgcn_raw_buffer_store_b128(yo[q], __builtin_amdgcn_make_buffer_rsrc((void*)F.YMIX, 0, 0x7fffffff, 0x00020000), (int)(((srow + (p >> 3)) * DMIX + nb * 64 + (p & 7) * 8) * 2), 0, 16);
            else *(GAS v4u*)(F.YMIX + (srow + (p >> 3)) * DMIX + nb * 64 + (p & 7) * 8) = yo[q]; }
        if (KIND == 0) {
            if (r == NR - 1 && wave == 7) { for (int e = lane; e < 192; e += 64) { const int j = e >> 6, c = e & 63;
                F.out[O_CP + ((size_t)sg * 3 + j) * 1024 + nb * 64 + c] = bf2f(((const LAS unsigned short*)XLw)[(32 + j) * 64 + c]); } }
        } else {
            for (int e = lane; e < 4 * 192; e += 64) { const int sq = e / 192, j = (e % 192) >> 6, c = e & 63;
                F.out[O_CS + ((size_t)(sg * 32 + wave * 4 + sq) * 3 + j) * 1024 + nb * 64 + c] = bf2f(((const LAS unsigned short*)XLw)[(sq * 11 + 8 + j) * 64 + c]); }
        }
        if (more) {
#pragma unroll
            for (int q = 0; q < 5; ++q) { const int p = lane + 64 * q; const int row = p >> 3, pc = p & 7;
                if (row < 35) *(LAS v4u*)(XLw + row * 128 + pc * 16) = xn[q]; }
        }
        if (more) {
#pragma unroll
            for (int q = 0; q < 4; ++q) { const int p = lane + 64 * q; *(LAS v4u*)(ZLw + (p >> 3) * 128 + (p & 7) * 16) = zn[q]; }
        }
    }
    __syncthreads();
}


constexpr int GL_BUF = 49152;
constexpr int GL_QT = 0, GL_KT = 16384, GL_VZ = 32768, GL_AT = 2 * GL_BUF, GL_SBT = GL_AT + 9216, GL_YL = GL_SBT + 17408, GL_DEC = GL_YL + 9216, GL_END = GL_DEC + 16384;
static_assert(GL_END <= RING_BYTES, "GLA LDS map");
__device__ __forceinline__ unsigned off_b(unsigned row, unsigned ch) { return 256u * row + 16u * (ch ^ (((row & 3u) << 2) | ((row >> 2) & 3u))); }
__device__ __forceinline__ void tr_addr(unsigned lane, unsigned c, unsigned ks, unsigned& a0, unsigned& a1) {
    const unsigned h = lane >> 5, blk = (lane >> 4) & 1u, q = (lane & 15u) >> 2, p = lane & 3u;
    a0 = off_b(16u * ks + 8u * h + q, 4u * c + 2u * blk + (p >> 1)) + 8u * (p & 1u);
    a1 = off_b(16u * ks + 8u * h + 4u + q, 4u * c + 2u * blk + (p >> 1)) + 8u * (p & 1u);
}
__device__ __forceinline__ void tr_frag4(unsigned base, const unsigned (&a)[8], bf16x8_t (&f)[4]) {
    v2u r0, r1, r2, r3, r4, r5, r6, r7;
    asm volatile("ds_read_b64_tr_b16 %0, %8\n\tds_read_b64_tr_b16 %1, %9\n\tds_read_b64_tr_b16 %2, %10\n\tds_read_b64_tr_b16 %3, %11\n\t"
                 "ds_read_b64_tr_b16 %4, %12\n\tds_read_b64_tr_b16 %5, %13\n\tds_read_b64_tr_b16 %6, %14\n\tds_read_b64_tr_b16 %7, %15\n\ts_waitcnt lgkmcnt(0)"
                 : "=&v"(r0), "=&v"(r1), "=&v"(r2), "=&v"(r3), "=&v"(r4), "=&v"(r5), "=&v"(r6), "=&v"(r7)
                 : "v"(base + a[0]), "v"(base + a[1]), "v"(base + a[2]), "v"(base + a[3]), "v"(base + a[4]), "v"(base + a[5]), "v"(base + a[6]), "v"(base + a[7]) : "memory");
    f[0] = __builtin_bit_cast(bf16x8_t, (v4u){r0.x, r0.y, r1.x, r1.y}); f[1] = __builtin_bit_cast(bf16x8_t, (v4u){r2.x, r2.y, r3.x, r3.y});
    f[2] = __builtin_bit_cast(bf16x8_t, (v4u){r4.x, r4.y, r5.x, r5.y}); f[3] = __builtin_bit_cast(bf16x8_t, (v4u){r6.x, r6.y, r7.x, r7.y});
}
__device__ __forceinline__ void gla_item(const Frame& F, int b, int h, int vs) {
    int tid = F.tid; asm volatile("" : "+v"(tid));
    const int lane = tid & 63, wave = F.wave, cl = lane & 31, hh = lane >> 5;
    LAS unsigned char* L = F.lds + RING_OFF;
    const unsigned Lb = (unsigned)(size_t)L;
    const int dt = wave >> 1, vt = wave & 1;
    const size_t row0 = (size_t)b * TP;
    f32x16 Sacc;
#pragma unroll
    for (int i = 0; i < 16; ++i) Sacc[i] = 0.f;
    v4u pq[2][2], pk[2][2], pv[2], pz[2];
    const int qrow = tid >> 4, qch = tid & 15, vrow = tid >> 3, vch = tid & 7;
    const unsigned sq0 = off_b(qrow, qch), sq1 = off_b(qrow + 32, qch), sv0 = off_b(vrow, vch), sv1 = off_b(vrow, 8 + vch);
    unsigned tk[8], tv[8];
#pragma unroll
    for (unsigned ks = 0; ks < 4; ++ks) { tr_addr(lane, dt, ks, tk[2 * ks], tk[2 * ks + 1]); tr_addr(lane, vt, ks, tv[2 * ks], tv[2 * ks + 1]); }
#define GL_LOAD(n, s) do { const bf16* pr = F.PROJ + (row0 + (size_t)(n) * 64) * DINP; \
        pq[s][0] = *(const GAS v4u*)(pr + (size_t)qrow * DINP + C_Q + h * 128 + qch * 8); pq[s][1] = *(const GAS v4u*)(pr + (size_t)(qrow + 32) * DINP + C_Q + h * 128 + qch * 8); \
        pk[s][0] = *(const GAS v4u*)(pr + (size_t)qrow * DINP + C_K + h * 128 + qch * 8); pk[s][1] = *(const GAS v4u*)(pr + (size_t)(qrow + 32) * DINP + C_K + h * 128 + qch * 8); \
        pv[s] = *(const GAS v4u*)(pr + (size_t)vrow * DINP + C_V + h * 256 + vs * 64 + vch * 8); pz[s] = *(const GAS v4u*)(pr + (size_t)vrow * DINP + C_ZG + h * 256 + vs * 64 + vch * 8); \
        } while (0)
#define GL_STAGE(bo, s) do { LAS unsigned char* B_ = L + (bo); \
        *(LAS v4u*)(B_ + GL_QT + sq0) = pq[s][0]; *(LAS v4u*)(B_ + GL_QT + sq1) = pq[s][1]; *(LAS v4u*)(B_ + GL_KT + sq0) = pk[s][0]; *(LAS v4u*)(B_ + GL_KT + sq1) = pk[s][1]; \
        *(LAS v4u*)(B_ + GL_VZ + sv0) = pv[s]; *(LAS v4u*)(B_ + GL_VZ + sv1) = pz[s]; } while (0)
#define GL_ROWF(img, row, ks) (*(const LAS bf16x8_t*)(L + (img) + off_b((row), 2 * (ks) + hh)))
#define GL_PADF(base, stride, row, ks) (*(const LAS bf16x8_t*)(L + (base) + (row) * (stride) + (16 * (ks) + 8 * hh) * 2))
#define GL_UPD(bo) do { bf16x8_t fa[4], fb[4]; f32x4 dc[4]; \
        _Pragma("unroll") for (int g = 0; g < 4; ++g) dc[g] = *(const LAS f32x4*)(L + GL_DEC + (n * 128 + 32 * dt + 8 * g + 4 * hh) * 4); \
        tr_frag4(Lb + (bo) + GL_KT, tk, fa); tr_frag4(Lb + (bo) + GL_VZ, tv, fb); \
        _Pragma("unroll") for (int ks = 0; ks < 4; ++ks) Sacc = __builtin_amdgcn_mfma_f32_32x32x16_bf16(fa[ks], fb[ks], Sacc, 0, 0, 0); \
        _Pragma("unroll") for (int i = 0; i < 16; ++i) Sacc[i] *= dc[i >> 2][i & 3]; } while (0)
    __syncthreads();
    GL_LOAD(0, 0);
    { f32x4 dcp[2];
#pragma unroll
      for (int q = 0; q < 2; ++q) { const int i = tid + q * NWAVES * 64; dcp[q] = *(const GAS f32x4*)(F.DEC + ((size_t)(b * (TP / 64) + (i >> 5))) * 512 + h * 128 + (i & 31) * 4); }
      GL_LOAD(1, 1);
#pragma unroll
      for (int q = 0; q < 2; ++q) { const int i = tid + q * NWAVES * 64; *(LAS f32x4*)(L + GL_DEC + i * 16) = dcp[q]; } }
    GL_STAGE(0, 0);
    GL_LOAD(2, 0);
#ifdef DIAG_DUR
    unsigned long long acc_ = 0ull, tA_ = 0ull;
#define DT0() do { tA_ = __builtin_amdgcn_s_memrealtime(); } while (0)
#define DT1(id) do { if (DIAG_ID == (id)) acc_ += __builtin_amdgcn_s_memrealtime() - tA_; } while (0)
#else
#define DT0() do {} while (0)
#define DT1(id) do {} while (0)
#endif
    for (int n2 = 0; n2 < TP / 64; n2 += 2) {
#define SET_ 1
      { const int n = n2;
        const int bo = (n & 1) * GL_BUF;
        __syncthreads();
        DT0(); if (wave >= 4) __builtin_amdgcn_s_setprio(1);
        if (n > 0) {
            *(GAS v4u*)(F.YMIX + (row0 + (size_t)(n - 1) * 64 + vrow) * DMIX + 1024 + h * 256 + vs * 64 + vch * 8) = *(const LAS v4u*)(L + GL_YL + vrow * 144 + vch * 16); }
        if (n + 1 < TP / 64) GL_STAGE(GL_BUF - bo, SET_);
        if (n + 3 < TP / 64) GL_LOAD(n + 3, SET_);
        DT1(34); DT0();
#pragma unroll
        for (int g = 0; g < 4; ++g) { v2u w; w.x = pg8::cvt_pk_bf16(Sacc[4 * g], Sacc[4 * g + 1]); w.y = pg8::cvt_pk_bf16(Sacc[4 * g + 2], Sacc[4 * g + 3]);
            *(LAS v2u*)(L + GL_SBT + (32 * vt + cl) * 272 + (32 * dt + 8 * g + 4 * hh) * 2) = w; }
        const bool attw = (wave >= 4 && wave < 7);
        if (attw) {
            const int st = (wave - 4) >> 1, ct = (wave - 3) >> 1;
            f32x16 a;
#pragma unroll
            for (int i = 0; i < 16; ++i) a[i] = 0.f;
            bf16x8_t ka[8], qb[8];
#pragma unroll
            for (int ks = 0; ks < 8; ++ks) { ka[ks] = GL_ROWF(bo + GL_KT, 32 * st + cl, ks); qb[ks] = GL_ROWF(bo + GL_QT, 32 * ct + cl, ks); }
            asm volatile("s_waitcnt lgkmcnt(0)" ::: "memory");
#pragma unroll
            for (int ks = 0; ks < 8; ++ks) a = __builtin_amdgcn_mfma_f32_32x32x16_bf16(ka[ks], qb[ks], a, 0, 0, 0);
            if (st == ct) {
#pragma unroll
                for (int i = 0; i < 16; ++i) { const int sl = (i & 3) + 8 * (i >> 2) + 4 * hh; a[i] = sl <= cl ? a[i] : 0.f; } }
#pragma unroll
            for (int g = 0; g < 4; ++g) { v2u w; w.x = pg8::cvt_pk_bf16(a[4 * g], a[4 * g + 1]); w.y = pg8::cvt_pk_bf16(a[4 * g + 2], a[4 * g + 3]);
                *(LAS v2u*)(L + GL_AT + (32 * ct + cl) * 144 + (32 * st + 8 * g + 4 * hh) * 2) = w; }
        } else GL_UPD(bo);
        DT1(35); if (wave >= 4) __builtin_amdgcn_s_setprio(0);
        __syncthreads();
        if (attw) GL_UPD(bo);
        if (wave < 4) {
            f32x16 o;
#pragma unroll
            for (int i = 0; i < 16; ++i) o[i] = 0.f;
            bf16x8_t fv[4], fa[4], fs[4], fq[4]; tr_frag4(Lb + bo + GL_VZ, tv, fv);
            v2u zc[4];
#pragma unroll
            for (int ks = 0; ks < 4; ++ks) { fa[ks] = GL_PADF(GL_AT, 144, 32 * dt + cl, ks); fs[ks] = GL_PADF(GL_SBT, 272, 32 * vt + cl, ks); fq[ks] = GL_ROWF(bo + GL_QT, 32 * dt + cl, ks); }
            asm volatile("s_waitcnt lgkmcnt(0)" ::: "memory");
            o = __builtin_amdgcn_mfma_f32_32x32x16_bf16(fv[0], fa[0], o, 0, 0, 0);
            o = __builtin_amdgcn_mfma_f32_32x32x16_bf16(fv[1], fa[1], o, 0, 0, 0);
            if (dt) { o = __builtin_amdgcn_mfma_f32_32x32x16_bf16(fv[2], fa[2], o, 0, 0, 0); o = __builtin_amdgcn_mfma_f32_32x32x16_bf16(fv[3], fa[3], o, 0, 0, 0); }
#pragma unroll
            for (int ks = 0; ks < 4; ++ks) o = __builtin_amdgcn_mfma_f32_32x32x16_bf16(fs[ks], fq[ks], o, 0, 0, 0);
#pragma unroll
            for (int ks = 0; ks < 4; ++ks) { fs[ks] = GL_PADF(GL_SBT, 272, 32 * vt + cl, 4 + ks); fq[ks] = GL_ROWF(bo + GL_QT, 32 * dt + cl, 4 + ks); }
#pragma unroll
            for (int g = 0; g < 4; ++g) zc[g] = *(const LAS v2u*)(L + bo + GL_VZ + off_b(32 * dt + cl, 8 + 4 * vt + g) + 8 * hh);
            asm volatile("s_waitcnt lgkmcnt(0)" ::: "memory");
#pragma unroll
            for (int ks = 0; ks < 4; ++ks) o = __builtin_amdgcn_mfma_f32_32x32x16_bf16(fs[ks], fq[ks], o, 0, 0, 0);
            float ss = 0.f;
#pragma unroll
            for (int i = 0; i < 16; ++i) ss += o[i] * o[i];
            ss += __shfl_xor(ss, 32);
            const size_t row = row0 + (size_t)n * 64 + 32 * dt + cl;
            if (hh == 0) F.PSS[(size_t)(h * 8 + vs * 2 + vt) * NROWP + row] = ss;
#pragma unroll
            for (int g = 0; g < 4; ++g) {
                const float y0 = o[4 * g] * bflo(zc[g].x), y1 = o[4 * g + 1] * bfhi(zc[g].x), y2 = o[4 * g + 2] * bflo(zc[g].y), y3 = o[4 * g + 3] * bfhi(zc[g].y);
                v2u w; w.x = pg8::cvt_pk_bf16(y0, y1); w.y = pg8::cvt_pk_bf16(y2, y3); *(LAS v2u*)(L + GL_YL + (32 * dt + cl) * 144 + (32 * vt + 8 * g + 4 * hh) * 2) = w; }
        }
          }
#undef SET_
#define SET_ 0
      { const int n = n2 + 1;
        const int bo = (n & 1) * GL_BUF;
        __syncthreads();
        DT0(); if (wave >= 4) __builtin_amdgcn_s_setprio(1);
        if (n > 0) {
            *(GAS v4u*)(F.YMIX + (row0 + (size_t)(n - 1) * 64 + vrow) * DMIX + 1024 + h * 256 + vs * 64 + vch * 8) = *(const LAS v4u*)(L + GL_YL + vrow * 144 + vch * 16); }
        if (n + 1 < TP / 64) GL_STAGE(GL_BUF - bo, SET_);
        if (n + 3 < TP / 64) GL_LOAD(n + 3, SET_);
        DT1(34); DT0();
#pragma unroll
        for (int g = 0; g < 4; ++g) { v2u w; w.x = pg8::cvt_pk_bf16(Sacc[4 * g], Sacc[4 * g + 1]); w.y = pg8::cvt_pk_bf16(Sacc[4 * g + 2], Sacc[4 * g + 3]);
            *(LAS v2u*)(L + GL_SBT + (32 * vt + cl) * 272 + (32 * dt + 8 * g + 4 * hh) * 2) = w; }
        const bool attw = (wave >= 4 && wave < 7);
        if (attw) {
            const int st = (wave - 4) >> 1, ct = (wave - 3) >> 1;
            f32x16 a;
#pragma unroll
            for (int i = 0; i < 16; ++i) a[i] = 0.f;
            bf16x8_t ka[8], qb[8];
#pragma unroll
            for (int ks = 0; ks < 8; ++ks) { ka[ks] = GL_ROWF(bo + GL_KT, 32 * st + cl, ks); qb[ks] = GL_ROWF(bo + GL_QT, 32 * ct + cl, ks); }
            asm volatile("s_waitcnt lgkmcnt(0)" ::: "memory");
#pragma unroll
            for (int ks = 0; ks < 8; ++ks) a = __builtin_amdgcn_mfma_f32_32x32x16_bf16(ka[ks], qb[ks], a, 0, 0, 0);
            if (st == ct) {
#pragma unroll
                for (int i = 0; i < 16; ++i) { const int sl = (i & 3) + 8 * (i >> 2) + 4 * hh; a[i] = sl <= cl ? a[i] : 0.f; } }
#pragma unroll
            for (int g = 0; g < 4; ++g) { v2u w; w.x = pg8::cvt_pk_bf16(a[4 * g], a[4 * g + 1]); w.y = pg8::cvt_pk_bf16(a[4 * g + 2], a[4 * g + 3]);
                *(LAS v2u*)(L + GL_AT + (32 * ct + cl) * 144 + (32 * st + 8 * g + 4 * hh) * 2) = w; }
        } else GL_UPD(bo);
        DT1(35); if (wave >= 4) __builtin_amdgcn_s_setprio(0);
        __syncthreads();
        if (attw) GL_UPD(bo);
        if (wave < 4) {
            f32x16 o;
#pragma unroll
            for (int i = 0; i < 16; ++i) o[i] = 0.f;
            bf16x8_t fv[4], fa[4], fs[4], fq[4]; tr_frag4(Lb + bo + GL_VZ, tv, fv);
            v2u zc[4];
#pragma unroll
            for (int ks = 0; ks < 4; ++ks) { fa[ks] = GL_PADF(GL_AT, 144, 32 * dt + cl, ks); fs[ks] = GL_PADF(GL_SBT, 272, 32 * vt + cl, ks); fq[ks] = GL_ROWF(bo + GL_QT, 32 * dt + cl, ks); }
            asm volatile("s_waitcnt lgkmcnt(0)" ::: "memory");
            o = __builtin_amdgcn_mfma_f32_32x32x16_bf16(fv[0], fa[0], o, 0, 0, 0);
            o = __builtin_amdgcn_mfma_f32_32x32x16_bf16(fv[1], fa[1], o, 0, 0, 0);
            if (dt) { o = __builtin_amdgcn_mfma_f32_32x32x16_bf16(fv[2], fa[2], o, 0, 0, 0); o = __builtin_amdgcn_mfma_f32_32x32x16_bf16(fv[3], fa[3], o, 0, 0, 0); }
#pragma unroll
            for (int ks = 0; ks < 4; ++ks) o = __builtin_amdgcn_mfma_f32_32x32x16_bf16(fs[ks], fq[ks], o, 0, 0, 0);
#pragma unroll
            for (int ks = 0; ks < 4; ++ks) { fs[ks] = GL_PADF(GL_SBT, 272, 32 * vt + cl, 4 + ks); fq[ks] = GL_ROWF(bo + GL_QT, 32 * dt + cl, 4 + ks); }
#pragma unroll
            for (int g = 0; g < 4; ++g) zc[g] = *(const LAS v2u*)(L + bo + GL_VZ + off_b(32 * dt + cl, 8 + 4 * vt + g) + 8 * hh);
            asm volatile("s_waitcnt lgkmcnt(0)" ::: "memory");
#pragma unroll
            for (int ks = 0; ks < 4; ++ks) o = __builtin_amdgcn_mfma_f32_32x32x16_bf16(fs[ks], fq[ks], o, 0, 0, 0);
            float ss = 0.f;
#pragma unroll
            for (int i = 0; i < 16; ++i) ss += o[i] * o[i];
            ss += __shfl_xor(ss, 32);
            const size_t row = row0 + (size_t)n * 64 + 32 * dt + cl;
            if (hh == 0) F.PSS[(size_t)(h * 8 + vs * 2 + vt) * NROWP + row] = ss;
#pragma unroll
            for (int g = 0; g < 4; ++g) {
                const float y0 = o[4 * g] * bflo(zc[g].x), y1 = o[4 * g + 1] * bfhi(zc[g].x), y2 = o[4 * g + 2] * bflo(zc[g].y), y3 = o[4 * g + 3] * bfhi(zc[g].y);
                v2u w; w.x = pg8::cvt_pk_bf16(y0, y1); w.y = pg8::cvt_pk_bf16(y2, y3); *(LAS v2u*)(L + GL_YL + (32 * dt + cl) * 144 + (32 * vt + 8 * g + 4 * hh) * 2) = w; }
        }
          }
#undef SET_
    }
    __syncthreads();
    *(GAS v4u*)(F.YMIX + (row0 + (size_t)(TP / 64 - 1) * 64 + vrow) * DMIX + 1024 + h * 256 + vs * 64 + vch * 8) = *(const LAS v4u*)(L + GL_YL + vrow * 144 + vch * 16);
    float* so = F.out + O_GP + (((size_t)b * NH + h) * HK + 32 * dt) * HV + vs * 64 + 32 * vt + cl;
#pragma unroll
    for (int i = 0; i < 16; ++i) so[(size_t)((i & 3) + 8 * (i >> 2) + 4 * hh) * HV] = Sacc[i];
    __syncthreads();
#ifdef DIAG_DUR
    if (blockIdx.x == DIAG_WG && tid == DIAG_WAVE * 64) __hip_atomic_fetch_max((unsigned long long*)((unsigned char*)F.ctl + CW_DIAG * 4) + 1, acc_, __ATOMIC_RELAXED, __HIP_MEMORY_SCOPE_AGENT);
#endif
#if defined(DIAG_ID) && DIAG_ID == 6
    if (tid == 0) __hip_atomic_fetch_max((unsigned long long*)((unsigned char*)F.ctl + CW_DIAG * 4) + 1, (unsigned long long)__builtin_amdgcn_s_memrealtime(), __ATOMIC_RELAXED, __HIP_MEMORY_SCOPE_AGENT);
#endif
#undef GL_LOAD
#undef GL_STAGE
#undef GL_ROWF
#undef GL_PADF
#undef GL_UPD
}
__device__ __forceinline__ void p2b_norm(Frame& F) {
    const int gw = F.vcu * NWAVES + F.wave, NGW = F.G * NWAVES;
    for (int r = gw; r < NROWP; r += NGW) {
        const int hd = F.lane >> 4;
        float tot = 0.f;
#pragma unroll
        for (int k = 0; k < 8; ++k) tot += F.PSS[(size_t)(hd * 8 + k) * NROWP + r];
        const float rs = rsqrtf(tot * (1.f / 256.f) + EPS);
        GAS v4u* yp = (GAS v4u*)(F.YMIX + (size_t)r * DMIX + 1024 + F.lane * 16);
#pragma unroll
        for (int q = 0; q < 2; ++q) { v4u w = yp[q];
            w.x = pk2(bflo(w.x) * rs, bfhi(w.x) * rs); w.y = pk2(bflo(w.y) * rs, bfhi(w.y) * rs); w.z = pk2(bflo(w.z) * rs, bfhi(w.z) * rs); w.w = pk2(bflo(w.w) * rs, bfhi(w.w) * rs); yp[q] = w; }
    }
}

constexpr int GS_Q = 0, GS_K = 4096, GS_V = 8192, GS_DEC = 16384, GS_ATT = 16896, GS_OP = 17408, GS_END = GS_OP + 8 * 8 * 256 * 4;
static_assert(GS_END <= RING_BYTES, "GLA sample LDS map");
struct GlsSmall { unsigned q2, k2; v2u vv, zz; float dec; };
__device__ __forceinline__ const float* gls_state_ptr(const Frame& F, int it, int tid) { return F.st_gla + (((size_t)(it >> 2) * NH + (it & 3)) * HK + 16 * (tid >> 6)) * HV + 4 * (tid & 63); }
__device__ __forceinline__ void gls_small(const Frame& F, int it, int tid, GlsSmall& P) {
    const int seq = it >> 2, h = it & 3, t = tid >> 6, c = tid & 63; const bf16* pr = F.PROJ + ((size_t)NROWP + (size_t)seq * TS + t) * DINP;
    P.q2 = *(const GAS unsigned*)(pr + C_Q + h * 128 + 2 * c); P.k2 = *(const GAS unsigned*)(pr + C_K + h * 128 + 2 * c);
    P.vv = *(const GAS v2u*)(pr + C_V + h * 256 + 4 * c);
    P.zz = *(const GAS v2u*)(pr + C_ZG + h * 256 + 4 * c);
    P.dec = F.DEC[(size_t)(NP * (TP / 64) + seq) * 512 + h * 128 + (tid & 127)];
}
__device__ __forceinline__ void gla_sample_chain(const Frame& F, int first, int count) {
    int tid = F.tid; asm volatile("" : "+v"(tid));
    const int lane = tid & 63, wave = F.wave, v4 = tid & 63, dg = wave;
    LAS float* Lq = (LAS float*)(F.lds + RING_OFF + GS_Q);
    LAS float* Lk = (LAS float*)(F.lds + RING_OFF + GS_K);
    LAS float* Lv = (LAS float*)(F.lds + RING_OFF + GS_V);
    LAS float* Ld = (LAS float*)(F.lds + RING_OFF + GS_DEC);
    LAS float* La = (LAS float*)(F.lds + RING_OFF + GS_ATT);
    LAS float* Lo = (LAS float*)(F.lds + RING_OFF + GS_OP);
    f32x4 S[16]; GlsSmall P, Pn;
    int a = first; const int last = first + count - 1;
    const int voff = ((16 * (tid >> 6)) * HV + 4 * (tid & 63)) * 4;
#define GLS_RSRC(base, it) __builtin_amdgcn_make_buffer_rsrc((void*)((base) + (size_t)(it) * (HK * HV)), 0, HK * HV * 4, 0x00020000)
#ifdef CHAIN_GLOBAL
#define GLS_LD(r, base, it, i) (*(const GAS f32x4*)((base) + (size_t)(it) * (HK * HV) + (size_t)(16 * (tid >> 6) + (i)) * HV + 4 * (tid & 63)))
#define GLS_ST(val, r, base, it, i) (*(GAS f32x4*)((base) + (size_t)(it) * (HK * HV) + (size_t)(16 * (tid >> 6) + (i)) * HV + 4 * (tid & 63)) = (val))
#else
#define GLS_LD(r, base, it, i) __builtin_bit_cast(f32x4, __builtin_amdgcn_raw_buffer_load_b128(r, voff, (i) * HV * 4, 0))
#define GLS_ST(val, r, base, it, i) __builtin_amdgcn_raw_buffer_store_b128(__builtin_bit_cast(v4u, (val)), r, voff, (i) * HV * 4, 0)
#endif
    { const __amdgpu_buffer_rsrc_t r0 = GLS_RSRC(F.st_gla, a);
      gls_small(F, a, tid, P);
#pragma unroll
      for (int i = 0; i < 16; ++i) S[i] = GLS_LD(r0, F.st_gla, a, i); }
    for (;;) {
        __syncthreads();
#ifdef CHAIN_VMWAIT
        VM_WAIT();
#endif
        const int b = a + 1; const bool nb = a < last;
        const __amdgpu_buffer_rsrc_t r1 = __builtin_amdgcn_make_buffer_rsrc((void*)(F.st_gla + (size_t)(nb ? b : a) * (HK * HV)), 0, nb ? HK * HV * 4 : 0, 0x00020000), rO = GLS_RSRC(F.out + O_GS, a);
        if (nb) gls_small(F, b, tid, Pn);
        const int seq = a >> 2, h = a & 3; const size_t row0 = (size_t)NROWP + (size_t)seq * TS;
        { const int t = tid >> 6, c = tid & 63;
          Lq[t * 128 + 2 * c] = bflo(P.q2); Lq[t * 128 + 2 * c + 1] = bfhi(P.q2); Lk[t * 128 + 2 * c] = bflo(P.k2); Lk[t * 128 + 2 * c + 1] = bfhi(P.k2);
          *(LAS f32x4*)(Lv + t * 256 + 4 * c) = (f32x4){bflo(P.vv.x), bfhi(P.vv.x), bflo(P.vv.y), bfhi(P.vv.y)};
          if (tid < 128) Ld[tid] = P.dec; }
        __syncthreads();
        if (wave == 0) { const int t = lane >> 3, s = lane & 7; float av = 0.f;
            for (int d = 0; d < 128; d += 4) { const f32x4 q = *(const LAS f32x4*)(Lq + t * 128 + d), k = *(const LAS f32x4*)(Lk + s * 128 + d); av += (q.x * k.x + q.y * k.y) + (q.z * k.z + q.w * k.w); }
            La[lane] = s <= t ? av : 0.f; }
        f32x4 o[8];
#pragma unroll
        for (int t = 0; t < 8; ++t) o[t] = (f32x4){0.f, 0.f, 0.f, 0.f};
        f32x4 vr[8];
#pragma unroll
        for (int t = 0; t < 8; ++t) vr[t] = *(const LAS f32x4*)(Lv + t * 256 + 4 * v4);
#pragma unroll
        for (int hf = 0; hf < 2; ++hf) {
#pragma unroll
            for (int i2 = 0; i2 < 8; i2 += 2) { const int i = 8 * hf + i2, d = 16 * dg + i;
                typedef float f32x2 __attribute__((ext_vector_type(2)));
                f32x2 qv[8], kv[8];
#pragma unroll
                for (int t = 0; t < 8; ++t) { qv[t] = *(const LAS f32x2*)(Lq + t * 128 + d); kv[t] = *(const LAS f32x2*)(Lk + t * 128 + d); }
                const f32x2 dv = *(const LAS f32x2*)(Ld + d);
                f32x4 sn0 = S[i], sn1 = S[i + 1];
#pragma unroll
                for (int t = 0; t < 8; ++t) { o[t] += qv[t].x * S[i]; sn0 += kv[t].x * vr[t]; o[t] += qv[t].y * S[i + 1]; sn1 += kv[t].y * vr[t]; }
                GLS_ST(sn0 * dv.x, rO, F.out + O_GS, a, i); GLS_ST(sn1 * dv.y, rO, F.out + O_GS, a, i + 1);
                asm volatile("" ::: "memory"); }
#pragma unroll
            for (int i8 = 0; i8 < 8; ++i8) S[8 * hf + i8] = GLS_LD(r1, F.st_gla, nb ? b : a, 8 * hf + i8);
            asm volatile("" ::: "memory");
        }
#pragma unroll
        for (int t = 0; t < 8; ++t) *(LAS f32x4*)(Lo + (dg * 8 + t) * 256 + 4 * v4) = o[t];
        __syncthreads();
        { const int t = wave; f32x4 acc = (f32x4){0.f, 0.f, 0.f, 0.f};
#pragma unroll
          for (int g = 0; g < 8; ++g) acc += *(const LAS f32x4*)(Lo + (g * 8 + t) * 256 + 4 * v4);
#pragma unroll
          for (int s = 0; s < 8; ++s) acc += La[t * 8 + s] * vr[s];
          const float ss = wave_sum((acc.x * acc.x + acc.y * acc.y) + (acc.z * acc.z + acc.w * acc.w));
          const float rs = rsqrtf(ss * (1.f / 256.f) + EPS);
          const float z0 = bflo(P.zz.x), z1 = bfhi(P.zz.x), z2 = bflo(P.zz.y), z3 = bfhi(P.zz.y);
          v2u w; w.x = pk2(acc.x * rs * z0, acc.y * rs * z1); w.y = pk2(acc.z * rs * z2, acc.w * rs * z3);
          __builtin_amdgcn_raw_buffer_store_b64(w, __builtin_amdgcn_make_buffer_rsrc((void*)F.YMIX, 0, 0x7fffffff, 0x00020000), (int)(((row0 + t) * DMIX + 1024 + h * 256 + 4 * v4) * 2), 0, 16); }
        if (!nb) break;
        a = b; P = Pn;
    }
#undef GLS_RSRC
#undef GLS_LD
#undef GLS_ST
}

struct GlsPre { f32x4 S[16]; unsigned q2, k2; v2u vv, zz; float dec; };
__device__ __forceinline__ void gls_load(const Frame& F, int seq, int h, GlsPre& P) {
    int tid = F.tid; asm volatile("" : "+v"(tid));
    const int v4 = tid & 63, dg = tid >> 6;
    const size_t row0 = (size_t)NROWP + (size_t)seq * TS;
    const float* s0 = F.st_gla + (((size_t)seq * NH + h) * HK + 16 * dg) * HV + 4 * v4;
#pragma unroll
    for (int i = 0; i < 16; ++i) P.S[i] = *(const GAS f32x4*)(s0 + (size_t)i * HV);
    const int t = tid >> 6, c = tid & 63; const bf16* pr = F.PROJ + (row0 + t) * DINP;
    P.q2 = *(const GAS unsigned*)(pr + C_Q + h * 128 + 2 * c); P.k2 = *(const GAS unsigned*)(pr + C_K + h * 128 + 2 * c);
    P.vv = *(const GAS v2u*)(pr + C_V + h * 256 + 4 * c);
    P.zz = *(const GAS v2u*)(pr + C_ZG + h * 256 + 4 * c);
    P.dec = F.DEC[(size_t)(NP * (TP / 64) + seq) * 512 + h * 128 + (tid & 127)];
}
__device__ __forceinline__ void gls_compute(const Frame& F, int seq, int h, const GlsPre& P) {
    int tid = F.tid; asm volatile("" : "+v"(tid));
    const int lane = tid & 63, wave = F.wave, v4 = tid & 63, dg = wave;
    LAS float* Lq = (LAS float*)(F.lds + RING_OFF + GS_Q);
    LAS float* Lk = (LAS float*)(F.lds + RING_OFF + GS_K);
    LAS float* Lv = (LAS float*)(F.lds + RING_OFF + GS_V);
    LAS float* Ld = (LAS float*)(F.lds + RING_OFF + GS_DEC);
    LAS float* La = (LAS float*)(F.lds + RING_OFF + GS_ATT);
    LAS float* Lo = (LAS float*)(F.lds + RING_OFF + GS_OP);
    const size_t row0 = (size_t)NROWP + (size_t)seq * TS;
    __syncthreads();
    { const int t = tid >> 6, c = tid & 63;
      Lq[t * 128 + 2 * c] = bflo(P.q2); Lq[t * 128 + 2 * c + 1] = bfhi(P.q2); Lk[t * 128 + 2 * c] = bflo(P.k2); Lk[t * 128 + 2 * c + 1] = bfhi(P.k2);
      *(LAS f32x4*)(Lv + t * 256 + 4 * c) = (f32x4){bflo(P.vv.x), bfhi(P.vv.x), bflo(P.vv.y), bfhi(P.vv.y)};
      if (tid < 128) Ld[tid] = P.dec; }
    __syncthreads();
    if (wave == 0) { const int t = lane >> 3, s = lane & 7; float a = 0.f;
        for (int d = 0; d < 128; d += 4) { const f32x4 q = *(const LAS f32x4*)(Lq + t * 128 + d), k = *(const LAS f32x4*)(Lk + s * 128 + d); a += (q.x * k.x + q.y * k.y) + (q.z * k.z + q.w * k.w); }
        La[lane] = s <= t ? a : 0.f; }
    f32x4 o[8];
#pragma unroll
    for (int t = 0; t < 8; ++t) o[t] = (f32x4){0.f, 0.f, 0.f, 0.f};
    f32x4 vr[8];
#pragma unroll
    for (int t = 0; t < 8; ++t) vr[t] = *(const LAS f32x4*)(Lv + t * 256 + 4 * v4);
    float* so = F.out + O_GS + (((size_t)seq * NH + h) * HK + 16 * dg) * HV + 4 * v4;
#pragma unroll
    for (int i = 0; i < 16; ++i) { const int d = 16 * dg + i; f32x4 sn = P.S[i];
#pragma unroll
        for (int t = 0; t < 8; ++t) { const float q = Lq[t * 128 + d], k = Lk[t * 128 + d]; o[t] += q * P.S[i]; sn += k * vr[t]; }
        *(GAS f32x4*)(so + (size_t)i * HV) = sn * Ld[d]; }
#pragma unroll
    for (int t = 0; t < 8; ++t) *(LAS f32x4*)(Lo + (dg * 8 + t) * 256 + 4 * v4) = o[t];
    __syncthreads();
    { const int t = wave; f32x4 a = (f32x4){0.f, 0.f, 0.f, 0.f};
#pragma unroll
      for (int g = 0; g < 8; ++g) a += *(const LAS f32x4*)(Lo + (g * 8 + t) * 256 + 4 * v4);
#pragma unroll
      for (int s = 0; s < 8; ++s) a += La[t * 8 + s] * vr[s];
      const float ss = wave_sum((a.x * a.x + a.y * a.y) + (a.z * a.z + a.w * a.w));
      const float rs = rsqrtf(ss * (1.f / 256.f) + EPS);
      const float z0 = bflo(P.zz.x), z1 = bfhi(P.zz.x), z2 = bflo(P.zz.y), z3 = bfhi(P.zz.y);
      v2u w; w.x = pk2(a.x * rs * z0, a.y * rs * z1); w.y = pk2(a.z * rs * z2, a.w * rs * z3);
      if (LATE_SAMPLE) __builtin_amdgcn_raw_buffer_store_b64(w, __builtin_amdgcn_make_buffer_rsrc((void*)F.YMIX, 0, 0x7fffffff, 0x00020000), (int)(((row0 + t) * DMIX + 1024 + h * 256 + 4 * v4) * 2), 0, 16);
      else *(GAS v2u*)(F.YMIX + (row0 + t) * DMIX + 1024 + h * 256 + 4 * v4) = w; }
}
__device__ __forceinline__ void gla_sample_item(const Frame& F, int seq, int h) { GlsPre P; gls_load(F, seq, h, P); gls_compute(F, seq, h, P); }

__device__ __forceinline__ bool tail_ws(const Frame& F) { return TAIL_SAMPLE && F.G == 256 && DUP_PHASE < 0; }
constexpr int GEMM1_WGS = 232;
__device__ __forceinline__ void p1_tail_sample(Frame& F, unsigned* cnt) {
    const int j = (int)blockIdx.x - GEMM1_WGS, nj = 256 - GEMM1_WGS;
    if (F.tid < 64) { unsigned sp = 0;
        while ((unsigned)__builtin_amdgcn_readfirstlane(__hip_atomic_load(cnt, __ATOMIC_RELAXED, __HIP_MEMORY_SCOPE_AGENT)) < 80u * 8u) { __builtin_amdgcn_s_sleep(8); if (++sp > (1u << 22)) break; }
        __builtin_amdgcn_fence(__ATOMIC_ACQUIRE, "agent");
        asm volatile("s_waitcnt vmcnt(0)" ::: "memory"); }
    __syncthreads();
    for (int it = j; it < NS * NH; it += nj) gla_sample_item(F, it >> 2, it & 3);
    __syncthreads();
}
#ifndef SPLIT_P1
#define SPLIT_P1 1
#endif
__device__ __forceinline__ bool split_p1(const Frame& F) { return SPLIT_P1 && F.G == 256 && DUP_PHASE < 0; }
__device__ __forceinline__ void wait_count(Frame& F, unsigned* cnt, unsigned target) {
    if (F.tid < 64) { unsigned sp = 0;
        for (;;) { unsigned v = F.lane < 8 ? __hip_atomic_load(cnt + 64 * F.lane, __ATOMIC_RELAXED, __HIP_MEMORY_SCOPE_AGENT) : 0u;
            v += __shfl_xor(v, 1); v += __shfl_xor(v, 2); v += __shfl_xor(v, 4);
            if ((unsigned)__builtin_amdgcn_readfirstlane(v) >= target) break;
            __builtin_amdgcn_s_sleep(8); if (++sp > (1u << 22)) break; }
        __builtin_amdgcn_fence(__ATOMIC_ACQUIRE, "agent");
        asm volatile("s_waitcnt vmcnt(0)" ::: "memory"); }
    __syncthreads();
}
__device__ __forceinline__ void wait_sample_units(Frame& F, unsigned* cnt) { wait_count(F, cnt, 80u * 8u); }
__device__ __forceinline__ void p12_mix(Frame& F, unsigned* cnt) {
    const int c = (int)blockIdx.x;
    if (c < 128) gla_item(F, c >> 4, (c >> 2) & 3, c & 3); else lru_item<0>(F, (c - 128) >> 4, (c - 128) & 15);
    if (c < 80) PSTAMP(10); else if (c < 128) PSTAMP(11); else PSTAMP(12);
    if (LATE_SAMPLE) return;
    wait_sample_units(F, cnt);
    PSTAMP(13);
    unsigned* head = cnt + 512;
    volatile LAS unsigned* slot = F.MISC + 16;
    for (;;) {
        if (F.tid == 0) slot[0] = __hip_atomic_fetch_add(head, 1u, __ATOMIC_RELAXED, __HIP_MEMORY_SCOPE_AGENT);
        __syncthreads();
        const int it = (int)slot[0];
        __syncthreads();
        if (it >= 64 + NS * NH) break;
        if (it < 64) lru_item<1>(F, it >> 4, it & 15); else gla_sample_item(F, (it - 64) >> 2, (it - 64) & 3);
    }
}
__device__ __forceinline__ void p3_late(Frame& F, unsigned* cntS) {
    const int c = (int)blockIdx.x;
    unsigned* cntQ = cntS + 1024;
    if (c < 80) {
        pg8::Gemm g{F.XN, F.WinT, NTOK, DINP, D}; pg8::OneUnit S{NROWP / 256 + c / 20, c % 20, 0, 0, -1};
        pg8::EpiProj E{F.PROJ, DINP, F.BCUM, F.g_head, NROWP / 256};
        pg8::gemm_phase<pg8::EpiProj, pg8::OneUnit, true, true>(F.lds + RING_OFF, g, S, E);
        if (F.tid == 0) __hip_atomic_fetch_add(cntS + 64 * (c & 7), 8u, __ATOMIC_RELAXED, __HIP_MEMORY_SCOPE_AGENT);
    }
    PSTAMP(14);
    { pg8::Gemm g{F.YMIX, F.WoutT, NTOK, D, DMIX}; pg8::Gemm2Order S; S.init(NROWP, NROWP, D, DMIX, 8, F.G, c);
      pg8::EpiY E{F.YBF, D, F.YS, NROWP, (size_t)NROWS * D};
      pg8::HeadScale KSc{F.PSS, NROWP, EPS};
      pg8::gemm_phase<pg8::EpiY, pg8::Gemm2Order, true, true, pg8::HeadScale>(F.lds + RING_OFF, g, S, E, KSc); }
    if (c < 80) PSTAMP(17); else PSTAMP(15);
    if (c < 80) return;
    wait_count(F, cntS, 80u * 8u);
    const int j = c - 80;
    if (j < 64) lru_item<1>(F, j >> 4, j & 15);
    const int gfirst = j < 64 ? 2 * j : (j < 112 ? 128 + 4 * (j - 64) : 320 + 3 * (j - 112)), gcount = j < 64 ? 2 : (j < 112 ? 4 : 3);
#ifdef NO_CHAIN
    for (int k = 0; k < gcount; ++k) gla_sample_item(F, (gfirst + k) >> 2, (gfirst + k) & 3);
#elif defined(CHAIN_ONE)
    for (int k = 0; k < gcount; ++k) gla_sample_chain(F, gfirst + k, 1);
#else
    gla_sample_chain(F, gfirst, gcount);
#endif
    const unsigned ndone = (unsigned)gcount + (j < 64 ? 1u : 0u);
    VM_WAIT();
    __syncthreads();
    if (F.tid == 0 && ndone) __hip_atomic_fetch_add(cntQ + 64 * (c & 7), ndone, __ATOMIC_RELAXED, __HIP_MEMORY_SCOPE_AGENT);
    PSTAMP(16);
    const int L = c - 80;
    if (L < 128) {
        wait_count(F, cntQ, 64u + NS * NH);
        pg8::Gemm g{F.YMIX, F.WoutT, NTOK, D, DMIX}; pg8::OneUnit S{NROWP / 256 + (L >> 3) / 4, (L >> 3) % 4, (L & 7) * 4, 4, L & 7};
        pg8::EpiY E{F.YBF, D, F.YS, NROWP, (size_t)NROWS * D};
        pg8::gemm_phase<pg8::EpiY, pg8::OneUnit, true, true>(F.lds + RING_OFF, g, S, E);
    }
}
__device__ __forceinline__ void p2_mix_simple(Frame& F) {
    if (tail_ws(F)) {
        const int v = F.vcu;
        if (v < 128) lru_item<0>(F, v >> 4, v & 15); else { const int g = v - 128; gla_item(F, g >> 4, (g >> 2) & 3, g & 3); if (g < 64) lru_item<1>(F, g >> 4, g & 15); }
        __syncthreads();
        return;
    }
    for (int it = F.vcu; it < 2 * NP * 16; it += F.G) {
        if (it < NP * 16) { for (int rep = 0; rep < (DUP_PHASE == 6 ? 2 : 1); ++rep) lru_item<0>(F, it >> 4, it & 15); }
        else { const int g = it - NP * 16; for (int rep = 0; rep < (DUP_PHASE == 7 ? 2 : 1); ++rep) gla_item(F, g >> 4, (g >> 2) & 3, g & 3); }
    }
    for (int rep = 0; rep < (DUP_PHASE == 8 ? 2 : 1); ++rep) for (int it = F.vcu; it < 4 * 16; it += F.G) lru_item<1>(F, it >> 4, it & 15);
    for (int rep = 0; rep < (DUP_PHASE == 9 ? 2 : 1); ++rep) for (int it = F.vcu; it < NS * NH; it += F.G) gla_sample_item(F, it >> 2, it & 3);
    __syncthreads();
}

__device__ __forceinline__ void p4_final(Frame& F) {
    int gw = F.vcu * NWAVES + F.wave, NGW = F.G * NWAVES;
    if (FUSE_P4 && !LATE_SAMPLE) {
        const int c = (int)blockIdx.x; if ((c & 63) < 32) return;
        gw = NROWP + ((c >> 6) * 32 + (c & 63) - 32) * NWAVES + F.wave; NGW = NTOK; }
    const GAS f32x4* gp = (const GAS f32x4*)F.g_post + F.lane;
    f32x4 g[4];
#pragma unroll
    for (int j = 0; j < 4; ++j) g[j] = gp[64 * j];
    for (int r = gw; r < NTOK; r += NGW) {
        const float* xrow = r < NROWP ? F.xp + (size_t)r * D : F.xs + (size_t)(r - NROWP) * D;
        const GAS f32x4* xr = (const GAS f32x4*)xrow + F.lane;
        f32x4 y[4], x[4];
#pragma unroll
        for (int j = 0; j < 4; ++j) x[j] = xr[64 * j];
        if (r < NROWP) { const GAS v2u* yr = (const GAS v2u*)(F.YBF + (size_t)r * D) + F.lane;
#pragma unroll
            for (int j = 0; j < 4; ++j) { const v2u w = yr[64 * j]; y[j] = (f32x4){bflo(w.x), bfhi(w.x), bflo(w.y), bfhi(w.y)}; }
        } else {
#pragma unroll
            for (int j = 0; j < 4; ++j) y[j] = (f32x4){0.f, 0.f, 0.f, 0.f};
#pragma unroll
            for (int s = 0; s < 8; ++s) { const GAS v2u* yr = (const GAS v2u*)(F.YS + ((size_t)s * NROWS + (r - NROWP)) * D) + F.lane;
#pragma unroll
                for (int j = 0; j < 4; ++j) { const v2u w = yr[64 * j]; y[j] += (f32x4){bflo(w.x), bfhi(w.x), bflo(w.y), bfhi(w.y)}; } }
        }
        float ss = 0.f;
#pragma unroll
        for (int j = 0; j < 4; ++j) ss += (y[j].x * y[j].x + y[j].y * y[j].y) + (y[j].z * y[j].z + y[j].w * y[j].w);
        const float rs = rsqrtf(wave_sum(ss) * (1.f / D) + EPS);
        GAS f32x4* orow = (GAS f32x4*)(F.out + (size_t)r * D) + F.lane;
#pragma unroll
        for (int j = 0; j < 4; ++j) orow[64 * j] = x[j] + y[j] * rs * g[j];
    }
}


struct Args { const float* in[19]; float* out; unsigned char* ws; int ph_lo, ph_hi, li, pad; };
__global__ void __launch_bounds__(NWAVES * 64, 2) mk_fwd(Args args) {
    extern __shared__ __attribute__((aligned(16))) unsigned char lds[];
    Frame F;
    F.lds = (LAS unsigned char*)lds;
    F.MISC = (volatile LAS unsigned*)(F.lds + MISC_OFF);
    F.tid = threadIdx.x; F.lane = F.tid & 63; F.wave = __builtin_amdgcn_readfirstlane(F.tid >> 6);
    F.G = gridDim.x; { const int bx = blockIdx.x; F.vcu = (F.G % 8 == 0) ? (bx % 8) * (F.G / 8) + bx / 8 : bx; }
    unsigned char* ws = args.ws;
    F.ctl = (gu32*)(ws + WS_CTL);
    F.xp = args.in[0]; F.xs = args.in[1]; F.st_h = args.in[2]; F.st_conv = args.in[3]; F.st_gla = args.in[4]; F.g_pre = args.in[5]; F.w_in = args.in[6];
    F.conv_w = args.in[7]; F.conv_b = args.in[8]; F.w_rg = args.in[9]; F.b_rg = args.in[10]; F.w_ig = args.in[11]; F.b_ig = args.in[12]; F.lam = args.in[13];
    F.w_gk2 = args.in[14]; F.b_gk = args.in[15]; F.g_head = args.in[16]; F.w_out = args.in[17]; F.g_post = args.in[18];
    F.out = args.out;
    F.WinT = (bf16*)(ws + WS_WINT); F.WoutT = (bf16*)(ws + WS_WOUT); F.XN = (bf16*)(ws + WS_XN); F.PROJ = (bf16*)(ws + WS_PROJ);
    F.YMIX = (bf16*)args.out;
    F.YBF = (bf16*)(ws + WS_XN);
    F.RGK = (float*)(ws + WS_RGK); F.PART = (float*)(ws + WS_PART); F.DEC = (float*)(ws + WS_DEC); F.PSS = (float*)(ws + WS_RGK); F.C8 = (float*)(ws + WS_PART); F.YS = (bf16*)(ws + WS_YS);
    F.BCUM = TAIL_SAMPLE ? args.out : args.out + O_GS;
    for (int u = F.tid; u < (LDS_BYTES - LDSCTL_OFF) / 4; u += NWAVES * 64) ((LAS unsigned*)(F.lds + LDSCTL_OFF))[u] = 0u;
    __syncthreads();
    XcdBarrier bar; bar.bar = (unsigned*)(F.ctl + CW_BAR); bar.x = 0; bar.st = nullptr;
    if (N_LAUNCHES == 1) bar = xcd_barrier_post((unsigned*)(F.ctl + CW_BAR), F.MISC + 8);
    if (N_LAUNCHES == 1 && (int)blockIdx.x < CHAIN_NS && F.tid == 0) (void)xb_add((unsigned*)(F.ctl + CW_CHAINBAR) + CB_CENSUS(bar.x), 1u);
#define GRID_BAR() do { if (N_LAUNCHES == 1) xcd_barrier(bar); } while (0)
    const int lo = args.ph_lo, hi = args.ph_hi;
#ifdef DIAG_ID
#define dg ((unsigned long long*)(args.ws + WS_CTL + CW_DIAG * 4))
    if (F.tid == 0) { __hip_atomic_fetch_max(dg, ~(unsigned long long)__builtin_amdgcn_s_memrealtime(), __ATOMIC_RELAXED, __HIP_MEMORY_SCOPE_AGENT); }
#ifndef DIAG_ID0
#define DIAG_ID0 -1
#endif
#define STAMP(id) do { if ((DIAG_ID == (id) || DIAG_ID0 == (id)) && F.tid == 0) __hip_atomic_fetch_max(dg + (DIAG_ID == (id) ? 1 : 2), (unsigned long long)__builtin_amdgcn_s_memrealtime(), __ATOMIC_RELAXED, __HIP_MEMORY_SCOPE_AGENT); } while (0)
#else
#define STAMP(id) do {} while (0)
#endif
#ifndef PH_MASK
#define PH_MASK 31
#endif
#define IN(k) (lo <= (k) && (k) < hi && ((PH_MASK >> (k)) & 1))
#define BOTH(k) (IN(k) && IN((k) + 1))
#ifndef MK_FALLBACK
#define MK_FALLBACK 0
#endif
#ifndef DUP_PHASE
#define DUP_PHASE -1
#endif
#define REPS(k) for (int rep_ = 0; rep_ < ((DUP_PHASE == (k)) ? 2 : 1); ++rep_)
    if (IN(0)) { REPS(0) { p0_prologue(F); STAMP(0); if (BOTH(0)) GRID_BAR(); } }
    if (split_p1(F)) {
        if (IN(1)) {
            unsigned* cntS = (unsigned*)(F.ctl + CW_SAMPLE);
            pg8::Gemm g{F.XN, F.WinT, NTOK, DINP, D}; pg8::Gemm1Chain S; S.init(NROWP, DINP, (int)blockIdx.x, cntS, &bar, (unsigned*)(F.ctl + CW_CHAINBAR));
            pg8::EpiProj E{F.PROJ, DINP, F.BCUM, F.g_head, NROWP / 256};
            pg8::gemm_phase<pg8::EpiProj, pg8::Gemm1Chain, true, true>(F.lds + RING_OFF, g, S, E);
            S.chain_end();
            STAMP(1);
            p12_mix(F, cntS);
            STAMP(2);
            GRID_BAR();
#if LATE_SAMPLE
            p3_late(F, cntS);
            STAMP(3);
            GRID_BAR();
#endif
        }
#if MK_FALLBACK
    } else {
    if (IN(1)) { REPS(1) {
        pg8::Gemm g{F.XN, F.WinT, NTOK, DINP, D}; pg8::EpiProj E{F.PROJ, DINP, F.BCUM, F.g_head, tail_ws(F) ? NROWP / 256 : (1 << 30)};
        if (tail_ws(F)) {
            unsigned* cntS = (unsigned*)(F.ctl + CW_SAMPLE);
            if (blockIdx.x < GEMM1_WGS) { pg8::Gemm1Order S; S.init(NROWP, NTOK, DINP, GEMM1_WGS, (int)blockIdx.x, cntS);
                pg8::gemm_phase<pg8::EpiProj, pg8::Gemm1Order, true, true>(F.lds + RING_OFF, g, S, E); }
            else p1_tail_sample(F, cntS);
        } else {
            pg8::StaticOrder S; S.init(NTOK, DINP, F.G, (int)blockIdx.x);
            pg8::gemm_phase<pg8::EpiProj, pg8::StaticOrder, true, true>(F.lds + RING_OFF, g, S, E);
        }
        STAMP(1); if (BOTH(1)) GRID_BAR(); }
    }
    if (IN(2)) { REPS(2) { p2_mix_simple(F); STAMP(2); if (BOTH(2)) GRID_BAR(); } }
    }
#else
    }
#endif
#if FUSE_P4
    if (IN(3) && !LATE_SAMPLE) {
        unsigned* cntL = (unsigned*)(F.ctl + CW_SAMPLE + 2048);
        pg8::Gemm g{F.YMIX, F.WoutT, NTOK, D, DMIX}; pg8::Gemm2FOrder S; S.init(NROWP, D, DMIX, 8, (int)blockIdx.x, cntL);
        pg8::EpiYF E{F.YS, NROWP, (size_t)NROWS * D, D, F.xp, F.out, F.g_post, (float*)(ws + WS_XBUF), (unsigned*)(F.ctl + CW_ROWS), EPS};
        pg8::HeadScale KSc{F.PSS, NROWP, EPS};
        pg8::gemm_phase<pg8::EpiYF, pg8::Gemm2FOrder, true, true, pg8::HeadScale>(F.lds + RING_OFF, g, S, E, KSc);
        STAMP(3);
        if (((int)blockIdx.x & 63) >= 32) wait_count(F, cntL, 128u * 8u);
    }
#else
    if (IN(3) && !LATE_SAMPLE) { REPS(3) {
        pg8::Gemm g{F.YMIX, F.WoutT, NTOK, D, DMIX}; pg8::Gemm2Order S; S.init(NROWP, NTOK, D, DMIX, 8, F.G, (int)blockIdx.x);
        pg8::EpiY E{F.YBF, D, F.YS, NROWP, (size_t)NROWS * D};
        pg8::HeadScale KSc{F.PSS, NROWP, EPS};
        pg8::gemm_phase<pg8::EpiY, pg8::Gemm2Order, true, true, pg8::HeadScale>(F.lds + RING_OFF, g, S, E, KSc);
        STAMP(3);
        if (BOTH(3)) GRID_BAR(); }
    }
#endif
    if (IN(4)) { REPS(4) { p4_final(F); if (DUP_PHASE == 4) GRID_BAR(); } }
#ifdef DIAG_ID
    STAMP(4);
    GRID_BAR();
    if (blockIdx.x == 0) {
#ifdef DIAG_DUR
        const unsigned long long t0 = 0ull, t1 = __hip_atomic_load(dg + 1, __ATOMIC_RELAXED, __HIP_MEMORY_SCOPE_AGENT);
#else
        const unsigned long long t0 = DIAG_ID0 >= 0 ? __hip_atomic_load(dg + 2, __ATOMIC_RELAXED, __HIP_MEMORY_SCOPE_AGENT) : ~__hip_atomic_load(dg, __ATOMIC_RELAXED, __HIP_MEMORY_SCOPE_AGENT), t1 = __hip_atomic_load(dg + 1, __ATOMIC_RELAXED, __HIP_MEMORY_SCOPE_AGENT);
#endif
#ifndef DIAG_BASE
#define DIAG_BASE 0.f
#define DIAG_SPAN 1000.f
#endif
        const float f = 1.f + ((float)(t1 - t0) * 0.01f - DIAG_BASE) * (1.f / DIAG_SPAN);
        for (int i = F.tid; i < NP * 1024; i += NWAVES * 64) F.out[O_HP + i] *= f; }
#endif
#undef IN
#undef BOTH
}

extern "C" void kernel_launch(void* const* d_in, const int* in_sizes, int n_in, void* d_out, int out_size, void* d_ws, size_t ws_size, hipStream_t stream) {
    static int grid = 0;
    if (grid == 0) {
        if (n_in != 19 || in_sizes[0] != NROWP * D || in_sizes[6] != D * DIN || (size_t)out_size != O_END || ws_size < WS_END) {
            fprintf(stderr, "kernel_launch: unexpected shapes: n_in %d in0 %d in6 %d out %d ws %zu; nothing launched\n", n_in, n_in > 0 ? in_sizes[0] : -1, n_in > 6 ? in_sizes[6] : -1, out_size, ws_size); grid = -1; return; }
        int dev = 0, cus = 0, per_cu = 0;
        if (hipGetDevice(&dev) != hipSuccess || hipDeviceGetAttribute(&cus, hipDeviceAttributeMultiprocessorCount, dev) != hipSuccess) { grid = -1; return; }
        if (hipFuncSetAttribute((const void*)mk_fwd, hipFuncAttributeMaxDynamicSharedMemorySize, LDS_BYTES) != hipSuccess) { fprintf(stderr, "kernel_launch: hipFuncSetAttribute failed\n"); grid = -1; return; }
        if (hipOccupancyMaxActiveBlocksPerMultiprocessor(&per_cu, (const void*)mk_fwd, NWAVES * 64, LDS_BYTES) != hipSuccess || per_cu < 1)
            fprintf(stderr, "kernel_launch: note: occupancy query reports %d workgroups per CU\n", per_cu);
        (void)hipGetLastError();
        grid = cus;
        if (!MK_FALLBACK && grid != 256) { fprintf(stderr, "kernel_launch: this build's phase schedule is for 256 CUs, found %d; rebuild with -DMK_FALLBACK=1 -DSPLIT_P1=0; nothing launched\n", grid); grid = -1; return; }
    }
    if (grid < 0) return;
    if (hipMemsetAsync((char*)d_ws + WS_CTL, 0, CTL_ZERO_BYTES, stream) != hipSuccess) { fprintf(stderr, "kernel_launch: hipMemsetAsync failed\n"); return; }
    Args a{};
    for (int i = 0; i < 19; ++i) a.in[i] = (const float*)d_in[i];
    a.out = (float*)d_out; a.ws = (unsigned char*)d_ws;
    for (int li = 0; li < N_LAUNCHES; ++li) {
        a.ph_lo = (N_LAUNCHES == 1) ? 0 : li; a.ph_hi = (N_LAUNCHES == 1) ? N_PHASES : li + 1; a.li = li;
        hipLaunchKernelGGL(mk_fwd, dim3(grid), dim3(NWAVES * 64), LDS_BYTES, stream, a);
        const hipError_t le = hipPeekAtLastError();
        if (le != hipSuccess) { fprintf(stderr, "kernel_launch: launch %d failed: %s\n", li, hipGetErrorName(le)); break; }
    }
}
```

```cpp
#define MK_N_LAUNCHES 1
#include <hip/hip_runtime.h>
#include <cstdio>
#include <cstdint>
namespace pg8 {
#define PG8_LAS __attribute__((address_space(3)))
typedef unsigned short bf16_t;
typedef short bf16x8 __attribute__((ext_vector_type(8)));
typedef float f32x4 __attribute__((ext_vector_type(4)));
typedef unsigned u32x4 __attribute__((ext_vector_type(4)));
constexpr int BM = 256, BK = 64, HALF = 128, HTB = HALF * BK * 2  , STAGE_BYTES = 8 * HTB, NXCD = 8, WGM = 8;

__host__ __device__ __forceinline__ int lds_byte(int r, int c) { const int st = (r >> 4) * 2 + (c >> 5), rr = r & 15, cc = c & 31, ob = rr * 64 + cc * 2; return st * 1024 + (ob ^ (((ob >> 9) & 1) << 5)); }
__host__ __device__ __forceinline__ void stage_rc(int b, int& R, int& C) { const int st = b / 1024, sb = b % 1024, swz = sb ^ (((sb >> 9) & 1) << 5); R = (st >> 1) * 16 + swz / 64; C = (st & 1) * 32 + (swz % 64) / 2; }
__host__ __device__ __forceinline__ int perm32(int rho) { const int n = rho >> 4, i = rho & 15; return 8 * (i >> 2) + 4 * n + (i & 3); }

struct Unit { int pm, pn, k0, nt, slab; };
struct Gemm { const bf16_t* A; const bf16_t* Bt; int M, N, K; };

struct StaticOrder {
    int nM, nN, nwg, G, c;
    __host__ __device__ void init(int M, int N, int G_, int c_) { nM = M / BM; nN = N / BM; nwg = nM * nN; G = G_; c = c_; }
    __host__ __device__ bool next(int i, Unit& u) const {
        const long L = (long)i * G + c; if (L >= nwg) return false;
        int wgid = (int)L; { const int q = nwg / NXCD, r = nwg % NXCD, xcd = wgid % NXCD, off = wgid / NXCD; wgid = (xcd < r ? xcd * (q + 1) : r * (q + 1) + (xcd - r) * q) + off; }
        const int nig = WGM * nN, gid = wgid / nig, fm = gid * WGM, gsz = (nM - fm) < WGM ? (nM - fm) : WGM;
        u.pm = fm + ((wgid % nig) % gsz); u.pn = (wgid % nig) / gsz; u.k0 = 0; u.nt = 0; u.slab = -1; return true;
    }
    __device__ __forceinline__ void a_ready(const Unit&) const {}
    __device__ __forceinline__ void done(const Unit&, int) const {}
};
__device__ __forceinline__ unsigned cvt_pk_bf16(float lo, float hi) { unsigned r; asm volatile("v_cvt_pk_bf16_f32 %0, %1, %2" : "=v"(r) : "v"(lo), "v"(hi)); return r; }
typedef float f32x2 __attribute__((ext_vector_type(2)));
struct EpiProj {
    static constexpr bool PERM = true, AFTER_DRAIN = false;
    bf16_t* O; int ldc; const float* bcum; const float* ghead;
    int pm_wt;
    __device__ __forceinline__ void store8(const f32x4 v0, const f32x4 v1, int row, int colb, bool wt) const {
        u32x4 w; w.x = cvt_pk_bf16(v0[0], v0[1]); w.y = cvt_pk_bf16(v0[2], v0[3]); w.z = cvt_pk_bf16(v1[0], v1[1]); w.w = cvt_pk_bf16(v1[2], v1[3]);
        if (wt) __builtin_amdgcn_raw_buffer_store_b128(w, __builtin_amdgcn_make_buffer_rsrc((void*)O, 0, 0x7fffffff, 0x00020000), (int)(((size_t)row * ldc + colb) * 2), 0, 16);
        else *(u32x4*)(O + (size_t)row * ldc + colb) = w;
    }
    __device__ __forceinline__ void operator()(const f32x4 (&acc)[2][2][4][2], const Unit& u, int wr, int wc, int fr, int fq) const {
        const int row0 = u.pm * BM + wr * 64 + fr; const int col0 = u.pn * BM + wc * 32 + 8 * fq;
        const int gk = (u.pn >= 8 && u.pn < 12) ? (u.pn < 10 ? 1 : 2) : (((u.pn >= 4 && u.pn < 8) || u.pn >= 16) ? 3 : 0);
        const bool wt = u.pm >= pm_wt;
        if (gk == 3) {
            const bool gh = u.pn >= 16;
            f32x4 g0[2], g1[2];
#pragma unroll
            for (int bj = 0; bj < 2; ++bj) { g0[bj] = (f32x4){1.f, 1.f, 1.f, 1.f}; g1[bj] = g0[bj];
                if (gh) { const float* gp = ghead + ((col0 + bj * HALF) & 255); g0[bj] = *(const f32x4*)gp; g1[bj] = *(const f32x4*)(gp + 4); } }
#pragma unroll
            for (int ai = 0; ai < 2; ++ai)
#pragma unroll
                for (int m = 0; m < 4; ++m) { const int row = row0 + ai * HALF + m * 16;
#pragma unroll
                    for (int bj = 0; bj < 2; ++bj) { f32x4 v0 = acc[ai][bj][m][0], v1 = acc[ai][bj][m][1];
#pragma unroll
                        for (int e = 0; e < 4; ++e) { v0[e] *= __builtin_amdgcn_rcpf(1.f + __builtin_amdgcn_exp2f(-1.4426950408889634f * v0[e])); v1[e] *= __builtin_amdgcn_rcpf(1.f + __builtin_amdgcn_exp2f(-1.4426950408889634f * v1[e])); }
                        store8(v0 * g0[bj], v1 * g1[bj], row, col0 + bj * HALF, wt); } }
        } else if (gk) {
            typedef _Float16 h8 __attribute__((ext_vector_type(8)));
            const float sgn = gk == 1 ? 1.f : -1.f, sc = gk == 1 ? 0.08838834764831845f : 1.f;
            const int cb = col0 - (gk == 1 ? 2048 : 2560);
            h8 hb[2][4][2];
#pragma unroll
            for (int ai = 0; ai < 2; ++ai)
#pragma unroll
                for (int m = 0; m < 4; ++m)
#pragma unroll
                    for (int bj = 0; bj < 2; ++bj) hb[ai][m][bj] = *(const h8*)((const _Float16*)bcum + (size_t)(row0 + ai * HALF + m * 16) * 512 + cb + bj * HALF);
#pragma unroll
            for (int ai = 0; ai < 2; ++ai)
#pragma unroll
                for (int m = 0; m < 4; ++m) { const int row = row0 + ai * HALF + m * 16;
#pragma unroll
                    for (int bj = 0; bj < 2; ++bj) { f32x4 v0 = acc[ai][bj][m][0], v1 = acc[ai][bj][m][1]; const h8 h = hb[ai][m][bj];
#pragma unroll
                        for (int e = 0; e < 4; ++e) { v0[e] *= sc * __builtin_amdgcn_exp2f(sgn * (float)h[e]); v1[e] *= sc * __builtin_amdgcn_exp2f(sgn * (float)h[4 + e]); }
                        store8(v0, v1, row, col0 + bj * HALF, wt); } }
        } else {
#pragma unroll
            for (int ai = 0; ai < 2; ++ai)
#pragma unroll
                for (int m = 0; m < 4; ++m) { const int row = row0 + ai * HALF + m * 16;
#pragma unroll
                    for (int bj = 0; bj < 2; ++bj) store8(acc[ai][bj][m][0], acc[ai][bj][m][1], row, col0 + bj * HALF, wt); }
        }
    }
};
struct EpiY {
    static constexpr bool PERM = true, AFTER_DRAIN = false;
    bf16_t* O; int ldc; bf16_t* slabs; int row_s; size_t slab_elems;
    __device__ __forceinline__ void operator()(const f32x4 (&acc)[2][2][4][2], const Unit& u, int wr, int wc, int fr, int fq) const {
        const int row0 = u.pm * BM + wr * 64 + fr; const int col0 = u.pn * BM + wc * 32 + 8 * fq;
        bf16_t* base = u.slab >= 0 ? slabs + (size_t)u.slab * slab_elems - (size_t)row_s * ldc : O;
#pragma unroll
        for (int ai = 0; ai < 2; ++ai)
#pragma unroll
            for (int m = 0; m < 4; ++m) { const int row = row0 + ai * HALF + m * 16; bf16_t* rowp = base + (size_t)row * ldc + col0;
#pragma unroll
                for (int bj = 0; bj < 2; ++bj) { const f32x4 v0 = acc[ai][bj][m][0], v1 = acc[ai][bj][m][1];
                    u32x4 w; w.x = cvt_pk_bf16(v0[0], v0[1]); w.y = cvt_pk_bf16(v0[2], v0[3]); w.z = cvt_pk_bf16(v1[0], v1[1]); w.w = cvt_pk_bf16(v1[2], v1[3]);
                    *(u32x4*)(rowp + bj * HALF) = w; } }
    }
};
struct EpiYF {
    static constexpr bool PERM = true, AFTER_DRAIN = true;
    bf16_t* slabs; int row_s; size_t slab_elems; int ldc;
    const float* base; float* out; const float* g; float* xbuf; unsigned* cnt; float eps;
    __device__ __forceinline__ void operator()(const f32x4 (&acc)[2][2][4][2], const Unit& u, int wr, int wc, int fr, int fq) const {
        const int row0 = u.pm * BM + wr * 64 + fr; const int col0 = u.pn * BM + wc * 32 + 8 * fq;
        const __amdgpu_buffer_rsrc_t rs = __builtin_amdgcn_make_buffer_rsrc((void*)slabs, 0, 0x7fffffff, 0x00020000);
        const size_t e0 = (size_t)u.slab * slab_elems - (size_t)row_s * ldc;
#pragma unroll
        for (int ai = 0; ai < 2; ++ai)
#pragma unroll
            for (int m = 0; m < 4; ++m) { const int row = row0 + ai * HALF + m * 16;
#pragma unroll
                for (int bj = 0; bj < 2; ++bj) { const f32x4 v0 = acc[ai][bj][m][0], v1 = acc[ai][bj][m][1];
                    u32x4 w; w.x = cvt_pk_bf16(v0[0], v0[1]); w.y = cvt_pk_bf16(v0[2], v0[3]); w.z = cvt_pk_bf16(v1[0], v1[1]); w.w = cvt_pk_bf16(v1[2], v1[3]);
                    __builtin_amdgcn_raw_buffer_store_b128(w, rs, (int)((e0 + (size_t)row * ldc + col0 + bj * HALF) * 2), 0, 16); } }
    }
    __device__ __forceinline__ void fused(f32x4 (&acc)[2][2][4][2], const Unit& u, int wr, int wc, int fr, int fq, PG8_LAS unsigned char* lds, int wid, int lane) const {
        PG8_LAS float* P = (PG8_LAS float*)lds;
        PG8_LAS float* Sr = (PG8_LAS float*)(lds + 4096);
        const int col0 = u.pn * BM + wc * 32 + 8 * fq;
        const float* bp = base + (size_t)(u.pm * BM + wr * 64 + fr) * ldc + col0;
        f32x4 xv[3][2][2];
#define EYF_LOAD(slot, gi) do { _Pragma("unroll") for (int bj = 0; bj < 2; ++bj) _Pragma("unroll") for (int n = 0; n < 2; ++n) xv[slot][bj][n] = *(const f32x4*)(bp + (size_t)((((gi) >> 2) * HALF) + ((gi) & 3) * 16) * ldc + bj * HALF + 4 * n); } while (0)
        EYF_LOAD(0, 0); EYF_LOAD(1, 1); EYF_LOAD(2, 2);
#pragma unroll
        for (int ai = 0; ai < 2; ++ai)
#pragma unroll
            for (int m = 0; m < 4; ++m) { float s = 0.f;
#pragma unroll
                for (int bj = 0; bj < 2; ++bj)
#pragma unroll
                    for (int n = 0; n < 2; ++n) { const f32x4 x = acc[ai][bj][m][n]; s += (x[0] * x[0] + x[1] * x[1]) + (x[2] * x[2] + x[3] * x[3]); }
                s += __shfl_xor(s, 16); s += __shfl_xor(s, 32);
                if (fq == 0) P[(ai * HALF + wr * 64 + m * 16 + fr) * 4 + wc] = s; }
        asm volatile("s_waitcnt lgkmcnt(0)" ::: "memory"); __builtin_amdgcn_s_barrier(); asm volatile("" ::: "memory");
        const int row = wid * 32 + (lane & 31);
        if (lane < 32) { const f32x4 p = *(const PG8_LAS f32x4*)(P + row * 4);
            __hip_atomic_store(xbuf + (size_t)(u.pm * BM + row) * 4 + u.pn, (p[0] + p[1]) + (p[2] + p[3]), __ATOMIC_RELAXED, __HIP_MEMORY_SCOPE_AGENT); }
        asm volatile("s_waitcnt vmcnt(0)" ::: "memory");
        if (lane == 0) __hip_atomic_fetch_add(cnt + 64 * u.pm, 1u, __ATOMIC_RELAXED, __HIP_MEMORY_SCOPE_AGENT);
        if (wid == 0) { unsigned sp = 0;
            while ((unsigned)__builtin_amdgcn_readfirstlane(__hip_atomic_load(cnt + 64 * u.pm, __ATOMIC_RELAXED, __HIP_MEMORY_SCOPE_AGENT)) < 32u) { __builtin_amdgcn_s_sleep(2); if (++sp > (1u << 22)) break; }
            __builtin_amdgcn_fence(__ATOMIC_ACQUIRE, "agent"); }
        asm volatile("s_waitcnt vmcnt(0) lgkmcnt(0)" ::: "memory"); __builtin_amdgcn_s_barrier(); asm volatile("" ::: "memory");
        if (lane < 32) { const float* sl = xbuf + (size_t)(u.pm * BM + row) * 4; float t = 0.f;
#pragma unroll
            for (int k = 0; k < 4; ++k) t += __hip_atomic_load(sl + k, __ATOMIC_RELAXED, __HIP_MEMORY_SCOPE_AGENT);
            Sr[row] = __builtin_amdgcn_rsqf(t * (1.f / 1024.f) + eps); }
        asm volatile("s_waitcnt vmcnt(0) lgkmcnt(0)" ::: "memory"); __builtin_amdgcn_s_barrier(); asm volatile("" ::: "memory");
        f32x4 gv[2][2];
#pragma unroll
        for (int bj = 0; bj < 2; ++bj)
#pragma unroll
            for (int n = 0; n < 2; ++n) gv[bj][n] = *(const f32x4*)(g + col0 + bj * HALF + 4 * n);
        float* op = out + (size_t)(u.pm * BM + wr * 64 + fr) * ldc + col0;
#pragma unroll
        for (int gi = 0; gi < 8; ++gi) { const int ai = gi >> 2, m = gi & 3; const float rs = Sr[ai * HALF + wr * 64 + m * 16 + fr];
            float* orow = op + (size_t)(ai * HALF + m * 16) * ldc;
#pragma unroll
            for (int bj = 0; bj < 2; ++bj)
#pragma unroll
                for (int n = 0; n < 2; ++n) *(f32x4*)(orow + bj * HALF + 4 * n) = xv[gi % 3][bj][n] + acc[ai][bj][m][n] * rs * gv[bj][n];
            asm volatile("" ::: "memory");
            if (gi + 3 < 8) EYF_LOAD(gi % 3, gi + 3);
            asm volatile("" ::: "memory"); }
#undef EYF_LOAD
    }
};
struct Gemm2FOrder {
    StaticOrder so; int c, nN, pm0, KS, ntS; unsigned* cnt;
    __host__ __device__ void init(int MP, int N, int K, int KS_, int c_, unsigned* cnt_) { so.init(MP, N, 256, c_); c = c_; nN = N / BM; pm0 = MP / BM; KS = KS_; ntS = K / BK / KS_; cnt = cnt_; }
    __host__ __device__ bool next(int i, Unit& u) const {
        const bool hs = (c & 63) < 32;
        if (hs && i == 0) { const int L = (c >> 6) * 32 + (c & 63), lu = L / KS, ks = L % KS; u.pm = pm0 + lu / nN; u.pn = lu % nN; u.k0 = ks * ntS; u.nt = ntS; u.slab = ks; return true; }
        if (i == (hs ? 1 : 0)) return so.next(0, u);
        return false;
    }
    __device__ __forceinline__ void a_ready(const Unit&) const {}
    __device__ __forceinline__ void done(const Unit& u, int) const {
        if (u.slab >= 0) { asm volatile("s_waitcnt vmcnt(0)" ::: "memory");
            if ((threadIdx.x & 63) == 0) __hip_atomic_fetch_add(cnt + 64 * (c & 7), 1u, __ATOMIC_RELAXED, __HIP_MEMORY_SCOPE_AGENT); }
    }
};
struct Gemm2Order {
    StaticOrder so; int nfull, nN, pm0, KS, ntS, nsl, G, c;
    __host__ __device__ void init(int MP, int M, int N, int K, int KS_, int G_, int c_) { so.init(MP, N, G_, c_); nfull = so.nwg; nN = N / BM; pm0 = MP / BM; KS = KS_; ntS = K / BK / KS_; nsl = ((M - MP) / BM) * nN * KS_; G = G_; c = c_; }
    __host__ __device__ bool next(int i, Unit& u) const {
        const long L = (long)i * G + c;
        if (L < nfull) return so.next(i, u);
        const long Ls = L - nfull; if (Ls >= nsl) return false;
        const int lu = (int)Ls / KS, ks = (int)Ls % KS; u.pm = pm0 + lu / nN; u.pn = lu % nN; u.k0 = ks * ntS; u.nt = ntS; u.slab = ks; return true;
    }
    __device__ __forceinline__ void a_ready(const Unit&) const {}
    __device__ __forceinline__ void done(const Unit&, int) const {}
};
struct NoKScale { static constexpr bool ON = false; };
struct HeadScale {
    static constexpr bool ON = true; static constexpr int MAXU = 2;
    const float* pss; int nrowp; float eps;
    static constexpr int OFF = 131072;
    __device__ __forceinline__ void prep(PG8_LAS unsigned char* lds, const Unit& u, int par) const {
        const int r = threadIdx.x & 255; const int row = u.pm * BM + r;
        PG8_LAS float* T = (PG8_LAS float*)(lds + OFF) + par * 5 * 256;
        const __amdgpu_buffer_rsrc_t rsrc = __builtin_amdgcn_make_buffer_rsrc((void*)pss, 0, 32 * nrowp * 4, 0x00020000);
        float v[32];
        if (row < nrowp) {
#pragma unroll
            for (int i = 0; i < 32; ++i) v[i] = __builtin_bit_cast(float, __builtin_amdgcn_raw_buffer_load_b32(rsrc, row * 4, i * nrowp * 4, 0));
        }
        float prev = 1.f;
#pragma unroll
        for (int h = 0; h < 4; ++h) { float rs = 1.f;
            if (row < nrowp) { const float tot = ((v[8 * h] + v[8 * h + 1]) + (v[8 * h + 2] + v[8 * h + 3])) + ((v[8 * h + 4] + v[8 * h + 5]) + (v[8 * h + 6] + v[8 * h + 7]));
                rs = __builtin_amdgcn_rsqf(tot * (1.f / 256.f) + eps); }
            T[h * 256 + r] = prev * __builtin_amdgcn_rcpf(rs); prev = rs; }
        T[4 * 256 + r] = prev;
    }
    __device__ __forceinline__ void scale(f32x4 (&acc)[2][2][4][2], PG8_LAS unsigned char* lds, int par, int idx, int wr, int fr) const {
        const unsigned a = (unsigned)(size_t)(lds + OFF) + (unsigned)(((par * 5 + idx) * 256 + wr * 64 + fr) * 4);
        float f0, f1, f2, f3, f4, f5, f6, f7;
        asm volatile("ds_read_b32 %0, %8\n\tds_read_b32 %1, %8 offset:64\n\tds_read_b32 %2, %8 offset:128\n\tds_read_b32 %3, %8 offset:192\n\t"
                     "ds_read_b32 %4, %8 offset:512\n\tds_read_b32 %5, %8 offset:576\n\tds_read_b32 %6, %8 offset:640\n\tds_read_b32 %7, %8 offset:704\n\ts_waitcnt lgkmcnt(0)"
                     : "=&v"(f0), "=&v"(f1), "=&v"(f2), "=&v"(f3), "=&v"(f4), "=&v"(f5), "=&v"(f6), "=&v"(f7) : "v"(a) : "memory");
        const float f[2][4] = {{f0, f1, f2, f3}, {f4, f5, f6, f7}};
#pragma unroll
        for (int ai = 0; ai < 2; ++ai)
#pragma unroll
            for (int m = 0; m < 4; ++m)
#pragma unroll
                for (int bj = 0; bj < 2; ++bj)
#pragma unroll
                    for (int n = 0; n < 2; ++n) acc[ai][bj][m][n] = acc[ai][bj][m][n] * f[ai][m];
    }
};

struct Gemm1Order {
    StaticOrder so; int nS, nN, pmS, G, c; unsigned* cnt;
    __host__ __device__ void init(int MP, int M, int N, int G_, int c_, unsigned* cnt_) { so.init(MP, N, G_, 0); nN = N / BM; pmS = MP / BM; nS = ((M - MP) / BM) * nN; G = G_; c = c_; cnt = cnt_; }
    __host__ __device__ bool next(int i, Unit& u) const {
        const long L = (long)i * G + c;
        if (L < nS) { u.pm = pmS + (int)L / nN; u.pn = (int)L % nN; u.k0 = 0; u.nt = 0; u.slab = -1; return true; }
        const long Lp = L - nS; if (Lp >= so.nwg) return false;
        StaticOrder t = so; t.G = 1; t.c = 0; return t.next((int)Lp, u);
    }
    __device__ __forceinline__ void a_ready(const Unit&) const {}
    __device__ __forceinline__ void done(const Unit& u, int) const {
        if (u.pm >= pmS) {
            asm volatile("s_waitcnt vmcnt(0)" ::: "memory");
            if ((threadIdx.x & 63) == 0) __hip_atomic_fetch_add(cnt, 1u, __ATOMIC_RELAXED, __HIP_MEMORY_SCOPE_AGENT);
        }
    }
};

struct OneUnitOrder {
    int pm, pn, have; unsigned* cnt;
    __host__ __device__ bool next(int i, Unit& u) const { if (i > 0 || !have) return false; u.pm = pm; u.pn = pn; u.k0 = 0; u.nt = 0; u.slab = -1; return true; }
    __device__ __forceinline__ void a_ready(const Unit&) const {}
    __device__ __forceinline__ void done(const Unit&, int) const {
        asm volatile("s_waitcnt vmcnt(0)" ::: "memory");
        if ((threadIdx.x & 63) == 0) __hip_atomic_fetch_add(cnt, 1u, __ATOMIC_RELAXED, __HIP_MEMORY_SCOPE_AGENT);
    }
};

template <class Epi, class Sched, bool ALIGN_EPI = false, bool SP2 = false, class KS = NoKScale>
__device__ __forceinline__ void gemm_phase(PG8_LAS unsigned char* lds, const Gemm g, const Sched& S, const Epi& E, const KS ksc = KS()) {
    int tid_ = threadIdx.x; asm volatile("" : "+v"(tid_));
    const int tid = tid_, wid = __builtin_amdgcn_readfirstlane(tid >> 6), lane = tid & 63, wr = wid >> 2, wc = wid & 3, fr = lane & 15, fq = lane >> 4;
    const int K = g.K, ntK = K / BK;
    unsigned voffA[2], voffB[2];
#pragma unroll
    for (int i = 0; i < 2; ++i) { int R, C; stage_rc(tid * 16 + i * 8192, R, C); const int Rb = Epi::PERM ? ((R & ~31) + perm32(R & 31)) : R;
        voffA[i] = (unsigned)(R * K + C) * 2u; voffB[i] = (unsigned)(Rb * K + C) * 2u; }
    const size_t kstep = (size_t)(BK * 2);
    const size_t hstep = (size_t)HALF * K * 2;
    const size_t tstep = 2 * hstep;
    const unsigned ldsw = (unsigned)wid * 1024u;
    const int aoff = lds_byte(wr * 64 + fr, fq * 8), boff = lds_byte(wc * 32 + fr, fq * 8);
#define PG8_SA(b, h) (((b) * 2 + (h)) * HTB)
#define PG8_SB(b, h) ((4 + (b) * 2 + (h)) * HTB)
#define PG8_STAGE(bufoff, gbase, voff) do { _Pragma("unroll") for (int _i = 0; _i < 2; ++_i) \
        __builtin_amdgcn_global_load_lds((const unsigned*)((const char*)(gbase) + (voff)[_i]), (PG8_LAS unsigned*)(lds + (bufoff) + ldsw + _i * 8192), 16, 0, 0); } while (0)
#define PG8_LDA(dst, b, h) do { _Pragma("unroll") for (int m = 0; m < 4; ++m) _Pragma("unroll") for (int k = 0; k < 2; ++k) dst[m][k] = *(const PG8_LAS bf16x8*)(lds + PG8_SA(b, h) + aoff + m * 2048 + k * 1024); } while (0)
#define PG8_LDB(dst, b, h) do { _Pragma("unroll") for (int n = 0; n < 2; ++n) _Pragma("unroll") for (int k = 0; k < 2; ++k) dst[n][k] = *(const PG8_LAS bf16x8*)(lds + PG8_SB(b, h) + boff + n * 2048 + k * 1024); } while (0)
#define PG8_MMA(ai, bj, At, Bt) do { __builtin_amdgcn_s_setprio(1); _Pragma("unroll") for (int m = 0; m < 4; ++m) _Pragma("unroll") for (int n = 0; n < 2; ++n) _Pragma("unroll") for (int k = 0; k < 2; ++k) \
        acc[ai][bj][m][n] = __builtin_amdgcn_mfma_f32_16x16x32_bf16(Bt[n][k], At[m][k], acc[ai][bj][m][n], 0, 0, 0); __builtin_amdgcn_s_setprio(0); } while (0)
#define PG8_WAIT_V(n) asm volatile("s_waitcnt vmcnt(" #n ")" ::: "memory")
#define PG8_WAIT_L(n) asm volatile("s_waitcnt lgkmcnt(" #n ")" ::: "memory")
#define PG8_BAR __builtin_amdgcn_s_barrier()
#define PG8_SCHED __builtin_amdgcn_sched_barrier(0)
    Unit cur, nxt; int ui = 0;
    if (!S.next(0, cur)) return;
    f32x4 acc[2][2][4][2];
#pragma unroll
    for (int a = 0; a < 2; ++a)
#pragma unroll
        for (int b = 0; b < 2; ++b)
#pragma unroll
            for (int m = 0; m < 4; ++m)
#pragma unroll
                for (int n = 0; n < 2; ++n) acc[a][b][m][n] = (f32x4){0.f, 0.f, 0.f, 0.f};
    bf16x8 At[4][2], B0[2][2], B1[2][2];
    const char* cA = (const char*)g.A + (size_t)cur.pm * tstep + (size_t)cur.k0 * (BK * 2); const char* cB = (const char*)g.Bt + (size_t)cur.pn * tstep + (size_t)cur.k0 * (BK * 2);
    S.a_ready(cur);
#if 0
    if constexpr (KS::ON) { Unit pu; for (int i = 0; i < KS::MAXU && S.next(i, pu); ++i) ksc.prep(lds, pu, i); }
#endif
    if constexpr (SP2) {
        PG8_STAGE(PG8_SB(0, 0), cB, voffB); PG8_STAGE(PG8_SB(0, 1), cB + hstep, voffB); PG8_STAGE(PG8_SA(0, 0), cA, voffA); PG8_STAGE(PG8_SA(0, 1), cA + hstep, voffA);
#if 1
        if constexpr (KS::ON) { Unit pu; for (int i = 0; i < KS::MAXU && S.next(i, pu); ++i) ksc.prep(lds, pu, i); }
#endif
        if (wr == 1) PG8_BAR;
        PG8_WAIT_V(2); PG8_BAR;
        PG8_STAGE(PG8_SB(1, 0), cB + kstep, voffB); PG8_STAGE(PG8_SA(1, 0), cA + kstep, voffA); PG8_STAGE(PG8_SB(1, 1), cB + hstep + kstep, voffB);
        PG8_WAIT_V(6); PG8_BAR;
    } else {
        PG8_STAGE(PG8_SB(0, 0), cB, voffB); PG8_STAGE(PG8_SA(0, 0), cA, voffA); PG8_STAGE(PG8_SB(0, 1), cB + hstep, voffB); PG8_STAGE(PG8_SA(0, 1), cA + hstep, voffA);
        if (wr == 1) PG8_BAR;
        PG8_WAIT_V(4); PG8_BAR;
        PG8_STAGE(PG8_SB(1, 0), cB + kstep, voffB); PG8_STAGE(PG8_SA(1, 0), cA + kstep, voffA); PG8_STAGE(PG8_SB(1, 1), cB + hstep + kstep, voffB);
        PG8_WAIT_V(6); PG8_BAR;
    }
    for (;;) {
        const bool has_next = S.next(ui + 1, nxt);
        const char* nA = has_next ? (const char*)g.A + (size_t)nxt.pm * tstep + (size_t)nxt.k0 * (BK * 2) : cA; const char* nB = has_next ? (const char*)g.Bt + (size_t)nxt.pn * tstep + (size_t)nxt.k0 * (BK * 2) : cB;
        const int nt = cur.nt ? cur.nt : ntK;
        for (int t = 0; t < nt; t += 2) {
            const bool last = (t == nt - 2);
            const char* a1 = cA + (size_t)(t + 1) * kstep;
            const char* a2 = last ? nA : cA + (size_t)(t + 2) * kstep; const char* b2 = last ? nB : cB + (size_t)(t + 2) * kstep;
            const char* a3 = a2 + kstep; const char* b3 = b2 + kstep;
            if (last && has_next) S.a_ready(nxt);
            if constexpr (KS::ON) { if (t >= 16 && (t & 3) == 0) ksc.scale(acc, lds, ui & 1, (t - 16) >> 2, wr, fr); }
            if constexpr (SP2) {
            PG8_LDB(B0, 0, 0); PG8_LDB(B1, 0, 1); PG8_SCHED; PG8_LDA(At, 0, 0); PG8_STAGE(PG8_SA(1, 1), a1 + hstep, voffA);
            PG8_WAIT_V(8); PG8_WAIT_L(0); PG8_BAR; PG8_MMA(0, 0, At, B0); PG8_MMA(0, 1, At, B1); PG8_BAR; PG8_SCHED;
            PG8_LDA(At, 0, 1); PG8_STAGE(PG8_SB(0, 0), b2, voffB); PG8_STAGE(PG8_SB(0, 1), b2 + hstep, voffB); PG8_STAGE(PG8_SA(0, 0), a2, voffA);
            PG8_WAIT_V(8); PG8_WAIT_L(0); PG8_BAR; PG8_MMA(1, 0, At, B0); PG8_MMA(1, 1, At, B1); PG8_BAR; PG8_SCHED;
            PG8_LDB(B0, 1, 0); PG8_LDB(B1, 1, 1); PG8_SCHED; PG8_LDA(At, 1, 0); PG8_STAGE(PG8_SA(0, 1), a2 + hstep, voffA);
            PG8_WAIT_V(8); PG8_WAIT_L(0); PG8_BAR; PG8_MMA(0, 0, At, B0); PG8_MMA(0, 1, At, B1); PG8_BAR; PG8_SCHED;
            PG8_LDA(At, 1, 1); PG8_STAGE(PG8_SB(1, 0), b3, voffB); PG8_STAGE(PG8_SB(1, 1), b3 + hstep, voffB); PG8_STAGE(PG8_SA(1, 0), a3, voffA);
            PG8_WAIT_V(8); PG8_WAIT_L(0); PG8_BAR; PG8_MMA(1, 0, At, B0); PG8_MMA(1, 1, At, B1); PG8_BAR; PG8_SCHED;
            } else {
            PG8_LDB(B0, 0, 0); PG8_SCHED; PG8_LDA(At, 0, 0); PG8_STAGE(PG8_SA(1, 1), a1 + hstep, voffA);
            PG8_WAIT_L(8); PG8_BAR; PG8_WAIT_L(0); PG8_MMA(0, 0, At, B0); PG8_BAR; PG8_SCHED;
            PG8_LDB(B1, 0, 1); PG8_STAGE(PG8_SB(0, 0), b2, voffB);
            PG8_BAR; PG8_WAIT_L(0); PG8_MMA(0, 1, At, B1); PG8_BAR;
            PG8_LDA(At, 0, 1); PG8_STAGE(PG8_SA(0, 0), a2, voffA);
            PG8_BAR; PG8_WAIT_L(0); PG8_MMA(1, 0, At, B0); PG8_BAR; PG8_SCHED;
            PG8_STAGE(PG8_SB(0, 1), b2 + hstep, voffB);
            PG8_WAIT_V(6); PG8_BAR; PG8_MMA(1, 1, At, B1); PG8_BAR;
            PG8_LDB(B0, 1, 0); PG8_SCHED; PG8_LDA(At, 1, 0); PG8_STAGE(PG8_SA(0, 1), a2 + hstep, voffA);
            PG8_WAIT_L(8); PG8_BAR; PG8_WAIT_L(0); PG8_MMA(0, 0, At, B0); PG8_BAR; PG8_SCHED;
            PG8_LDB(B1, 1, 1); PG8_STAGE(PG8_SB(1, 0), b3, voffB);
            PG8_BAR; PG8_WAIT_L(0); PG8_MMA(0, 1, At, B1); PG8_BAR;
            PG8_LDA(At, 1, 1); PG8_STAGE(PG8_SA(1, 0), a3, voffA);
            PG8_BAR; PG8_WAIT_L(0); PG8_MMA(1, 0, At, B0); PG8_BAR; PG8_SCHED;
            PG8_STAGE(PG8_SB(1, 1), b3 + hstep, voffB);
            PG8_WAIT_V(6); PG8_BAR; PG8_MMA(1, 1, At, B1); PG8_BAR;
            }
        }
        if constexpr (KS::ON) ksc.scale(acc, lds, ui & 1, 4, wr, fr);
        if constexpr (ALIGN_EPI) { if (wr == 0) PG8_BAR; }
        if constexpr (!Epi::AFTER_DRAIN) { E(acc, cur, wr, wc, fr, fq); S.done(cur, ui); }
        else { if (has_next) { E(acc, cur, wr, wc, fr, fq); S.done(cur, ui); } }
        if (!has_next) break;
#pragma unroll
        for (int a = 0; a < 2; ++a)
#pragma unroll
            for (int b = 0; b < 2; ++b)
#pragma unroll
                for (int m = 0; m < 4; ++m)
#pragma unroll
                    for (int n = 0; n < 2; ++n) acc[a][b][m][n] = (f32x4){0.f, 0.f, 0.f, 0.f};
        cur = nxt; cA = nA; cB = nB; ++ui;
        if constexpr (ALIGN_EPI) { if (wr == 1) PG8_BAR; }
    }
    PG8_WAIT_V(0);
    if constexpr (!ALIGN_EPI) { if (wr == 0) PG8_BAR; }
    PG8_BAR;
    if constexpr (Epi::AFTER_DRAIN) { E.fused(acc, cur, wr, wc, fr, fq, lds, wid, lane); S.done(cur, ui); }
#undef PG8_SA
#undef PG8_SB
#undef PG8_STAGE
#undef PG8_LDA
#undef PG8_LDB
#undef PG8_MMA
#undef PG8_WAIT_V
#undef PG8_WAIT_L
#undef PG8_BAR
#undef PG8_SCHED
}
}

#ifndef MK_N_LAUNCHES
#define MK_N_LAUNCHES 1
#endif
constexpr int N_PHASES = 5, N_LAUNCHES = MK_N_LAUNCHES;
constexpr int NWAVES = 8;
constexpr int D = 1024, NP = 8, TP = 2048, NS = 128, TS = 8, NROWP = NP * TP, NROWS = NS * TS, NTOK = NROWP + NROWS;
constexpr int DIN = 5136, DINP = 5120, DMIX = 2048, HK = 128, HV = 256, NH = 4;
constexpr int C_XL = 0, C_ZL = 1024, C_Q = 2048, C_K = 2560, C_V = 3072, C_ZG = 4096;
constexpr float EPS = 1e-6f;
constexpr size_t O_YP = 0, O_YS = 16777216, O_HP = 17825792, O_CP = 17833984, O_GP = 17858560, O_HS = 18907136, O_CS = 19038208, O_GS = 19431424, O_END = 36208640;
constexpr size_t MiB = 1u << 20;
constexpr size_t WS_CTL = 0, CTL_ZERO_BYTES = 64 * 1024;
constexpr size_t WS_WINT = 2 * MiB, WS_WOUT = 12 * MiB, WS_RGK = 16 * MiB, WS_PART = 18 * MiB, WS_DEC = 19 * MiB + 256 * 1024, WS_XN = 20 * MiB, WS_PROJ = 54 * MiB, WS_YS = 224 * MiB, WS_END = 240 * MiB;
static_assert(WS_DEC + (size_t)(NP * (TP / 64) + NS) * 512 * 4 <= WS_XN && WS_PART + (size_t)16 * NTOK * 4 <= WS_DEC, "d_ws map (DEC)");
static_assert(WS_WINT + (size_t)DINP * D * 2 <= WS_WOUT && WS_WOUT + (size_t)D * DMIX * 2 <= WS_RGK && WS_RGK + (size_t)NTOK * 16 * 4 <= WS_PART && WS_PART + (size_t)16 * NTOK * 4 <= WS_XN &&
              WS_XN + (size_t)NTOK * D * 2 <= WS_PROJ && WS_PROJ + (size_t)NTOK * DINP * 2 <= WS_YS && WS_YS + (size_t)8 * NROWS * D * 2 <= WS_END, "d_ws map");
constexpr int CW_BAR = 4096, CW_SAMPLE = 8192, CW_DIAG = 12288;
#ifndef LATE_SAMPLE
#define LATE_SAMPLE 0
#endif
constexpr int CHAIN_NS = LATE_SAMPLE ? 0 : 80;
#ifndef FUSE_P4
#define FUSE_P4 1
#endif
constexpr int CW_ROWS = 0;
constexpr size_t WS_XBUF = WS_PART + 65536;
static_assert(WS_XBUF + (size_t)NROWP * 4 * 4 <= WS_DEC, "d_ws map (XBUF)");
static_assert((CW_DIAG + 64) * 4 <= (int)CTL_ZERO_BYTES, "control words inside the zeroed region");
constexpr int RING_OFF = 0, RING_BYTES = 162816, LDSCTL_OFF = RING_BYTES, MISC_OFF = LDSCTL_OFF + 320, LDS_BYTES = 163840;

#define GAS __attribute__((address_space(1)))
#define LAS __attribute__((address_space(3)))
typedef unsigned short bf16;
typedef unsigned v4u __attribute__((ext_vector_type(4)));
typedef unsigned v2u __attribute__((ext_vector_type(2)));
typedef float f32x4 __attribute__((ext_vector_type(4)));
typedef GAS unsigned gu32;
#define RLX_AGENT __ATOMIC_RELAXED, __HIP_MEMORY_SCOPE_AGENT
#define LDS_WAIT() asm volatile("s_waitcnt lgkmcnt(0)" ::: "memory")
#define VM_WAIT() asm volatile("s_waitcnt vmcnt(0)" ::: "memory")
__device__ __forceinline__ unsigned f2bf(float f) { unsigned u = __builtin_bit_cast(unsigned, f); return (u + 0x7fffu + ((u >> 16) & 1u)) >> 16; }
__device__ __forceinline__ unsigned pk2(float lo, float hi) { return f2bf(lo) | (f2bf(hi) << 16); }
__device__ __forceinline__ float bf2f(unsigned b) { return __builtin_bit_cast(float, b << 16); }
__device__ __forceinline__ float bflo(unsigned w) { return __builtin_bit_cast(float, w << 16); }
__device__ __forceinline__ float bfhi(unsigned w) { return __builtin_bit_cast(float, w & 0xffff0000u); }
__device__ __forceinline__ float sigmoidf_(float x) { return 1.f / (1.f + __expf(-x)); }
__device__ __forceinline__ float logsigf_(float x) { return fminf(x, 0.f) - log1pf(__expf(-fabsf(x))); }
#define XB_TMO      128
#define XB_XCNT(j)  (256  + 64 * (j))
#define XB_XSUB(j)  (1280 + 64 * (j))
#define XB_XGEN(j)  (2304 + 64 * (j))
#define XB_TOP      3328
#define XB_TOPGEN   3392
#define XCD_BAR_WORDS 3456
#define XB_SPIN_CAP (1u << 18)

__device__ __forceinline__ unsigned xb_ld(unsigned* p)              { return __hip_atomic_load(p, __ATOMIC_RELAXED, __HIP_MEMORY_SCOPE_AGENT); }
__device__ __forceinline__ unsigned xb_add(unsigned* p, unsigned v) { return __hip_atomic_fetch_add(p, v, __ATOMIC_RELAXED, __HIP_MEMORY_SCOPE_AGENT); }
__device__ __forceinline__ unsigned xb_xcc_id() { return (unsigned)__builtin_amdgcn_s_getreg((3 << 11) | 20) & 0xFu; }
#define XB_SPIN(cond, bar) do { unsigned _sp = 0; while (cond) { __builtin_amdgcn_s_sleep(1); \
    if ((++_sp & 255u) == 0u) { if (xb_ld(&(bar)[XB_TMO])) break; if (_sp > XB_SPIN_CAP) { atomicAdd(&(bar)[XB_TMO], 1u); break; } } } } while (0)

struct XcdBarrier {
    unsigned* bar; unsigned x;
    volatile LAS unsigned* st;
};

__device__ __forceinline__ XcdBarrier xcd_barrier_post(unsigned* bar, volatile LAS unsigned* st) {
    XcdBarrier b; b.bar = bar; b.x = xb_xcc_id(); b.st = st;
    if (threadIdx.x == 0) (void)xb_add(&bar[XB_XCNT(b.x)], 1u);
    return b;
}
__device__ __forceinline__ void xcd_barrier_complete(unsigned* bar, unsigned x, unsigned& nloc, unsigned& nx) {
    const unsigned G = gridDim.x * gridDim.y * gridDim.z;
    unsigned sum, cnt, mine, sp = 0u;
    for (;;) {
        sum = 0u; cnt = 0u; mine = 0u;
#pragma unroll
        for (unsigned j = 0; j < 16; ++j) { const unsigned c = xb_ld(&bar[XB_XCNT(j)]); sum += c; cnt += (c > 0u) ? 1u : 0u; mine = (j == x) ? c : mine; }
        if (sum == G) break;
        __builtin_amdgcn_s_sleep(1);
        if ((++sp & 255u) == 0u) { if (xb_ld(&bar[XB_TMO])) break; if (sp > XB_SPIN_CAP) { atomicAdd(&bar[XB_TMO], 1u); break; } }
    }
    nloc = mine > 0u ? mine : 1u; nx = cnt > 0u ? cnt : 1u;
}

__device__ __forceinline__ void xcd_barrier(const XcdBarrier& b) {
    asm volatile("s_waitcnt vmcnt(0)" ::: "memory");
    __syncthreads();
    if (threadIdx.x == 0) {
        unsigned* bar = b.bar;
        __builtin_amdgcn_s_waitcnt(0);
        unsigned nloc = b.st[0], nx = b.st[1];
        if (nloc == 0u) { xcd_barrier_complete(bar, b.x, nloc, nx); b.st[0] = nloc; b.st[1] = nx; }
        const unsigned old = xb_add(&bar[XB_XSUB(b.x)], 1u);
        const unsigned gen = old / nloc;
        if (old + 1u == (gen + 1u) * nloc) {
            __builtin_amdgcn_fence(__ATOMIC_RELEASE, "agent");
            asm volatile("s_waitcnt vmcnt(0)" ::: "memory");
            const unsigned og = xb_add(&bar[XB_TOP], 1u);
            const unsigned tg = og / nx;
            if (og + 1u == (tg + 1u) * nx) xb_add(&bar[XB_TOPGEN], 1u);
            else XB_SPIN(xb_ld(&bar[XB_TOPGEN]) == tg, bar);
            __builtin_amdgcn_fence(__ATOMIC_ACQUIRE, "agent");
            xb_add(&bar[XB_XGEN(b.x)], 1u);
            asm volatile("s_waitcnt vmcnt(0)" ::: "memory");
        } else {
            XB_SPIN(xb_ld(&bar[XB_XGEN(b.x)]) == gen, bar);
            __builtin_amdgcn_fence(__ATOMIC_ACQUIRE, "agent");
            asm volatile("s_waitcnt vmcnt(0)" ::: "memory");
        }
    }
    __syncthreads();
}

#define CB_A(j)      (16 * (j))
#define CB_N(j)      (256 + 16 * (j))
#define CB_GEN(j)    (512 + 16 * (j))
#define CB_TOP       768
#define CB_TOPGEN    784
#define CB_CENSUS(j) (800 + 16 * (j))
constexpr int CW_CHAINBAR = CW_SAMPLE + 2688;
static_assert(CW_CHAINBAR + 1056 <= CW_DIAG, "control words (chain barrier)");
__device__ __forceinline__ bool cb_role(const XcdBarrier& b, unsigned* w, bool sixth, unsigned& nA, unsigned& nN) {
    const unsigned nloc = b.st[0]; unsigned a = xb_ld(&w[CB_CENSUS(b.x)]); if (a >= nloc) a = 0u;
    nA = a; nN = nloc - a; return sixth && a > 0u;
}
__device__ __forceinline__ void cb_npath(const XcdBarrier& b, unsigned* w, unsigned nA, unsigned nN) {
    const unsigned old = xb_add(&w[CB_N(b.x)], 1u);
    if (old + 1u == nN) {
        XB_SPIN(xb_ld(&w[CB_A(b.x)]) < nA, b.bar);
        __builtin_amdgcn_fence(__ATOMIC_RELEASE, "agent");
        asm volatile("s_waitcnt vmcnt(0)" ::: "memory");
        const unsigned og = xb_add(&w[CB_TOP], 1u);
        if (og + 1u == b.st[1]) xb_add(&w[CB_TOPGEN], 1u);
        else XB_SPIN(xb_ld(&w[CB_TOPGEN]) == 0u, b.bar);
        __builtin_amdgcn_fence(__ATOMIC_ACQUIRE, "agent");
        xb_add(&w[CB_GEN(b.x)], 1u);
        asm volatile("s_waitcnt vmcnt(0)" ::: "memory");
    } else {
        XB_SPIN(xb_ld(&w[CB_GEN(b.x)]) == 0u, b.bar);
        __builtin_amdgcn_fence(__ATOMIC_ACQUIRE, "agent");
        asm volatile("s_waitcnt vmcnt(0)" ::: "memory");
    }
}
__device__ __forceinline__ void cb_arrive(const XcdBarrier& b, unsigned* w) {
    asm volatile("s_waitcnt vmcnt(0)" ::: "memory");
    __syncthreads();
    if (threadIdx.x == 0) { unsigned nA, nN; if (cb_role(b, w, true, nA, nN)) xb_add(&w[CB_A(b.x)], 1u); else cb_npath(b, w, nA, nN); }
}
__device__ __forceinline__ void cb_wait(const XcdBarrier& b, unsigned* w) {
    if (threadIdx.x == 0) { unsigned nA, nN; if (cb_role(b, w, true, nA, nN)) { XB_SPIN(xb_ld(&w[CB_GEN(b.x)]) == 0u, b.bar); __builtin_amdgcn_fence(__ATOMIC_ACQUIRE, "agent"); asm volatile("s_waitcnt vmcnt(0)" ::: "memory"); } }
    __syncthreads();
}
__device__ __forceinline__ void cb_full(const XcdBarrier& b, unsigned* w) {
    asm volatile("s_waitcnt vmcnt(0)" ::: "memory");
    __syncthreads();
    if (threadIdx.x == 0) { unsigned nA, nN; (void)cb_role(b, w, false, nA, nN); cb_npath(b, w, nA, nN); }
    __syncthreads();
}
namespace pg8 {
struct Gemm1Chain {
    StaticOrder so; int c; unsigned* cntS; const XcdBarrier* bar; unsigned* cb;
    __host__ __device__ void init(int MP, int N, int c_, unsigned* s, const XcdBarrier* b, unsigned* cb_) { so.init(MP, N, 256, c_); c = c_; cntS = s; bar = b; cb = cb_; }
    __host__ __device__ bool next(int i, Unit& u) const {
        if (i < 5) return so.next(i, u);
        if (i == 5 && c < CHAIN_NS) { u.pm = so.nM + c / so.nN; u.pn = c % so.nN; u.k0 = 0; u.nt = 0; u.slab = -1; return true; }
        return false;
    }
    __device__ __forceinline__ void a_ready(const Unit&) const {}
    __device__ __forceinline__ void done(const Unit&, int ui) const { if (ui == 4 && c < CHAIN_NS) cb_arrive(*bar, cb); }
    __device__ __forceinline__ void chain_end() const {
        if (c < CHAIN_NS) { if (threadIdx.x == 0) __hip_atomic_fetch_add(cntS + 64 * (c & 7), 8u, __ATOMIC_RELAXED, __HIP_MEMORY_SCOPE_AGENT); cb_wait(*bar, cb); }
        else cb_full(*bar, cb);
    }
};
struct OneUnit {
    int pm, pn, k0, nt, slab;
    __host__ __device__ bool next(int i, Unit& u) const { if (i > 0) return false; u.pm = pm; u.pn = pn; u.k0 = k0; u.nt = nt; u.slab = slab; return true; }
    __device__ __forceinline__ void a_ready(const Unit&) const {}
    __device__ __forceinline__ void done(const Unit&, int) const {}
};
}
#ifndef DUP_PHASE
#define DUP_PHASE -1
#endif
#ifdef DIAG_ID
#ifndef DIAG_ID0
#define DIAG_ID0 -1
#endif
#define PSTAMP(id) do { if (DIAG_ID == (id) || DIAG_ID0 == (id)) { __syncthreads(); if (F.tid == 0) { unsigned long long q_ = (unsigned long long)(size_t)F.ctl; asm volatile("" : "+s"(q_)); \
    __hip_atomic_fetch_max((unsigned long long*)(q_ + CW_DIAG * 4) + (DIAG_ID == (id) ? 1 : 2), (unsigned long long)__builtin_amdgcn_s_memrealtime(), __ATOMIC_RELAXED, __HIP_MEMORY_SCOPE_AGENT); } } } while (0)
#else
#define PSTAMP(id) do {} while (0)
#endif

struct Frame {
    LAS unsigned char* lds;
    volatile LAS unsigned* MISC;
    gu32* ctl;
    int tid, lane, wave, vcu, G;
    const float *xp, *xs, *st_h, *st_conv, *st_gla, *g_pre, *w_in, *conv_w, *conv_b, *w_rg, *b_rg, *w_ig, *b_ig, *lam, *w_gk2, *b_gk, *g_head, *w_out, *g_post;
    float* out;
    bf16 *WinT, *WoutT, *XN, *PROJ, *YMIX, *YBF, *YS;
    float *RGK, *PART, *BCUM, *DEC, *PSS, *C8;
};
__device__ __forceinline__ float wave_sum(float v) {
#pragma unroll
    for (int o = 1; o < 64; o <<= 1) v += __shfl_xor(v, o);
    return v;
}

struct TxItem { const float* W; bf16* WT; int ldw, K, k0, n0; };
__device__ __forceinline__ TxItem p0_tx_item(const Frame& F, int it) {
    constexpr int I_IN = (D / 64) * (DINP / 32);
    TxItem t; const bool in = it < I_IN; const int item = in ? it : it - I_IN, nblk = in ? DINP / 32 : D / 32;
    t.W = in ? F.w_in : F.w_out; t.WT = in ? F.WinT : F.WoutT; t.ldw = in ? DIN : D; t.K = in ? D : DMIX; t.k0 = 64 * (item / nblk); t.n0 = 32 * (item % nblk); return t;
}
__device__ __forceinline__ void p0_tx_load(const TxItem& t, int lane, f32x4 (&wv)[8]) {
#pragma unroll
    for (int i = 0; i < 8; ++i) wv[i] = *(const GAS f32x4*)(t.W + (size_t)(t.k0 + 8 * i + (lane >> 3)) * t.ldw + t.n0 + 4 * (lane & 7));
}
__device__ __forceinline__ void p0_tx_finish(const TxItem& t, LAS float* scr, int lane, const f32x4 (&wv)[8]) {
#pragma unroll
    for (int i = 0; i < 8; ++i) { LAS float* d = scr + (8 * i + (lane >> 3)) * 33 + 4 * (lane & 7); d[0] = wv[i].x; d[1] = wv[i].y; d[2] = wv[i].z; d[3] = wv[i].w; }
    LDS_WAIT(); asm volatile("" ::: "memory");
    const int c = lane & 7;
#pragma unroll
    for (int j = 0; j < 4; ++j) { const int n = (lane >> 3) + 8 * j; const LAS float* s = scr + (8 * c) * 33 + n;
        v4u o; o.x = pk2(s[0 * 33], s[1 * 33]); o.y = pk2(s[2 * 33], s[3 * 33]); o.z = pk2(s[4 * 33], s[5 * 33]); o.w = pk2(s[6 * 33], s[7 * 33]);
        *(GAS v4u*)(t.WT + (size_t)(t.n0 + n) * t.K + t.k0 + 8 * c) = o; }
    LDS_WAIT(); asm volatile("" ::: "memory");
}
struct RowX { f32x4 v[4]; };
__device__ __forceinline__ RowX p0_load_row(const Frame& F, int r) {
    const float* xrow = r < NROWP ? F.xp + (size_t)r * D : F.xs + (size_t)(r - NROWP) * D;
    const GAS f32x4* xr = (const GAS f32x4*)xrow + F.lane; RowX x;
#pragma unroll
    for (int j = 0; j < 4; ++j) x.v[j] = xr[64 * j];
    return x;
}
__device__ __forceinline__ float p0_treduce16(const float (&p)[16], int lane) {
    const bool b5 = lane & 32, b4 = lane & 16, b3 = lane & 8, b2 = lane & 4;
    float q8[8], q4[4], q2[2], q1;
#pragma unroll
    for (int i = 0; i < 8; ++i) { const float send = b5 ? p[i] : p[i + 8], keep = b5 ? p[i + 8] : p[i]; q8[i] = keep + __shfl_xor(send, 32); }
#pragma unroll
    for (int i = 0; i < 4; ++i) { const float send = b4 ? q8[i] : q8[i + 4], keep = b4 ? q8[i + 4] : q8[i]; q4[i] = keep + __shfl_xor(send, 16); }
#pragma unroll
    for (int i = 0; i < 2; ++i) { const float send = b3 ? q4[i] : q4[i + 2], keep = b3 ? q4[i + 2] : q4[i]; q2[i] = keep + __shfl_xor(send, 8); }
    { const float send = b2 ? q2[0] : q2[1], keep = b2 ? q2[1] : q2[0]; q1 = keep + __shfl_xor(send, 4); }
    q1 += __shfl_xor(q1, 2); q1 += __shfl_xor(q1, 1);
    return q1;
}
constexpr int P0_WRB = 0, P0_XT = 33280, P0_PART = 66560, P0_RGL = 74752, P0_ROWB = 2064;
__device__ __forceinline__ void p0_rows2(const Frame& F, int rA, int rB, RowX xa, RowX xb, LAS unsigned char* xt, int sA, int sB, const f32x4 (&gpre)[4]) {
    float sa = 0.f, sb = 0.f;
#pragma unroll
    for (int j = 0; j < 4; ++j) { sa += (xa.v[j].x * xa.v[j].x + xa.v[j].y * xa.v[j].y) + (xa.v[j].z * xa.v[j].z + xa.v[j].w * xa.v[j].w); sb += (xb.v[j].x * xb.v[j].x + xb.v[j].y * xb.v[j].y) + (xb.v[j].z * xb.v[j].z + xb.v[j].w * xb.v[j].w); }
#pragma unroll
    for (int o = 1; o < 64; o <<= 1) { sa += __shfl_xor(sa, o); sb += __shfl_xor(sb, o); }
    const float ra = rsqrtf(sa * (1.f / D) + EPS), rb = rsqrtf(sb * (1.f / D) + EPS);
    GAS v2u* oa = (GAS v2u*)(F.XN + (size_t)rA * D) + F.lane; GAS v2u* ob = (GAS v2u*)(F.XN + (size_t)rB * D) + F.lane;
#pragma unroll
    for (int j = 0; j < 4; ++j) { const f32x4 g = gpre[j]; const f32x4 va = xa.v[j] * ra * g, vb = xb.v[j] * rb * g;
        v2u wa, wb; wa.x = pg8::cvt_pk_bf16(va.x, va.y); wa.y = pg8::cvt_pk_bf16(va.z, va.w); wb.x = pg8::cvt_pk_bf16(vb.x, vb.y); wb.y = pg8::cvt_pk_bf16(vb.z, vb.w);
        oa[64 * j] = wa; ob[64 * j] = wb;
        *(LAS v2u*)(xt + sA * P0_ROWB + (256 * j + 4 * F.lane) * 2) = wa; *(LAS v2u*)(xt + sB * P0_ROWB + (256 * j + 4 * F.lane) * 2) = wb; }
}
__device__ __forceinline__ void p0_rgk(const Frame& F, LAS unsigned char* L0, int step, int nvalid) {
    typedef short bf16x8v __attribute__((ext_vector_type(8)));
    const int l15 = F.lane & 15, kq = F.lane >> 4;
    f32x4 acc = (f32x4){0.f, 0.f, 0.f, 0.f};
    bf16x8v a[4], b[4];
#pragma unroll
    for (int s = 0; s < 4; ++s) { a[s] = *(const LAS bf16x8v*)(L0 + P0_XT + l15 * P0_ROWB + (128 * F.wave + 32 * s + 8 * kq) * 2); b[s] = *(const LAS bf16x8v*)(L0 + P0_WRB + l15 * P0_ROWB + (128 * F.wave + 32 * s + 8 * kq) * 2); }
#pragma unroll
    for (int s = 0; s < 4; ++s) acc = __builtin_amdgcn_mfma_f32_16x16x32_bf16(a[s], b[s], acc, 0, 0, 0);
    LAS float* part = (LAS float*)(L0 + P0_PART) + F.wave * 256;
#pragma unroll
    for (int i = 0; i < 4; ++i) part[(4 * kq + i) * 16 + l15] = acc[i];
    __syncthreads();
    if (F.tid < 256) { const LAS float* pp = (const LAS float*)(L0 + P0_PART) + F.tid; float s = 0.f;
#pragma unroll
        for (int w = 0; w < 8; ++w) s += pp[w * 256];
        const int slot = F.tid >> 4;
        if (slot < nvalid) ((LAS float*)(L0 + P0_RGL))[((slot >> 1) + 16 * step + 8 * (slot & 1)) * 16 + (F.tid & 15)] = s; }
}
__device__ __forceinline__ void p0_prologue(Frame& F) {
    LAS float* scr = (LAS float*)(F.lds + RING_OFF + F.wave * 16384);
    LAS unsigned char* L0 = F.lds + RING_OFF;
    const int gw = F.vcu * NWAVES + F.wave, NGW = F.G * NWAVES;
    if (blockIdx.x == 0) for (int c = F.tid; c < D; c += NWAVES * 64) F.C8[c] = 8.f * 1.4426950408889634f * logsigf_(F.lam[c]);
    f32x4 wrb[8];
#pragma unroll
    for (int q = 0; q < 8; ++q) { const int idx = F.tid + 512 * q; wrb[q] = *(const GAS f32x4*)(F.w_in + (size_t)(idx >> 2) * DIN + DINP + 4 * (idx & 3)); }
    constexpr int I_IN = (D / 64) * (DINP / 32), I_OUT = (DMIX / 64) * (D / 32);
    { f32x4 wa[8], wb[8];
      for (int it = gw; it < I_IN + I_OUT; it += 2 * NGW) {
          const TxItem ta = p0_tx_item(F, it); const bool two = it + NGW < I_IN + I_OUT; const TxItem tb = p0_tx_item(F, two ? it + NGW : it);
          p0_tx_load(ta, F.lane, wa); if (two) p0_tx_load(tb, F.lane, wb);
          p0_tx_finish(ta, scr, F.lane, wa); if (two) p0_tx_finish(tb, scr, F.lane, wb); } }
    PSTAMP(20);
    __syncthreads();
#pragma unroll
    for (int q = 0; q < 8; ++q) { const int idx = F.tid + 512 * q; const int k = idx >> 2, jq = idx & 3; const f32x4 w = wrb[q];
        LAS unsigned short* wp = (LAS unsigned short*)(L0 + P0_WRB) + (4 * jq) * (P0_ROWB / 2) + k;
        wp[0] = (unsigned short)f2bf(w.x); wp[P0_ROWB / 2] = (unsigned short)f2bf(w.y); wp[2 * (P0_ROWB / 2)] = (unsigned short)f2bf(w.z); wp[3 * (P0_ROWB / 2)] = (unsigned short)f2bf(w.w); }
    __syncthreads();
    PSTAMP(21);
    LAS float* rgl = (LAS float*)(L0 + P0_RGL);
    float w2[16];
#pragma unroll
    for (int j = 0; j < 16; ++j) w2[j] = F.w_gk2[j * 512 + F.tid];
    const float bg = F.b_gk[F.tid];
    const bool hasS = F.vcu < NS;
    float cum = 0.f;
    int r0 = F.vcu * 64;
#define P0_BCUM(t0, nt) do { for (int t = (t0); t < (t0) + (nt); t += 4) { float z[4]; \
        _Pragma("unroll") for (int u = 0; u < 4; ++u) { z[u] = bg; \
            _Pragma("unroll") for (int j4 = 0; j4 < 4; ++j4) { const f32x4 rg = *(const LAS f32x4*)(rgl + (t + u) * 16 + 4 * j4); z[u] += (rg.x * w2[4 * j4] + rg.y * w2[4 * j4 + 1]) + (rg.z * w2[4 * j4 + 2] + rg.w * w2[4 * j4 + 3]); } } \
        _Pragma("unroll") for (int u = 0; u < 4; ++u) {          \
            cum -= 0.04332169878499658f * __builtin_amdgcn_logf(1.f + __builtin_amdgcn_exp2f(-1.4426950408889634f * z[u])); \
            ((_Float16*)F.BCUM)[(size_t)(r0 + t + u) * 512 + F.tid] = (_Float16)(1.4426950408889634f * cum); } } } while (0)
    f32x4 gpre[4];
#pragma unroll
    for (int j = 0; j < 4; ++j) gpre[j] = ((const GAS f32x4*)F.g_pre + F.lane)[64 * j];
    RowX xa = p0_load_row(F, r0 + F.wave), xb = p0_load_row(F, r0 + F.wave + 8);
#pragma unroll
    for (int i = 0; i < 4; ++i) { const int ra = F.wave + 16 * i, rb = ra + 8;
        const RowX na = p0_load_row(F, i < 3 ? r0 + ra + 16 : (hasS ? NROWP + F.vcu * TS + F.wave : r0 + ra)), nb = p0_load_row(F, i < 3 ? r0 + rb + 16 : r0 + rb);
        p0_rows2(F, r0 + ra, r0 + rb, xa, xb, L0 + P0_XT, 2 * F.wave, 2 * F.wave + 1, gpre);
        __syncthreads();
        p0_rgk(F, L0, i, 16);
        __syncthreads();
        P0_BCUM(16 * i, 16);
        xa = na; xb = nb; }
    F.DEC[(size_t)F.vcu * 512 + F.tid] = __builtin_amdgcn_exp2f(1.4426950408889634f * cum);
    __syncthreads();
    if (hasS) {
        cum = 0.f; r0 = NROWP + F.vcu * TS;
        p0_rows2(F, r0 + F.wave, r0 + F.wave, xa, xa, L0 + P0_XT, 2 * F.wave, 2 * F.wave + 1, gpre);
        __syncthreads();
        p0_rgk(F, L0, 0, 16);
        __syncthreads();
        P0_BCUM(0, TS);
        F.DEC[(size_t)(NP * (TP / 64) + F.vcu) * 512 + F.tid] = __builtin_amdgcn_exp2f(1.4426950408889634f * cum);
        __syncthreads();
    }
#undef P0_BCUM
}

__device__ __forceinline__ float rdlane(float v, int l) { return __builtin_bit_cast(float, __builtin_amdgcn_readlane(__builtin_bit_cast(int, v), l)); }
__device__ __forceinline__ void lru_simple_item(const Frame& F, int kind, int seq, int nb) {
    const int lane = F.lane, c = nb * 64 + lane;
    const int T = kind ? TS : TP; const size_t row0 = kind ? (size_t)NROWP + (size_t)seq * TS : (size_t)seq * TP;
    float wrg[64], wig[64];
#pragma unroll
    for (int d = 0; d < 64; ++d) { wrg[d] = F.w_rg[(size_t)(nb * 64 + d) * 64 + lane]; wig[d] = F.w_ig[(size_t)(nb * 64 + d) * 64 + lane]; }
    const float brg = F.b_rg[c], big = F.b_ig[c], cb = F.conv_b[c], cw0 = F.conv_w[c], cw1 = F.conv_w[1024 + c], cw2 = F.conv_w[2048 + c], cw3 = F.conv_w[3072 + c];
    const float c8 = 8.f * logsigf_(F.lam[c]);
    float h = kind ? F.st_h[(size_t)seq * 1024 + c] : 0.f;
    float xm3 = kind ? F.st_conv[((size_t)seq * 3 + 0) * 1024 + c] : 0.f, xm2 = kind ? F.st_conv[((size_t)seq * 3 + 1) * 1024 + c] : 0.f, xm1 = kind ? F.st_conv[((size_t)seq * 3 + 2) * 1024 + c] : 0.f;
    for (int t0 = 0; t0 < T; t0 += 8) {
        float xv[8], zv[8];
#pragma unroll
        for (int i = 0; i < 8; ++i) { const bf16* pr = F.PROJ + (row0 + t0 + i) * DINP; xv[i] = bf2f(pr[C_XL + c]); zv[i] = bf2f(pr[C_ZL + c]); }
#pragma unroll 1
        for (int i = 0; i < 8; ++i) {
            const float x = xv[i]; const float xc = cb + cw0 * xm3 + cw1 * xm2 + cw2 * xm1 + cw3 * x; xm3 = xm2; xm2 = xm1; xm1 = x;
            float ar = brg, ai = big;
#pragma unroll
            for (int d = 0; d < 64; ++d) { const float xd = rdlane(xc, d); ar += xd * wrg[d]; ai += xd * wig[d]; }
            const float r = sigmoidf_(ar), ig = sigmoidf_(ai);
            const float la = c8 * r, a = __expf(la), u = sqrtf(-expm1f(2.f * la)) * (ig * xc);
            h = a * h + u;
            const float z = zv[i], y = h * z * sigmoidf_(z);
            F.YMIX[(row0 + t0 + i) * DMIX + c] = (bf16)f2bf(y);
        }
    }
    float* ho = F.out + (kind ? O_HS : O_HP) + (size_t)seq * 1024 + c; *ho = h;
    float* co = F.out + (kind ? O_CS : O_CP) + (size_t)seq * 3 * 1024 + c; co[0] = xm3; co[1024] = xm2; co[2048] = xm1;
}
__device__ __forceinline__ void gla_simple_item(const Frame& F, int kind, int seq, int h, int hsel) {
    int t2 = F.tid & 255; asm volatile("" : "+v"(t2)); const int w4 = t2 >> 6;
    const int T = kind ? TS : TP; const size_t row0 = kind ? (size_t)NROWP + (size_t)seq * TS : (size_t)seq * TP;
    LAS float* L = (LAS float*)(F.lds + RING_OFF + hsel * 4096);
    LAS float* al = L, *qs = L + 128, *ks = L + 256, *red = L + 384;
    float S[128];
    const float* s0 = F.st_gla + (((size_t)seq * NH + h) * HK) * HV + t2;
#pragma unroll
    for (int d = 0; d < 128; ++d) S[d] = kind ? s0[(size_t)d * HV] : 0.f;
    const float gh = F.g_head[t2];
    for (int t = 0; t < T; ++t) {
        const size_t row = row0 + t; const bf16* pr = F.PROJ + row * DINP;
        if (t2 < 128) { const bool cbeg = kind ? false : ((t & 63) == 0 && t > 0); const size_t ci = (size_t)(seq * (TP / 64) + (t >> 6) - 1);
            al[t2] = cbeg ? F.DEC[ci * 512 + h * 128 + t2] : 1.f; qs[t2] = bf2f(pr[C_Q + h * 128 + t2]); ks[t2] = bf2f(pr[C_K + h * 128 + t2]); }
        const float vv = bf2f(pr[C_V + h * 256 + t2]), zz = bf2f(pr[C_ZG + h * 256 + t2]);
        __syncthreads();
        float o = 0.f;
#pragma unroll
        for (int d4 = 0; d4 < 32; ++d4) { const f32x4 a4 = *(const LAS f32x4*)(al + 4 * d4), k4 = *(const LAS f32x4*)(ks + 4 * d4), q4 = *(const LAS f32x4*)(qs + 4 * d4);
            S[4 * d4 + 0] = a4.x * S[4 * d4 + 0] + k4.x * vv; o += q4.x * S[4 * d4 + 0];
            S[4 * d4 + 1] = a4.y * S[4 * d4 + 1] + k4.y * vv; o += q4.y * S[4 * d4 + 1];
            S[4 * d4 + 2] = a4.z * S[4 * d4 + 2] + k4.z * vv; o += q4.z * S[4 * d4 + 2];
            S[4 * d4 + 3] = a4.w * S[4 * d4 + 3] + k4.w * vv; o += q4.w * S[4 * d4 + 3]; }
        const float ss = wave_sum(o * o);
        if (F.lane == 0) red[w4] = ss;
        __syncthreads();
        const float tot = (red[0] + red[1]) + (red[2] + red[3]);
        const float rs = rsqrtf(tot * (1.f / 256.f) + EPS);
        const float y = o * rs * gh * (zz * sigmoidf_(zz));
        F.YMIX[row * DMIX + 1024 + h * 256 + t2] = (bf16)f2bf(y);
        __syncthreads();
    }
    if (t2 < 128) al[t2] = F.DEC[(kind ? (size_t)(NP * (TP / 64) + seq) : (size_t)(seq * (TP / 64) + TP / 64 - 1)) * 512 + h * 128 + t2];
    __syncthreads();
    float* so = F.out + (kind ? O_GS : O_GP) + (((size_t)seq * NH + h) * HK) * HV + t2;
#pragma unroll
    for (int d = 0; d < 128; ++d) so[(size_t)d * HV] = S[d] * al[d];
    __syncthreads();
}
#ifndef TAIL_SAMPLE
#define TAIL_SAMPLE 0
#endif


typedef short bf16x8_t __attribute__((ext_vector_type(8)));
typedef float f32x16 __attribute__((ext_vector_type(16)));
constexpr int LRU_XL_ROWS = 44;
constexpr int LRU_XL_OFF = 0, LRU_XL_WB = LRU_XL_ROWS * 128;
constexpr int LRU_ZL_OFF = LRU_XL_OFF + 8 * LRU_XL_WB, LRU_ZL_WB = 32 * 128;
constexpr int LRU_XC_OFF = LRU_ZL_OFF + 8 * LRU_ZL_WB, LRU_XC_WB = 32 * 144;
constexpr int LRU_SL_OFF = LRU_XC_OFF + 8 * LRU_XC_WB;
constexpr int LRU_HC_OFF = LRU_SL_OFF + 2 * 8 * 2 * 64 * 4;
constexpr int LRU_WG_OFF = LRU_HC_OFF + 2 * 64 * 4;
constexpr int LRU_END = LRU_WG_OFF + 128 * 144;
static_assert(LRU_END <= RING_BYTES, "LRU LDS map");
#define L2E 1.4426950408889634f
template <int KIND>
__device__ __forceinline__ void lru_item(const Frame& F, int sg, int nb) {
    int lane = F.lane; asm volatile("" : "+v"(lane));
    const int wave = F.wave, cl = lane & 31, hh = lane >> 5;
    LAS unsigned char* XLw = F.lds + RING_OFF + LRU_XL_OFF + wave * LRU_XL_WB;
    LAS unsigned char* ZLw = F.lds + RING_OFF + LRU_ZL_OFF + wave * LRU_ZL_WB;
    LAS unsigned char* XCw = F.lds + RING_OFF + LRU_XC_OFF + wave * LRU_XC_WB;
    LAS float* SL = (LAS float*)(F.lds + RING_OFF + LRU_SL_OFF);
    LAS float* HC = (LAS float*)(F.lds + RING_OFF + LRU_HC_OFF);
    LAS unsigned char* WGl = F.lds + RING_OFF + LRU_WG_OFF;
    __syncthreads();
    constexpr int NR = KIND ? 1 : 8;
    const size_t rowbase = KIND ? (size_t)NROWP + (size_t)sg * 256 : (size_t)sg * TP;
    if (KIND == 0) { if (F.tid < 64) HC[F.tid] = 0.f; }
    v4u xl0[KIND ? 6 : 5], zl0[4];
    if (KIND == 0) {
#pragma unroll
        for (int q = 0; q < 5; ++q) { const int p = lane + 64 * q; const int row = p >> 3, pc = p & 7; xl0[q] = (v4u){0u, 0u, 0u, 0u};
            if (row < 35) { const long tok = (long)wave * 32 + row - 3; if (tok >= 0) xl0[q] = *(const GAS v4u*)(F.PROJ + (rowbase + tok) * DINP + C_XL + nb * 64 + pc * 8); } }
    } else {
        f32x4 ca[6], cbv_[6]; v4u pv[6];
#pragma unroll
        for (int q = 0; q < 6; ++q) { const int p = lane + 64 * q; const int row = (p >> 3) < 44 ? (p >> 3) : 43, pc = p & 7; const int sq = row / 11, rr = row - sq * 11; const int seq = sg * 32 + wave * 4 + sq;
            const float* sp = F.st_conv + ((size_t)seq * 3 + (rr < 3 ? rr : 2)) * 1024 + nb * 64 + pc * 8; ca[q] = *(const GAS f32x4*)sp; cbv_[q] = *(const GAS f32x4*)(sp + 4);
            pv[q] = *(const GAS v4u*)(F.PROJ + ((size_t)NROWP + (size_t)seq * 8 + (rr < 3 ? 0 : rr - 3)) * DINP + C_XL + nb * 64 + pc * 8); }
#pragma unroll
        for (int q = 0; q < 6; ++q) { const int p = lane + 64 * q; const int row = (p >> 3) < 44 ? (p >> 3) : 43; const int rr = row - (row / 11) * 11;
            v4u cv; cv.x = pk2(ca[q].x, ca[q].y); cv.y = pk2(ca[q].z, ca[q].w); cv.z = pk2(cbv_[q].x, cbv_[q].y); cv.w = pk2(cbv_[q].z, cbv_[q].w);
            xl0[q].x = rr < 3 ? cv.x : pv[q].x; xl0[q].y = rr < 3 ? cv.y : pv[q].y; xl0[q].z = rr < 3 ? cv.z : pv[q].z; xl0[q].w = rr < 3 ? cv.w : pv[q].w; }
    }
#pragma unroll
    for (int q = 0; q < 4; ++q) { const int p = lane + 64 * q; const int row = p >> 3, pc = p & 7; zl0[q] = *(const GAS v4u*)(F.PROJ + (rowbase + wave * 32 + row) * DINP + C_ZL + nb * 64 + pc * 8); }
    { const int col = F.tid & 127, kq = F.tid >> 7; const float* W = ((col >> 6) ? F.w_ig : F.w_rg) + (size_t)nb * 4096 + (size_t)(16 * kq) * 64 + (col & 63);
      float wv[16];
#pragma unroll
      for (int j = 0; j < 16; ++j) wv[j] = W[j * 64];
      v4u p0, p1;
      p0.x = pk2(-L2E * wv[0], -L2E * wv[1]); p0.y = pk2(-L2E * wv[2], -L2E * wv[3]); p0.z = pk2(-L2E * wv[4], -L2E * wv[5]); p0.w = pk2(-L2E * wv[6], -L2E * wv[7]);
      p1.x = pk2(-L2E * wv[8], -L2E * wv[9]); p1.y = pk2(-L2E * wv[10], -L2E * wv[11]); p1.z = pk2(-L2E * wv[12], -L2E * wv[13]); p1.w = pk2(-L2E * wv[14], -L2E * wv[15]);
      *(LAS v4u*)(WGl + col * 144 + (16 * kq) * 2) = p0; *(LAS v4u*)(WGl + col * 144 + (16 * kq + 8) * 2) = p1; }
#pragma unroll
    for (int q = 0; q < (KIND ? 6 : 5); ++q) { const int p = lane + 64 * q; const int row = p >> 3, pc = p & 7; if (row < (KIND ? 44 : 35)) *(LAS v4u*)(XLw + row * 128 + pc * 16) = xl0[q]; }
#pragma unroll
    for (int q = 0; q < 4; ++q) { const int p = lane + 64 * q; *(LAS v4u*)(ZLw + (p >> 3) * 128 + (p & 7) * 16) = zl0[q]; }
    float hs0v[2][4];
    if (KIND == 1) {
#pragma unroll
        for (int ct = 0; ct < 2; ++ct)
#pragma unroll
            for (int g = 0; g < 4; ++g) hs0v[ct][g] = F.st_h[(size_t)(sg * 32 + wave * 4 + g) * 1024 + nb * 64 + 32 * ct + cl]; }
    for (int r = 0; r < NR; ++r) {
        const int par = r & 1;
        const size_t srow = rowbase + (size_t)r * 256 + wave * 32;
        const bool more = (KIND == 0) && (r + 1 < NR);
        __syncthreads();
        float gbr[2], gbi[2], gc8[2], cwv[2][4], cbv[2];
#pragma unroll
        for (int ct = 0; ct < 2; ++ct) { const int cg = nb * 64 + 32 * ct + cl; gbr[ct] = F.b_rg[cg]; gbi[ct] = F.b_ig[cg]; gc8[ct] = F.C8[cg]; cbv[ct] = F.conv_b[cg];
#pragma unroll
            for (int j = 0; j < 4; ++j) cwv[ct][j] = F.conv_w[j * 1024 + cg]; }
        float xc[2][16];
#pragma unroll
        for (int ct = 0; ct < 2; ++ct) {
            float cw[4]; const float cb = cbv[ct];
#pragma unroll
            for (int j = 0; j < 4; ++j) cw[j] = cwv[ct][j];
            v2u xa0, xb0, xa1, xb1, xa2, xb2, xa3, xb3;
            { const unsigned xad = (unsigned)(size_t)XLw + (unsigned)((4 * hh + ((lane & 15) >> 2)) * 128 + (32 * ct + 16 * ((lane >> 4) & 1) + 4 * (lane & 3)) * 2);
              if (KIND) asm volatile("ds_read_b64_tr_b16 %0, %8\n\tds_read_b64_tr_b16 %1, %8 offset:512\n\tds_read_b64_tr_b16 %2, %8 offset:1408\n\tds_read_b64_tr_b16 %3, %8 offset:1920\n\t"
                                     "ds_read_b64_tr_b16 %4, %8 offset:2816\n\tds_read_b64_tr_b16 %5, %8 offset:3328\n\tds_read_b64_tr_b16 %6, %8 offset:4224\n\tds_read_b64_tr_b16 %7, %8 offset:4736\n\ts_waitcnt lgkmcnt(0)"
                                     : "=&v"(xa0), "=&v"(xb0), "=&v"(xa1), "=&v"(xb1), "=&v"(xa2), "=&v"(xb2), "=&v"(xa3), "=&v"(xb3) : "v"(xad) : "memory");
              else asm volatile("ds_read_b64_tr_b16 %0, %8\n\tds_read_b64_tr_b16 %1, %8 offset:512\n\tds_read_b64_tr_b16 %2, %8 offset:1024\n\tds_read_b64_tr_b16 %3, %8 offset:1536\n\t"
                                "ds_read_b64_tr_b16 %4, %8 offset:2048\n\tds_read_b64_tr_b16 %5, %8 offset:2560\n\tds_read_b64_tr_b16 %6, %8 offset:3072\n\tds_read_b64_tr_b16 %7, %8 offset:3584\n\ts_waitcnt lgkmcnt(0)"
                                : "=&v"(xa0), "=&v"(xb0), "=&v"(xa1), "=&v"(xb1), "=&v"(xa2), "=&v"(xb2), "=&v"(xa3), "=&v"(xb3) : "v"(xad) : "memory"); }
            const unsigned xw[4][4] = {{xa0.x, xa0.y, xb0.x, xb0.y}, {xa1.x, xa1.y, xb1.x, xb1.y}, {xa2.x, xa2.y, xb2.x, xb2.y}, {xa3.x, xa3.y, xb3.x, xb3.y}};
#pragma unroll
            for (int g = 0; g < 4; ++g) { const float x0 = bflo(xw[g][0]), x1 = bfhi(xw[g][0]), x2 = bflo(xw[g][1]), x3 = bfhi(xw[g][1]), x4 = bflo(xw[g][2]), x5 = bfhi(xw[g][2]), x6 = bflo(xw[g][3]);
                xc[ct][4 * g + 0] = cb + cw[0] * x0 + cw[1] * x1 + cw[2] * x2 + cw[3] * x3; xc[ct][4 * g + 1] = cb + cw[0] * x1 + cw[1] * x2 + cw[2] * x3 + cw[3] * x4;
                xc[ct][4 * g + 2] = cb + cw[0] * x2 + cw[1] * x3 + cw[2] * x4 + cw[3] * x5; xc[ct][4 * g + 3] = cb + cw[0] * x3 + cw[1] * x4 + cw[2] * x5 + cw[3] * x6; }
        }
#pragma unroll
        for (int ct = 0; ct < 2; ++ct)
#pragma unroll
            for (int i = 0; i < 16; i += 2) { const unsigned w = pg8::cvt_pk_bf16(xc[ct][i], xc[ct][i + 1]);
                *(LAS unsigned short*)(XCw + ((i & 3) + 8 * (i >> 2) + 4 * hh) * 144 + (32 * ct + cl) * 2) = (unsigned short)w;
                *(LAS unsigned short*)(XCw + (((i + 1) & 3) + 8 * (i >> 2) + 4 * hh) * 144 + (32 * ct + cl) * 2) = (unsigned short)(w >> 16); }
        bf16x8_t Af[4];
#pragma unroll
        for (int s = 0; s < 4; ++s) Af[s] = *(const LAS bf16x8_t*)(XCw + cl * 144 + (16 * s + 8 * hh) * 2);
        float At_[2], Ut_[2];
        float Aloc[2][16], Hloc[2][16], AGk[2][4], UGk[2][4];
#pragma unroll
        for (int ct = 0; ct < 2; ++ct) {
            f32x16 ar, ai;
            const float brg = -L2E * gbr[ct], big = -L2E * gbi[ct], c8 = gc8[ct];
#pragma unroll
            for (int i = 0; i < 16; ++i) { ar[i] = brg; ai[i] = big; }
            bf16x8_t b0[4], b1[4];
#pragma unroll
            for (int s = 0; s < 4; ++s) { b0[s] = *(const LAS bf16x8_t*)(WGl + (32 * ct + cl) * 144 + (16 * s + 8 * hh) * 2); b1[s] = *(const LAS bf16x8_t*)(WGl + (64 + 32 * ct + cl) * 144 + (16 * s + 8 * hh) * 2); }
#pragma unroll
            for (int s = 0; s < 4; ++s) { ar = __builtin_amdgcn_mfma_f32_32x32x16_bf16(Af[s], b0[s], ar, 0, 0, 0); ai = __builtin_amdgcn_mfma_f32_32x32x16_bf16(Af[s], b1[s], ai, 0, 0, 0); }
            float AG[4], UG[4];
#pragma unroll
            for (int g = 0; g < 4; ++g) { float Ap = 1.f, Hp = 0.f;
#pragma unroll
                for (int e = 0; e < 4; ++e) { const int i = 4 * g + e;
                    const float rr = __builtin_amdgcn_rcpf(1.f + __builtin_amdgcn_exp2f(ar[i])), di = 1.f + __builtin_amdgcn_exp2f(ai[i]);
                    const float a = __builtin_amdgcn_exp2f(c8 * rr);
                    const float w = fmaxf(1.f - a * a, 0.f);
                    const float u = w * __builtin_amdgcn_rsqf(fmaxf(w * di * di, 1e-30f)) * xc[ct][i];
                    Hp = a * Hp + u; Ap = a * Ap; Aloc[ct][i] = Ap; Hloc[ct][i] = Hp; }
                AG[g] = Ap; UG[g] = Hp; }
            float At = 1.f, Ut = 0.f;
#pragma unroll
            for (int g = 0; g < 4; ++g) { const float pA = __shfl_xor(AG[g], 32), pU = __shfl_xor(UG[g], 32);
                const float a0 = hh ? pA : AG[g], u0 = hh ? pU : UG[g], a1 = hh ? AG[g] : pA, u1 = hh ? UG[g] : pU;
                Ut = a0 * Ut + u0; At = a0 * At; Ut = a1 * Ut + u1; At = a1 * At; AGk[ct][g] = AG[g]; UGk[ct][g] = UG[g]; }
            At_[ct] = At; Ut_[ct] = Ut;
        }
        v4u xn[5];
        if (more) {
#pragma unroll
            for (int q = 0; q < 5; ++q) { const int p = lane + 64 * q; const int row = p >> 3, pc = p & 7;
                if (row < 35) xn[q] = *(const GAS v4u*)(F.PROJ + (srow + 256 + row - 3) * DINP + C_XL + nb * 64 + pc * 8); }
        }
        v4u zn[4];
        if (more) {
#pragma unroll
            for (int q = 0; q < 4; ++q) { const int p = lane + 64 * q; const int row = p >> 3, pc = p & 7;
                zn[q] = *(const GAS v4u*)(F.PROJ + (srow + 256 + row) * DINP + C_ZL + nb * 64 + pc * 8); }
        }
        float hin[2] = {0.f, 0.f};
        if (KIND == 0) {
            if (hh == 0) {
#pragma unroll
                for (int ct = 0; ct < 2; ++ct) { SL[((par * 8 + wave) * 2 + 0) * 64 + 32 * ct + cl] = At_[ct]; SL[((par * 8 + wave) * 2 + 1) * 64 + 32 * ct + cl] = Ut_[ct]; } }
            __syncthreads();
#pragma unroll
            for (int ct = 0; ct < 2; ++ct) { float sa[7], su[7]; float hs = HC[par * 64 + 32 * ct + cl];
#pragma unroll
                for (int w2 = 0; w2 < 7; ++w2) { sa[w2] = SL[((par * 8 + w2) * 2 + 0) * 64 + 32 * ct + cl]; su[w2] = SL[((par * 8 + w2) * 2 + 1) * 64 + 32 * ct + cl]; }
#pragma unroll
                for (int w2 = 0; w2 < 7; ++w2) { const float hn = sa[w2] * hs + su[w2]; hs = w2 < wave ? hn : hs; }
                hin[ct] = hs;
                if (wave == 7 && hh == 0) HC[(par ^ 1) * 64 + 32 * ct + cl] = At_[ct] * hs + Ut_[ct]; }
        }
#pragma unroll
        for (int ct = 0; ct < 2; ++ct) {
            float hst[4]; float hs = hin[ct];
#pragma unroll
            for (int g = 0; g < 4; ++g) { const float pA = __shfl_xor(AGk[ct][g], 32), pU = __shfl_xor(UGk[ct][g], 32);
                const float a0 = hh ? pA : AGk[ct][g], u0 = hh ? pU : UGk[ct][g], a1 = hh ? AGk[ct][g] : pA, u1 = hh ? UGk[ct][g] : pU;
                if (KIND == 1) hs = hs0v[ct][g];
                const float hs0 = hs; hs = a0 * hs + u0;
                hst[g] = hh ? hs : hs0; hs = a1 * hs + u1;
                if (KIND == 1 && hh == 0) F.out[O_HS + (size_t)(sg * 32 + wave * 4 + g) * 1024 + nb * 64 + 32 * ct + cl] = hs;
            }
            if (KIND == 0 && r == NR - 1 && wave == 7 && hh == 0) F.out[O_HP + (size_t)sg * 1024 + nb * 64 + 32 * ct + cl] = hs;
            LAS unsigned short* zl = (LAS unsigned short*)ZLw + 32 * ct + cl;
            v2u zt0, zt1, zt2, zt3;
            { const unsigned za = (unsigned)(size_t)ZLw + (unsigned)((4 * hh + ((lane & 15) >> 2)) * 128 + (32 * ct + 16 * ((lane >> 4) & 1) + 4 * (lane & 3)) * 2);
              asm volatile("ds_read_b64_tr_b16 %0, %4\n\tds_read_b64_tr_b16 %1, %4 offset:1024\n\tds_read_b64_tr_b16 %2, %4 offset:2048\n\tds_read_b64_tr_b16 %3, %4 offset:3072\n\ts_waitcnt lgkmcnt(0)"
                           : "=&v"(zt0), "=&v"(zt1), "=&v"(zt2), "=&v"(zt3) : "v"(za) : "memory"); }
            const unsigned zw[8] = {zt0.x, zt0.y, zt1.x, zt1.y, zt2.x, zt2.y, zt3.x, zt3.y};
            unsigned short yr[16];
#pragma unroll
            for (int i = 0; i < 16; i += 2) { const float y0 = (Aloc[ct][i] * hst[i >> 2] + Hloc[ct][i]) * bflo(zw[i >> 1]), y1 = (Aloc[ct][i + 1] * hst[i >> 2] + Hloc[ct][i + 1]) * bfhi(zw[i >> 1]);
                const unsigned w = pg8::cvt_pk_bf16(y0, y1); yr[i] = (unsigned short)w; yr[i + 1] = (unsigned short)(w >> 16); }
#pragma unroll
            for (int i = 0; i < 16; ++i) zl[((i & 3) + 8 * (i >> 2) + 4 * hh) * 64] = yr[i];
        }
        v4u yo[4];
#pragma unroll
        for (int q = 0; q < 4; ++q) { const int p = lane + 64 * q; yo[q] = *(const LAS v4u*)(ZLw + (p >> 3) * 128 + (p & 7) * 16); }
#pragma unroll
        for (int q = 0; q < 4; ++q) { const int p = lane + 64 * q;
            if (KIND == 1 && LATE_SAMPLE) __builtin_amdgcn_raw_buffer_store_b128(yo[q], __builtin_amdgcn_make_buffer_rsrc((void*)F.YMIX, 0, 0x7fffffff, 0x00020000), (int)(((srow + (p >> 3)) * DMIX + nb * 64 + (p & 7) * 8) * 2), 0, 16);
            else *(GAS v4u*)(F.YMIX + (srow + (p >> 3)) * DMIX + nb * 64 + (p & 7) * 8) = yo[q]; }
        if (KIND == 0) {
            if (r == NR - 1 && wave == 7) { for (int e = lane; e < 192; e += 64) { const int j = e >> 6, c = e & 63;
                F.out[O_CP + ((size_t)sg * 3 + j) * 1024 + nb * 64 + c] = bf2f(((const LAS unsigned short*)XLw)[(32 + j) * 64 + c]); } }
        } else {
            for (int e = lane; e < 4 * 192; e += 64) { const int sq = e / 192, j = (e % 192) >> 6, c = e & 63;
                F.out[O_CS + ((size_t)(sg * 32 + wave * 4 + sq) * 3 + j) * 1024 + nb * 64 + c] = bf2f(((const LAS unsigned short*)XLw)[(sq * 11 + 8 + j) * 64 + c]); }
        }
        if (more) {
#pragma unroll
            for (int q = 0; q < 5; ++q) { const int p = lane + 64 * q; const int row = p >> 3, pc = p & 7;
                if (row < 35) *(LAS v4u*)(XLw + row * 128 + pc * 16) = xn[q]; }
        }
        if (more) {
#pragma unroll
            for (int q = 0; q < 4; ++q) { const int p = lane + 64 * q; *(LAS v4u*)(ZLw + (p >> 3) * 128 + (p & 7) * 16) = zn[q]; }
        }
    }
    __syncthreads();
}


constexpr int GL_BUF = 49152;
constexpr int GL_QT = 0, GL_KT = 16384, GL_VZ = 32768, GL_AT = 2 * GL_BUF, GL_SBT = GL_AT + 9216, GL_YL = GL_SBT + 17408, GL_DEC = GL_YL + 9216, GL_END = GL_DEC + 16384;
static_assert(GL_END <= RING_BYTES, "GLA LDS map");
__device__ __forceinline__ unsigned off_b(unsigned row, unsigned ch) { return 256u * row + 16u * (ch ^ (((row & 3u) << 2) | ((row >> 2) & 3u))); }
__device__ __forceinline__ void tr_addr(unsigned lane, unsigned c, unsigned ks, unsigned& a0, unsigned& a1) {
    const unsigned h = lane >> 5, blk = (lane >> 4) & 1u, q = (lane & 15u) >> 2, p = lane & 3u;
    a0 = off_b(16u * ks + 8u * h + q, 4u * c + 2u * blk + (p >> 1)) + 8u * (p & 1u);
    a1 = off_b(16u * ks + 8u * h + 4u + q, 4u * c + 2u * blk + (p >> 1)) + 8u * (p & 1u);
}
__device__ __forceinline__ void tr_frag4(unsigned base, const unsigned (&a)[8], bf16x8_t (&f)[4]) {
    v2u r0, r1, r2, r3, r4, r5, r6, r7;
    asm volatile("ds_read_b64_tr_b16 %0, %8\n\tds_read_b64_tr_b16 %1, %9\n\tds_read_b64_tr_b16 %2, %10\n\tds_read_b64_tr_b16 %3, %11\n\t"
                 "ds_read_b64_tr_b16 %4, %12\n\tds_read_b64_tr_b16 %5, %13\n\tds_read_b64_tr_b16 %6, %14\n\tds_read_b64_tr_b16 %7, %15\n\ts_waitcnt lgkmcnt(0)"
                 : "=&v"(r0), "=&v"(r1), "=&v"(r2), "=&v"(r3), "=&v"(r4), "=&v"(r5), "=&v"(r6), "=&v"(r7)
                 : "v"(base + a[0]), "v"(base + a[1]), "v"(base + a[2]), "v"(base + a[3]), "v"(base + a[4]), "v"(base + a[5]), "v"(base + a[6]), "v"(base + a[7]) : "memory");
    f[0] = __builtin_bit_cast(bf16x8_t, (v4u){r0.x, r0.y, r1.x, r1.y}); f[1] = __builtin_bit_cast(bf16x8_t, (v4u){r2.x, r2.y, r3.x, r3.y});
    f[2] = __builtin_bit_cast(bf16x8_t, (v4u){r4.x, r4.y, r5.x, r5.y}); f[3] = __builtin_bit_cast(bf16x8_t, (v4u){r6.x, r6.y, r7.x, r7.y});
}
__device__ __forceinline__ void gla_item(const Frame& F, int b, int h, int vs) {
    int tid = F.tid; asm volatile("" : "+v"(tid));
    const int lane = tid & 63, wave = F.wave, cl = lane & 31, hh = lane >> 5;
    LAS unsigned char* L = F.lds + RING_OFF;
    const unsigned Lb = (unsigned)(size_t)L;
    const int dt = wave >> 1, vt = wave & 1;
    const size_t row0 = (size_t)b * TP;
    f32x16 Sacc;
#pragma unroll
    for (int i = 0; i < 16; ++i) Sacc[i] = 0.f;
    v4u pq[2][2], pk[2][2], pv[2], pz[2];
    const int qrow = tid >> 4, qch = tid & 15, vrow = tid >> 3, vch = tid & 7;
    const unsigned sq0 = off_b(qrow, qch), sq1 = off_b(qrow + 32, qch), sv0 = off_b(vrow, vch), sv1 = off_b(vrow, 8 + vch);
    unsigned tk[8], tv[8];
#pragma unroll
    for (unsigned ks = 0; ks < 4; ++ks) { tr_addr(lane, dt, ks, tk[2 * ks], tk[2 * ks + 1]); tr_addr(lane, vt, ks, tv[2 * ks], tv[2 * ks + 1]); }
#define GL_LOAD(n, s) do { const bf16* pr = F.PROJ + (row0 + (size_t)(n) * 64) * DINP; \
        pq[s][0] = *(const GAS v4u*)(pr + (size_t)qrow * DINP + C_Q + h * 128 + qch * 8); pq[s][1] = *(const GAS v4u*)(pr + (size_t)(qrow + 32) * DINP + C_Q + h * 128 + qch * 8); \
        pk[s][0] = *(const GAS v4u*)(pr + (size_t)qrow * DINP + C_K + h * 128 + qch * 8); pk[s][1] = *(const GAS v4u*)(pr + (size_t)(qrow + 32) * DINP + C_K + h * 128 + qch * 8); \
        pv[s] = *(const GAS v4u*)(pr + (size_t)vrow * DINP + C_V + h * 256 + vs * 64 + vch * 8); pz[s] = *(const GAS v4u*)(pr + (size_t)vrow * DINP + C_ZG + h * 256 + vs * 64 + vch * 8); \
        } while (0)
#define GL_STAGE(bo, s) do { LAS unsigned char* B_ = L + (bo); \
        *(LAS v4u*)(B_ + GL_QT + sq0) = pq[s][0]; *(LAS v4u*)(B_ + GL_QT + sq1) = pq[s][1]; *(LAS v4u*)(B_ + GL_KT + sq0) = pk[s][0]; *(LAS v4u*)(B_ + GL_KT + sq1) = pk[s][1]; \
        *(LAS v4u*)(B_ + GL_VZ + sv0) = pv[s]; *(LAS v4u*)(B_ + GL_VZ + sv1) = pz[s]; } while (0)
#define GL_ROWF(img, row, ks) (*(const LAS bf16x8_t*)(L + (img) + off_b((row), 2 * (ks) + hh)))
#define GL_PADF(base, stride, row, ks) (*(const LAS bf16x8_t*)(L + (base) + (row) * (stride) + (16 * (ks) + 8 * hh) * 2))
#define GL_UPD(bo) do { bf16x8_t fa[4], fb[4]; f32x4 dc[4]; \
        _Pragma("unroll") for (int g = 0; g < 4; ++g) dc[g] = *(const LAS f32x4*)(L + GL_DEC + (n * 128 + 32 * dt + 8 * g + 4 * hh) * 4); \
        tr_frag4(Lb + (bo) + GL_KT, tk, fa); tr_frag4(Lb + (bo) + GL_VZ, tv, fb); \
        _Pragma("unroll") for (int ks = 0; ks < 4; ++ks) Sacc = __builtin_amdgcn_mfma_f32_32x32x16_bf16(fa[ks], fb[ks], Sacc, 0, 0, 0); \
        _Pragma("unroll") for (int i = 0; i < 16; ++i) Sacc[i] *= dc[i >> 2][i & 3]; } while (0)
    __syncthreads();
    GL_LOAD(0, 0);
    { f32x4 dcp[2];
#pragma unroll
      for (int q = 0; q < 2; ++q) { const int i = tid + q * NWAVES * 64; dcp[q] = *(const GAS f32x4*)(F.DEC + ((size_t)(b * (TP / 64) + (i >> 5))) * 512 + h * 128 + (i & 31) * 4); }
      GL_LOAD(1, 1);
#pragma unroll
      for (int q = 0; q < 2; ++q) { const int i = tid + q * NWAVES * 64; *(LAS f32x4*)(L + GL_DEC + i * 16) = dcp[q]; } }
    GL_STAGE(0, 0);
    GL_LOAD(2, 0);
#ifdef DIAG_DUR
    unsigned long long acc_ = 0ull, tA_ = 0ull;
#define DT0() do { tA_ = __builtin_amdgcn_s_memrealtime(); } while (0)
#define DT1(id) do { if (DIAG_ID == (id)) acc_ += __builtin_amdgcn_s_memrealtime() - tA_; } while (0)
#else
#define DT0() do {} while (0)
#define DT1(id) do {} while (0)
#endif
    for (int n2 = 0; n2 < TP / 64; n2 += 2) {
#define SET_ 1
      { const int n = n2;
        const int bo = (n & 1) * GL_BUF;
        __syncthreads();
        DT0(); if (wave >= 4) __builtin_amdgcn_s_setprio(1);
        if (n > 0) {
            *(GAS v4u*)(F.YMIX + (row0 + (size_t)(n - 1) * 64 + vrow) * DMIX + 1024 + h * 256 + vs * 64 + vch * 8) = *(const LAS v4u*)(L + GL_YL + vrow * 144 + vch * 16); }
        if (n + 1 < TP / 64) GL_STAGE(GL_BUF - bo, SET_);
        if (n + 3 < TP / 64) GL_LOAD(n + 3, SET_);
        DT1(34); DT0();
#pragma unroll
        for (int g = 0; g < 4; ++g) { v2u w; w.x = pg8::cvt_pk_bf16(Sacc[4 * g], Sacc[4 * g + 1]); w.y = pg8::cvt_pk_bf16(Sacc[4 * g + 2], Sacc[4 * g + 3]);
            *(LAS v2u*)(L + GL_SBT + (32 * vt + cl) * 272 + (32 * dt + 8 * g + 4 * hh) * 2) = w; }
        const bool attw = (wave >= 4 && wave < 7);
        if (attw) {
            const int st = (wave - 4) >> 1, ct = (wave - 3) >> 1;
            f32x16 a;
#pragma unroll
            for (int i = 0; i < 16; ++i) a[i] = 0.f;
            bf16x8_t ka[8], qb[8];
#pragma unroll
            for (int ks = 0; ks < 8; ++ks) { ka[ks] = GL_ROWF(bo + GL_KT, 32 * st + cl, ks); qb[ks] = GL_ROWF(bo + GL_QT, 32 * ct + cl, ks); }
            asm volatile("s_waitcnt lgkmcnt(0)" ::: "memory");
#pragma unroll
            for (int ks = 0; ks < 8; ++ks) a = __builtin_amdgcn_mfma_f32_32x32x16_bf16(ka[ks], qb[ks], a, 0, 0, 0);
            if (st == ct) {
#pragma unroll
                for (int i = 0; i < 16; ++i) { const int sl = (i & 3) + 8 * (i >> 2) + 4 * hh; a[i] = sl <= cl ? a[i] : 0.f; } }
#pragma unroll
            for (int g = 0; g < 4; ++g) { v2u w; w.x = pg8::cvt_pk_bf16(a[4 * g], a[4 * g + 1]); w.y = pg8::cvt_pk_bf16(a[4 * g + 2], a[4 * g + 3]);
                *(LAS v2u*)(L + GL_AT + (32 * ct + cl) * 144 + (32 * st + 8 * g + 4 * hh) * 2) = w; }
        } else GL_UPD(bo);
        DT1(35); if (wave >= 4) __builtin_amdgcn_s_setprio(0);
        __syncthreads();
        if (attw) GL_UPD(bo);
        if (wave < 4) {
            f32x16 o;
#pragma unroll
            for (int i = 0; i < 16; ++i) o[i] = 0.f;
            bf16x8_t fv[4], fa[4], fs[4], fq[4]; tr_frag4(Lb + bo + GL_VZ, tv, fv);
            v2u zc[4];
#pragma unroll
            for (int ks = 0; ks < 4; ++ks) { fa[ks] = GL_PADF(GL_AT, 144, 32 * dt + cl, ks); fs[ks] = GL_PADF(GL_SBT, 272, 32 * vt + cl, ks); fq[ks] = GL_ROWF(bo + GL_QT, 32 * dt + cl, ks); }
            asm volatile("s_waitcnt lgkmcnt(0)" ::: "memory");
            o = __builtin_amdgcn_mfma_f32_32x32x16_bf16(fv[0], fa[0], o, 0, 0, 0);
            o = __builtin_amdgcn_mfma_f32_32x32x16_bf16(fv[1], fa[1], o, 0, 0, 0);
            if (dt) { o = __builtin_amdgcn_mfma_f32_32x32x16_bf16(fv[2], fa[2], o, 0, 0, 0); o = __builtin_amdgcn_mfma_f32_32x32x16_bf16(fv[3], fa[3], o, 0, 0, 0); }
#pragma unroll
            for (int ks = 0; ks < 4; ++ks) o = __builtin_amdgcn_mfma_f32_32x32x16_bf16(fs[ks], fq[ks], o, 0, 0, 0);
#pragma unroll
            for (int ks = 0; ks < 4; ++ks) { fs[ks] = GL_PADF(GL_SBT, 272, 32 * vt + cl, 4 + ks); fq[ks] = GL_ROWF(bo + GL_QT, 32 * dt + cl, 4 + ks); }
#pragma unroll
            for (int g = 0; g < 4; ++g) zc[g] = *(const LAS v2u*)(L + bo + GL_VZ + off_b(32 * dt + cl, 8 + 4 * vt + g) + 8 * hh);
            asm volatile("s_waitcnt lgkmcnt(0)" ::: "memory");
#pragma unroll
            for (int ks = 0; ks < 4; ++ks) o = __builtin_amdgcn_mfma_f32_32x32x16_bf16(fs[ks], fq[ks], o, 0, 0, 0);
            float ss = 0.f;
#pragma unroll
            for (int i = 0; i < 16; ++i) ss += o[i] * o[i];
            ss += __shfl_xor(ss, 32);
            const size_t row = row0 + (size_t)n * 64 + 32 * dt + cl;
            if (hh == 0) F.PSS[(size_t)(h * 8 + vs * 2 + vt) * NROWP + row] = ss;
#pragma unroll
            for (int g = 0; g < 4; ++g) {
                const float y0 = o[4 * g] * bflo(zc[g].x), y1 = o[4 * g + 1] * bfhi(zc[g].x), y2 = o[4 * g + 2] * bflo(zc[g].y), y3 = o[4 * g + 3] * bfhi(zc[g].y);
                v2u w; w.x = pg8::cvt_pk_bf16(y0, y1); w.y = pg8::cvt_pk_bf16(y2, y3); *(LAS v2u*)(L + GL_YL + (32 * dt + cl) * 144 + (32 * vt + 8 * g + 4 * hh) * 2) = w; }
        }
          }
#undef SET_
#define SET_ 0
      { const int n = n2 + 1;
        const int bo = (n & 1) * GL_BUF;
        __syncthreads();
        DT0(); if (wave >= 4) __builtin_amdgcn_s_setprio(1);
        if (n > 0) {
            *(GAS v4u*)(F.YMIX + (row0 + (size_t)(n - 1) * 64 + vrow) * DMIX + 1024 + h * 256 + vs * 64 + vch * 8) = *(const LAS v4u*)(L + GL_YL + vrow * 144 + vch * 16); }
        if (n + 1 < TP / 64) GL_STAGE(GL_BUF - bo, SET_);
        if (n + 3 < TP / 64) GL_LOAD(n + 3, SET_);
        DT1(34); DT0();
#pragma unroll
        for (int g = 0; g < 4; ++g) { v2u w; w.x = pg8::cvt_pk_bf16(Sacc[4 * g], Sacc[4 * g + 1]); w.y = pg8::cvt_pk_bf16(Sacc[4 * g + 2], Sacc[4 * g + 3]);
            *(LAS v2u*)(L + GL_SBT + (32 * vt + cl) * 272 + (32 * dt + 8 * g + 4 * hh) * 2) = w; }
        const bool attw = (wave >= 4 && wave < 7);
        if (attw) {
            const int st = (wave - 4) >> 1, ct = (wave - 3) >> 1;
            f32x16 a;
#pragma unroll
            for (int i = 0; i < 16; ++i) a[i] = 0.f;
            bf16x8_t ka[8], qb[8];
#pragma unroll
            for (int ks = 0; ks < 8; ++ks) { ka[ks] = GL_ROWF(bo + GL_KT, 32 * st + cl, ks); qb[ks] = GL_ROWF(bo + GL_QT, 32 * ct + cl, ks); }
            asm volatile("s_waitcnt lgkmcnt(0)" ::: "memory");
#pragma unroll
            for (int ks = 0; ks < 8; ++ks) a = __builtin_amdgcn_mfma_f32_32x32x16_bf16(ka[ks], qb[ks], a, 0, 0, 0);
            if (st == ct) {
#pragma unroll
                for (int i = 0; i < 16; ++i) { const int sl = (i & 3) + 8 * (i >> 2) + 4 * hh; a[i] = sl <= cl ? a[i] : 0.f; } }
#pragma unroll
            for (int g = 0; g < 4; ++g) { v2u w; w.x = pg8::cvt_pk_bf16(a[4 * g], a[4 * g + 1]); w.y = pg8::cvt_pk_bf16(a[4 * g + 2], a[4 * g + 3]);
                *(LAS v2u*)(L + GL_AT + (32 * ct + cl) * 144 + (32 * st + 8 * g + 4 * hh) * 2) = w; }
        } else GL_UPD(bo);
        DT1(35); if (wave >= 4) __builtin_amdgcn_s_setprio(0);
        __syncthreads();
        if (attw) GL_UPD(bo);
        if (wave < 4) {
            f32x16 o;
#pragma unroll
            for (int i = 0; i < 16; ++i) o[i] = 0.f;
            bf16x8_t fv[4], fa[4], fs[4], fq[4]; tr_frag4(Lb + bo + GL_VZ, tv, fv);
            v2u zc[4];
#pragma unroll
            for (int ks = 0; ks < 4; ++ks) { fa[ks] = GL_PADF(GL_AT, 144, 32 * dt + cl, ks); fs[ks] = GL_PADF(GL_SBT, 272, 32 * vt + cl, ks); fq[ks] = GL_ROWF(bo + GL_QT, 32 * dt + cl, ks); }
            asm volatile("s_waitcnt lgkmcnt(0)" ::: "memory");
            o = __builtin_amdgcn_mfma_f32_32x32x16_bf16(fv[0], fa[0], o, 0, 0, 0);
            o = __builtin_amdgcn_mfma_f32_32x32x16_bf16(fv[1], fa[1], o, 0, 0, 0);
            if (dt) { o = __builtin_amdgcn_mfma_f32_32x32x16_bf16(fv[2], fa[2], o, 0, 0, 0); o = __builtin_amdgcn_mfma_f32_32x32x16_bf16(fv[3], fa[3], o, 0, 0, 0); }
#pragma unroll
            for (int ks = 0; ks < 4; ++ks) o = __builtin_amdgcn_mfma_f32_32x32x16_bf16(fs[ks], fq[ks], o, 0, 0, 0);
#pragma unroll
            for (int ks = 0; ks < 4; ++ks) { fs[ks] = GL_PADF(GL_SBT, 272, 32 * vt + cl, 4 + ks); fq[ks] = GL_ROWF(bo + GL_QT, 32 * dt + cl, 4 + ks); }
#pragma unroll
            for (int g = 0; g < 4; ++g) zc[g] = *(const LAS v2u*)(L + bo + GL_VZ + off_b(32 * dt + cl, 8 + 4 * vt + g) + 8 * hh);
            asm volatile("s_waitcnt lgkmcnt(0)" ::: "memory");
#pragma unroll
            for (int ks = 0; ks < 4; ++ks) o = __builtin_amdgcn_mfma_f32_32x32x16_bf16(fs[ks], fq[ks], o, 0, 0, 0);
            float ss = 0.f;
#pragma unroll
            for (int i = 0; i < 16; ++i) ss += o[i] * o[i];
            ss += __shfl_xor(ss, 32);
            const size_t row = row0 + (size_t)n * 64 + 32 * dt + cl;
            if (hh == 0) F.PSS[(size_t)(h * 8 + vs * 2 + vt) * NROWP + row] = ss;
#pragma unroll
            for (int g = 0; g < 4; ++g) {
                const float y0 = o[4 * g] * bflo(zc[g].x), y1 = o[4 * g + 1] * bfhi(zc[g].x), y2 = o[4 * g + 2] * bflo(zc[g].y), y3 = o[4 * g + 3] * bfhi(zc[g].y);
                v2u w; w.x = pg8::cvt_pk_bf16(y0, y1); w.y = pg8::cvt_pk_bf16(y2, y3); *(LAS v2u*)(L + GL_YL + (32 * dt + cl) * 144 + (32 * vt + 8 * g + 4 * hh) * 2) = w; }
        }
          }
#undef SET_
    }
    __syncthreads();
    *(GAS v4u*)(F.YMIX + (row0 + (size_t)(TP / 64 - 1) * 64 + vrow) * DMIX + 1024 + h * 256 + vs * 64 + vch * 8) = *(const LAS v4u*)(L + GL_YL + vrow * 144 + vch * 16);
    float* so = F.out + O_GP + (((size_t)b * NH + h) * HK + 32 * dt) * HV + vs * 64 + 32 * vt + cl;
#pragma unroll
    for (int i = 0; i < 16; ++i) so[(size_t)((i & 3) + 8 * (i >> 2) + 4 * hh) * HV] = Sacc[i];
    __syncthreads();
#ifdef DIAG_DUR
    if (blockIdx.x == DIAG_WG && tid == DIAG_WAVE * 64) __hip_atomic_fetch_max((unsigned long long*)((unsigned char*)F.ctl + CW_DIAG * 4) + 1, acc_, __ATOMIC_RELAXED, __HIP_MEMORY_SCOPE_AGENT);
#endif
#if defined(DIAG_ID) && DIAG_ID == 6
    if (tid == 0) __hip_atomic_fetch_max((unsigned long long*)((unsigned char*)F.ctl + CW_DIAG * 4) + 1, (unsigned long long)__builtin_amdgcn_s_memrealtime(), __ATOMIC_RELAXED, __HIP_MEMORY_SCOPE_AGENT);
#endif
#undef GL_LOAD
#undef GL_STAGE
#undef GL_ROWF
#undef GL_PADF
#undef GL_UPD
}
__device__ __forceinline__ void p2b_norm(Frame& F) {
    const int gw = F.vcu * NWAVES + F.wave, NGW = F.G * NWAVES;
    for (int r = gw; r < NROWP; r += NGW) {
        const int hd = F.lane >> 4;
        float tot = 0.f;
#pragma unroll
        for (int k = 0; k < 8; ++k) tot += F.PSS[(size_t)(hd * 8 + k) * NROWP + r];
        const float rs = rsqrtf(tot * (1.f / 256.f) + EPS);
        GAS v4u* yp = (GAS v4u*)(F.YMIX + (size_t)r * DMIX + 1024 + F.lane * 16);
#pragma unroll
        for (int q = 0; q < 2; ++q) { v4u w = yp[q];
            w.x = pk2(bflo(w.x) * rs, bfhi(w.x) * rs); w.y = pk2(bflo(w.y) * rs, bfhi(w.y) * rs); w.z = pk2(bflo(w.z) * rs, bfhi(w.z) * rs); w.w = pk2(bflo(w.w) * rs, bfhi(w.w) * rs); yp[q] = w; }
    }
}

constexpr int GS_Q = 0, GS_K = 4096, GS_V = 8192, GS_DEC = 16384, GS_ATT = 16896, GS_OP = 17408, GS_END = GS_OP + 8 * 8 * 256 * 4;
static_assert(GS_END <= RING_BYTES, "GLA sample LDS map");
struct GlsSmall { unsigned q2, k2; v2u vv, zz; float dec; };
__device__ __forceinline__ const float* gls_state_ptr(const Frame& F, int it, int tid) { return F.st_gla + (((size_t)(it >> 2) * NH + (it & 3)) * HK + 16 * (tid >> 6)) * HV + 4 * (tid & 63); }
__device__ __forceinline__ void gls_small(const Frame& F, int it, int tid, GlsSmall& P) {
    const int seq = it >> 2, h = it & 3, t = tid >> 6, c = tid & 63; const bf16* pr = F.PROJ + ((size_t)NROWP + (size_t)seq * TS + t) * DINP;
    P.q2 = *(const GAS unsigned*)(pr + C_Q + h * 128 + 2 * c); P.k2 = *(const GAS unsigned*)(pr + C_K + h * 128 + 2 * c);
    P.vv = *(const GAS v2u*)(pr + C_V + h * 256 + 4 * c);
    P.zz = *(const GAS v2u*)(pr + C_ZG + h * 256 + 4 * c);
    P.dec = F.DEC[(size_t)(NP * (TP / 64) + seq) * 512 + h * 128 + (tid & 127)];
}
__device__ __forceinline__ void gla_sample_chain(const Frame& F, int first, int count) {
    int tid = F.tid; asm volatile("" : "+v"(tid));
    const int lane = tid & 63, wave = F.wave, v4 = tid & 63, dg = wave;
    LAS float* Lq = (LAS float*)(F.lds + RING_OFF + GS_Q);
    LAS float* Lk = (LAS float*)(F.lds + RING_OFF + GS_K);
    LAS float* Lv = (LAS float*)(F.lds + RING_OFF + GS_V);
    LAS float* Ld = (LAS float*)(F.lds + RING_OFF + GS_DEC);
    LAS float* La = (LAS float*)(F.lds + RING_OFF + GS_ATT);
    LAS float* Lo = (LAS float*)(F.lds + RING_OFF + GS_OP);
    f32x4 S[16]; GlsSmall P, Pn;
    int a = first; const int last = first + count - 1;
    const int voff = ((16 * (tid >> 6)) * HV + 4 * (tid & 63)) * 4;
#define GLS_RSRC(base, it) __builtin_amdgcn_make_buffer_rsrc((void*)((base) + (size_t)(it) * (HK * HV)), 0, HK * HV * 4, 0x00020000)
#ifdef CHAIN_GLOBAL
#define GLS_LD(r, base, it, i) (*(const GAS f32x4*)((base) + (size_t)(it) * (HK * HV) + (size_t)(16 * (tid >> 6) + (i)) * HV + 4 * (tid & 63)))
#define GLS_ST(val, r, base, it, i) (*(GAS f32x4*)((base) + (size_t)(it) * (HK * HV) + (size_t)(16 * (tid >> 6) + (i)) * HV + 4 * (tid & 63)) = (val))
#else
#define GLS_LD(r, base, it, i) __builtin_bit_cast(f32x4, __builtin_amdgcn_raw_buffer_load_b128(r, voff, (i) * HV * 4, 0))
#define GLS_ST(val, r, base, it, i) __builtin_amdgcn_raw_buffer_store_b128(__builtin_bit_cast(v4u, (val)), r, voff, (i) * HV * 4, 0)
#endif
    { const __amdgpu_buffer_rsrc_t r0 = GLS_RSRC(F.st_gla, a);
      gls_small(F, a, tid, P);
#pragma unroll
      for (int i = 0; i < 16; ++i) S[i] = GLS_LD(r0, F.st_gla, a, i); }
    for (;;) {
        __syncthreads();
#ifdef CHAIN_VMWAIT
        VM_WAIT();
#endif
        const int b = a + 1; const bool nb = a < last;
        const __amdgpu_buffer_rsrc_t r1 = __builtin_amdgcn_make_buffer_rsrc((void*)(F.st_gla + (size_t)(nb ? b : a) * (HK * HV)), 0, nb ? HK * HV * 4 : 0, 0x00020000), rO = GLS_RSRC(F.out + O_GS, a);
        if (nb) gls_small(F, b, tid, Pn);
        const int seq = a >> 2, h = a & 3; const size_t row0 = (size_t)NROWP + (size_t)seq * TS;
        { const int t = tid >> 6, c = tid & 63;
          Lq[t * 128 + 2 * c] = bflo(P.q2); Lq[t * 128 + 2 * c + 1] = bfhi(P.q2); Lk[t * 128 + 2 * c] = bflo(P.k2); Lk[t * 128 + 2 * c + 1] = bfhi(P.k2);
          *(LAS f32x4*)(Lv + t * 256 + 4 * c) = (f32x4){bflo(P.vv.x), bfhi(P.vv.x), bflo(P.vv.y), bfhi(P.vv.y)};
          if (tid < 128) Ld[tid] = P.dec; }
        __syncthreads();
        if (wave == 0) { const int t = lane >> 3, s = lane & 7; float av = 0.f;
            for (int d = 0; d < 128; d += 4) { const f32x4 q = *(const LAS f32x4*)(Lq + t * 128 + d), k = *(const LAS f32x4*)(Lk + s * 128 + d); av += (q.x * k.x + q.y * k.y) + (q.z * k.z + q.w * k.w); }
            La[lane] = s <= t ? av : 0.f; }
        f32x4 o[8];
#pragma unroll
        for (int t = 0; t < 8; ++t) o[t] = (f32x4){0.f, 0.f, 0.f, 0.f};
        f32x4 vr[8];
#pragma unroll
        for (int t = 0; t < 8; ++t) vr[t] = *(const LAS f32x4*)(Lv + t * 256 + 4 * v4);
#pragma unroll
        for (int hf = 0; hf < 2; ++hf) {
#pragma unroll
            for (int i2 = 0; i2 < 8; i2 += 2) { const int i = 8 * hf + i2, d = 16 * dg + i;
                typedef float f32x2 __attribute__((ext_vector_type(2)));
                f32x2 qv[8], kv[8];
#pragma unroll
                for (int t = 0; t < 8; ++t) { qv[t] = *(const LAS f32x2*)(Lq + t * 128 + d); kv[t] = *(const LAS f32x2*)(Lk + t * 128 + d); }
                const f32x2 dv = *(const LAS f32x2*)(Ld + d);
                f32x4 sn0 = S[i], sn1 = S[i + 1];
#pragma unroll
                for (int t = 0; t < 8; ++t) { o[t] += qv[t].x * S[i]; sn0 += kv[t].x * vr[t]; o[t] += qv[t].y * S[i + 1]; sn1 += kv[t].y * vr[t]; }
                GLS_ST(sn0 * dv.x, rO, F.out + O_GS, a, i); GLS_ST(sn1 * dv.y, rO, F.out + O_GS, a, i + 1);
                asm volatile("" ::: "memory"); }
#pragma unroll
            for (int i8 = 0; i8 < 8; ++i8) S[8 * hf + i8] = GLS_LD(r1, F.st_gla, nb ? b : a, 8 * hf + i8);
            asm volatile("" ::: "memory");
        }
#pragma unroll
        for (int t = 0; t < 8; ++t) *(LAS f32x4*)(Lo + (dg * 8 + t) * 256 + 4 * v4) = o[t];
        __syncthreads();
        { const int t = wave; f32x4 acc = (f32x4){0.f, 0.f, 0.f, 0.f};
#pragma unroll
          for (int g = 0; g < 8; ++g) acc += *(const LAS f32x4*)(Lo + (g * 8 + t) * 256 + 4 * v4);
#pragma unroll
          for (int s = 0; s < 8; ++s) acc += La[t * 8 + s] * vr[s];
          const float ss = wave_sum((acc.x * acc.x + acc.y * acc.y) + (acc.z * acc.z + acc.w * acc.w));
          const float rs = rsqrtf(ss * (1.f / 256.f) + EPS);
          const float z0 = bflo(P.zz.x), z1 = bfhi(P.zz.x), z2 = bflo(P.zz.y), z3 = bfhi(P.zz.y);
          v2u w; w.x = pk2(acc.x * rs * z0, acc.y * rs * z1); w.y = pk2(acc.z * rs * z2, acc.w * rs * z3);
          __builtin_amdgcn_raw_buffer_store_b64(w, __builtin_amdgcn_make_buffer_rsrc((void*)F.YMIX, 0, 0x7fffffff, 0x00020000), (int)(((row0 + t) * DMIX + 1024 + h * 256 + 4 * v4) * 2), 0, 16); }
        if (!nb) break;
        a = b; P = Pn;
    }
#undef GLS_RSRC
#undef GLS_LD
#undef GLS_ST
}

struct GlsPre { f32x4 S[16]; unsigned q2, k2; v2u vv, zz; float dec; };
__device__ __forceinline__ void gls_load(const Frame& F, int seq, int h, GlsPre& P) {
    int tid = F.tid; asm volatile("" : "+v"(tid));
    const int v4 = tid & 63, dg = tid >> 6;
    const size_t row0 = (size_t)NROWP + (size_t)seq * TS;
    const float* s0 = F.st_gla + (((size_t)seq * NH + h) * HK + 16 * dg) * HV + 4 * v4;
    const int t = tid >> 6, c = tid & 63; const bf16* pr = F.PROJ + (row0 + t) * DINP;
    P.q2 = *(const GAS unsigned*)(pr + C_Q + h * 128 + 2 * c); P.k2 = *(const GAS unsigned*)(pr + C_K + h * 128 + 2 * c);
    P.vv = *(const GAS v2u*)(pr + C_V + h * 256 + 4 * c);
    P.dec = F.DEC[(size_t)(NP * (TP / 64) + seq) * 512 + h * 128 + (tid & 127)];
    P.zz = *(const GAS v2u*)(pr + C_ZG + h * 256 + 4 * c);
#pragma unroll
    for (int i = 0; i < 16; ++i) P.S[i] = *(const GAS f32x4*)(s0 + (size_t)i * HV);
}
__device__ __forceinline__ void gls_compute(const Frame& F, int seq, int h, const GlsPre& P) {
    int tid = F.tid; asm volatile("" : "+v"(tid));
    const int lane = tid & 63, wave = F.wave, v4 = tid & 63, dg = wave;
    LAS float* Lq = (LAS float*)(F.lds + RING_OFF + GS_Q);
    LAS float* Lk = (LAS float*)(F.lds + RING_OFF + GS_K);
    LAS float* Lv = (LAS float*)(F.lds + RING_OFF + GS_V);
    LAS float* Ld = (LAS float*)(F.lds + RING_OFF + GS_DEC);
    LAS float* La = (LAS float*)(F.lds + RING_OFF + GS_ATT);
    LAS float* Lo = (LAS float*)(F.lds + RING_OFF + GS_OP);
    const size_t row0 = (size_t)NROWP + (size_t)seq * TS;
    __syncthreads();
    { const int t = tid >> 6, c = tid & 63;
      Lq[t * 128 + 2 * c] = bflo(P.q2); Lq[t * 128 + 2 * c + 1] = bfhi(P.q2); Lk[t * 128 + 2 * c] = bflo(P.k2); Lk[t * 128 + 2 * c + 1] = bfhi(P.k2);
      *(LAS f32x4*)(Lv + t * 256 + 4 * c) = (f32x4){bflo(P.vv.x), bfhi(P.vv.x), bflo(P.vv.y), bfhi(P.vv.y)};
      Ld[tid & 127] = P.dec; }
    __syncthreads();
    f32x4 o[8];
#pragma unroll
    for (int t = 0; t < 8; ++t) o[t] = (f32x4){0.f, 0.f, 0.f, 0.f};
    f32x4 vr[8];
#pragma unroll
    for (int t = 0; t < 8; ++t) vr[t] = *(const LAS f32x4*)(Lv + t * 256 + 4 * v4);
    float* so = F.out + O_GS + (((size_t)seq * NH + h) * HK + 16 * dg) * HV + 4 * v4;
#pragma unroll
    for (int i = 0; i < 16; ++i) { const int d = 16 * dg + i; f32x4 sn = P.S[i];
#pragma unroll
        for (int t = 0; t < 8; ++t) { const float q = Lq[t * 128 + d], k = Lk[t * 128 + d]; o[t] += q * P.S[i]; sn += k * vr[t]; }
        *(GAS f32x4*)(so + (size_t)i * HV) = sn * Ld[d]; }
#pragma unroll
    for (int t = 0; t < 8; ++t) *(LAS f32x4*)(Lo + (dg * 8 + t) * 256 + 4 * v4) = o[t];
    __syncthreads();
    { const int t = wave; f32x4 a = (f32x4){0.f, 0.f, 0.f, 0.f};
#pragma unroll
      for (int g = 0; g < 8; ++g) a += *(const LAS f32x4*)(Lo + (g * 8 + t) * 256 + 4 * v4);
      { const int s_ = lane & 7, part = lane >> 3; float av = 0.f;
#pragma unroll
        for (int d4 = 0; d4 < 4; ++d4) { const f32x4 q = *(const LAS f32x4*)(Lq + t * 128 + part * 16 + 4 * d4), k = *(const LAS f32x4*)(Lk + s_ * 128 + part * 16 + 4 * d4); av += (q.x * k.x + q.y * k.y) + (q.z * k.z + q.w * k.w); }
        av += __shfl_xor(av, 8); av += __shfl_xor(av, 16); av += __shfl_xor(av, 32);
        av = s_ <= t ? av : 0.f;
#pragma unroll
        for (int s = 0; s < 8; ++s) a += rdlane(av, s) * vr[s]; }
      const float ss = wave_sum((a.x * a.x + a.y * a.y) + (a.z * a.z + a.w * a.w));
      const float rs = rsqrtf(ss * (1.f / 256.f) + EPS);
      const float z0 = bflo(P.zz.x), z1 = bfhi(P.zz.x), z2 = bflo(P.zz.y), z3 = bfhi(P.zz.y);
      v2u w; w.x = pk2(a.x * rs * z0, a.y * rs * z1); w.y = pk2(a.z * rs * z2, a.w * rs * z3);
      if (LATE_SAMPLE) __builtin_amdgcn_raw_buffer_store_b64(w, __builtin_amdgcn_make_buffer_rsrc((void*)F.YMIX, 0, 0x7fffffff, 0x00020000), (int)(((row0 + t) * DMIX + 1024 + h * 256 + 4 * v4) * 2), 0, 16);
      else *(GAS v2u*)(F.YMIX + (row0 + t) * DMIX + 1024 + h * 256 + 4 * v4) = w; }
}
__device__ __forceinline__ void gla_sample_item(const Frame& F, int seq, int h) { GlsPre P; gls_load(F, seq, h, P); gls_compute(F, seq, h, P); }

__device__ __forceinline__ bool tail_ws(const Frame& F) { return TAIL_SAMPLE && F.G == 256 && DUP_PHASE < 0; }
constexpr int GEMM1_WGS = 232;
__device__ __forceinline__ void p1_tail_sample(Frame& F, unsigned* cnt) {
    const int j = (int)blockIdx.x - GEMM1_WGS, nj = 256 - GEMM1_WGS;
    if (F.tid < 64) { unsigned sp = 0;
        while ((unsigned)__builtin_amdgcn_readfirstlane(__hip_atomic_load(cnt, __ATOMIC_RELAXED, __HIP_MEMORY_SCOPE_AGENT)) < 80u * 8u) { __builtin_amdgcn_s_sleep(8); if (++sp > (1u << 22)) break; }
        __builtin_amdgcn_fence(__ATOMIC_ACQUIRE, "agent");
        asm volatile("s_waitcnt vmcnt(0)" ::: "memory"); }
    __syncthreads();
    for (int it = j; it < NS * NH; it += nj) gla_sample_item(F, it >> 2, it & 3);
    __syncthreads();
}
#ifndef SPLIT_P1
#define SPLIT_P1 1
#endif
__device__ __forceinline__ bool split_p1(const Frame& F) { return SPLIT_P1 && F.G == 256 && DUP_PHASE < 0; }
__device__ __forceinline__ void wait_count(Frame& F, unsigned* cnt, unsigned target) {
    if (F.tid < 64) { unsigned sp = 0;
        for (;;) { unsigned v = F.lane < 8 ? __hip_atomic_load(cnt + 64 * F.lane, __ATOMIC_RELAXED, __HIP_MEMORY_SCOPE_AGENT) : 0u;
            v += __shfl_xor(v, 1); v += __shfl_xor(v, 2); v += __shfl_xor(v, 4);
            if ((unsigned)__builtin_amdgcn_readfirstlane(v) >= target) break;
            __builtin_amdgcn_s_sleep(8); if (++sp > (1u << 22)) break; }
        __builtin_amdgcn_fence(__ATOMIC_ACQUIRE, "agent");
        asm volatile("s_waitcnt vmcnt(0)" ::: "memory"); }
    __syncthreads();
}
__device__ __forceinline__ void wait_sample_units(Frame& F, unsigned* cnt) { wait_count(F, cnt, 80u * 8u); }
__device__ __forceinline__ void p12_mix(Frame& F, unsigned* cnt) {
    const int c = (int)blockIdx.x;
    if (c < 128) gla_item(F, c >> 4, (c >> 2) & 3, c & 3); else lru_item<0>(F, (c - 128) >> 4, (c - 128) & 15);
    if (c < 80) PSTAMP(10); else if (c < 128) PSTAMP(11); else PSTAMP(12);
    if (LATE_SAMPLE) return;
    wait_sample_units(F, cnt);
    PSTAMP(13);
    unsigned* head = cnt + 512;
    volatile LAS unsigned* slot = F.MISC + 16;
    for (;;) {
        if (F.tid == 0) slot[0] = __hip_atomic_fetch_add(head, 1u, __ATOMIC_RELAXED, __HIP_MEMORY_SCOPE_AGENT);
        __syncthreads();
        const int it = (int)slot[0];
        __syncthreads();
        if (it >= 64 + NS * NH) break;
        if (it < 64) lru_item<1>(F, it >> 4, it & 15); else gla_sample_item(F, (it - 64) >> 2, (it - 64) & 3);
    }
}
__device__ __forceinline__ void p3_late(Frame& F, unsigned* cntS) {
    const int c = (int)blockIdx.x;
    unsigned* cntQ = cntS + 1024;
    if (c < 80) {
        pg8::Gemm g{F.XN, F.WinT, NTOK, DINP, D}; pg8::OneUnit S{NROWP / 256 + c / 20, c % 20, 0, 0, -1};
        pg8::EpiProj E{F.PROJ, DINP, F.BCUM, F.g_head, NROWP / 256};
        pg8::gemm_phase<pg8::EpiProj, pg8::OneUnit, true, true>(F.lds + RING_OFF, g, S, E);
        if (F.tid == 0) __hip_atomic_fetch_add(cntS + 64 * (c & 7), 8u, __ATOMIC_RELAXED, __HIP_MEMORY_SCOPE_AGENT);
    }
    PSTAMP(14);
    { pg8::Gemm g{F.YMIX, F.WoutT, NTOK, D, DMIX}; pg8::Gemm2Order S; S.init(NROWP, NROWP, D, DMIX, 8, F.G, c);
      pg8::EpiY E{F.YBF, D, F.YS, NROWP, (size_t)NROWS * D};
      pg8::HeadScale KSc{F.PSS, NROWP, EPS};
      pg8::gemm_phase<pg8::EpiY, pg8::Gemm2Order, true, true, pg8::HeadScale>(F.lds + RING_OFF, g, S, E, KSc); }
    if (c < 80) PSTAMP(17); else PSTAMP(15);
    if (c < 80) return;
    wait_count(F, cntS, 80u * 8u);
    const int j = c - 80;
    if (j < 64) lru_item<1>(F, j >> 4, j & 15);
    const int gfirst = j < 64 ? 2 * j : (j < 112 ? 128 + 4 * (j - 64) : 320 + 3 * (j - 112)), gcount = j < 64 ? 2 : (j < 112 ? 4 : 3);
#ifdef NO_CHAIN
    for (int k = 0; k < gcount; ++k) gla_sample_item(F, (gfirst + k) >> 2, (gfirst + k) & 3);
#elif defined(CHAIN_ONE)
    for (int k = 0; k < gcount; ++k) gla_sample_chain(F, gfirst + k, 1);
#else
    gla_sample_chain(F, gfirst, gcount);
#endif
    const unsigned ndone = (unsigned)gcount + (j < 64 ? 1u : 0u);
    VM_WAIT();
    __syncthreads();
    if (F.tid == 0 && ndone) __hip_atomic_fetch_add(cntQ + 64 * (c & 7), ndone, __ATOMIC_RELAXED, __HIP_MEMORY_SCOPE_AGENT);
    PSTAMP(16);
    const int L = c - 80;
    if (L < 128) {
        wait_count(F, cntQ, 64u + NS * NH);
        pg8::Gemm g{F.YMIX, F.WoutT, NTOK, D, DMIX}; pg8::OneUnit S{NROWP / 256 + (L >> 3) / 4, (L >> 3) % 4, (L & 7) * 4, 4, L & 7};
        pg8::EpiY E{F.YBF, D, F.YS, NROWP, (size_t)NROWS * D};
        pg8::gemm_phase<pg8::EpiY, pg8::OneUnit, true, true>(F.lds + RING_OFF, g, S, E);
    }
}
__device__ __forceinline__ void p2_mix_simple(Frame& F) {
    if (tail_ws(F)) {
        const int v = F.vcu;
        if (v < 128) lru_item<0>(F, v >> 4, v & 15); else { const int g = v - 128; gla_item(F, g >> 4, (g >> 2) & 3, g & 3); if (g < 64) lru_item<1>(F, g >> 4, g & 15); }
        __syncthreads();
        return;
    }
    for (int it = F.vcu; it < 2 * NP * 16; it += F.G) {
        if (it < NP * 16) { for (int rep = 0; rep < (DUP_PHASE == 6 ? 2 : 1); ++rep) lru_item<0>(F, it >> 4, it & 15); }
        else { const int g = it - NP * 16; for (int rep = 0; rep < (DUP_PHASE == 7 ? 2 : 1); ++rep) gla_item(F, g >> 4, (g >> 2) & 3, g & 3); }
    }
    for (int rep = 0; rep < (DUP_PHASE == 8 ? 2 : 1); ++rep) for (int it = F.vcu; it < 4 * 16; it += F.G) lru_item<1>(F, it >> 4, it & 15);
    for (int rep = 0; rep < (DUP_PHASE == 9 ? 2 : 1); ++rep) for (int it = F.vcu; it < NS * NH; it += F.G) gla_sample_item(F, it >> 2, it & 3);
    __syncthreads();
}

__device__ __forceinline__ void p4_sample_rows(Frame& F) {
    const int c = (int)blockIdx.x; if ((c & 63) < 32) return;
    const int r = NROWP + ((c >> 6) * 32 + (c & 63) - 32) * NWAVES + F.wave;
    const GAS f32x4* gp = (const GAS f32x4*)F.g_post + F.lane;
    const GAS f32x4* xr = (const GAS f32x4*)(F.xs + (size_t)(r - NROWP) * D) + F.lane;
    f32x4 g[4], x[4]; v2u sl[8][4];
#pragma unroll
    for (int j = 0; j < 4; ++j) { g[j] = gp[64 * j]; x[j] = xr[64 * j]; }
#pragma unroll
    for (int s = 0; s < 8; ++s)
#pragma unroll
        for (int j = 0; j < 4; ++j) sl[s][j] = ((const GAS v2u*)(F.YS + ((size_t)s * NROWS + (r - NROWP)) * D) + F.lane)[64 * j];
#pragma unroll
    for (int j = 0; j < 4; ++j) asm volatile("" : "+v"(g[j]), "+v"(x[j]));
    f32x4 y[4]; float ss = 0.f;
#pragma unroll
    for (int j = 0; j < 4; ++j) { y[j] = (f32x4){0.f, 0.f, 0.f, 0.f};
#pragma unroll
        for (int s = 0; s < 8; ++s) y[j] += (f32x4){bflo(sl[s][j].x), bfhi(sl[s][j].x), bflo(sl[s][j].y), bfhi(sl[s][j].y)};
        ss += (y[j].x * y[j].x + y[j].y * y[j].y) + (y[j].z * y[j].z + y[j].w * y[j].w); }
    const float rs = rsqrtf(wave_sum(ss) * (1.f / D) + EPS);
    GAS f32x4* orow = (GAS f32x4*)(F.out + (size_t)r * D) + F.lane;
#pragma unroll
    for (int j = 0; j < 4; ++j) orow[64 * j] = x[j] + y[j] * rs * g[j];
}
__device__ __forceinline__ void p4_final(Frame& F) {
    int gw = F.vcu * NWAVES + F.wave, NGW = F.G * NWAVES;
    if (FUSE_P4 && !LATE_SAMPLE) {
        const int c = (int)blockIdx.x; if ((c & 63) < 32) return;
        gw = NROWP + ((c >> 6) * 32 + (c & 63) - 32) * NWAVES + F.wave; NGW = NTOK; }
    const GAS f32x4* gp = (const GAS f32x4*)F.g_post + F.lane;
    f32x4 g[4];
#pragma unroll
    for (int j = 0; j < 4; ++j) g[j] = gp[64 * j];
    for (int r = gw; r < NTOK; r += NGW) {
        const float* xrow = r < NROWP ? F.xp + (size_t)r * D : F.xs + (size_t)(r - NROWP) * D;
        const GAS f32x4* xr = (const GAS f32x4*)xrow + F.lane;
        f32x4 y[4], x[4];
#pragma unroll
        for (int j = 0; j < 4; ++j) x[j] = xr[64 * j];
        if (r < NROWP) { const GAS v2u* yr = (const GAS v2u*)(F.YBF + (size_t)r * D) + F.lane;
#pragma unroll
            for (int j = 0; j < 4; ++j) { const v2u w = yr[64 * j]; y[j] = (f32x4){bflo(w.x), bfhi(w.x), bflo(w.y), bfhi(w.y)}; }
        } else {
#pragma unroll
            for (int j = 0; j < 4; ++j) y[j] = (f32x4){0.f, 0.f, 0.f, 0.f};
#pragma unroll
            for (int s = 0; s < 8; ++s) { const GAS v2u* yr = (const GAS v2u*)(F.YS + ((size_t)s * NROWS + (r - NROWP)) * D) + F.lane;
#pragma unroll
                for (int j = 0; j < 4; ++j) { const v2u w = yr[64 * j]; y[j] += (f32x4){bflo(w.x), bfhi(w.x), bflo(w.y), bfhi(w.y)}; } }
        }
        float ss = 0.f;
#pragma unroll
        for (int j = 0; j < 4; ++j) ss += (y[j].x * y[j].x + y[j].y * y[j].y) + (y[j].z * y[j].z + y[j].w * y[j].w);
        const float rs = rsqrtf(wave_sum(ss) * (1.f / D) + EPS);
        GAS f32x4* orow = (GAS f32x4*)(F.out + (size_t)r * D) + F.lane;
#pragma unroll
        for (int j = 0; j < 4; ++j) orow[64 * j] = x[j] + y[j] * rs * g[j];
    }
}


struct Args { const float* in[19]; float* out; unsigned char* ws; int ph_lo, ph_hi, li, pad; };
__global__ void __launch_bounds__(NWAVES * 64, 2) mk_fwd(Args args) {
    extern __shared__ __attribute__((aligned(16))) unsigned char lds[];
    Frame F;
    F.lds = (LAS unsigned char*)lds;
    F.MISC = (volatile LAS unsigned*)(F.lds + MISC_OFF);
    F.tid = threadIdx.x; F.lane = F.tid & 63; F.wave = __builtin_amdgcn_readfirstlane(F.tid >> 6);
    F.G = gridDim.x; { const int bx = blockIdx.x; F.vcu = (F.G % 8 == 0) ? (bx % 8) * (F.G / 8) + bx / 8 : bx; }
    unsigned char* ws = args.ws;
    F.ctl = (gu32*)(ws + WS_CTL);
    F.xp = args.in[0]; F.xs = args.in[1]; F.st_h = args.in[2]; F.st_conv = args.in[3]; F.st_gla = args.in[4]; F.g_pre = args.in[5]; F.w_in = args.in[6];
    F.conv_w = args.in[7]; F.conv_b = args.in[8]; F.w_rg = args.in[9]; F.b_rg = args.in[10]; F.w_ig = args.in[11]; F.b_ig = args.in[12]; F.lam = args.in[13];
    F.w_gk2 = args.in[14]; F.b_gk = args.in[15]; F.g_head = args.in[16]; F.w_out = args.in[17]; F.g_post = args.in[18];
    F.out = args.out;
    F.WinT = (bf16*)(ws + WS_WINT); F.WoutT = (bf16*)(ws + WS_WOUT); F.XN = (bf16*)(ws + WS_XN); F.PROJ = (bf16*)(ws + WS_PROJ);
    F.YMIX = (bf16*)args.out;
    F.YBF = (bf16*)(ws + WS_XN);
    F.RGK = (float*)(ws + WS_RGK); F.PART = (float*)(ws + WS_PART); F.DEC = (float*)(ws + WS_DEC); F.PSS = (float*)(ws + WS_RGK); F.C8 = (float*)(ws + WS_PART); F.YS = (bf16*)(ws + WS_YS);
    F.BCUM = TAIL_SAMPLE ? args.out : args.out + O_GS;
    for (int u = F.tid; u < (LDS_BYTES - LDSCTL_OFF) / 4; u += NWAVES * 64) ((LAS unsigned*)(F.lds + LDSCTL_OFF))[u] = 0u;
    __syncthreads();
    XcdBarrier bar; bar.bar = (unsigned*)(F.ctl + CW_BAR); bar.x = 0; bar.st = nullptr;
    if (N_LAUNCHES == 1) bar = xcd_barrier_post((unsigned*)(F.ctl + CW_BAR), F.MISC + 8);
    if (N_LAUNCHES == 1 && (int)blockIdx.x < CHAIN_NS && F.tid == 0) (void)xb_add((unsigned*)(F.ctl + CW_CHAINBAR) + CB_CENSUS(bar.x), 1u);
#define GRID_BAR() do { if (N_LAUNCHES == 1) xcd_barrier(bar); } while (0)
    const int lo = args.ph_lo, hi = args.ph_hi;
#ifdef DIAG_ID
#define dg ((unsigned long long*)(args.ws + WS_CTL + CW_DIAG * 4))
    if (F.tid == 0) { __hip_atomic_fetch_max(dg, ~(unsigned long long)__builtin_amdgcn_s_memrealtime(), __ATOMIC_RELAXED, __HIP_MEMORY_SCOPE_AGENT); }
#ifndef DIAG_ID0
#define DIAG_ID0 -1
#endif
#define STAMP(id) do { if ((DIAG_ID == (id) || DIAG_ID0 == (id)) && F.tid == 0) __hip_atomic_fetch_max(dg + (DIAG_ID == (id) ? 1 : 2), (unsigned long long)__builtin_amdgcn_s_memrealtime(), __ATOMIC_RELAXED, __HIP_MEMORY_SCOPE_AGENT); } while (0)
#else
#define STAMP(id) do {} while (0)
#endif
#ifndef PH_MASK
#define PH_MASK 31
#endif
#define IN(k) (lo <= (k) && (k) < hi && ((PH_MASK >> (k)) & 1))
#define BOTH(k) (IN(k) && IN((k) + 1))
#ifndef MK_FALLBACK
#define MK_FALLBACK 0
#endif
#ifndef DUP_PHASE
#define DUP_PHASE -1
#endif
#define REPS(k) for (int rep_ = 0; rep_ < ((DUP_PHASE == (k)) ? 2 : 1); ++rep_)
    if (IN(0)) { REPS(0) { p0_prologue(F); STAMP(0); if (BOTH(0)) GRID_BAR(); } }
    if (split_p1(F)) {
        if (IN(1)) {
            unsigned* cntS = (unsigned*)(F.ctl + CW_SAMPLE);
            pg8::Gemm g{F.XN, F.WinT, NTOK, DINP, D}; pg8::Gemm1Chain S; S.init(NROWP, DINP, (int)blockIdx.x, cntS, &bar, (unsigned*)(F.ctl + CW_CHAINBAR));
            pg8::EpiProj E{F.PROJ, DINP, F.BCUM, F.g_head, NROWP / 256};
            pg8::gemm_phase<pg8::EpiProj, pg8::Gemm1Chain, true, true>(F.lds + RING_OFF, g, S, E);
            S.chain_end();
            STAMP(1);
            p12_mix(F, cntS);
            STAMP(2);
            GRID_BAR();
#if LATE_SAMPLE
            p3_late(F, cntS);
            STAMP(3);
            GRID_BAR();
#endif
        }
#if MK_FALLBACK
    } else {
    if (IN(1)) { REPS(1) {
        pg8::Gemm g{F.XN, F.WinT, NTOK, DINP, D}; pg8::EpiProj E{F.PROJ, DINP, F.BCUM, F.g_head, tail_ws(F) ? NROWP / 256 : (1 << 30)};
        if (tail_ws(F)) {
            unsigned* cntS = (unsigned*)(F.ctl + CW_SAMPLE);
            if (blockIdx.x < GEMM1_WGS) { pg8::Gemm1Order S; S.init(NROWP, NTOK, DINP, GEMM1_WGS, (int)blockIdx.x, cntS);
                pg8::gemm_phase<pg8::EpiProj, pg8::Gemm1Order, true, true>(F.lds + RING_OFF, g, S, E); }
            else p1_tail_sample(F, cntS);
        } else {
            pg8::StaticOrder S; S.init(NTOK, DINP, F.G, (int)blockIdx.x);
            pg8::gemm_phase<pg8::EpiProj, pg8::StaticOrder, true, true>(F.lds + RING_OFF, g, S, E);
        }
        STAMP(1); if (BOTH(1)) GRID_BAR(); }
    }
    if (IN(2)) { REPS(2) { p2_mix_simple(F); STAMP(2); if (BOTH(2)) GRID_BAR(); } }
    }
#else
    }
#endif
#if FUSE_P4
    if (IN(3) && !LATE_SAMPLE) {
        unsigned* cntL = (unsigned*)(F.ctl + CW_SAMPLE + 2048);
        pg8::Gemm g{F.YMIX, F.WoutT, NTOK, D, DMIX}; pg8::Gemm2FOrder S; S.init(NROWP, D, DMIX, 8, (int)blockIdx.x, cntL);
        pg8::EpiYF E{F.YS, NROWP, (size_t)NROWS * D, D, F.xp, F.out, F.g_post, (float*)(ws + WS_XBUF), (unsigned*)(F.ctl + CW_ROWS), EPS};
        pg8::HeadScale KSc{F.PSS, NROWP, EPS};
        pg8::gemm_phase<pg8::EpiYF, pg8::Gemm2FOrder, true, true, pg8::HeadScale>(F.lds + RING_OFF, g, S, E, KSc);
        STAMP(3);
        if (((int)blockIdx.x & 63) >= 32) wait_count(F, cntL, 128u * 8u);
    }
#else
    if (IN(3) && !LATE_SAMPLE) { REPS(3) {
        pg8::Gemm g{F.YMIX, F.WoutT, NTOK, D, DMIX}; pg8::Gemm2Order S; S.init(NROWP, NTOK, D, DMIX, 8, F.G, (int)blockIdx.x);
        pg8::EpiY E{F.YBF, D, F.YS, NROWP, (size_t)NROWS * D};
        pg8::HeadScale KSc{F.PSS, NROWP, EPS};
        pg8::gemm_phase<pg8::EpiY, pg8::Gemm2Order, true, true, pg8::HeadScale>(F.lds + RING_OFF, g, S, E, KSc);
        STAMP(3);
        if (BOTH(3)) GRID_BAR(); }
    }
#endif
    if (IN(4)) { if (FUSE_P4 && !LATE_SAMPLE) p4_sample_rows(F); else { REPS(4) { p4_final(F); if (DUP_PHASE == 4) GRID_BAR(); } } }
#ifdef DIAG_ID
    STAMP(4);
    GRID_BAR();
    if (blockIdx.x == 0) {
#ifdef DIAG_DUR
        const unsigned long long t0 = 0ull, t1 = __hip_atomic_load(dg + 1, __ATOMIC_RELAXED, __HIP_MEMORY_SCOPE_AGENT);
#else
        const unsigned long long t0 = DIAG_ID0 >= 0 ? __hip_atomic_load(dg + 2, __ATOMIC_RELAXED, __HIP_MEMORY_SCOPE_AGENT) : ~__hip_atomic_load(dg, __ATOMIC_RELAXED, __HIP_MEMORY_SCOPE_AGENT), t1 = __hip_atomic_load(dg + 1, __ATOMIC_RELAXED, __HIP_MEMORY_SCOPE_AGENT);
#endif
#ifndef DIAG_BASE
#define DIAG_BASE 0.f
#define DIAG_SPAN 1000.f
#endif
        const float f = 1.f + ((float)(t1 - t0) * 0.01f - DIAG_BASE) * (1.f / DIAG_SPAN);
        for (int i = F.tid; i < NP * 1024; i += NWAVES * 64) F.out[O_HP + i] *= f; }
#endif
#undef IN
#undef BOTH
}

extern "C" void kernel_launch(void* const* d_in, const int* in_sizes, int n_in, void* d_out, int out_size, void* d_ws, size_t ws_size, hipStream_t stream) {
    static int grid = 0;
    if (grid == 0) {
        if (n_in != 19 || in_sizes[0] != NROWP * D || in_sizes[6] != D * DIN || (size_t)out_size != O_END || ws_size < WS_END) {
            fprintf(stderr, "kernel_launch: unexpected shapes: n_in %d in0 %d in6 %d out %d ws %zu; nothing launched\n", n_in, n_in > 0 ? in_sizes[0] : -1, n_in > 6 ? in_sizes[6] : -1, out_size, ws_size); grid = -1; return; }
        int dev = 0, cus = 0, per_cu = 0;
        if (hipGetDevice(&dev) != hipSuccess || hipDeviceGetAttribute(&cus, hipDeviceAttributeMultiprocessorCount, dev) != hipSuccess) { grid = -1; return; }
        if (hipFuncSetAttribute((const void*)mk_fwd, hipFuncAttributeMaxDynamicSharedMemorySize, LDS_BYTES) != hipSuccess) { fprintf(stderr, "kernel_launch: hipFuncSetAttribute failed\n"); grid = -1; return; }
        if (hipOccupancyMaxActiveBlocksPerMultiprocessor(&per_cu, (const void*)mk_fwd, NWAVES * 64, LDS_BYTES) != hipSuccess || per_cu < 1)
            fprintf(stderr, "kernel_launch: note: occupancy query reports %d workgroups per CU\n", per_cu);
        (void)hipGetLastError();
        grid = cus;
        if (!MK_FALLBACK && grid != 256) { fprintf(stderr, "kernel_launch: this build's phase schedule is for 256 CUs, found %d; rebuild with -DMK_FALLBACK=1 -DSPLIT_P1=0; nothing launched\n", grid); grid = -1; return; }
    }
    if (grid < 0) return;
    if (hipMemsetAsync((char*)d_ws + WS_CTL, 0, CTL_ZERO_BYTES, stream) != hipSuccess) { fprintf(stderr, "kernel_launch: hipMemsetAsync failed\n"); return; }
    Args a{};
    for (int i = 0; i < 19; ++i) a.in[i] = (const float*)d_in[i];
    a.out = (float*)d_out; a.ws = (unsigned char*)d_ws;
    for (int li = 0; li < N_LAUNCHES; ++li) {
        a.ph_lo = (N_LAUNCHES == 1) ? 0 : li; a.ph_hi = (N_LAUNCHES == 1) ? N_PHASES : li + 1; a.li = li;
        hipLaunchKernelGGL(mk_fwd, dim3(grid), dim3(NWAVES * 64), LDS_BYTES, stream, a);
        const hipError_t le = hipPeekAtLastError();
        if (le != hipSuccess) { fprintf(stderr, "kernel_launch: launch %d failed: %s\n", li, hipGetErrorName(le)); break; }
    }
}
```
